# Optimizing an MI355X kernel written in HIP

```python
import math
import jax, jax.numpy as jnp
from jax import lax
import numpy as np

D_MODEL = 1024
BATCH = 8
SEQ = 4096
DEPTH = 2

HEAD_DIM = 64
D_ATTN = D_MODEL // 2
N_HEADS = D_ATTN // HEAD_DIM
DILATED_GROUPS = ((128, 1), (512, 4), (2048, 16))
N_GROUPS = len(DILATED_GROUPS)
N_QKV = 3 * N_GROUPS * N_HEADS * HEAD_DIM
D_HYENA = D_MODEL // 2
HYENA_ORDER = 2
FILTER_EMB = 33
FILTER_WIDTH = 64
DECAY_TARGET = 1e-2
FAST_DECAY_PCT = 0.3
SLOW_DECAY_PCT = 1.5
N_IN = N_QKV + D_ATTN + 3 * D_HYENA + D_HYENA + 2 * D_MODEL
DEEPNORM_ALPHA = (2 * DEPTH) ** 0.25
DEEPNORM_BETA = (8 * DEPTH) ** -0.25
LN_EPS = 1e-5

kernel_name = "dilated_attn_hyena_hybrid_encoder"


def _layer_norm(x):
    xf = x.astype(jnp.float32)
    mu = jnp.mean(xf, axis=-1, keepdims=True)
    var = jnp.mean(jnp.square(xf - mu), axis=-1, keepdims=True)
    return (xf - mu) * lax.rsqrt(var + LN_EPS)


def _alibi_slopes(n_heads):
    return jnp.asarray(2.0 ** (-8.0 * (np.arange(n_heads) + 1) / n_heads), dtype=jnp.float32)


def dilated_window_attention(q, k, v, slopes, dilation, radius):
    B, S, H, E = q.shape
    L = S // dilation
    nb = -(-L // radius)
    Lp = nb * radius

    def by_residue(a):
        return a.reshape(B, L, dilation, H, E).transpose(0, 2, 1, 3, 4)

    qs, ks, vs = by_residue(q), by_residue(k), by_residue(v)
    qb = jnp.pad(qs, ((0, 0), (0, 0), (0, Lp - L), (0, 0), (0, 0))).reshape(B, dilation, nb, radius, H, E)

    def windows(a):
        ap = jnp.pad(a, ((0, 0), (0, 0), (radius, Lp - L + radius), (0, 0), (0, 0)))
        ap = ap.reshape(B, dilation, nb + 2, radius, H, E)
        return jnp.concatenate([ap[:, :, :-2], ap[:, :, 1:-1], ap[:, :, 2:]], axis=3)

    kw, vw = windows(ks), windows(vs)
    qi = jnp.arange(nb)[:, None] * radius + jnp.arange(radius)[None, :]
    ki = jnp.arange(nb)[:, None] * radius - radius + jnp.arange(3 * radius)[None, :]
    rel = ki[:, None, :] - qi[:, :, None]
    valid = (jnp.abs(rel) <= radius) & (ki[:, None, :] >= 0) & (ki[:, None, :] < L)
    dist = (jnp.abs(rel) * dilation).astype(jnp.float32)

    s = jnp.einsum('bdnqhe,bdnkhe->bdnhqk', qb, kw).astype(jnp.float32) * (E ** -0.5)
    s = s - slopes[:, None, None] * dist[:, None]
    s = jnp.where(valid[:, None], s, -jnp.inf)
    lse = jax.nn.logsumexp(s, axis=-1)
    p = jnp.exp(s - lse[..., None]).astype(v.dtype)
    o = jnp.einsum('bdnhqk,bdnkhe->bdnqhe', p, vw)

    o = o.reshape(B, dilation, Lp, H, E)[:, :, :L].transpose(0, 2, 1, 3, 4).reshape(B, S, H, E)
    lse = lse.transpose(0, 1, 2, 4, 3).reshape(B, dilation, Lp, H)[:, :, :L]
    lse = lse.transpose(0, 2, 1, 3).reshape(B, S, H)
    return o, lse


def _hyena_pos_features(L):
    t = jnp.linspace(0.0, 1.0, L, dtype=jnp.float32)[:, None]
    bands = (FILTER_EMB - 1) // 2
    w = 2.0 * math.pi * jnp.arange(L, dtype=jnp.float32)[:, None] / L
    f = jnp.linspace(1e-4, bands - 1, bands, dtype=jnp.float32)[None, :]
    return jnp.concatenate([t, jnp.cos(f * w), -jnp.sin(f * w)], axis=-1)


def implicit_filters(L, w1, b1, w2, b2, w3, b3, w4, freq):
    f32 = jnp.float32
    freq = freq.astype(f32)
    h = jnp.sin(freq * (_hyena_pos_features(L) @ w1.astype(f32) + b1.astype(f32)))
    h = jnp.sin(freq * (h @ w2.astype(f32) + b2.astype(f32)))
    h = jnp.sin(freq * (h @ w3.astype(f32) + b3.astype(f32)))
    h = h @ w4.astype(f32)
    t = jnp.linspace(0.0, 1.0, L, dtype=f32)[:, None]
    deltas = jnp.linspace(math.log(DECAY_TARGET) / SLOW_DECAY_PCT,
                          math.log(DECAY_TARGET) / FAST_DECAY_PCT, D_HYENA, dtype=f32)
    decay = jnp.exp(-t * jnp.abs(deltas)[None, :])
    return h.reshape(L, HYENA_ORDER, 2, D_HYENA) * decay[:, None, None, :]


def bidirectional_long_conv(z, h_fwd, h_bwd):
    L, C = h_fwd.shape
    circ = jnp.concatenate([h_fwd, jnp.zeros((1, C), jnp.float32), h_bwd[:0:-1]], axis=0)
    hf = jnp.fft.rfft(circ, axis=0)
    zf = jnp.fft.rfft(z.astype(jnp.float32), n=2 * L, axis=1)
    y = jnp.fft.irfft(zf * hf[None], n=2 * L, axis=1)[:, :L]
    return y.astype(z.dtype)


def centred_conv3(u, w, b):
    up = jnp.pad(u, ((0, 0), (1, 1), (0, 0)))
    return w[0] * up[:, :-2] + w[1] * up[:, 1:-1] + w[2] * up[:, 2:] + b


def hybrid_layer(x, c, w_ada, b_ada, w_in, b_in, conv_w, conv_b,
                 filt_w1, filt_b1, filt_w2, filt_b2, filt_w3, filt_b3, filt_w4, filt_freq, filt_bias,
                 w_proj_attn, w_proj_hyena, w_out, b_out, ln_g, ln_b):
    B, S, _ = x.shape
    mod = (c @ w_ada + b_ada)[:, None, :]
    shift, scale, gate = jnp.split(mod, 3, axis=-1)
    h = (_layer_norm(x) * (1.0 + scale) + shift).astype(x.dtype)

    p = h @ w_in + b_in
    i1 = N_QKV
    i2 = i1 + D_ATTN
    i3 = i2 + 3 * D_HYENA
    i4 = i3 + D_HYENA
    p_qkv, g_attn, p_hy, g_hy, r_merge = jnp.split(p, [i1, i2, i3, i4], axis=-1)
    r_attn, r_hy = jnp.split(r_merge, 2, axis=-1)

    qkv = p_qkv.reshape(B, S, 3, N_GROUPS, N_HEADS, HEAD_DIM)
    slopes = _alibi_slopes(N_HEADS)
    outs, lses = [], []
    for g, (window, dilation) in enumerate(DILATED_GROUPS):
        radius = window // (2 * dilation)
        o_g, lse_g = dilated_window_attention(qkv[:, :, 0, g], qkv[:, :, 1, g], qkv[:, :, 2, g],
                                              slopes, dilation, radius)
        outs.append(o_g)
        lses.append(lse_g)
    wts = jax.nn.softmax(jnp.stack(lses, axis=0), axis=0)
    o_attn = jnp.einsum('gbsh,gbshe->bshe', wts.astype(x.dtype), jnp.stack(outs, axis=0))
    y_attn = o_attn.reshape(B, S, D_ATTN) * jax.nn.silu(g_attn)

    u = centred_conv3(p_hy, conv_w, conv_b)
    v, x1, x2 = jnp.split(u, 3, axis=-1)
    filters = implicit_filters(S, filt_w1, filt_b1, filt_w2, filt_b2, filt_w3, filt_b3, filt_w4, filt_freq)
    z = v
    for o, gate_o in enumerate((x1, x2)):
        z = gate_o * (bidirectional_long_conv(z, filters[:, o, 0], filters[:, o, 1]) + filt_bias[o] * z)
    y_hy = z * jax.nn.silu(g_hy)

    merged = jax.nn.sigmoid(r_attn) * (y_attn @ w_proj_attn) + jax.nn.sigmoid(r_hy) * (y_hy @ w_proj_hyena)
    out = merged @ w_out + b_out

    res = DEEPNORM_ALPHA * x.astype(jnp.float32) + (gate * out).astype(jnp.float32)
    return (_layer_norm(res) * ln_g + ln_b).astype(x.dtype)


def setup_inputs(seed: int = 0) -> dict:
    key = jax.random.key(seed)
    ks = jax.random.split(key, 24)
    f32 = jnp.float32

    def nrm(k, shape, scale):
        return jax.random.normal(k, shape, f32) * scale

    return {
        "x": nrm(ks[0], (BATCH, SEQ, D_MODEL), 1.0),
        "c": nrm(ks[1], (BATCH, D_MODEL), 1.0),
        "w_ada": nrm(ks[2], (DEPTH, D_MODEL, 3 * D_MODEL), 0.5 * D_MODEL ** -0.5),
        "b_ada": nrm(ks[3], (DEPTH, 3 * D_MODEL), 0.01),
        "w_in": nrm(ks[4], (DEPTH, D_MODEL, N_IN), D_MODEL ** -0.5),
        "b_in": nrm(ks[5], (DEPTH, N_IN), 0.01),
        "conv_w": nrm(ks[6], (DEPTH, 3, 3 * D_HYENA), 3 ** -0.5),
        "conv_b": nrm(ks[7], (DEPTH, 3 * D_HYENA), 0.01),
        "filt_w1": nrm(ks[8], (DEPTH, FILTER_EMB, FILTER_WIDTH), FILTER_EMB ** -0.5),
        "filt_b1": nrm(ks[9], (DEPTH, FILTER_WIDTH), 0.1),
        "filt_w2": nrm(ks[10], (DEPTH, FILTER_WIDTH, FILTER_WIDTH), FILTER_WIDTH ** -0.5),
        "filt_b2": nrm(ks[11], (DEPTH, FILTER_WIDTH), 0.1),
        "filt_w3": nrm(ks[12], (DEPTH, FILTER_WIDTH, FILTER_WIDTH), FILTER_WIDTH ** -0.5),
        "filt_b3": nrm(ks[13], (DEPTH, FILTER_WIDTH), 0.1),
        "filt_w4": nrm(ks[14], (DEPTH, FILTER_WIDTH, HYENA_ORDER * 2 * D_HYENA), 0.1 * FILTER_WIDTH ** -0.5),
        "filt_freq": 1.0 + nrm(ks[15], (DEPTH, FILTER_WIDTH), 0.05),
        "filt_bias": nrm(ks[16], (DEPTH, HYENA_ORDER, D_HYENA), 0.1),
        "w_proj_attn": nrm(ks[17], (DEPTH, D_ATTN, D_MODEL), DEEPNORM_BETA * D_ATTN ** -0.5),
        "w_proj_hyena": nrm(ks[18], (DEPTH, D_HYENA, D_MODEL), DEEPNORM_BETA * D_HYENA ** -0.5),
        "w_out": nrm(ks[19], (DEPTH, D_MODEL, D_MODEL), DEEPNORM_BETA * D_MODEL ** -0.5),
        "b_out": nrm(ks[20], (DEPTH, D_MODEL), 0.01),
        "ln_g": 1.0 + nrm(ks[21], (DEPTH, D_MODEL), 0.05),
        "ln_b": nrm(ks[22], (DEPTH, D_MODEL), 0.01),
    }


def reference(x, c, w_ada, b_ada, w_in, b_in, conv_w, conv_b,
              filt_w1, filt_b1, filt_w2, filt_b2, filt_w3, filt_b3, filt_w4, filt_freq, filt_bias,
              w_proj_attn, w_proj_hyena, w_out, b_out, ln_g, ln_b):
    for l in range(DEPTH):
        x = hybrid_layer(x, c, w_ada[l], b_ada[l], w_in[l], b_in[l], conv_w[l], conv_b[l],
                         filt_w1[l], filt_b1[l], filt_w2[l], filt_b2[l], filt_w3[l], filt_b3[l],
                         filt_w4[l], filt_freq[l], filt_bias[l],
                         w_proj_attn[l], w_proj_hyena[l], w_out[l], b_out[l], ln_g[l], ln_b[l])
    return x
```

```cpp
#include <hip/hip_runtime.h>
#include <cstdio>
#include <cstdint>
#include <cmath>

constexpr int D = 1024, NB = 8, S = 4096, DEPTH = 2;
constexpr int HD = 64, DA = 512, NH = 8, NG = 3, DHY = 512, NIN = 9216;
constexpr int FE = 33, FW = 64;
constexpr int OFF_GA = 4608, OFF_HY = 5120, OFF_GH = 6656, OFF_RA = 7168, OFF_RH = 8192;
constexpr float LN_EPS = 1e-5f;
constexpr float DN_ALPHA = 1.41421356237309515f;

__device__ __forceinline__ float wave_sum(float v) {
#pragma unroll
    for (int o = 1; o < 64; o <<= 1) v += __shfl_xor(v, o);
    return v;
}
__device__ __forceinline__ float wave_max(float v) {
#pragma unroll
    for (int o = 1; o < 64; o <<= 1) v = fmaxf(v, __shfl_xor(v, o));
    return v;
}
__device__ __forceinline__ float sigmoidf_(float x) { return 1.f / (1.f + expf(-x)); }
__device__ __forceinline__ float siluf_(float x) { return x / (1.f + expf(-x)); }

__global__ void k_mod(const float* __restrict__ c, const float* __restrict__ w_ada, const float* __restrict__ b_ada, float* __restrict__ mod) {
    const int idx = blockIdx.x * blockDim.x + threadIdx.x;
    if (idx >= DEPTH * NB * 3 * D) return;
    const int n = idx % (3 * D), b = (idx / (3 * D)) % NB, l = idx / (3 * D * NB);
    const float* w = w_ada + (size_t)l * D * 3 * D + n;
    const float* cb = c + b * D;
    float acc = 0.f;
    for (int k = 0; k < D; ++k) acc = fmaf(cb[k], w[(size_t)k * 3 * D], acc);
    mod[idx] = acc + b_ada[l * 3 * D + n];
}

__device__ __forceinline__ void sincos_cw(float x, float& sn, float& cs) {
    const float j = rintf(x * 0.63661977236758134f);
    float y = fmaf(-j, 1.5703125f, x);
    y = fmaf(-j, 4.837512969970703125e-4f, y);
    y = fmaf(-j, 7.54978995489188216e-8f, y);
    const float z = y * y;
    const float sp = fmaf(fmaf(fmaf(-1.9515295891e-4f, z, 8.3321608736e-3f), z, -1.6666654611e-1f) * z, y, y);
    const float cp = fmaf(fmaf(fmaf(2.443315711809948e-5f, z, -1.388731625493765e-3f), z, 4.166664568298827e-2f), z * z, fmaf(-0.5f, z, 1.0f));
    const int q = ((int)j) & 3;
    const float s0 = (q & 1) ? cp : sp, c0 = (q & 1) ? sp : cp;
    sn = (q & 2) ? -s0 : s0;
    cs = ((q + 1) & 2) ? -c0 : c0;
}
__device__ __forceinline__ float sin_cw(float x) { float s, c; sincos_cw(x, s, c); return s; }
__global__ void k_filt_h3(const float* __restrict__ w1, const float* __restrict__ b1, const float* __restrict__ w2, const float* __restrict__ b2,
                          const float* __restrict__ w3, const float* __restrict__ b3, const float* __restrict__ freq, float* __restrict__ H3) {
    const int t = blockIdx.x, l = blockIdx.y, j = threadIdx.x;
    __shared__ float feat[FE]; __shared__ float ha[FW]; __shared__ float hb[FW];
    if (j < FE) {
        const float tt = (float)t / (float)(S - 1);
        float v;
        if (j == 0) v = tt;
        else {
            const int q = (j - 1) & 15;
            const double f = (double)(1e-4f) + (double)q * (((double)15.0f - (double)1e-4f) / 15.0);
            double u = f * (double)t / (double)S;
            u -= rint(u);
            float sn, cs; sincos_cw((float)(u * 6.283185307179586476925), sn, cs);
            v = (j <= 16) ? cs : -sn;
        }
        feat[j] = v;
    }
    __syncthreads();
    const float fr = freq[l * FW + j];
    float a = b1[l * FW + j];
    for (int k = 0; k < FE; ++k) a = fmaf(feat[k], w1[(l * FE + k) * FW + j], a);
    ha[j] = sin_cw(fr * a);
    __syncthreads();
    a = b2[l * FW + j];
    for (int k = 0; k < FW; ++k) a = fmaf(ha[k], w2[(l * FW + k) * FW + j], a);
    hb[j] = sin_cw(fr * a);
    __syncthreads();
    a = b3[l * FW + j];
    for (int k = 0; k < FW; ++k) a = fmaf(hb[k], w3[(l * FW + k) * FW + j], a);
    H3[((size_t)l * S + t) * FW + j] = sin_cw(fr * a);
}
__global__ void k_filt_g(const float* __restrict__ H3, const float* __restrict__ w4, float* __restrict__ G) {
    const size_t idx = (size_t)blockIdx.x * blockDim.x + threadIdx.x;
    const size_t total = (size_t)DEPTH * 2 * (2 * S - 1) * DHY;
    if (idx >= total) return;
    const int c = (int)(idx % DHY); size_t r = idx / DHY;
    const int dd = (int)(r % (2 * S - 1)); r /= (2 * S - 1);
    const int o = (int)(r % 2), l = (int)(r / 2);
    const int d = dd - (S - 1), ta = d < 0 ? -d : d, dir = d < 0 ? 1 : 0;
    const int n = (o * 2 + dir) * DHY + c;
    const float* h3 = H3 + ((size_t)l * S + ta) * FW;
    const float* w = w4 + (size_t)l * FW * (4 * DHY) + n;
    float a = 0.f;
    for (int j = 0; j < FW; ++j) a = fmaf(h3[j], w[(size_t)j * 4 * DHY], a);
    const float d0 = -4.605170185988091f / 1.5f, d1 = -4.605170185988091f / 0.3f;
    const float delta = d0 + (d1 - d0) * ((float)c / (float)(DHY - 1));
    const float tt = (float)ta / (float)(S - 1);
    G[idx] = a * expf(-tt * fabsf(delta));
}

__global__ void k_ln_mod(const float* __restrict__ x, const float* __restrict__ modb  , float* __restrict__ h, int nrows) {
    const int row = blockIdx.x * 4 + (threadIdx.x >> 6), lane = threadIdx.x & 63;
    if (row >= nrows) return;
    const float* xr = x + (size_t)row * D;
    float v[16]; float s = 0.f;
#pragma unroll
    for (int j = 0; j < 16; ++j) { v[j] = xr[lane + 64 * j]; s += v[j]; }
    const float mean = wave_sum(s) * (1.f / D);
    float q = 0.f;
#pragma unroll
    for (int j = 0; j < 16; ++j) { v[j] -= mean; q += v[j] * v[j]; }
    const float rstd = 1.f / sqrtf(wave_sum(q) * (1.f / D) + LN_EPS);
#pragma unroll
    for (int j = 0; j < 16; ++j) { const int n = lane + 64 * j; h[(size_t)row * D + n] = v[j] * rstd * (1.f + modb[D + n]) + modb[n]; }
}

__global__ void __launch_bounds__(256) k_gemm(const float* __restrict__ A, int lda, const float* __restrict__ B, int ldb, const float* __restrict__ bias,
                                              float* __restrict__ C, int ldc, int K) {
    __shared__ float As[8][128 + 4];
    __shared__ float Bs[8][128 + 4];
    const int tid = threadIdx.x, tx = tid & 15, ty = tid >> 4;
    const int m0 = blockIdx.y * 128, n0 = blockIdx.x * 128;
    float acc[8][8];
#pragma unroll
    for (int i = 0; i < 8; ++i)
#pragma unroll
        for (int j = 0; j < 8; ++j) acc[i][j] = 0.f;
    const int ar = tid >> 1, ak = (tid & 1) * 4;
    const int bk = tid >> 5, bn = (tid & 31) * 4;
    for (int k0 = 0; k0 < K; k0 += 8) {
        const float4 av = *(const float4*)(A + (size_t)(m0 + ar) * lda + k0 + ak);
        const float4 bv = *(const float4*)(B + (size_t)(k0 + bk) * ldb + n0 + bn);
        __syncthreads();
        As[ak + 0][ar] = av.x; As[ak + 1][ar] = av.y; As[ak + 2][ar] = av.z; As[ak + 3][ar] = av.w;
        *(float4*)&Bs[bk][bn] = bv;
        __syncthreads();
#pragma unroll
        for (int k = 0; k < 8; ++k) {
            float a[8], b[8];
#pragma unroll
            for (int i = 0; i < 8; ++i) a[i] = As[k][ty * 8 + i];
#pragma unroll
            for (int j = 0; j < 8; ++j) b[j] = Bs[k][tx * 8 + j];
#pragma unroll
            for (int i = 0; i < 8; ++i)
#pragma unroll
                for (int j = 0; j < 8; ++j) acc[i][j] = fmaf(a[i], b[j], acc[i][j]);
        }
    }
#pragma unroll
    for (int i = 0; i < 8; ++i) {
        float* cr = C + (size_t)(m0 + ty * 8 + i) * ldc + n0 + tx * 8;
#pragma unroll
        for (int j = 0; j < 8; ++j) cr[j] = acc[i][j] + (bias ? bias[n0 + tx * 8 + j] : 0.f);
    }
}

__global__ void __launch_bounds__(256) k_attn(const float* __restrict__ P, float* __restrict__ YA) {
    __shared__ float sq[4][NG][HD];
    __shared__ float sc[4][NG][132];
    const int w = threadIdx.x >> 6, lane = threadIdx.x & 63;
    const int item = blockIdx.x * 4 + w;
    const int t = item / NH, h = item % NH;
    const float slope = exp2f(-(float)(h + 1));
    const float* prow = P + (size_t)t * NIN;
#pragma unroll
    for (int g = 0; g < NG; ++g) sq[w][g][lane] = prow[(0 * NG + g) * DA + h * HD + lane];
    __syncthreads();
    float mx = -INFINITY;
#pragma unroll
    for (int g = 0; g < NG; ++g) {
        const int dil = (g == 0) ? 1 : (g == 1 ? 4 : 16);
        const int kcol = (1 * NG + g) * DA + h * HD;
        for (int pass = 0; pass < 3; ++pass) {
            const int jj = pass * 64 + lane;
            if (jj <= 128) {
                const int j = jj - 64;
                const int tk = t + j * dil;
                float s = -INFINITY;
                if (tk >= 0 && tk < S) {
                    const float4* kr = (const float4*)(P + (size_t)tk * NIN + kcol);
                    float a = 0.f;
#pragma unroll
                    for (int e = 0; e < 16; ++e) { const float4 kv = kr[e]; a = fmaf(sq[w][g][4 * e], kv.x, a); a = fmaf(sq[w][g][4 * e + 1], kv.y, a); a = fmaf(sq[w][g][4 * e + 2], kv.z, a); a = fmaf(sq[w][g][4 * e + 3], kv.w, a); }
                    s = a * 0.125f - slope * (float)((j < 0 ? -j : j) * dil);
                }
                sc[w][g][jj] = s;
                mx = fmaxf(mx, s);
            }
        }
    }
    mx = wave_max(mx);
    __syncthreads();
    float sum = 0.f;
#pragma unroll
    for (int g = 0; g < NG; ++g)
        for (int pass = 0; pass < 3; ++pass) {
            const int jj = pass * 64 + lane;
            if (jj <= 128) { const float s = sc[w][g][jj]; const float p = (s == -INFINITY) ? 0.f : expf(s - mx); sc[w][g][jj] = p; sum += p; }
        }
    sum = wave_sum(sum);
    __syncthreads();
    float o = 0.f;
#pragma unroll
    for (int g = 0; g < NG; ++g) {
        const int dil = (g == 0) ? 1 : (g == 1 ? 4 : 16);
        const int vcol = (2 * NG + g) * DA + h * HD + lane;
        for (int jj = 0; jj <= 128; ++jj) {
            const int tk = t + (jj - 64) * dil;
            if (tk >= 0 && tk < S) o = fmaf(sc[w][g][jj], P[(size_t)tk * NIN + vcol], o);
        }
    }
    o /= sum;
    const float ga = prow[OFF_GA + h * HD + lane];
    YA[(size_t)t * DA + h * HD + lane] = o * siluf_(ga);
}

__global__ void k_conv3(const float* __restrict__ P, const float* __restrict__ cw  , const float* __restrict__ cb, float* __restrict__ U) {
    const int idx = blockIdx.x * blockDim.x + threadIdx.x;
    if (idx >= S * 3 * DHY) return;
    const int c = idx % (3 * DHY), t = idx / (3 * DHY);
    const float pm = t > 0 ? P[(size_t)(t - 1) * NIN + OFF_HY + c] : 0.f;
    const float p0 = P[(size_t)t * NIN + OFF_HY + c];
    const float pp = t < S - 1 ? P[(size_t)(t + 1) * NIN + OFF_HY + c] : 0.f;
    U[idx] = cw[c] * pm + cw[3 * DHY + c] * p0 + cw[2 * 3 * DHY + c] * pp + cb[c];
}
__global__ void __launch_bounds__(256) k_longconv(const float* __restrict__ Z, int ldz, const float* __restrict__ G  , const float* __restrict__ X, int ldx,
                                                  const float* __restrict__ bias, const float* __restrict__ gate, int ldg, float* __restrict__ Zout, int ldo) {
    const int lane = threadIdx.x & 63, w = threadIdx.x >> 6;
    const int c = blockIdx.x * 64 + lane;
    const int t0 = (blockIdx.y * 4 + w) * 8;
    float y[8];
#pragma unroll
    for (int i = 0; i < 8; ++i) y[i] = 0.f;
    for (int s0 = 0; s0 < S; s0 += 8) {
        float z[8], g[15];
#pragma unroll
        for (int j = 0; j < 8; ++j) z[j] = Z[(size_t)(s0 + j) * ldz + c];
        const int base = t0 - s0 + (S - 1);
#pragma unroll
        for (int m = 0; m < 15; ++m) g[m] = G[(size_t)(base + m - 7) * DHY + c];
#pragma unroll
        for (int i = 0; i < 8; ++i)
#pragma unroll
            for (int j = 0; j < 8; ++j) y[i] = fmaf(g[i - j + 7], z[j], y[i]);
    }
    const float bc = bias[c];
#pragma unroll
    for (int i = 0; i < 8; ++i) {
        const int t = t0 + i;
        float v = X[(size_t)t * ldx + c] * (y[i] + bc * Z[(size_t)t * ldz + c]);
        if (gate) v *= siluf_(gate[(size_t)t * ldg + c]);
        Zout[(size_t)t * ldo + c] = v;
    }
}

__global__ void k_merge(const float* __restrict__ P, const float* __restrict__ T1, const float* __restrict__ T2, float* __restrict__ Mg) {
    const int idx = blockIdx.x * blockDim.x + threadIdx.x;
    if (idx >= S * D) return;
    const int n = idx % D, t = idx / D;
    Mg[idx] = sigmoidf_(P[(size_t)t * NIN + OFF_RA + n]) * T1[idx] + sigmoidf_(P[(size_t)t * NIN + OFF_RH + n]) * T2[idx];
}
__global__ void k_res_ln(const float* __restrict__ x, const float* __restrict__ O, const float* __restrict__ modb, const float* __restrict__ lg, const float* __restrict__ lb,
                         float* __restrict__ xo, int nrows) {
    const int row = blockIdx.x * 4 + (threadIdx.x >> 6), lane = threadIdx.x & 63;
    if (row >= nrows) return;
    float v[16]; float s = 0.f;
#pragma unroll
    for (int j = 0; j < 16; ++j) { const int n = lane + 64 * j; v[j] = DN_ALPHA * x[(size_t)row * D + n] + modb[2 * D + n] * O[(size_t)row * D + n]; s += v[j]; }
    const float mean = wave_sum(s) * (1.f / D);
    float q = 0.f;
#pragma unroll
    for (int j = 0; j < 16; ++j) { v[j] -= mean; q += v[j] * v[j]; }
    const float rstd = 1.f / sqrtf(wave_sum(q) * (1.f / D) + LN_EPS);
#pragma unroll
    for (int j = 0; j < 16; ++j) { const int n = lane + 64 * j; xo[(size_t)row * D + n] = v[j] * rstd * lg[n] + lb[n]; }
}

extern "C" void kernel_launch(void* const* d_in, const int* in_sizes, int n_in, void* d_out, int out_size, void* d_ws, size_t ws_size, hipStream_t stream) {
    const float* x = (const float*)d_in[0];      const float* c = (const float*)d_in[1];
    const float* w_ada = (const float*)d_in[2];  const float* b_ada = (const float*)d_in[3];
    const float* w_in = (const float*)d_in[4];   const float* b_in = (const float*)d_in[5];
    const float* conv_w = (const float*)d_in[6]; const float* conv_b = (const float*)d_in[7];
    const float* fw1 = (const float*)d_in[8];    const float* fb1 = (const float*)d_in[9];
    const float* fw2 = (const float*)d_in[10];   const float* fb2 = (const float*)d_in[11];
    const float* fw3 = (const float*)d_in[12];   const float* fb3 = (const float*)d_in[13];
    const float* fw4 = (const float*)d_in[14];   const float* ffreq = (const float*)d_in[15];
    const float* fbias = (const float*)d_in[16];
    const float* wpa = (const float*)d_in[17];   const float* wph = (const float*)d_in[18];
    const float* w_out = (const float*)d_in[19]; const float* b_out = (const float*)d_in[20];
    const float* ln_g = (const float*)d_in[21];  const float* ln_b = (const float*)d_in[22];
    float* out = (float*)d_out;

    float* ws = (float*)d_ws;
    size_t off = 0;
    auto take = [&](size_t n) { float* p = ws + off; off += (n + 63) & ~(size_t)63; return p; };
    float* MOD = take((size_t)DEPTH * NB * 3 * D);
    float* H3 = take((size_t)DEPTH * S * FW);
    float* G = take((size_t)DEPTH * 2 * (2 * S - 1) * DHY);
    float* Hb = take((size_t)S * D);
    float* P = take((size_t)S * NIN);
    float* U = take((size_t)S * 3 * DHY);
    float* Z1 = take((size_t)S * DHY);
    float* YA = take((size_t)S * DA);
    float* YH = take((size_t)S * DHY);
    float* T1 = take((size_t)S * D);
    float* T2 = take((size_t)S * D);
    float* MG = take((size_t)S * D);
    float* OB = take((size_t)S * D);
    if (off * sizeof(float) > ws_size) { fprintf(stderr, "kernel_launch: workspace too small: need %zu have %zu\n", off * sizeof(float), ws_size); return; }

    k_mod<<<(DEPTH * NB * 3 * D + 255) / 256, 256, 0, stream>>>(c, w_ada, b_ada, MOD);
    k_filt_h3<<<dim3(S, DEPTH), 64, 0, stream>>>(fw1, fb1, fw2, fb2, fw3, fb3, ffreq, H3);
    { const size_t total = (size_t)DEPTH * 2 * (2 * S - 1) * DHY; k_filt_g<<<(unsigned)((total + 255) / 256), 256, 0, stream>>>(H3, fw4, G); }

    for (int l = 0; l < DEPTH; ++l) {
        const float* xin = (l == 0) ? x : out;
        for (int b = 0; b < NB; ++b) {
            const float* xb = xin + (size_t)b * S * D;
            float* xob = out + (size_t)b * S * D;
            const float* modb = MOD + ((size_t)l * NB + b) * 3 * D;
            k_ln_mod<<<S / 4, 256, 0, stream>>>(xb, modb, Hb, S);
            k_gemm<<<dim3(NIN / 128, S / 128), 256, 0, stream>>>(Hb, D, w_in + (size_t)l * D * NIN, NIN, b_in + (size_t)l * NIN, P, NIN, D);
            k_attn<<<S * NH / 4, 256, 0, stream>>>(P, YA);
            k_conv3<<<(S * 3 * DHY + 255) / 256, 256, 0, stream>>>(P, conv_w + (size_t)l * 3 * 3 * DHY, conv_b + (size_t)l * 3 * DHY, U);
            const float* G0 = G + ((size_t)l * 2 + 0) * (2 * S - 1) * DHY;
            const float* G1 = G + ((size_t)l * 2 + 1) * (2 * S - 1) * DHY;
            k_longconv<<<dim3(DHY / 64, S / 32), 256, 0, stream>>>(U, 3 * DHY, G0, U + DHY, 3 * DHY, fbias + (size_t)l * 2 * DHY, nullptr, 0, Z1, DHY);
            k_longconv<<<dim3(DHY / 64, S / 32), 256, 0, stream>>>(Z1, DHY, G1, U + 2 * DHY, 3 * DHY, fbias + (size_t)l * 2 * DHY + DHY, P + OFF_GH, NIN, YH, DHY);
            k_gemm<<<dim3(D / 128, S / 128), 256, 0, stream>>>(YA, DA, wpa + (size_t)l * DA * D, D, nullptr, T1, D, DA);
            k_gemm<<<dim3(D / 128, S / 128), 256, 0, stream>>>(YH, DHY, wph + (size_t)l * DHY * D, D, nullptr, T2, D, DHY);
            k_merge<<<(S * D + 255) / 256, 256, 0, stream>>>(P, T1, T2, MG);
            k_gemm<<<dim3(D / 128, S / 128), 256, 0, stream>>>(MG, D, w_out + (size_t)l * D * D, D, b_out + (size_t)l * D, OB, D, D);
            k_res_ln<<<S / 4, 256, 0, stream>>>(xb, OB, modb, ln_g + (size_t)l * D, ln_b + (size_t)l * D, xob, S);
        }
    }
}
```

```cpp
#include <hip/hip_runtime.h>
#include <hip/hip_cooperative_groups.h>
#include <cstdio>
#include <cstdint>
#include <cmath>
namespace cg = cooperative_groups;
namespace pg8 {
#define PG8_LAS __attribute__((address_space(3)))
typedef unsigned short bf16_t;
typedef short bf16x8 __attribute__((ext_vector_type(8)));
typedef float f32x4 __attribute__((ext_vector_type(4)));
typedef unsigned u32x4 __attribute__((ext_vector_type(4)));
constexpr int BM = 256, BK = 64, HALF = 128, HTB = HALF * BK * 2  , STAGE_BYTES = 8 * HTB, NXCD = 8, WGM = 8;

__host__ __device__ __forceinline__ int lds_byte(int r, int c) { const int st = (r >> 4) * 2 + (c >> 5), rr = r & 15, cc = c & 31, ob = rr * 64 + cc * 2; return st * 1024 + (ob ^ (((ob >> 9) & 1) << 5)); }
__host__ __device__ __forceinline__ void stage_rc(int b, int& R, int& C) { const int st = b / 1024, sb = b % 1024, swz = sb ^ (((sb >> 9) & 1) << 5); R = (st >> 1) * 16 + swz / 64; C = (st & 1) * 32 + (swz % 64) / 2; }
__host__ __device__ __forceinline__ int perm32(int rho) { const int n = rho >> 4, i = rho & 15; return 8 * (i >> 2) + 4 * n + (i & 3); }

struct Unit { int pm, pn; };
struct Gemm { const bf16_t* A; const bf16_t* Bt; int M, N, K; };

struct StaticOrder {
    int nM, nN, nwg, G, c;
    __host__ __device__ void init(int M, int N, int G_, int c_) { nM = M / BM; nN = N / BM; nwg = nM * nN; G = G_; c = c_; }
    __host__ __device__ bool next(int i, Unit& u) const {
        const long L = (long)i * G + c; if (L >= nwg) return false;
        int wgid = (int)L; { const int q = nwg / NXCD, r = nwg % NXCD, xcd = wgid % NXCD, off = wgid / NXCD; wgid = (xcd < r ? xcd * (q + 1) : r * (q + 1) + (xcd - r) * q) + off; }
        const int nig = WGM * nN, gid = wgid / nig, fm = gid * WGM, gsz = (nM - fm) < WGM ? (nM - fm) : WGM;
        u.pm = fm + ((wgid % nig) % gsz); u.pn = (wgid % nig) / gsz; return true;
    }
    __device__ __forceinline__ void a_ready(const Unit&) const {}
    __device__ __forceinline__ void done(const Unit&) const {}
};

__device__ __forceinline__ unsigned cvt_pk_bf16(float lo, float hi) { unsigned r; asm volatile("v_cvt_pk_bf16_f32 %0, %1, %2" : "=v"(r) : "v"(lo), "v"(hi)); return r; }
typedef float f32x2 __attribute__((ext_vector_type(2)));
__device__ __forceinline__ f32x2 gelu_pk(f32x2 v) {
    const f32x2 av = __builtin_elementwise_abs(v), d = av * 0.2316418882f + 1.0f;
    f32x2 t; t.x = __builtin_amdgcn_rcpf(d.x); t.y = __builtin_amdgcn_rcpf(d.y);
    f32x2 q = t * 0.5307027145f + (-0.7265760135f); q = q * t + 0.7107068705f; q = q * t + (-0.142248368f); q = q * t + 0.127414796f; q = q * t;
    const f32x2 s = (v * v) * (-0.72134752044f);
    f32x2 e; e.x = __builtin_amdgcn_exp2f(s.x); e.y = __builtin_amdgcn_exp2f(s.y);
    const f32x2 m = v * (q * e), r = v - m;
    f32x2 o; o.x = v.x < 0.f ? m.x : r.x; o.y = v.y < 0.f ? m.y : r.y; return o;
}

template <int ACT  > struct EpiBf16 {
    static constexpr bool PERM = true, AFTER_DRAIN = false; static_assert(ACT == 0 || ACT == 1, "EpiBf16: ACT is 0 (none) or 1 (gelu_pk)");
    bf16_t* O; int ldc; const float* bias; int split_cols; size_t split_stride; float scale0;
    __device__ __forceinline__ void operator()(const f32x4 (&acc)[2][2][4][2], const Unit& u, int wr, int wc, int fr, int fq) const {
        const int row0 = u.pm * BM + wr * 64 + fr; int colt = u.pn * BM; bf16_t* base = O;
        float sc = 1.f; if (split_cols) { const int t = colt / split_cols; base += (size_t)t * split_stride; colt -= t * split_cols; if (t == 0) sc = scale0; }
        const int col0 = colt + wc * 32 + 8 * fq, bcol0 = u.pn * BM + wc * 32 + 8 * fq;
        f32x4 bv[2][2];
#pragma unroll
        for (int bj = 0; bj < 2; ++bj)
#pragma unroll
            for (int n = 0; n < 2; ++n) bv[bj][n] = bias ? *(const f32x4*)(bias + bcol0 + bj * HALF + 4 * n) : (f32x4){0.f, 0.f, 0.f, 0.f};
#pragma unroll
        for (int ai = 0; ai < 2; ++ai)
#pragma unroll
            for (int m = 0; m < 4; ++m) { bf16_t* rowp = base + (size_t)(row0 + ai * HALF + m * 16) * ldc + col0;
#pragma unroll
                for (int bj = 0; bj < 2; ++bj) { f32x4 v0 = acc[ai][bj][m][0] + bv[bj][0], v1 = acc[ai][bj][m][1] + bv[bj][1];
                    if (ACT == 1) { f32x2 a = gelu_pk((f32x2){v0[0], v0[1]}), b = gelu_pk((f32x2){v0[2], v0[3]}), c = gelu_pk((f32x2){v1[0], v1[1]}), d = gelu_pk((f32x2){v1[2], v1[3]});
                        v0 = (f32x4){a.x, a.y, b.x, b.y}; v1 = (f32x4){c.x, c.y, d.x, d.y}; }
                    v0 = v0 * sc; v1 = v1 * sc; u32x4 w; w.x = cvt_pk_bf16(v0[0], v0[1]); w.y = cvt_pk_bf16(v0[2], v0[3]); w.z = cvt_pk_bf16(v1[0], v1[1]); w.w = cvt_pk_bf16(v1[2], v1[3]);
                    *(u32x4*)(rowp + bj * HALF) = w; } }
    }
};
__device__ __forceinline__ float bf_lo(unsigned w) { return __uint_as_float(w << 16); }
__device__ __forceinline__ float bf_hi(unsigned w) { return __uint_as_float(w & 0xffff0000u); }
__device__ __forceinline__ float sigm(float x) { return 1.f / (1.f + __expf(-x)); }
template <bool ACCUM> struct EpiMerge {
    static constexpr bool PERM = true, AFTER_DRAIN = false;
    bf16_t* O; int ldc; const bf16_t* Gt; int ldg;
    __device__ __forceinline__ void operator()(const f32x4 (&acc)[2][2][4][2], const Unit& u, int wr, int wc, int fr, int fq) const {
        const int row0 = u.pm * BM + wr * 64 + fr, col0 = u.pn * BM + wc * 32 + 8 * fq;
#pragma unroll
        for (int ai = 0; ai < 2; ++ai)
#pragma unroll
            for (int m = 0; m < 4; ++m) { const size_t row = (size_t)(row0 + ai * HALF + m * 16);
#pragma unroll
                for (int bj = 0; bj < 2; ++bj) { const int col = col0 + bj * HALF;
                    const u32x4 g = *(const u32x4*)(Gt + row * ldg + col);
                    const f32x4 v0 = acc[ai][bj][m][0], v1 = acc[ai][bj][m][1];
                    float r[8];
                    r[0] = sigm(bf_lo(g.x)) * v0[0]; r[1] = sigm(bf_hi(g.x)) * v0[1]; r[2] = sigm(bf_lo(g.y)) * v0[2]; r[3] = sigm(bf_hi(g.y)) * v0[3];
                    r[4] = sigm(bf_lo(g.z)) * v1[0]; r[5] = sigm(bf_hi(g.z)) * v1[1]; r[6] = sigm(bf_lo(g.w)) * v1[2]; r[7] = sigm(bf_hi(g.w)) * v1[3];
                    bf16_t* op = O + row * ldc + col;
                    if (ACCUM) { const u32x4 o = *(const u32x4*)op;
                        r[0] += bf_lo(o.x); r[1] += bf_hi(o.x); r[2] += bf_lo(o.y); r[3] += bf_hi(o.y); r[4] += bf_lo(o.z); r[5] += bf_hi(o.z); r[6] += bf_lo(o.w); r[7] += bf_hi(o.w); }
                    u32x4 w; w.x = cvt_pk_bf16(r[0], r[1]); w.y = cvt_pk_bf16(r[2], r[3]); w.z = cvt_pk_bf16(r[4], r[5]); w.w = cvt_pk_bf16(r[6], r[7]);
                    *(u32x4*)op = w; } }
    }
};
struct EpiRes {
    static constexpr bool PERM = false, AFTER_DRAIN = false;
    const float* xin; float* out; int ldc; const float* bias; const float* gate0; int tiles_per_batch; int gate_stride; float alpha;
    __device__ __forceinline__ void operator()(const f32x4 (&acc)[2][2][4][2], const Unit& u, int wr, int wc, int fr, int fq) const {
        const int col0 = u.pn * BM + wc * 32 + 4 * fq;
        const float* gate = gate0 + (size_t)(u.pm / tiles_per_batch) * gate_stride;
#pragma unroll
        for (int bj = 0; bj < 2; ++bj)
#pragma unroll
            for (int n = 0; n < 2; ++n) { const int col = col0 + bj * HALF + n * 16;
                const f32x4 bv = *(const f32x4*)(bias + col), gv = *(const f32x4*)(gate + col);
#pragma unroll
                for (int ai = 0; ai < 2; ++ai)
#pragma unroll
                    for (int m = 0; m < 4; ++m) { const size_t off = (size_t)(u.pm * BM + ai * HALF + wr * 64 + m * 16 + fr) * ldc + col;
                        const f32x4 xv = *(const f32x4*)(xin + off);
                        *(f32x4*)(out + off) = xv * alpha + gv * (acc[ai][bj][m][n] + bv); } }
    }
};
template <class Epi, class Sched, bool ALIGN_EPI = false, bool SP2 = false>
__device__ __forceinline__ void gemm_phase(PG8_LAS unsigned char* lds, const Gemm g, const Sched& S, const Epi& E) {
    int tid_ = threadIdx.x; asm volatile("" : "+v"(tid_));
    const int tid = tid_, wid = __builtin_amdgcn_readfirstlane(tid >> 6), lane = tid & 63, wr = wid >> 2, wc = wid & 3, fr = lane & 15, fq = lane >> 4;
    const int K = g.K, nt = K / BK;
    unsigned voffA[2], voffB[2];
#pragma unroll
    for (int i = 0; i < 2; ++i) { int R, C; stage_rc(tid * 16 + i * 8192, R, C); const int Rb = Epi::PERM ? ((R & ~31) + perm32(R & 31)) : R;
        voffA[i] = (unsigned)(R * K + C) * 2u; voffB[i] = (unsigned)(Rb * K + C) * 2u; }
    const size_t kstep = (size_t)(BK * 2);
    const size_t hstep = (size_t)HALF * K * 2;
    const size_t tstep = 2 * hstep;
    const unsigned ldsw = (unsigned)wid * 1024u;
    const int aoff = lds_byte(wr * 64 + fr, fq * 8), boff = lds_byte(wc * 32 + fr, fq * 8);
#define PG8_SA(b, h) (((b) * 2 + (h)) * HTB)
#define PG8_SB(b, h) ((4 + (b) * 2 + (h)) * HTB)
#define PG8_STAGE(bufoff, gbase, voff) do { _Pragma("unroll") for (int _i = 0; _i < 2; ++_i) \
        __builtin_amdgcn_global_load_lds((const unsigned*)((const char*)(gbase) + (voff)[_i]), (PG8_LAS unsigned*)(lds + (bufoff) + ldsw + _i * 8192), 16, 0, 0); } while (0)
#define PG8_LDA(dst, b, h) do { _Pragma("unroll") for (int m = 0; m < 4; ++m) _Pragma("unroll") for (int k = 0; k < 2; ++k) dst[m][k] = *(const PG8_LAS bf16x8*)(lds + PG8_SA(b, h) + aoff + m * 2048 + k * 1024); } while (0)
#define PG8_LDB(dst, b, h) do { _Pragma("unroll") for (int n = 0; n < 2; ++n) _Pragma("unroll") for (int k = 0; k < 2; ++k) dst[n][k] = *(const PG8_LAS bf16x8*)(lds + PG8_SB(b, h) + boff + n * 2048 + k * 1024); } while (0)
#define PG8_MMA(ai, bj, At, Bt) do { __builtin_amdgcn_s_setprio(1); _Pragma("unroll") for (int m = 0; m < 4; ++m) _Pragma("unroll") for (int n = 0; n < 2; ++n) _Pragma("unroll") for (int k = 0; k < 2; ++k) \
        acc[ai][bj][m][n] = __builtin_amdgcn_mfma_f32_16x16x32_bf16(Bt[n][k], At[m][k], acc[ai][bj][m][n], 0, 0, 0); __builtin_amdgcn_s_setprio(0); } while (0)
#define PG8_WAIT_V(n) asm volatile("s_waitcnt vmcnt(" #n ")" ::: "memory")
#define PG8_WAIT_L(n) asm volatile("s_waitcnt lgkmcnt(" #n ")" ::: "memory")
#define PG8_BAR __builtin_amdgcn_s_barrier()
#define PG8_SCHED __builtin_amdgcn_sched_barrier(0)
    Unit cur, nxt; int ui = 0;
    if (!S.next(0, cur)) return;
    f32x4 acc[2][2][4][2];
#pragma unroll
    for (int a = 0; a < 2; ++a)
#pragma unroll
        for (int b = 0; b < 2; ++b)
#pragma unroll
            for (int m = 0; m < 4; ++m)
#pragma unroll
                for (int n = 0; n < 2; ++n) acc[a][b][m][n] = (f32x4){0.f, 0.f, 0.f, 0.f};
    bf16x8 At[4][2], B0[2][2], B1[2][2];
    const char* cA = (const char*)g.A + (size_t)cur.pm * tstep; const char* cB = (const char*)g.Bt + (size_t)cur.pn * tstep;
    S.a_ready(cur);
    if constexpr (SP2) {
        PG8_STAGE(PG8_SB(0, 0), cB, voffB); PG8_STAGE(PG8_SB(0, 1), cB + hstep, voffB); PG8_STAGE(PG8_SA(0, 0), cA, voffA); PG8_STAGE(PG8_SA(0, 1), cA + hstep, voffA);
        if (wr == 1) PG8_BAR;
        PG8_WAIT_V(2); PG8_BAR;
        PG8_STAGE(PG8_SB(1, 0), cB + kstep, voffB); PG8_STAGE(PG8_SA(1, 0), cA + kstep, voffA); PG8_STAGE(PG8_SB(1, 1), cB + hstep + kstep, voffB);
        PG8_WAIT_V(6); PG8_BAR;
    } else {
        PG8_STAGE(PG8_SB(0, 0), cB, voffB); PG8_STAGE(PG8_SA(0, 0), cA, voffA); PG8_STAGE(PG8_SB(0, 1), cB + hstep, voffB); PG8_STAGE(PG8_SA(0, 1), cA + hstep, voffA);
        if (wr == 1) PG8_BAR;
        PG8_WAIT_V(4); PG8_BAR;
        PG8_STAGE(PG8_SB(1, 0), cB + kstep, voffB); PG8_STAGE(PG8_SA(1, 0), cA + kstep, voffA); PG8_STAGE(PG8_SB(1, 1), cB + hstep + kstep, voffB);
        PG8_WAIT_V(6); PG8_BAR;
    }
    for (;;) {
        const bool has_next = S.next(ui + 1, nxt);
        const char* nA = has_next ? (const char*)g.A + (size_t)nxt.pm * tstep : cA; const char* nB = has_next ? (const char*)g.Bt + (size_t)nxt.pn * tstep : cB;
        for (int t = 0; t < nt; t += 2) {
            const bool last = (t == nt - 2);
            const char* a1 = cA + (size_t)(t + 1) * kstep;
            const char* a2 = last ? nA : cA + (size_t)(t + 2) * kstep; const char* b2 = last ? nB : cB + (size_t)(t + 2) * kstep;
            const char* a3 = a2 + kstep; const char* b3 = b2 + kstep;
            if (last && has_next) S.a_ready(nxt);
            if constexpr (SP2) {
            PG8_LDB(B0, 0, 0); PG8_LDB(B1, 0, 1); PG8_SCHED; PG8_LDA(At, 0, 0); PG8_STAGE(PG8_SA(1, 1), a1 + hstep, voffA);
            PG8_WAIT_V(8); PG8_WAIT_L(0); PG8_BAR; PG8_MMA(0, 0, At, B0); PG8_MMA(0, 1, At, B1); PG8_BAR; PG8_SCHED;
            PG8_LDA(At, 0, 1); PG8_STAGE(PG8_SB(0, 0), b2, voffB); PG8_STAGE(PG8_SB(0, 1), b2 + hstep, voffB); PG8_STAGE(PG8_SA(0, 0), a2, voffA);
            PG8_WAIT_V(8); PG8_WAIT_L(0); PG8_BAR; PG8_MMA(1, 0, At, B0); PG8_MMA(1, 1, At, B1); PG8_BAR; PG8_SCHED;
            PG8_LDB(B0, 1, 0); PG8_LDB(B1, 1, 1); PG8_SCHED; PG8_LDA(At, 1, 0); PG8_STAGE(PG8_SA(0, 1), a2 + hstep, voffA);
            PG8_WAIT_V(8); PG8_WAIT_L(0); PG8_BAR; PG8_MMA(0, 0, At, B0); PG8_MMA(0, 1, At, B1); PG8_BAR; PG8_SCHED;
            PG8_LDA(At, 1, 1); PG8_STAGE(PG8_SB(1, 0), b3, voffB); PG8_STAGE(PG8_SB(1, 1), b3 + hstep, voffB); PG8_STAGE(PG8_SA(1, 0), a3, voffA);
            PG8_WAIT_V(8); PG8_WAIT_L(0); PG8_BAR; PG8_MMA(1, 0, At, B0); PG8_MMA(1, 1, At, B1); PG8_BAR; PG8_SCHED;
            } else {
            PG8_LDB(B0, 0, 0); PG8_SCHED; PG8_LDA(At, 0, 0); PG8_STAGE(PG8_SA(1, 1), a1 + hstep, voffA);
            PG8_WAIT_L(8); PG8_BAR; PG8_WAIT_L(0); PG8_MMA(0, 0, At, B0); PG8_BAR; PG8_SCHED;
            PG8_LDB(B1, 0, 1); PG8_STAGE(PG8_SB(0, 0), b2, voffB);
            PG8_BAR; PG8_WAIT_L(0); PG8_MMA(0, 1, At, B1); PG8_BAR;
            PG8_LDA(At, 0, 1); PG8_STAGE(PG8_SA(0, 0), a2, voffA);
            PG8_BAR; PG8_WAIT_L(0); PG8_MMA(1, 0, At, B0); PG8_BAR; PG8_SCHED;
            PG8_STAGE(PG8_SB(0, 1), b2 + hstep, voffB);
            PG8_WAIT_V(6); PG8_BAR; PG8_MMA(1, 1, At, B1); PG8_BAR;
            PG8_LDB(B0, 1, 0); PG8_SCHED; PG8_LDA(At, 1, 0); PG8_STAGE(PG8_SA(0, 1), a2 + hstep, voffA);
            PG8_WAIT_L(8); PG8_BAR; PG8_WAIT_L(0); PG8_MMA(0, 0, At, B0); PG8_BAR; PG8_SCHED;
            PG8_LDB(B1, 1, 1); PG8_STAGE(PG8_SB(1, 0), b3, voffB);
            PG8_BAR; PG8_WAIT_L(0); PG8_MMA(0, 1, At, B1); PG8_BAR;
            PG8_LDA(At, 1, 1); PG8_STAGE(PG8_SA(1, 0), a3, voffA);
            PG8_BAR; PG8_WAIT_L(0); PG8_MMA(1, 0, At, B0); PG8_BAR; PG8_SCHED;
            PG8_STAGE(PG8_SB(1, 1), b3 + hstep, voffB);
            PG8_WAIT_V(6); PG8_BAR; PG8_MMA(1, 1, At, B1); PG8_BAR;
            }
        }
        if constexpr (ALIGN_EPI) { if (wr == 0) PG8_BAR; }
        if constexpr (!Epi::AFTER_DRAIN) { E(acc, cur, wr, wc, fr, fq); S.done(cur); }
        if (!has_next) break;
#pragma unroll
        for (int a = 0; a < 2; ++a)
#pragma unroll
            for (int b = 0; b < 2; ++b)
#pragma unroll
                for (int m = 0; m < 4; ++m)
#pragma unroll
                    for (int n = 0; n < 2; ++n) acc[a][b][m][n] = (f32x4){0.f, 0.f, 0.f, 0.f};
        cur = nxt; cA = nA; cB = nB; ++ui;
        if constexpr (ALIGN_EPI) { if (wr == 1) PG8_BAR; }
    }
    PG8_WAIT_V(0);
    if constexpr (!ALIGN_EPI) { if (wr == 0) PG8_BAR; }
    PG8_BAR;
    if constexpr (Epi::AFTER_DRAIN) { E.fused(acc, cur, wr, wc, fr, fq, lds, wid, lane); S.done(cur); }
#undef PG8_SA
#undef PG8_SB
#undef PG8_STAGE
#undef PG8_LDA
#undef PG8_LDB
#undef PG8_MMA
#undef PG8_WAIT_V
#undef PG8_WAIT_L
#undef PG8_BAR
#undef PG8_SCHED
}
}
constexpr int D = 1024, NB = 8, S = 4096, DEPTH = 2;
constexpr int HD = 64, DA = 512, NH = 8, NG = 3, DHY = 512, NIN = 9216;
constexpr int FE = 33, FW = 64;
constexpr int OFF_GA = 4608, OFF_HY = 5120, OFF_GH = 6656, OFF_RA = 7168, OFF_RH = 8192;
constexpr float LN_EPS = 1e-5f, DN_ALPHA = 1.41421356237309515f;
constexpr int CH = 2, NCHUNK = NB / CH, MC = CH * S;
constexpr int NWAVES = 8, NTHREADS = NWAVES * 64;
constexpr int GLEN = 2 * S - 1;

constexpr size_t MiB = 1u << 20;
constexpr size_t WS_WIN = 1 * MiB;
constexpr size_t WS_WPA = WS_WIN + (size_t)DEPTH * NIN * D * 2;
constexpr size_t WS_WPH = WS_WPA + (size_t)DEPTH * D * DA * 2;
constexpr size_t WS_WOUT = WS_WPH + (size_t)DEPTH * D * DHY * 2;
constexpr size_t WS_MOD = WS_WOUT + (size_t)DEPTH * D * D * 2;
constexpr size_t WS_G = WS_MOD + 1 * MiB;
constexpr size_t WS_H = WS_G + 64 * MiB;
constexpr size_t WS_P = WS_H + (size_t)MC * D * 2;
constexpr size_t WS_U = WS_P + (size_t)MC * NIN * 2;
constexpr size_t WS_Z1 = WS_U + (size_t)MC * 3 * DHY * 2;
constexpr size_t WS_YA = WS_Z1 + (size_t)MC * DHY * 2;
constexpr size_t WS_YH = WS_YA + (size_t)MC * DA * 2;
constexpr size_t WS_END = WS_YH + (size_t)MC * DHY * 2;
static_assert((size_t)DEPTH * 2 * GLEN * DHY * 4 <= 64 * MiB, "G fits");

constexpr int LDS_BYTES = 147456;
constexpr int RING_BYTES = 131072;

#define LAS __attribute__((address_space(3)))
typedef unsigned short bf16;
typedef unsigned v4u __attribute__((ext_vector_type(4)));
typedef unsigned v2u __attribute__((ext_vector_type(2)));
typedef float f32x4 __attribute__((ext_vector_type(4)));
#define LDS_WAIT() asm volatile("s_waitcnt lgkmcnt(0)" ::: "memory")
__device__ __forceinline__ unsigned f2bf(float f) { unsigned u = __builtin_bit_cast(unsigned, f); return (u + 0x7fffu + ((u >> 16) & 1u)) >> 16; }
__device__ __forceinline__ unsigned pk2(float lo, float hi) { return f2bf(lo) | (f2bf(hi) << 16); }
__device__ __forceinline__ float bf2f(unsigned short h) { return __uint_as_float((unsigned)h << 16); }
__device__ __forceinline__ float blo(unsigned w) { return __uint_as_float(w << 16); }
__device__ __forceinline__ float bhi(unsigned w) { return __uint_as_float(w & 0xffff0000u); }
__device__ __forceinline__ float wave_sum(float v) {
#pragma unroll
    for (int o = 1; o < 64; o <<= 1) v += __shfl_xor(v, o);
    return v;
}
__device__ __forceinline__ float wave_max(float v) {
#pragma unroll
    for (int o = 1; o < 64; o <<= 1) v = fmaxf(v, __shfl_xor(v, o));
    return v;
}
__device__ __forceinline__ float siluf_(float x) { return x / (1.f + expf(-x)); }
__device__ __forceinline__ void sincos_cw(float x, float& sn, float& cs) {
    const float j = rintf(x * 0.63661977236758134f);
    float y = fmaf(-j, 1.5703125f, x);
    y = fmaf(-j, 4.837512969970703125e-4f, y);
    y = fmaf(-j, 7.54978995489188216e-8f, y);
    const float z = y * y;
    const float sp = fmaf(fmaf(fmaf(-1.9515295891e-4f, z, 8.3321608736e-3f), z, -1.6666654611e-1f) * z, y, y);
    const float cp = fmaf(fmaf(fmaf(2.443315711809948e-5f, z, -1.388731625493765e-3f), z, 4.166664568298827e-2f), z * z, fmaf(-0.5f, z, 1.0f));
    const int q = ((int)j) & 3;
    const float s0 = (q & 1) ? cp : sp, c0 = (q & 1) ? sp : cp;
    sn = (q & 2) ? -s0 : s0;
    cs = ((q + 1) & 2) ? -c0 : c0;
}
__device__ __forceinline__ float sin_cw(float x) { float s, c; sincos_cw(x, s, c); return s; }

struct Ctx {
    unsigned char* lds;
    int tid, lane, wave, gw, NGW, G;
};

__device__ __forceinline__ void p0_transpose_item(const float* W, int K, int N, bf16* WT, float* scr, int item, int lane) {
    const int nblk = N / 32, kb = item / nblk, nb = item % nblk, k0 = 64 * kb, n0 = 32 * nb;
#pragma unroll 8
    for (int i = 0; i < 32; ++i) { const int kk = 2 * i + (lane >> 5); scr[kk * 33 + (lane & 31)] = W[(size_t)(k0 + kk) * N + n0 + (lane & 31)]; }
    LDS_WAIT(); asm volatile("" ::: "memory");
    const int c = lane & 7;
#pragma unroll
    for (int j = 0; j < 4; ++j) { const int n = (lane >> 3) + 8 * j; const float* s = scr + (8 * c) * 33 + n;
        v4u o; o.x = pk2(s[0 * 33], s[1 * 33]); o.y = pk2(s[2 * 33], s[3 * 33]); o.z = pk2(s[4 * 33], s[5 * 33]); o.w = pk2(s[6 * 33], s[7 * 33]);
        *(v4u*)(WT + (size_t)(n0 + n) * K + k0 + 8 * c) = o; }
    LDS_WAIT(); asm volatile("" ::: "memory");
}
__device__ __forceinline__ void p0_filter_item(const float* const* in, float* G, float* sf, int l, int t, int lane) {
    const float* w1 = in[8]; const float* b1 = in[9]; const float* w2 = in[10]; const float* b2 = in[11];
    const float* w3 = in[12]; const float* b3 = in[13]; const float* w4 = in[14]; const float* freq = in[15];
    const float tt = (float)t / (float)(S - 1);
    if (lane < FE) {
        float v;
        if (lane == 0) v = tt;
        else {
            const int q = (lane - 1) & 15;
            const double f = (double)(1e-4f) + (double)q * (((double)15.0f - (double)1e-4f) / 15.0);
            double u = f * (double)t / (double)S; u -= rint(u);
            float sn, cs; sincos_cw((float)(u * 6.283185307179586476925), sn, cs);
            v = (lane <= 16) ? cs : -sn;
        }
        sf[lane] = v;
    }
    LDS_WAIT(); asm volatile("" ::: "memory");
    const float fr = freq[l * FW + lane];
    float a = b1[l * FW + lane];
    for (int k = 0; k < FE; ++k) a = fmaf(sf[k], w1[(l * FE + k) * FW + lane], a);
    sf[64 + lane] = sin_cw(fr * a);
    LDS_WAIT(); asm volatile("" ::: "memory");
    a = b2[l * FW + lane];
    for (int k = 0; k < FW; ++k) a = fmaf(sf[64 + k], w2[(l * FW + k) * FW + lane], a);
    sf[128 + lane] = sin_cw(fr * a);
    LDS_WAIT(); asm volatile("" ::: "memory");
    a = b3[l * FW + lane];
    for (int k = 0; k < FW; ++k) a = fmaf(sf[128 + k], w3[(l * FW + k) * FW + lane], a);
    sf[192 + lane] = sin_cw(fr * a);
    LDS_WAIT(); asm volatile("" ::: "memory");
    const float d0 = -4.605170185988091f / 1.5f, d1 = -4.605170185988091f / 0.3f;
    const float* w4l = w4 + (size_t)l * FW * (4 * DHY);
    for (int q = 0; q < 32; ++q) {
        const int n = q * 64 + lane, o = n >> 10, dir = (n >> 9) & 1, c = n & 511;
        float acc = 0.f;
#pragma unroll 8
        for (int j = 0; j < FW; ++j) acc = fmaf(sf[192 + j], w4l[(size_t)j * 4 * DHY + n], acc);
        const float delta = d0 + (d1 - d0) * ((float)c / (float)(DHY - 1));
        const float val = acc * expf(-tt * fabsf(delta));
        const int dd = dir ? (S - 1 - t) : (S - 1 + t);
        if (!(dir == 1 && t == 0)) G[((size_t)(l * 2 + o) * GLEN + dd) * DHY + c] = val;
    }
    LDS_WAIT(); asm volatile("" ::: "memory");
}
__device__ __forceinline__ void p0_prologue(const Ctx& C, const float* const* in, unsigned char* ws) {
    float* scr = (float*)(C.lds + C.wave * 16384);
    constexpr int I_IN = (D / 64) * (NIN / 32), I_PA = (DA / 64) * (D / 32), I_PH = (DHY / 64) * (D / 32), I_OUT = (D / 64) * (D / 32);
    constexpr int I_L = I_IN + I_PA + I_PH + I_OUT;
    for (int it = C.gw; it < DEPTH * I_L; it += C.NGW) {
        const int l = it / I_L; int r = it % I_L;
        if (r < I_IN) { p0_transpose_item(in[4] + (size_t)l * D * NIN, D, NIN, (bf16*)(ws + WS_WIN) + (size_t)l * NIN * D, scr, r, C.lane); continue; } r -= I_IN;
        if (r < I_PA) { p0_transpose_item(in[17] + (size_t)l * DA * D, DA, D, (bf16*)(ws + WS_WPA) + (size_t)l * D * DA, scr, r, C.lane); continue; } r -= I_PA;
        if (r < I_PH) { p0_transpose_item(in[18] + (size_t)l * DHY * D, DHY, D, (bf16*)(ws + WS_WPH) + (size_t)l * D * DHY, scr, r, C.lane); continue; } r -= I_PH;
        p0_transpose_item(in[19] + (size_t)l * D * D, D, D, (bf16*)(ws + WS_WOUT) + (size_t)l * D * D, scr, r, C.lane);
    }
    {
        float* mod = (float*)(ws + WS_MOD);
        const float* c = in[1]; const float* w_ada = in[2]; const float* b_ada = in[3];
        for (int idx = blockIdx.x * NTHREADS + C.tid; idx < DEPTH * NB * 3 * D; idx += C.G * NTHREADS) {
            const int n = idx % (3 * D), b = (idx / (3 * D)) % NB, l = idx / (3 * D * NB);
            const float* w = w_ada + (size_t)l * D * 3 * D + n; const float* cb = c + b * D;
            float acc = 0.f;
            for (int k = 0; k < D; ++k) acc = fmaf(cb[k], w[(size_t)k * 3 * D], acc);
            mod[idx] = acc + b_ada[l * 3 * D + n];
        }
    }
    for (int it = C.gw; it < DEPTH * S; it += C.NGW) p0_filter_item(in, (float*)(ws + WS_G), scr, it / S, it % S, C.lane);
}

__device__ __forceinline__ void ln_mod_row(const float* xrow, const float* modb, bf16* orow, int lane) {
    const f32x4* xr = (const f32x4*)xrow + lane;
    f32x4 v[4]; float s = 0.f;
#pragma unroll
    for (int j = 0; j < 4; ++j) { v[j] = xr[64 * j]; s += (v[j].x + v[j].y) + (v[j].z + v[j].w); }
    const float mean = wave_sum(s) * (1.f / D); float s2 = 0.f;
#pragma unroll
    for (int j = 0; j < 4; ++j) { v[j] = v[j] - mean; s2 += (v[j].x * v[j].x + v[j].y * v[j].y) + (v[j].z * v[j].z + v[j].w * v[j].w); }
    const float rstd = 1.f / sqrtf(wave_sum(s2) * (1.f / D) + LN_EPS);
    v2u* o8 = (v2u*)orow + lane;
#pragma unroll
    for (int j = 0; j < 4; ++j) {
        const f32x4 sh = *((const f32x4*)modb + lane + 64 * j), sc = *((const f32x4*)(modb + D) + lane + 64 * j);
        const f32x4 r = v[j] * rstd * (sc + 1.f) + sh;
        v2u w; w.x = pk2(r.x, r.y); w.y = pk2(r.z, r.w); o8[64 * j] = w;
    }
}
__device__ __forceinline__ void ln_final_row(float* row, const float* lg, const float* lb, int lane) {
    f32x4* xr = (f32x4*)row + lane;
    f32x4 v[4]; float s = 0.f;
#pragma unroll
    for (int j = 0; j < 4; ++j) { v[j] = xr[64 * j]; s += (v[j].x + v[j].y) + (v[j].z + v[j].w); }
    const float mean = wave_sum(s) * (1.f / D); float s2 = 0.f;
#pragma unroll
    for (int j = 0; j < 4; ++j) { v[j] = v[j] - mean; s2 += (v[j].x * v[j].x + v[j].y * v[j].y) + (v[j].z * v[j].z + v[j].w * v[j].w); }
    const float rstd = 1.f / sqrtf(wave_sum(s2) * (1.f / D) + LN_EPS);
#pragma unroll
    for (int j = 0; j < 4; ++j) { const f32x4 g = *((const f32x4*)lg + lane + 64 * j), b = *((const f32x4*)lb + lane + 64 * j); xr[64 * j] = v[j] * rstd * g + b; }
}

__device__ __forceinline__ void attn_naive_item(const bf16* P, bf16* YA, float* sw  , int row, int h, int lane) {
    float* sq = sw; float* sc = sw + 192;
    const int t = row % S, rb = row - t;
    const float slope = exp2f(-(float)(h + 1));
    const bf16* prow = P + (size_t)row * NIN;
#pragma unroll
    for (int g = 0; g < NG; ++g) sq[g * 64 + lane] = bf2f(prow[(0 * NG + g) * DA + h * HD + lane]);
    LDS_WAIT(); asm volatile("" ::: "memory");
    float mx = -INFINITY;
#pragma unroll
    for (int g = 0; g < NG; ++g) {
        const int dil = (g == 0) ? 1 : (g == 1 ? 4 : 16);
        const int kcol = (1 * NG + g) * DA + h * HD;
        for (int pass = 0; pass < 3; ++pass) {
            const int jj = pass * 64 + lane;
            if (jj <= 128) {
                const int j = jj - 64, tk = t + j * dil;
                float s = -INFINITY;
                if (tk >= 0 && tk < S) {
                    const v4u* kr = (const v4u*)(P + (size_t)(rb + tk) * NIN + kcol);
                    float a = 0.f;
#pragma unroll
                    for (int e = 0; e < 8; ++e) { const v4u kv = kr[e]; const float* q = sq + g * 64 + 8 * e;
                        a = fmaf(q[0], blo(kv.x), a); a = fmaf(q[1], bhi(kv.x), a); a = fmaf(q[2], blo(kv.y), a); a = fmaf(q[3], bhi(kv.y), a);
                        a = fmaf(q[4], blo(kv.z), a); a = fmaf(q[5], bhi(kv.z), a); a = fmaf(q[6], blo(kv.w), a); a = fmaf(q[7], bhi(kv.w), a); }
                    s = a * 0.125f - slope * (float)((j < 0 ? -j : j) * dil);
                }
                sc[g * 132 + jj] = s;
                mx = fmaxf(mx, s);
            }
        }
    }
    mx = wave_max(mx);
    float sum = 0.f;
#pragma unroll
    for (int g = 0; g < NG; ++g)
        for (int pass = 0; pass < 3; ++pass) {
            const int jj = pass * 64 + lane;
            if (jj <= 128) { const float s = sc[g * 132 + jj]; const float p = (s == -INFINITY) ? 0.f : expf(s - mx); sc[g * 132 + jj] = p; sum += p; }
        }
    sum = wave_sum(sum);
    LDS_WAIT(); asm volatile("" ::: "memory");
    float o = 0.f;
#pragma unroll
    for (int g = 0; g < NG; ++g) {
        const int dil = (g == 0) ? 1 : (g == 1 ? 4 : 16);
        const int vcol = (2 * NG + g) * DA + h * HD + lane;
        for (int jj = 0; jj <= 128; ++jj) {
            const int tk = t + (jj - 64) * dil;
            if (tk >= 0 && tk < S) o = fmaf(sc[g * 132 + jj], bf2f(P[(size_t)(rb + tk) * NIN + vcol]), o);
        }
    }
    o /= sum;
    const float ga = bf2f(prow[OFF_GA + h * HD + lane]);
    YA[(size_t)row * DA + h * HD + lane] = (bf16)f2bf(o * siluf_(ga));
    LDS_WAIT(); asm volatile("" ::: "memory");
}
__device__ __forceinline__ void conv3_phase(const Ctx& C, const bf16* P, const float* cw, const float* cb, bf16* U) {
    constexpr int HALFC = 3 * DHY / 2;
    int tid_ = threadIdx.x; asm volatile("" : "+v"(tid_));
    for (int idx = blockIdx.x * NTHREADS + tid_; idx < MC * HALFC; idx += C.G * NTHREADS) {
        const int row = idx / HALFC, c = (idx % HALFC) * 2, t = row % S;
        const unsigned w0 = *(const unsigned*)(P + (size_t)row * NIN + OFF_HY + c);
        const unsigned wm = t > 0 ? *(const unsigned*)(P + (size_t)(row - 1) * NIN + OFF_HY + c) : 0u;
        const unsigned wp = t < S - 1 ? *(const unsigned*)(P + (size_t)(row + 1) * NIN + OFF_HY + c) : 0u;
        const float r0 = cw[c] * blo(wm) + cw[3 * DHY + c] * blo(w0) + cw[6 * DHY + c] * blo(wp) + cb[c];
        const float r1 = cw[c + 1] * bhi(wm) + cw[3 * DHY + c + 1] * bhi(w0) + cw[6 * DHY + c + 1] * bhi(wp) + cb[c + 1];
        *(unsigned*)(U + (size_t)row * 3 * DHY + c) = pk2(r0, r1);
    }
}
__device__ __forceinline__ void longconv_naive_item(const bf16* Z, int ldz, const float* G, const bf16* X, int ldx, const float* bias, const bf16* gate, int ldg,
                                                    bf16* Zout, int ldo, int item, int lane) {
    const int cg8 = item & 7, tb = (item >> 3) & 511, bl = item >> 12;
    const int c = cg8 * 64 + lane, t0 = tb * 8; const size_t rb = (size_t)bl * S;
    float y[8];
#pragma unroll
    for (int i = 0; i < 8; ++i) y[i] = 0.f;
    for (int s0 = 0; s0 < S; s0 += 8) {
        float z[8], g[15];
#pragma unroll
        for (int j = 0; j < 8; ++j) z[j] = bf2f(Z[(rb + s0 + j) * ldz + c]);
        const int base = t0 - s0 + (S - 1);
#pragma unroll
        for (int m = 0; m < 15; ++m) g[m] = G[(size_t)(base + m - 7) * DHY + c];
#pragma unroll
        for (int i = 0; i < 8; ++i)
#pragma unroll
            for (int j = 0; j < 8; ++j) y[i] = fmaf(g[i - j + 7], z[j], y[i]);
    }
    const float bc = bias[c];
#pragma unroll
    for (int i = 0; i < 8; ++i) {
        const size_t r = rb + t0 + i;
        float v = bf2f(X[r * ldx + c]) * (y[i] + bc * bf2f(Z[r * ldz + c]));
        if (gate) v *= siluf_(bf2f(gate[r * ldg + c]));
        Zout[r * ldo + c] = (bf16)f2bf(v);
    }
}

struct Args { const float* in[23]; float* out; unsigned char* ws; int pad0, pad1; };
#ifndef PG8_SP2
#define PG8_SP2 true
#endif
#ifndef PG8_ALIGN
#define PG8_ALIGN true
#endif
#ifndef PHM
#define PHM 0xFF
#endif
__global__ void __launch_bounds__(NTHREADS, 2) mk_fwd(Args args) {
    extern __shared__ __attribute__((aligned(16))) unsigned char lds[];
    cg::grid_group grid = cg::this_grid();
    Ctx C; C.lds = lds; C.tid = threadIdx.x; C.lane = C.tid & 63; C.wave = __builtin_amdgcn_readfirstlane(C.tid >> 6);
    C.G = gridDim.x; C.gw = blockIdx.x * NWAVES + C.wave; C.NGW = C.G * NWAVES;
    unsigned char* ws = args.ws;
    const float* const* in = args.in;
    float* out = args.out;
    bf16* Hb = (bf16*)(ws + WS_H); bf16* Pb = (bf16*)(ws + WS_P); bf16* Ub = (bf16*)(ws + WS_U); bf16* Z1 = (bf16*)(ws + WS_Z1);
    bf16* YA = (bf16*)(ws + WS_YA); bf16* YH = (bf16*)(ws + WS_YH); bf16* MG = Hb;
    const float* MOD = (const float*)(ws + WS_MOD); const float* Gf = (const float*)(ws + WS_G);
    PG8_LAS unsigned char* ldsl = (PG8_LAS unsigned char*)lds;

    if (PHM & 1) p0_prologue(C, in, ws);
    grid.sync();

    int pend_l = -1, pend_ch = 0;
    for (int l = 0; l < DEPTH; ++l) {
        const float* xin = (l == 0) ? in[0] : out;
        for (int ch = 0; ch < NCHUNK; ++ch) {
            const float* xc = xin + (size_t)ch * MC * D; float* oc = out + (size_t)ch * MC * D;
            { int ln_ = threadIdx.x & 63; asm volatile("" : "+v"(ln_));
            if (pend_l >= 0) { float* pr = out + (size_t)pend_ch * MC * D;
                for (int m = C.gw; m < MC; m += C.NGW) ln_final_row(pr + (size_t)m * D, in[21] + (size_t)pend_l * D, in[22] + (size_t)pend_l * D, ln_); }
            for (int m = C.gw; m < MC; m += C.NGW) ln_mod_row(xc + (size_t)m * D, MOD + ((size_t)l * NB + ch * CH + m / S) * 3 * D, Hb + (size_t)m * D, ln_); }
            grid.sync();
            if (PHM & 2) { pg8::Gemm g{Hb, (const bf16*)(ws + WS_WIN) + (size_t)l * NIN * D, MC, NIN, D}; pg8::StaticOrder So; So.init(MC, NIN, C.G, (int)blockIdx.x);
              pg8::EpiBf16<0> E{Pb, NIN, in[5] + (size_t)l * NIN, 0, 0, 1.f};
              pg8::gemm_phase<pg8::EpiBf16<0>, pg8::StaticOrder, PG8_ALIGN, PG8_SP2>(ldsl, g, So, E); }
            grid.sync();
            if (PHM & 4) { float* sw = (float*)(lds + C.wave * 2560); int ln_ = threadIdx.x & 63; asm volatile("" : "+v"(ln_));
              for (int it = C.gw; it < MC * NH; it += C.NGW) attn_naive_item(Pb, YA, sw, it / NH, it % NH, ln_);
              conv3_phase(C, Pb, in[6] + (size_t)l * 9 * DHY, in[7] + (size_t)l * 3 * DHY, Ub); }
            grid.sync();
            if (PHM & 8) { int ln_ = threadIdx.x & 63; asm volatile("" : "+v"(ln_));
              for (int it = C.gw; it < CH * 512 * 8; it += C.NGW)
                longconv_naive_item(Ub, 3 * DHY, Gf + (size_t)(l * 2 + 0) * GLEN * DHY, Ub + DHY, 3 * DHY, in[16] + (size_t)l * 2 * DHY, nullptr, 0, Z1, DHY, it, ln_); }
            grid.sync();
            if (PHM & 16) { int ln_ = threadIdx.x & 63; asm volatile("" : "+v"(ln_));
              for (int it = C.gw; it < CH * 512 * 8; it += C.NGW)
                longconv_naive_item(Z1, DHY, Gf + (size_t)(l * 2 + 1) * GLEN * DHY, Ub + 2 * DHY, 3 * DHY, in[16] + (size_t)l * 2 * DHY + DHY, Pb + OFF_GH, NIN, YH, DHY, it, ln_); }
            grid.sync();
            if (PHM & 32) { pg8::StaticOrder So; So.init(MC, D, C.G, (int)blockIdx.x);
              { pg8::Gemm g{YA, (const bf16*)(ws + WS_WPA) + (size_t)l * D * DA, MC, D, DA}; pg8::EpiMerge<false> E{MG, D, Pb + OFF_RA, NIN};
                pg8::gemm_phase<pg8::EpiMerge<false>, pg8::StaticOrder, PG8_ALIGN, PG8_SP2>(ldsl, g, So, E); }
              { pg8::Gemm g{YH, (const bf16*)(ws + WS_WPH) + (size_t)l * D * DHY, MC, D, DHY}; pg8::EpiMerge<true> E{MG, D, Pb + OFF_RH, NIN};
                pg8::gemm_phase<pg8::EpiMerge<true>, pg8::StaticOrder, PG8_ALIGN, PG8_SP2>(ldsl, g, So, E); } }
            grid.sync();
            if (PHM & 64) { pg8::Gemm g{MG, (const bf16*)(ws + WS_WOUT) + (size_t)l * D * D, MC, D, D}; pg8::StaticOrder So; So.init(MC, D, C.G, (int)blockIdx.x);
              pg8::EpiRes E{xc, oc, D, in[20] + (size_t)l * D, MOD + ((size_t)l * NB + ch * CH) * 3 * D + 2 * D, S / 256, 3 * D, DN_ALPHA};
              pg8::gemm_phase<pg8::EpiRes, pg8::StaticOrder, PG8_ALIGN, PG8_SP2>(ldsl, g, So, E); }
            grid.sync();
            pend_l = l; pend_ch = ch;
        }
    }
    { float* pr = out + (size_t)pend_ch * MC * D;
      for (int m = C.gw; m < MC; m += C.NGW) ln_final_row(pr + (size_t)m * D, in[21] + (size_t)pend_l * D, in[22] + (size_t)pend_l * D, C.lane); }
}

extern "C" void kernel_launch(void* const* d_in, const int* in_sizes, int n_in, void* d_out, int out_size, void* d_ws, size_t ws_size, hipStream_t stream) {
    static int grid = 0;
    if (grid == 0) {
        if (n_in != 23 || out_size != NB * S * D || ws_size < WS_END) { fprintf(stderr, "kernel_launch: unexpected shapes (n_in %d, out %d, ws %zu, need %zu); nothing launched\n", n_in, out_size, ws_size, (size_t)WS_END); grid = -1; return; }
        int dev = 0, cus = 0, per_cu = 0;
        if (hipGetDevice(&dev) != hipSuccess || hipDeviceGetAttribute(&cus, hipDeviceAttributeMultiprocessorCount, dev) != hipSuccess) { fprintf(stderr, "kernel_launch: device query failed\n"); grid = -1; return; }
        if (hipFuncSetAttribute((const void*)mk_fwd, hipFuncAttributeMaxDynamicSharedMemorySize, LDS_BYTES) != hipSuccess) { fprintf(stderr, "kernel_launch: hipFuncSetAttribute failed\n"); grid = -1; return; }
        if (hipOccupancyMaxActiveBlocksPerMultiprocessor(&per_cu, (const void*)mk_fwd, NTHREADS, LDS_BYTES) != hipSuccess || per_cu < 1) { fprintf(stderr, "kernel_launch: occupancy query says %d blocks per CU\n", per_cu); grid = -1; return; }
        grid = cus;
        fprintf(stderr, "kernel_launch: grid %d (cus %d, per_cu %d), ws %zu MiB\n", grid, cus, per_cu, ws_size >> 20);
    }
    if (grid < 0) return;
    Args a{};
    for (int i = 0; i < 23; ++i) a.in[i] = (const float*)d_in[i];
    a.out = (float*)d_out; a.ws = (unsigned char*)d_ws;
    void* kargs[] = {&a};
    const hipError_t e = hipLaunchCooperativeKernel((const void*)mk_fwd, dim3(grid), dim3(NTHREADS), kargs, LDS_BYTES, stream);
    if (e != hipSuccess) fprintf(stderr, "kernel_launch: cooperative launch failed: %s (grid %d)\n", hipGetErrorString(e), grid);
}
```

```cpp
#include <hip/hip_runtime.h>
#include <hip/hip_cooperative_groups.h>
#include <cstdio>
#include <cstdint>
#include <cmath>
namespace cg = cooperative_groups;
namespace pg8 {
#define PG8_LAS __attribute__((address_space(3)))
typedef unsigned short bf16_t;
typedef short bf16x8 __attribute__((ext_vector_type(8)));
typedef float f32x4 __attribute__((ext_vector_type(4)));
typedef unsigned u32x4 __attribute__((ext_vector_type(4)));
constexpr int BM = 256, BK = 64, HALF = 128, HTB = HALF * BK * 2  , STAGE_BYTES = 8 * HTB, NXCD = 8, WGM = 8;

__host__ __device__ __forceinline__ int lds_byte(int r, int c) { const int st = (r >> 4) * 2 + (c >> 5), rr = r & 15, cc = c & 31, ob = rr * 64 + cc * 2; return st * 1024 + (ob ^ (((ob >> 9) & 1) << 5)); }
__host__ __device__ __forceinline__ void stage_rc(int b, int& R, int& C) { const int st = b / 1024, sb = b % 1024, swz = sb ^ (((sb >> 9) & 1) << 5); R = (st >> 1) * 16 + swz / 64; C = (st & 1) * 32 + (swz % 64) / 2; }
__host__ __device__ __forceinline__ int perm32(int rho) { const int n = rho >> 4, i = rho & 15; return 8 * (i >> 2) + 4 * n + (i & 3); }

struct Unit { int pm, pn; };
struct Gemm { const bf16_t* A; const bf16_t* Bt; int M, N, K; };

struct StaticOrder {
    int nM, nN, nwg, G, c;
    __host__ __device__ void init(int M, int N, int G_, int c_) { nM = M / BM; nN = N / BM; nwg = nM * nN; G = G_; c = c_; }
    __host__ __device__ bool next(int i, Unit& u) const {
        const long L = (long)i * G + c; if (L >= nwg) return false;
        int wgid = (int)L; { const int q = nwg / NXCD, r = nwg % NXCD, xcd = wgid % NXCD, off = wgid / NXCD; wgid = (xcd < r ? xcd * (q + 1) : r * (q + 1) + (xcd - r) * q) + off; }
        const int nig = WGM * nN, gid = wgid / nig, fm = gid * WGM, gsz = (nM - fm) < WGM ? (nM - fm) : WGM;
        u.pm = fm + ((wgid % nig) % gsz); u.pn = (wgid % nig) / gsz; return true;
    }
    __device__ __forceinline__ void a_ready(const Unit&) const {}
    __device__ __forceinline__ void done(const Unit&) const {}
};

__device__ __forceinline__ unsigned cvt_pk_bf16(float lo, float hi) { unsigned r; asm volatile("v_cvt_pk_bf16_f32 %0, %1, %2" : "=v"(r) : "v"(lo), "v"(hi)); return r; }
typedef float f32x2 __attribute__((ext_vector_type(2)));
__device__ __forceinline__ f32x2 gelu_pk(f32x2 v) {
    const f32x2 av = __builtin_elementwise_abs(v), d = av * 0.2316418882f + 1.0f;
    f32x2 t; t.x = __builtin_amdgcn_rcpf(d.x); t.y = __builtin_amdgcn_rcpf(d.y);
    f32x2 q = t * 0.5307027145f + (-0.7265760135f); q = q * t + 0.7107068705f; q = q * t + (-0.142248368f); q = q * t + 0.127414796f; q = q * t;
    const f32x2 s = (v * v) * (-0.72134752044f);
    f32x2 e; e.x = __builtin_amdgcn_exp2f(s.x); e.y = __builtin_amdgcn_exp2f(s.y);
    const f32x2 m = v * (q * e), r = v - m;
    f32x2 o; o.x = v.x < 0.f ? m.x : r.x; o.y = v.y < 0.f ? m.y : r.y; return o;
}

template <int ACT  > struct EpiBf16 {
    static constexpr bool PERM = true, AFTER_DRAIN = false; static_assert(ACT == 0 || ACT == 1, "EpiBf16: ACT is 0 (none) or 1 (gelu_pk)");
    bf16_t* O; int ldc; const float* bias; int split_cols; size_t split_stride; float scale0;
    __device__ __forceinline__ void operator()(const f32x4 (&acc)[2][2][4][2], const Unit& u, int wr, int wc, int fr, int fq) const {
        const int row0 = u.pm * BM + wr * 64 + fr; int colt = u.pn * BM; bf16_t* base = O;
        float sc = 1.f; if (split_cols) { const int t = colt / split_cols; base += (size_t)t * split_stride; colt -= t * split_cols; if (t == 0) sc = scale0; }
        const int col0 = colt + wc * 32 + 8 * fq, bcol0 = u.pn * BM + wc * 32 + 8 * fq;
        f32x4 bv[2][2];
#pragma unroll
        for (int bj = 0; bj < 2; ++bj)
#pragma unroll
            for (int n = 0; n < 2; ++n) bv[bj][n] = bias ? *(const f32x4*)(bias + bcol0 + bj * HALF + 4 * n) : (f32x4){0.f, 0.f, 0.f, 0.f};
#pragma unroll
        for (int ai = 0; ai < 2; ++ai)
#pragma unroll
            for (int m = 0; m < 4; ++m) { bf16_t* rowp = base + (size_t)(row0 + ai * HALF + m * 16) * ldc + col0;
#pragma unroll
                for (int bj = 0; bj < 2; ++bj) { f32x4 v0 = acc[ai][bj][m][0] + bv[bj][0], v1 = acc[ai][bj][m][1] + bv[bj][1];
                    if (ACT == 1) { f32x2 a = gelu_pk((f32x2){v0[0], v0[1]}), b = gelu_pk((f32x2){v0[2], v0[3]}), c = gelu_pk((f32x2){v1[0], v1[1]}), d = gelu_pk((f32x2){v1[2], v1[3]});
                        v0 = (f32x4){a.x, a.y, b.x, b.y}; v1 = (f32x4){c.x, c.y, d.x, d.y}; }
                    v0 = v0 * sc; v1 = v1 * sc; u32x4 w; w.x = cvt_pk_bf16(v0[0], v0[1]); w.y = cvt_pk_bf16(v0[2], v0[3]); w.z = cvt_pk_bf16(v1[0], v1[1]); w.w = cvt_pk_bf16(v1[2], v1[3]);
                    *(u32x4*)(rowp + bj * HALF) = w; } }
    }
};
__device__ __forceinline__ float bf_lo(unsigned w) { return __uint_as_float(w << 16); }
__device__ __forceinline__ float bf_hi(unsigned w) { return __uint_as_float(w & 0xffff0000u); }
__device__ __forceinline__ float sigm(float x) { return 1.f / (1.f + __expf(-x)); }
template <bool ACCUM> struct EpiMerge {
    static constexpr bool PERM = true, AFTER_DRAIN = false;
    bf16_t* O; int ldc; const bf16_t* Gt; int ldg;
    __device__ __forceinline__ void operator()(const f32x4 (&acc)[2][2][4][2], const Unit& u, int wr, int wc, int fr, int fq) const {
        const int row0 = u.pm * BM + wr * 64 + fr, col0 = u.pn * BM + wc * 32 + 8 * fq;
#pragma unroll
        for (int ai = 0; ai < 2; ++ai)
#pragma unroll
            for (int m = 0; m < 4; ++m) { const size_t row = (size_t)(row0 + ai * HALF + m * 16);
#pragma unroll
                for (int bj = 0; bj < 2; ++bj) { const int col = col0 + bj * HALF;
                    const u32x4 g = *(const u32x4*)(Gt + row * ldg + col);
                    const f32x4 v0 = acc[ai][bj][m][0], v1 = acc[ai][bj][m][1];
                    float r[8];
                    r[0] = sigm(bf_lo(g.x)) * v0[0]; r[1] = sigm(bf_hi(g.x)) * v0[1]; r[2] = sigm(bf_lo(g.y)) * v0[2]; r[3] = sigm(bf_hi(g.y)) * v0[3];
                    r[4] = sigm(bf_lo(g.z)) * v1[0]; r[5] = sigm(bf_hi(g.z)) * v1[1]; r[6] = sigm(bf_lo(g.w)) * v1[2]; r[7] = sigm(bf_hi(g.w)) * v1[3];
                    bf16_t* op = O + row * ldc + col;
                    if (ACCUM) { const u32x4 o = *(const u32x4*)op;
                        r[0] += bf_lo(o.x); r[1] += bf_hi(o.x); r[2] += bf_lo(o.y); r[3] += bf_hi(o.y); r[4] += bf_lo(o.z); r[5] += bf_hi(o.z); r[6] += bf_lo(o.w); r[7] += bf_hi(o.w); }
                    u32x4 w; w.x = cvt_pk_bf16(r[0], r[1]); w.y = cvt_pk_bf16(r[2], r[3]); w.z = cvt_pk_bf16(r[4], r[5]); w.w = cvt_pk_bf16(r[6], r[7]);
                    *(u32x4*)op = w; } }
    }
};
struct EpiRes {
    static constexpr bool PERM = false, AFTER_DRAIN = false;
    const float* xin; float* out; int ldc; const float* bias; const float* gate0; int tiles_per_batch; int gate_stride; float alpha;
    __device__ __forceinline__ void operator()(const f32x4 (&acc)[2][2][4][2], const Unit& u, int wr, int wc, int fr, int fq) const {
        const int col0 = u.pn * BM + wc * 32 + 4 * fq;
        const float* gate = gate0 + (size_t)(u.pm / tiles_per_batch) * gate_stride;
#pragma unroll
        for (int bj = 0; bj < 2; ++bj)
#pragma unroll
            for (int n = 0; n < 2; ++n) { const int col = col0 + bj * HALF + n * 16;
                const f32x4 bv = *(const f32x4*)(bias + col), gv = *(const f32x4*)(gate + col);
#pragma unroll
                for (int ai = 0; ai < 2; ++ai)
#pragma unroll
                    for (int m = 0; m < 4; ++m) { const size_t off = (size_t)(u.pm * BM + ai * HALF + wr * 64 + m * 16 + fr) * ldc + col;
                        const f32x4 xv = *(const f32x4*)(xin + off);
                        *(f32x4*)(out + off) = xv * alpha + gv * (acc[ai][bj][m][n] + bv); } }
    }
};
template <class Epi, class Sched, bool ALIGN_EPI = false, bool SP2 = false>
__device__ __forceinline__ void gemm_phase(PG8_LAS unsigned char* lds, const Gemm g, const Sched& S, const Epi& E) {
    int tid_ = threadIdx.x; asm volatile("" : "+v"(tid_));
    const int tid = tid_, wid = __builtin_amdgcn_readfirstlane(tid >> 6), lane = tid & 63, wr = wid >> 2, wc = wid & 3, fr = lane & 15, fq = lane >> 4;
    const int K = g.K, nt = K / BK;
    unsigned voffA[2], voffB[2];
#pragma unroll
    for (int i = 0; i < 2; ++i) { int R, C; stage_rc(tid * 16 + i * 8192, R, C); const int Rb = Epi::PERM ? ((R & ~31) + perm32(R & 31)) : R;
        voffA[i] = (unsigned)(R * K + C) * 2u; voffB[i] = (unsigned)(Rb * K + C) * 2u; }
    const size_t kstep = (size_t)(BK * 2);
    const size_t hstep = (size_t)HALF * K * 2;
    const size_t tstep = 2 * hstep;
    const unsigned ldsw = (unsigned)wid * 1024u;
    const int aoff = lds_byte(wr * 64 + fr, fq * 8), boff = lds_byte(wc * 32 + fr, fq * 8);
#define PG8_SA(b, h) (((b) * 2 + (h)) * HTB)
#define PG8_SB(b, h) ((4 + (b) * 2 + (h)) * HTB)
#define PG8_STAGE(bufoff, gbase, voff) do { _Pragma("unroll") for (int _i = 0; _i < 2; ++_i) \
        __builtin_amdgcn_global_load_lds((const unsigned*)((const char*)(gbase) + (voff)[_i]), (PG8_LAS unsigned*)(lds + (bufoff) + ldsw + _i * 8192), 16, 0, 0); } while (0)
#define PG8_LDA(dst, b, h) do { _Pragma("unroll") for (int m = 0; m < 4; ++m) _Pragma("unroll") for (int k = 0; k < 2; ++k) dst[m][k] = *(const PG8_LAS bf16x8*)(lds + PG8_SA(b, h) + aoff + m * 2048 + k * 1024); } while (0)
#define PG8_LDB(dst, b, h) do { _Pragma("unroll") for (int n = 0; n < 2; ++n) _Pragma("unroll") for (int k = 0; k < 2; ++k) dst[n][k] = *(const PG8_LAS bf16x8*)(lds + PG8_SB(b, h) + boff + n * 2048 + k * 1024); } while (0)
#define PG8_MMA(ai, bj, At, Bt) do { __builtin_amdgcn_s_setprio(1); _Pragma("unroll") for (int m = 0; m < 4; ++m) _Pragma("unroll") for (int n = 0; n < 2; ++n) _Pragma("unroll") for (int k = 0; k < 2; ++k) \
        acc[ai][bj][m][n] = __builtin_amdgcn_mfma_f32_16x16x32_bf16(Bt[n][k], At[m][k], acc[ai][bj][m][n], 0, 0, 0); __builtin_amdgcn_s_setprio(0); } while (0)
#define PG8_WAIT_V(n) asm volatile("s_waitcnt vmcnt(" #n ")" ::: "memory")
#define PG8_WAIT_L(n) asm volatile("s_waitcnt lgkmcnt(" #n ")" ::: "memory")
#define PG8_BAR __builtin_amdgcn_s_barrier()
#define PG8_SCHED __builtin_amdgcn_sched_barrier(0)
    Unit cur, nxt; int ui = 0;
    if (!S.next(0, cur)) return;
    f32x4 acc[2][2][4][2];
#pragma unroll
    for (int a = 0; a < 2; ++a)
#pragma unroll
        for (int b = 0; b < 2; ++b)
#pragma unroll
            for (int m = 0; m < 4; ++m)
#pragma unroll
                for (int n = 0; n < 2; ++n) acc[a][b][m][n] = (f32x4){0.f, 0.f, 0.f, 0.f};
    bf16x8 At[4][2], B0[2][2], B1[2][2];
    const char* cA = (const char*)g.A + (size_t)cur.pm * tstep; const char* cB = (const char*)g.Bt + (size_t)cur.pn * tstep;
    S.a_ready(cur);
    if constexpr (SP2) {
        PG8_STAGE(PG8_SB(0, 0), cB, voffB); PG8_STAGE(PG8_SB(0, 1), cB + hstep, voffB); PG8_STAGE(PG8_SA(0, 0), cA, voffA); PG8_STAGE(PG8_SA(0, 1), cA + hstep, voffA);
        if (wr == 1) PG8_BAR;
        PG8_WAIT_V(2); PG8_BAR;
        PG8_STAGE(PG8_SB(1, 0), cB + kstep, voffB); PG8_STAGE(PG8_SA(1, 0), cA + kstep, voffA); PG8_STAGE(PG8_SB(1, 1), cB + hstep + kstep, voffB);
        PG8_WAIT_V(6); PG8_BAR;
    } else {
        PG8_STAGE(PG8_SB(0, 0), cB, voffB); PG8_STAGE(PG8_SA(0, 0), cA, voffA); PG8_STAGE(PG8_SB(0, 1), cB + hstep, voffB); PG8_STAGE(PG8_SA(0, 1), cA + hstep, voffA);
        if (wr == 1) PG8_BAR;
        PG8_WAIT_V(4); PG8_BAR;
        PG8_STAGE(PG8_SB(1, 0), cB + kstep, voffB); PG8_STAGE(PG8_SA(1, 0), cA + kstep, voffA); PG8_STAGE(PG8_SB(1, 1), cB + hstep + kstep, voffB);
        PG8_WAIT_V(6); PG8_BAR;
    }
    for (;;) {
        const bool has_next = S.next(ui + 1, nxt);
        const char* nA = has_next ? (const char*)g.A + (size_t)nxt.pm * tstep : cA; const char* nB = has_next ? (const char*)g.Bt + (size_t)nxt.pn * tstep : cB;
        for (int t = 0; t < nt; t += 2) {
            const bool last = (t == nt - 2);
            const char* a1 = cA + (size_t)(t + 1) * kstep;
            const char* a2 = last ? nA : cA + (size_t)(t + 2) * kstep; const char* b2 = last ? nB : cB + (size_t)(t + 2) * kstep;
            const char* a3 = a2 + kstep; const char* b3 = b2 + kstep;
            if (last && has_next) S.a_ready(nxt);
            if constexpr (SP2) {
            PG8_LDB(B0, 0, 0); PG8_LDB(B1, 0, 1); PG8_SCHED; PG8_LDA(At, 0, 0); PG8_STAGE(PG8_SA(1, 1), a1 + hstep, voffA);
            PG8_WAIT_V(8); PG8_WAIT_L(0); PG8_BAR; PG8_MMA(0, 0, At, B0); PG8_MMA(0, 1, At, B1); PG8_BAR; PG8_SCHED;
            PG8_LDA(At, 0, 1); PG8_STAGE(PG8_SB(0, 0), b2, voffB); PG8_STAGE(PG8_SB(0, 1), b2 + hstep, voffB); PG8_STAGE(PG8_SA(0, 0), a2, voffA);
            PG8_WAIT_V(8); PG8_WAIT_L(0); PG8_BAR; PG8_MMA(1, 0, At, B0); PG8_MMA(1, 1, At, B1); PG8_BAR; PG8_SCHED;
            PG8_LDB(B0, 1, 0); PG8_LDB(B1, 1, 1); PG8_SCHED; PG8_LDA(At, 1, 0); PG8_STAGE(PG8_SA(0, 1), a2 + hstep, voffA);
            PG8_WAIT_V(8); PG8_WAIT_L(0); PG8_BAR; PG8_MMA(0, 0, At, B0); PG8_MMA(0, 1, At, B1); PG8_BAR; PG8_SCHED;
            PG8_LDA(At, 1, 1); PG8_STAGE(PG8_SB(1, 0), b3, voffB); PG8_STAGE(PG8_SB(1, 1), b3 + hstep, voffB); PG8_STAGE(PG8_SA(1, 0), a3, voffA);
            PG8_WAIT_V(8); PG8_WAIT_L(0); PG8_BAR; PG8_MMA(1, 0, At, B0); PG8_MMA(1, 1, At, B1); PG8_BAR; PG8_SCHED;
            } else {
            PG8_LDB(B0, 0, 0); PG8_SCHED; PG8_LDA(At, 0, 0); PG8_STAGE(PG8_SA(1, 1), a1 + hstep, voffA);
            PG8_WAIT_L(8); PG8_BAR; PG8_WAIT_L(0); PG8_MMA(0, 0, At, B0); PG8_BAR; PG8_SCHED;
            PG8_LDB(B1, 0, 1); PG8_STAGE(PG8_SB(0, 0), b2, voffB);
            PG8_BAR; PG8_WAIT_L(0); PG8_MMA(0, 1, At, B1); PG8_BAR;
            PG8_LDA(At, 0, 1); PG8_STAGE(PG8_SA(0, 0), a2, voffA);
            PG8_BAR; PG8_WAIT_L(0); PG8_MMA(1, 0, At, B0); PG8_BAR; PG8_SCHED;
            PG8_STAGE(PG8_SB(0, 1), b2 + hstep, voffB);
            PG8_WAIT_V(6); PG8_BAR; PG8_MMA(1, 1, At, B1); PG8_BAR;
            PG8_LDB(B0, 1, 0); PG8_SCHED; PG8_LDA(At, 1, 0); PG8_STAGE(PG8_SA(0, 1), a2 + hstep, voffA);
            PG8_WAIT_L(8); PG8_BAR; PG8_WAIT_L(0); PG8_MMA(0, 0, At, B0); PG8_BAR; PG8_SCHED;
            PG8_LDB(B1, 1, 1); PG8_STAGE(PG8_SB(1, 0), b3, voffB);
            PG8_BAR; PG8_WAIT_L(0); PG8_MMA(0, 1, At, B1); PG8_BAR;
            PG8_LDA(At, 1, 1); PG8_STAGE(PG8_SA(1, 0), a3, voffA);
            PG8_BAR; PG8_WAIT_L(0); PG8_MMA(1, 0, At, B0); PG8_BAR; PG8_SCHED;
            PG8_STAGE(PG8_SB(1, 1), b3 + hstep, voffB);
            PG8_WAIT_V(6); PG8_BAR; PG8_MMA(1, 1, At, B1); PG8_BAR;
            }
        }
        if constexpr (ALIGN_EPI) { if (wr == 0) PG8_BAR; }
        if constexpr (!Epi::AFTER_DRAIN) { E(acc, cur, wr, wc, fr, fq); S.done(cur); }
        if (!has_next) break;
#pragma unroll
        for (int a = 0; a < 2; ++a)
#pragma unroll
            for (int b = 0; b < 2; ++b)
#pragma unroll
                for (int m = 0; m < 4; ++m)
#pragma unroll
                    for (int n = 0; n < 2; ++n) acc[a][b][m][n] = (f32x4){0.f, 0.f, 0.f, 0.f};
        cur = nxt; cA = nA; cB = nB; ++ui;
        if constexpr (ALIGN_EPI) { if (wr == 1) PG8_BAR; }
    }
    PG8_WAIT_V(0);
    if constexpr (!ALIGN_EPI) { if (wr == 0) PG8_BAR; }
    PG8_BAR;
    if constexpr (Epi::AFTER_DRAIN) { E.fused(acc, cur, wr, wc, fr, fq, lds, wid, lane); S.done(cur); }
#undef PG8_SA
#undef PG8_SB
#undef PG8_STAGE
#undef PG8_LDA
#undef PG8_LDB
#undef PG8_MMA
#undef PG8_WAIT_V
#undef PG8_WAIT_L
#undef PG8_BAR
#undef PG8_SCHED
}
}
constexpr int D = 1024, NB = 8, S = 4096, DEPTH = 2;
constexpr int HD = 64, DA = 512, NH = 8, NG = 3, DHY = 512, NIN = 9216;
constexpr int FE = 33, FW = 64;
constexpr int OFF_GA = 4608, OFF_HY = 5120, OFF_GH = 6656, OFF_RA = 7168, OFF_RH = 8192;
constexpr float LN_EPS = 1e-5f, DN_ALPHA = 1.41421356237309515f;
constexpr int CH = 2, NCHUNK = NB / CH, MC = CH * S;
constexpr int NWAVES = 8, NTHREADS = NWAVES * 64;
constexpr int GLEN = 2 * S - 1;

constexpr size_t MiB = 1u << 20;
constexpr size_t WS_WIN = 1 * MiB;
constexpr size_t WS_WPA = WS_WIN + (size_t)DEPTH * NIN * D * 2;
constexpr size_t WS_WPH = WS_WPA + (size_t)DEPTH * D * DA * 2;
constexpr size_t WS_WOUT = WS_WPH + (size_t)DEPTH * D * DHY * 2;
constexpr size_t WS_MOD = WS_WOUT + (size_t)DEPTH * D * D * 2;
constexpr size_t WS_R = WS_MOD + 1 * MiB;
constexpr size_t WS_H = WS_R + (size_t)DEPTH * 2 * DHY * 8192 * 2;
constexpr size_t WS_P = WS_H + (size_t)MC * D * 2;
constexpr size_t WS_UT = WS_P + (size_t)MC * NIN * 2;
constexpr size_t WS_YHT = WS_UT + (size_t)MC * 4 * DHY * 2;
constexpr size_t WS_YA = WS_YHT + (size_t)MC * DHY * 2;
constexpr size_t WS_YH = WS_YA + (size_t)MC * DA * 2;
constexpr size_t WS_Z1T = WS_YH + (size_t)MC * DHY * 2;
constexpr size_t WS_YHTR = WS_Z1T + (size_t)MC * DHY * 2;
constexpr size_t WS_END = WS_YHTR + (size_t)MC * DHY * 2;
#ifndef MK_CHECK
#define MK_CHECK 0
#endif
constexpr float CHECK_K = 30.f;

constexpr int LDS_BYTES = 147456;
constexpr int RING_BYTES = 131072;

#define LAS __attribute__((address_space(3)))
typedef unsigned short bf16;
typedef unsigned v4u __attribute__((ext_vector_type(4)));
typedef unsigned v2u __attribute__((ext_vector_type(2)));
typedef float f32x4 __attribute__((ext_vector_type(4)));
#define LDS_WAIT() asm volatile("s_waitcnt lgkmcnt(0)" ::: "memory")
__device__ __forceinline__ unsigned f2bf(float f) { unsigned u = __builtin_bit_cast(unsigned, f); return (u + 0x7fffu + ((u >> 16) & 1u)) >> 16; }
__device__ __forceinline__ unsigned pk2(float lo, float hi) { return f2bf(lo) | (f2bf(hi) << 16); }
__device__ __forceinline__ float bf2f(unsigned short h) { return __uint_as_float((unsigned)h << 16); }
__device__ __forceinline__ float blo(unsigned w) { return __uint_as_float(w << 16); }
__device__ __forceinline__ float bhi(unsigned w) { return __uint_as_float(w & 0xffff0000u); }
__device__ __forceinline__ float wave_sum(float v) {
#pragma unroll
    for (int o = 1; o < 64; o <<= 1) v += __shfl_xor(v, o);
    return v;
}
__device__ __forceinline__ float wave_max(float v) {
#pragma unroll
    for (int o = 1; o < 64; o <<= 1) v = fmaxf(v, __shfl_xor(v, o));
    return v;
}
__device__ __forceinline__ float siluf_(float x) { return x / (1.f + expf(-x)); }
__device__ __forceinline__ void sincos_cw(float x, float& sn, float& cs) {
    const float j = rintf(x * 0.63661977236758134f);
    float y = fmaf(-j, 1.5703125f, x);
    y = fmaf(-j, 4.837512969970703125e-4f, y);
    y = fmaf(-j, 7.54978995489188216e-8f, y);
    const float z = y * y;
    const float sp = fmaf(fmaf(fmaf(-1.9515295891e-4f, z, 8.3321608736e-3f), z, -1.6666654611e-1f) * z, y, y);
    const float cp = fmaf(fmaf(fmaf(2.443315711809948e-5f, z, -1.388731625493765e-3f), z, 4.166664568298827e-2f), z * z, fmaf(-0.5f, z, 1.0f));
    const int q = ((int)j) & 3;
    const float s0 = (q & 1) ? cp : sp, c0 = (q & 1) ? sp : cp;
    sn = (q & 2) ? -s0 : s0;
    cs = ((q + 1) & 2) ? -c0 : c0;
}
__device__ __forceinline__ float sin_cw(float x) { float s, c; sincos_cw(x, s, c); return s; }

struct Ctx {
    unsigned char* lds;
    int tid, lane, wave, gw, NGW, G;
};

__device__ __forceinline__ void p0_transpose_item(const float* W, int K, int N, bf16* WT, float* scr, int item, int lane) {
    const int nblk = N / 32, kb = item / nblk, nb = item % nblk, k0 = 64 * kb, n0 = 32 * nb;
#pragma unroll 8
    for (int i = 0; i < 32; ++i) { const int kk = 2 * i + (lane >> 5); scr[kk * 33 + (lane & 31)] = W[(size_t)(k0 + kk) * N + n0 + (lane & 31)]; }
    LDS_WAIT(); asm volatile("" ::: "memory");
    const int c = lane & 7;
#pragma unroll
    for (int j = 0; j < 4; ++j) { const int n = (lane >> 3) + 8 * j; const float* s = scr + (8 * c) * 33 + n;
        v4u o; o.x = pk2(s[0 * 33], s[1 * 33]); o.y = pk2(s[2 * 33], s[3 * 33]); o.z = pk2(s[4 * 33], s[5 * 33]); o.w = pk2(s[6 * 33], s[7 * 33]);
        *(v4u*)(WT + (size_t)(n0 + n) * K + k0 + 8 * c) = o; }
    LDS_WAIT(); asm volatile("" ::: "memory");
}
__device__ __forceinline__ void p0_filter_unit(const float* const* in, bf16* R, float* sf  , int unit, int lane) {
    const float* w1 = in[8]; const float* b1 = in[9]; const float* w2 = in[10]; const float* b2 = in[11];
    const float* w3 = in[12]; const float* b3 = in[13]; const float* w4 = in[14]; const float* freq = in[15];
    const int l = unit / 256, tb = (unit >> 2) & 63, nq = unit & 3;
    float* H3s = sf + 256;
    const float fr = freq[l * FW + lane];
    for (int k = 0; k < 64; ++k) {
        const int t = 64 * tb + k;
        if (lane < FE) {
            float v;
            if (lane == 0) v = (float)t / (float)(S - 1);
            else {
                const int q = (lane - 1) & 15;
                const double f = (double)(1e-4f) + (double)q * (((double)15.0f - (double)1e-4f) / 15.0);
                double u = f * (double)t / (double)S; u -= rint(u);
                float sn, cs; sincos_cw((float)(u * 6.283185307179586476925), sn, cs);
                v = (lane <= 16) ? cs : -sn;
            }
            sf[lane] = v;
        }
        LDS_WAIT(); asm volatile("" ::: "memory");
        float a = b1[l * FW + lane];
        for (int kk = 0; kk < FE; ++kk) a = fmaf(sf[kk], w1[(l * FE + kk) * FW + lane], a);
        sf[64 + lane] = sin_cw(fr * a);
        LDS_WAIT(); asm volatile("" ::: "memory");
        a = b2[l * FW + lane];
        for (int kk = 0; kk < FW; ++kk) a = fmaf(sf[64 + kk], w2[(l * FW + kk) * FW + lane], a);
        sf[128 + lane] = sin_cw(fr * a);
        LDS_WAIT(); asm volatile("" ::: "memory");
        a = b3[l * FW + lane];
        for (int kk = 0; kk < FW; ++kk) a = fmaf(sf[128 + kk], w3[(l * FW + kk) * FW + lane], a);
        H3s[k * 65 + lane] = sin_cw(fr * a);
        LDS_WAIT(); asm volatile("" ::: "memory");
    }
    float hr[64];
#pragma unroll
    for (int j = 0; j < 64; ++j) hr[j] = H3s[lane * 65 + j];
    const int t = 64 * tb + lane, o = nq >> 1, dir = nq & 1;
    const float tt = (float)t / (float)(S - 1);
    const float d0 = -4.605170185988091f / 1.5f, d1 = -4.605170185988091f / 0.3f;
    const float* w4n = w4 + (size_t)l * FW * (4 * DHY) + nq * DHY;
    const int x = dir ? ((t == 0) ? 8191 : 4095 + t) : 4095 - t;
    bf16* Rb = R + ((size_t)(l * 2 + o) * DHY) * 8192 + x;
    for (int c = 0; c < DHY; ++c) {
        float acc = 0.f;
#pragma unroll
        for (int j = 0; j < 64; ++j) acc = fmaf(hr[j], w4n[(size_t)j * 4 * DHY + c], acc);
        const float delta = d0 + (d1 - d0) * ((float)c / (float)(DHY - 1));
        float val = acc * expf(-tt * fabsf(delta));
        if (dir == 1 && t == 0) val = 0.f;
        Rb[(size_t)c * 8192] = (bf16)f2bf(val);
    }
    LDS_WAIT(); asm volatile("" ::: "memory");
}
__device__ __forceinline__ void p0_prologue(const Ctx& C, const float* const* in, unsigned char* ws) {
    float* scr = (float*)(C.lds + C.wave * 17920);
    constexpr int I_IN = (D / 64) * (NIN / 32), I_PA = (DA / 64) * (D / 32), I_PH = (DHY / 64) * (D / 32), I_OUT = (D / 64) * (D / 32);
    constexpr int I_L = I_IN + I_PA + I_PH + I_OUT;
    for (int it = C.gw; it < DEPTH * I_L; it += C.NGW) {
        const int l = it / I_L; int r = it % I_L;
        if (r < I_IN) { p0_transpose_item(in[4] + (size_t)l * D * NIN, D, NIN, (bf16*)(ws + WS_WIN) + (size_t)l * NIN * D, scr, r, C.lane); continue; } r -= I_IN;
        if (r < I_PA) { p0_transpose_item(in[17] + (size_t)l * DA * D, DA, D, (bf16*)(ws + WS_WPA) + (size_t)l * D * DA, scr, r, C.lane); continue; } r -= I_PA;
        if (r < I_PH) { p0_transpose_item(in[18] + (size_t)l * DHY * D, DHY, D, (bf16*)(ws + WS_WPH) + (size_t)l * D * DHY, scr, r, C.lane); continue; } r -= I_PH;
        p0_transpose_item(in[19] + (size_t)l * D * D, D, D, (bf16*)(ws + WS_WOUT) + (size_t)l * D * D, scr, r, C.lane);
    }
    {
        float* mod = (float*)(ws + WS_MOD);
        const float* c = in[1]; const float* w_ada = in[2]; const float* b_ada = in[3];
        for (int idx = blockIdx.x * NTHREADS + C.tid; idx < DEPTH * NB * 3 * D; idx += C.G * NTHREADS) {
            const int n = idx % (3 * D), b = (idx / (3 * D)) % NB, l = idx / (3 * D * NB);
            const float* w = w_ada + (size_t)l * D * 3 * D + n; const float* cb = c + b * D;
            float acc = 0.f;
            for (int k = 0; k < D; ++k) acc = fmaf(cb[k], w[(size_t)k * 3 * D], acc);
            mod[idx] = acc + b_ada[l * 3 * D + n];
        }
    }
    for (int it = C.gw; it < DEPTH * 256; it += C.NGW) p0_filter_unit(in, (bf16*)(ws + WS_R), scr, it, C.lane);
}

__device__ __forceinline__ void ln_mod_row(const float* xrow, const float* modb, bf16* orow, int lane) {
    const f32x4* xr = (const f32x4*)xrow + lane;
    f32x4 v[4]; float s = 0.f;
#pragma unroll
    for (int j = 0; j < 4; ++j) { v[j] = xr[64 * j]; s += (v[j].x + v[j].y) + (v[j].z + v[j].w); }
    const float mean = wave_sum(s) * (1.f / D); float s2 = 0.f;
#pragma unroll
    for (int j = 0; j < 4; ++j) { v[j] = v[j] - mean; s2 += (v[j].x * v[j].x + v[j].y * v[j].y) + (v[j].z * v[j].z + v[j].w * v[j].w); }
    const float rstd = 1.f / sqrtf(wave_sum(s2) * (1.f / D) + LN_EPS);
    v2u* o8 = (v2u*)orow + lane;
#pragma unroll
    for (int j = 0; j < 4; ++j) {
        const f32x4 sh = *((const f32x4*)modb + lane + 64 * j), sc = *((const f32x4*)(modb + D) + lane + 64 * j);
        const f32x4 r = v[j] * rstd * (sc + 1.f) + sh;
        v2u w; w.x = pk2(r.x, r.y); w.y = pk2(r.z, r.w); o8[64 * j] = w;
    }
}
__device__ __forceinline__ void ln_final_row(float* row, const float* lg, const float* lb, int lane) {
    f32x4* xr = (f32x4*)row + lane;
    f32x4 v[4]; float s = 0.f;
#pragma unroll
    for (int j = 0; j < 4; ++j) { v[j] = xr[64 * j]; s += (v[j].x + v[j].y) + (v[j].z + v[j].w); }
    const float mean = wave_sum(s) * (1.f / D); float s2 = 0.f;
#pragma unroll
    for (int j = 0; j < 4; ++j) { v[j] = v[j] - mean; s2 += (v[j].x * v[j].x + v[j].y * v[j].y) + (v[j].z * v[j].z + v[j].w * v[j].w); }
    const float rstd = 1.f / sqrtf(wave_sum(s2) * (1.f / D) + LN_EPS);
#pragma unroll
    for (int j = 0; j < 4; ++j) { const f32x4 g = *((const f32x4*)lg + lane + 64 * j), b = *((const f32x4*)lb + lane + 64 * j); xr[64 * j] = v[j] * rstd * g + b; }
}

__device__ __forceinline__ void attn_naive_item(const bf16* P, bf16* YA, float* sw  , int row, int h, int lane) {
    float* sq = sw; float* sc = sw + 192;
    const int t = row % S, rb = row - t;
    const float slope = exp2f(-(float)(h + 1));
    const bf16* prow = P + (size_t)row * NIN;
#pragma unroll
    for (int g = 0; g < NG; ++g) sq[g * 64 + lane] = bf2f(prow[(0 * NG + g) * DA + h * HD + lane]);
    LDS_WAIT(); asm volatile("" ::: "memory");
    float mx = -INFINITY;
#pragma unroll
    for (int g = 0; g < NG; ++g) {
        const int dil = (g == 0) ? 1 : (g == 1 ? 4 : 16);
        const int kcol = (1 * NG + g) * DA + h * HD;
        for (int pass = 0; pass < 3; ++pass) {
            const int jj = pass * 64 + lane;
            if (jj <= 128) {
                const int j = jj - 64, tk = t + j * dil;
                float s = -INFINITY;
                if (tk >= 0 && tk < S) {
                    const v4u* kr = (const v4u*)(P + (size_t)(rb + tk) * NIN + kcol);
                    float a = 0.f;
#pragma unroll
                    for (int e = 0; e < 8; ++e) { const v4u kv = kr[e]; const float* q = sq + g * 64 + 8 * e;
                        a = fmaf(q[0], blo(kv.x), a); a = fmaf(q[1], bhi(kv.x), a); a = fmaf(q[2], blo(kv.y), a); a = fmaf(q[3], bhi(kv.y), a);
                        a = fmaf(q[4], blo(kv.z), a); a = fmaf(q[5], bhi(kv.z), a); a = fmaf(q[6], blo(kv.w), a); a = fmaf(q[7], bhi(kv.w), a); }
                    s = a * 0.125f - slope * (float)((j < 0 ? -j : j) * dil);
                }
                sc[g * 132 + jj] = s;
                mx = fmaxf(mx, s);
            }
        }
    }
    mx = wave_max(mx);
    float sum = 0.f;
#pragma unroll
    for (int g = 0; g < NG; ++g)
        for (int pass = 0; pass < 3; ++pass) {
            const int jj = pass * 64 + lane;
            if (jj <= 128) { const float s = sc[g * 132 + jj]; const float p = (s == -INFINITY) ? 0.f : expf(s - mx); sc[g * 132 + jj] = p; sum += p; }
        }
    sum = wave_sum(sum);
    LDS_WAIT(); asm volatile("" ::: "memory");
    float o = 0.f;
#pragma unroll
    for (int g = 0; g < NG; ++g) {
        const int dil = (g == 0) ? 1 : (g == 1 ? 4 : 16);
        const int vcol = (2 * NG + g) * DA + h * HD + lane;
        for (int jj = 0; jj <= 128; ++jj) {
            const int tk = t + (jj - 64) * dil;
            if (tk >= 0 && tk < S) o = fmaf(sc[g * 132 + jj], bf2f(P[(size_t)(rb + tk) * NIN + vcol]), o);
        }
    }
    o /= sum;
    const float ga = bf2f(prow[OFF_GA + h * HD + lane]);
    YA[(size_t)row * DA + h * HD + lane] = (bf16)f2bf(o * siluf_(ga));
    LDS_WAIT(); asm volatile("" ::: "memory");
}
typedef short bf16x8_t __attribute__((ext_vector_type(8)));
typedef float f32x16_t __attribute__((ext_vector_type(16)));
struct LCG {
    static constexpr int NI = 32 / CH, NCT = 128 / NI, TPW = NCT / NWAVES;
    static constexpr int PADZ = (2 * NI - 2) * 16, ZSTRIDE = 4096 + 2 * PADZ;
    static constexpr int GC_STRIDE = 16416, ZB_OFF = 4 * GC_STRIDE, LDS_END = ZB_OFF + CH * ZSTRIDE * 2;
};
static_assert(LCG::TPW >= 1 && LCG::LDS_END <= RING_BYTES, "long-conv LDS map");
constexpr int UT_ROWS = 4 * DHY;

__device__ __forceinline__ void lc_stage_R(LAS unsigned char* lds, const bf16* Rg, int tid) {
#pragma unroll
    for (int it = 0; it < 2; ++it) {
        const int k = tid + it * NTHREADS;
        const v4u cur = *(const v4u*)(Rg + 8 * k);
        v4u prv = (v4u){0u, 0u, 0u, 0u}; if (k > 0) prv = *(const v4u*)(Rg + 8 * k - 8);
        *(LAS v4u*)(lds + 0 * LCG::GC_STRIDE + 16 * k) = cur;
        v4u s1; s1.x = __builtin_amdgcn_alignbit(cur.x, prv.w, 16); s1.y = __builtin_amdgcn_alignbit(cur.y, cur.x, 16); s1.z = __builtin_amdgcn_alignbit(cur.z, cur.y, 16); s1.w = __builtin_amdgcn_alignbit(cur.w, cur.z, 16);
        *(LAS v4u*)(lds + 1 * LCG::GC_STRIDE + 16 * k) = s1;
        v4u s2; s2.x = prv.w; s2.y = cur.x; s2.z = cur.y; s2.w = cur.z;
        *(LAS v4u*)(lds + 2 * LCG::GC_STRIDE + 16 * k) = s2;
        v4u s3; s3.x = __builtin_amdgcn_alignbit(prv.w, prv.z, 16); s3.y = __builtin_amdgcn_alignbit(cur.x, prv.w, 16); s3.z = __builtin_amdgcn_alignbit(cur.y, cur.x, 16); s3.w = __builtin_amdgcn_alignbit(cur.z, cur.y, 16);
        *(LAS v4u*)(lds + 3 * LCG::GC_STRIDE + 16 * k) = s3;
    }
}
__device__ __forceinline__ void lc_mma(LAS unsigned char* lds, f32x16_t (&acc)[LCG::TPW], int wave, int lane) {
    const int r = lane & 31, h = lane >> 5, kap = (r + 1) & 3, b = r / LCG::NI, ii = r % LCG::NI;
    const int baseA = kap * LCG::GC_STRIDE + 2 * (4095 - r + 8 * h + kap);
    int baseB[LCG::TPW], dlo[LCG::TPW], dhi[LCG::TPW];
#pragma unroll
    for (int k = 0; k < LCG::TPW; ++k) { const int i0 = LCG::NI * (wave * LCG::TPW + k);
        baseB[k] = LCG::ZB_OFF + 2 * (b * LCG::ZSTRIDE + LCG::PADZ + 32 * (i0 + ii) + 8 * h); dlo[k] = 2 * i0 - 255; dhi[k] = 2 * i0 + 2 * LCG::NI - 2;
        acc[k] = (f32x16_t){0.f, 0.f, 0.f, 0.f, 0.f, 0.f, 0.f, 0.f, 0.f, 0.f, 0.f, 0.f, 0.f, 0.f, 0.f, 0.f}; }
    const int d0 = dlo[0], d1 = dhi[LCG::TPW - 1];
#pragma unroll 2
    for (int d = d0; d <= d1; ++d) {
        const v2u a0 = *(const LAS v2u*)(lds + baseA - 32 * d), a1 = *(const LAS v2u*)(lds + baseA - 32 * d + 8);
        const v4u av = (v4u){a0.x, a0.y, a1.x, a1.y};
        const bf16x8_t A = __builtin_bit_cast(bf16x8_t, av);
#pragma unroll
        for (int k = 0; k < LCG::TPW; ++k)
            if (LCG::TPW == 1 || (d >= dlo[k] && d <= dhi[k])) {
                const v4u bv = *(const LAS v4u*)(lds + baseB[k] - 32 * d);
                acc[k] = __builtin_amdgcn_mfma_f32_32x32x16_bf16(A, __builtin_bit_cast(bf16x8_t, bv), acc[k], 0, 0, 0);
            }
    }
}
__device__ __forceinline__ void longconv_mfma_unit(LAS unsigned char* lds, const bf16* UT, const bf16* Rl, const float* fb, bf16* YHT, int c, int tid_) {
    const int tid = tid_, lane = tid & 63, wave = __builtin_amdgcn_readfirstlane(tid >> 6);
    const int r = lane & 31, h = lane >> 5, b = r / LCG::NI, ii = r % LCG::NI;
    for (int k = tid; k < CH * 512; k += NTHREADS) { const int bb = k >> 9, s8 = (k & 511) * 8;
        *(LAS v4u*)(lds + LCG::ZB_OFF + 2 * (bb * LCG::ZSTRIDE + LCG::PADZ + s8)) = *(const v4u*)(UT + (size_t)c * MC + bb * S + s8); }
    for (int k = tid; k < CH * 2 * (LCG::PADZ / 8); k += NTHREADS) { const int bb = k / (2 * (LCG::PADZ / 8)), q = k % (2 * (LCG::PADZ / 8));
        const int e = (q < LCG::PADZ / 8) ? q * 8 : LCG::PADZ + 4096 + (q - LCG::PADZ / 8) * 8;
        *(LAS v4u*)(lds + LCG::ZB_OFF + 2 * (bb * LCG::ZSTRIDE + e)) = (v4u){0u, 0u, 0u, 0u}; }
    lc_stage_R(lds, Rl + (size_t)(0 * DHY + c) * 8192, tid);
    __syncthreads();
    f32x16_t acc[LCG::TPW];
    lc_mma(lds, acc, wave, lane);
    v2u zn[LCG::TPW][4];
    { const float bias0 = fb[c];
#pragma unroll
      for (int k = 0; k < LCG::TPW; ++k) { const int i = LCG::NI * (wave * LCG::TPW + k) + ii;
#pragma unroll
        for (int q = 0; q < 4; ++q) { const int t = 32 * i + 8 * q + 4 * h;
            const v2u zo = *(const LAS v2u*)(lds + LCG::ZB_OFF + 2 * (b * LCG::ZSTRIDE + LCG::PADZ + t));
            const v2u x1 = *(const v2u*)(UT + (size_t)(DHY + c) * MC + b * S + t);
            const float y0 = blo(x1.x) * (acc[k][4 * q + 0] + bias0 * blo(zo.x)), y1 = bhi(x1.x) * (acc[k][4 * q + 1] + bias0 * bhi(zo.x));
            const float y2 = blo(x1.y) * (acc[k][4 * q + 2] + bias0 * blo(zo.y)), y3 = bhi(x1.y) * (acc[k][4 * q + 3] + bias0 * bhi(zo.y));
            zn[k][q].x = pk2(y0, y1); zn[k][q].y = pk2(y2, y3); } } }
    __syncthreads();
#pragma unroll
    for (int k = 0; k < LCG::TPW; ++k) { const int i = LCG::NI * (wave * LCG::TPW + k) + ii;
#pragma unroll
        for (int q = 0; q < 4; ++q) *(LAS v2u*)(lds + LCG::ZB_OFF + 2 * (b * LCG::ZSTRIDE + LCG::PADZ + 32 * i + 8 * q + 4 * h)) = zn[k][q]; }
    lc_stage_R(lds, Rl + (size_t)(1 * DHY + c) * 8192, tid);
    __syncthreads();
    lc_mma(lds, acc, wave, lane);
    { const float bias1 = fb[DHY + c];
#pragma unroll
      for (int k = 0; k < LCG::TPW; ++k) { const int i = LCG::NI * (wave * LCG::TPW + k) + ii;
#pragma unroll
        for (int q = 0; q < 4; ++q) { const int t = 32 * i + 8 * q + 4 * h;
            const v2u zo = *(const LAS v2u*)(lds + LCG::ZB_OFF + 2 * (b * LCG::ZSTRIDE + LCG::PADZ + t));
            const v2u x2 = *(const v2u*)(UT + (size_t)(2 * DHY + c) * MC + b * S + t);
            const v2u sg = *(const v2u*)(UT + (size_t)(3 * DHY + c) * MC + b * S + t);
            const float y0 = blo(sg.x) * blo(x2.x) * (acc[k][4 * q + 0] + bias1 * blo(zo.x)), y1 = bhi(sg.x) * bhi(x2.x) * (acc[k][4 * q + 1] + bias1 * bhi(zo.x));
            const float y2 = blo(sg.y) * blo(x2.y) * (acc[k][4 * q + 2] + bias1 * blo(zo.y)), y3 = bhi(sg.y) * bhi(x2.y) * (acc[k][4 * q + 3] + bias1 * bhi(zo.y));
            v2u o; o.x = pk2(y0, y1); o.y = pk2(y2, y3);
            *(v2u*)(YHT + (size_t)c * MC + b * S + t) = o; } } }
    __syncthreads();
}
__device__ __forceinline__ void hyena_prep_tile(unsigned char* lds, const bf16* P, const float* cw, const float* cb, bf16* UT, int tile, int tid) {
    constexpr int TS = 72;
    const int tr = tile / (UT_ROWS / 64), tc = tile % (UT_ROWS / 64), row0 = tr * 64, c0 = tc * 64;
    bf16* T = (bf16*)lds;
    { const int rr = tid >> 3, seg = tid & 7, row = row0 + rr, t = row % S, cc = c0 + 8 * seg;
      float o[8];
      if (c0 < 3 * DHY) {
          const v4u w0 = *(const v4u*)(P + (size_t)row * NIN + OFF_HY + cc);
          v4u wm = (v4u){0u, 0u, 0u, 0u}, wp = (v4u){0u, 0u, 0u, 0u};
          if (t > 0) wm = *(const v4u*)(P + (size_t)(row - 1) * NIN + OFF_HY + cc);
          if (t < S - 1) wp = *(const v4u*)(P + (size_t)(row + 1) * NIN + OFF_HY + cc);
          const unsigned am[4] = {wm.x, wm.y, wm.z, wm.w}, a0[4] = {w0.x, w0.y, w0.z, w0.w}, ap[4] = {wp.x, wp.y, wp.z, wp.w};
#pragma unroll
          for (int j = 0; j < 4; ++j) { const int c = cc + 2 * j;
              o[2 * j] = cw[c] * blo(am[j]) + cw[3 * DHY + c] * blo(a0[j]) + cw[6 * DHY + c] * blo(ap[j]) + cb[c];
              o[2 * j + 1] = cw[c + 1] * bhi(am[j]) + cw[3 * DHY + c + 1] * bhi(a0[j]) + cw[6 * DHY + c + 1] * bhi(ap[j]) + cb[c + 1]; }
      } else {
          const v4u w0 = *(const v4u*)(P + (size_t)row * NIN + OFF_GH + (cc - 3 * DHY));
          const unsigned a0[4] = {w0.x, w0.y, w0.z, w0.w};
#pragma unroll
          for (int j = 0; j < 4; ++j) { o[2 * j] = siluf_(blo(a0[j])); o[2 * j + 1] = siluf_(bhi(a0[j])); }
      }
#pragma unroll
      for (int j = 0; j < 8; ++j) T[(8 * seg + j) * TS + rr] = (bf16)f2bf(o[j]); }
    __syncthreads();
    { const int chn = tid >> 3, sg = tid & 7;
      *(v4u*)(UT + (size_t)(c0 + chn) * MC + row0 + 8 * sg) = *(const v4u*)(T + chn * TS + 8 * sg); }
    __syncthreads();
}
__device__ __forceinline__ void hyena_post_tile(unsigned char* lds, const bf16* YHT, bf16* YH, int tile, int tid) {
    constexpr int TS = 72;
    const int tr = tile / (DHY / 64), tc = tile % (DHY / 64), row0 = tr * 64, c0 = tc * 64;
    bf16* T = (bf16*)lds;
    { const int chn = tid >> 3, sg = tid & 7;
      const v4u w = *(const v4u*)(YHT + (size_t)(c0 + chn) * MC + row0 + 8 * sg);
      const unsigned a[4] = {w.x, w.y, w.z, w.w};
#pragma unroll
      for (int j = 0; j < 4; ++j) { T[(8 * sg + 2 * j) * TS + chn] = (bf16)(a[j] & 0xffffu); T[(8 * sg + 2 * j + 1) * TS + chn] = (bf16)(a[j] >> 16); } }
    __syncthreads();
    { const int rr = tid >> 3, seg = tid & 7;
      *(v4u*)(YH + (size_t)(row0 + rr) * DHY + c0 + 8 * seg) = *(const v4u*)(T + rr * TS + 8 * seg); }
    __syncthreads();
}

#if MK_CHECK
__device__ __forceinline__ void longconv_check_item(const bf16* Zrow  , const bf16* Rrow  , const bf16* Xrow, const bf16* SGrow, float bias, bf16* Orow, int b, int tb, int lane) {
    const int t = tb * 64 + lane;
    const bf16* z = Zrow + (size_t)b * S; const bf16* g = Rrow + 4095 - t;
    float y = 0.f;
    for (int s0 = 0; s0 < S; s0 += 8) {
#pragma unroll
        for (int j = 0; j < 8; ++j) y = fmaf(bf2f(g[s0 + j]), bf2f(z[s0 + j]), y);
    }
    float v = bf2f(Xrow[(size_t)b * S + t]) * (y + bias * bf2f(z[t]));
    if (SGrow) v *= bf2f(SGrow[(size_t)b * S + t]);
    Orow[(size_t)b * S + t] = (bf16)f2bf(v);
}
#endif
struct Args { const float* in[23]; float* out; unsigned char* ws; int pad0, pad1; };
#ifndef PG8_SP2
#define PG8_SP2 true
#endif
#ifndef PG8_ALIGN
#define PG8_ALIGN true
#endif
#ifndef PHM
#define PHM 0xFF
#endif
__global__ void __launch_bounds__(NTHREADS, 2) mk_fwd(Args args) {
    extern __shared__ __attribute__((aligned(16))) unsigned char lds[];
    cg::grid_group grid = cg::this_grid();
    Ctx C; C.lds = lds; C.tid = threadIdx.x; C.lane = C.tid & 63; C.wave = __builtin_amdgcn_readfirstlane(C.tid >> 6);
    C.G = gridDim.x; C.gw = blockIdx.x * NWAVES + C.wave; C.NGW = C.G * NWAVES;
    unsigned char* ws = args.ws;
    const float* const* in = args.in;
    float* out = args.out;
    bf16* Hb = (bf16*)(ws + WS_H); bf16* Pb = (bf16*)(ws + WS_P); bf16* UT = (bf16*)(ws + WS_UT); bf16* YHT = (bf16*)(ws + WS_YHT);
    bf16* YA = (bf16*)(ws + WS_YA); bf16* YH = (bf16*)(ws + WS_YH); bf16* MG = Hb;
    const float* MOD = (const float*)(ws + WS_MOD); const bf16* Rg = (const bf16*)(ws + WS_R);
    float* ERR = (float*)ws;
    if (MK_CHECK && blockIdx.x == 0 && threadIdx.x == 0) { ERR[0] = 0.f; ERR[1] = 0.f; }
    PG8_LAS unsigned char* ldsl = (PG8_LAS unsigned char*)lds;

    if (PHM & 1) p0_prologue(C, in, ws);
    grid.sync();

    int pend_l = -1, pend_ch = 0;
    for (int l = 0; l < DEPTH; ++l) {
        const float* xin = (l == 0) ? in[0] : out;
        for (int ch = 0; ch < NCHUNK; ++ch) {
            const float* xc = xin + (size_t)ch * MC * D; float* oc = out + (size_t)ch * MC * D;
            { int ln_ = threadIdx.x & 63; asm volatile("" : "+v"(ln_));
            if (pend_l >= 0) { float* pr = out + (size_t)pend_ch * MC * D;
                for (int m = C.gw; m < MC; m += C.NGW) ln_final_row(pr + (size_t)m * D, in[21] + (size_t)pend_l * D, in[22] + (size_t)pend_l * D, ln_); }
            for (int m = C.gw; m < MC; m += C.NGW) ln_mod_row(xc + (size_t)m * D, MOD + ((size_t)l * NB + ch * CH + m / S) * 3 * D, Hb + (size_t)m * D, ln_); }
            grid.sync();
            if (PHM & 2) { pg8::Gemm g{Hb, (const bf16*)(ws + WS_WIN) + (size_t)l * NIN * D, MC, NIN, D}; pg8::StaticOrder So; So.init(MC, NIN, C.G, (int)blockIdx.x);
              pg8::EpiBf16<0> E{Pb, NIN, in[5] + (size_t)l * NIN, 0, 0, 1.f};
              pg8::gemm_phase<pg8::EpiBf16<0>, pg8::StaticOrder, PG8_ALIGN, PG8_SP2>(ldsl, g, So, E); }
            grid.sync();
            if (PHM & 4) { float* sw = (float*)(lds + C.wave * 2560); int ln_ = threadIdx.x & 63; asm volatile("" : "+v"(ln_));
              for (int it = C.gw; it < MC * NH; it += C.NGW) attn_naive_item(Pb, YA, sw, it / NH, it % NH, ln_);
              __syncthreads();
              int tid_ = threadIdx.x; asm volatile("" : "+v"(tid_));
              for (int tile = blockIdx.x; tile < (MC / 64) * (UT_ROWS / 64); tile += C.G) hyena_prep_tile(lds, Pb, in[6] + (size_t)l * 9 * DHY, in[7] + (size_t)l * 3 * DHY, UT, tile, tid_); }
            grid.sync();
            if (PHM & 8) { int tid_ = threadIdx.x; asm volatile("" : "+v"(tid_));
              for (int c = blockIdx.x; c < DHY; c += C.G) longconv_mfma_unit(ldsl, UT, Rg + (size_t)l * 2 * DHY * 8192, in[16] + (size_t)l * 2 * DHY, YHT, c, tid_); }
#if MK_CHECK
            { bf16* Z1T = (bf16*)(ws + WS_Z1T); bf16* YHTR = (bf16*)(ws + WS_YHTR); int ln_ = threadIdx.x & 63; asm volatile("" : "+v"(ln_));
              for (int it = C.gw; it < DHY * CH * 64; it += C.NGW) { const int c = it / (CH * 64), b = (it / 64) % CH, tb = it % 64;
                  longconv_check_item(UT + (size_t)c * MC, Rg + ((size_t)(l * 2 + 0) * DHY + c) * 8192, UT + (size_t)(DHY + c) * MC, nullptr, in[16][(size_t)l * 2 * DHY + c], Z1T + (size_t)c * MC, b, tb, ln_); }
              grid.sync();
              for (int it = C.gw; it < DHY * CH * 64; it += C.NGW) { const int c = it / (CH * 64), b = (it / 64) % CH, tb = it % 64;
                  longconv_check_item(Z1T + (size_t)c * MC, Rg + ((size_t)(l * 2 + 1) * DHY + c) * 8192, UT + (size_t)(2 * DHY + c) * MC, UT + (size_t)(3 * DHY + c) * MC, in[16][(size_t)l * 2 * DHY + DHY + c], YHTR + (size_t)c * MC, b, tb, ln_); }
              grid.sync();
              float e0 = 0.f, e1 = 0.f;
              { int tq_ = threadIdx.x; asm volatile("" : "+v"(tq_));
              for (int i = blockIdx.x * NTHREADS + tq_; i < DHY * MC; i += C.G * NTHREADS) { const float a = bf2f(YHT[i]), r = bf2f(YHTR[i]); e0 += (a - r) * (a - r); e1 += r * r; } }
              e0 = wave_sum(e0); e1 = wave_sum(e1);
              if (ln_ == 0) { atomicAdd(ERR + 0, e0); atomicAdd(ERR + 1, e1); }
              YHT = YHTR; }
#endif
            grid.sync();
            if (PHM & 16) { int tid_ = threadIdx.x; asm volatile("" : "+v"(tid_));
              for (int tile = blockIdx.x; tile < (MC / 64) * (DHY / 64); tile += C.G) hyena_post_tile(lds, YHT, YH, tile, tid_); }
#if MK_CHECK
            YHT = (bf16*)(ws + WS_YHT);
#endif
            grid.sync();
            if (PHM & 32) { pg8::StaticOrder So; So.init(MC, D, C.G, (int)blockIdx.x);
              { pg8::Gemm g{YA, (const bf16*)(ws + WS_WPA) + (size_t)l * D * DA, MC, D, DA}; pg8::EpiMerge<false> E{MG, D, Pb + OFF_RA, NIN};
                pg8::gemm_phase<pg8::EpiMerge<false>, pg8::StaticOrder, PG8_ALIGN, PG8_SP2>(ldsl, g, So, E); }
              { pg8::Gemm g{YH, (const bf16*)(ws + WS_WPH) + (size_t)l * D * DHY, MC, D, DHY}; pg8::EpiMerge<true> E{MG, D, Pb + OFF_RH, NIN};
                pg8::gemm_phase<pg8::EpiMerge<true>, pg8::StaticOrder, PG8_ALIGN, PG8_SP2>(ldsl, g, So, E); } }
            grid.sync();
            if (PHM & 64) { pg8::Gemm g{MG, (const bf16*)(ws + WS_WOUT) + (size_t)l * D * D, MC, D, D}; pg8::StaticOrder So; So.init(MC, D, C.G, (int)blockIdx.x);
              pg8::EpiRes E{xc, oc, D, in[20] + (size_t)l * D, MOD + ((size_t)l * NB + ch * CH) * 3 * D + 2 * D, S / 256, 3 * D, DN_ALPHA};
              pg8::gemm_phase<pg8::EpiRes, pg8::StaticOrder, PG8_ALIGN, PG8_SP2>(ldsl, g, So, E); }
            grid.sync();
            pend_l = l; pend_ch = ch;
        }
    }
    { float* pr = out + (size_t)pend_ch * MC * D;
      for (int m = C.gw; m < MC; m += C.NGW) ln_final_row(pr + (size_t)m * D, in[21] + (size_t)pend_l * D, in[22] + (size_t)pend_l * D, C.lane); }
#if MK_CHECK
    grid.sync();
    { const float e0 = __hip_atomic_load(ERR + 0, __ATOMIC_RELAXED, __HIP_MEMORY_SCOPE_AGENT), e1 = __hip_atomic_load(ERR + 1, __ATOMIC_RELAXED, __HIP_MEMORY_SCOPE_AGENT);
      const float f = 1.f + CHECK_K * sqrtf(e0 / fmaxf(e1, 1e-30f));
      int tq_ = threadIdx.x; asm volatile("" : "+v"(tq_));
      for (int i = blockIdx.x * NTHREADS + tq_; i < NB * S * D; i += C.G * NTHREADS) out[i] *= f; }
#endif
}

extern "C" void kernel_launch(void* const* d_in, const int* in_sizes, int n_in, void* d_out, int out_size, void* d_ws, size_t ws_size, hipStream_t stream) {
    static int grid = 0;
    if (grid == 0) {
        if (n_in != 23 || out_size != NB * S * D || ws_size < WS_END) { fprintf(stderr, "kernel_launch: unexpected shapes (n_in %d, out %d, ws %zu, need %zu); nothing launched\n", n_in, out_size, ws_size, (size_t)WS_END); grid = -1; return; }
        int dev = 0, cus = 0, per_cu = 0;
        if (hipGetDevice(&dev) != hipSuccess || hipDeviceGetAttribute(&cus, hipDeviceAttributeMultiprocessorCount, dev) != hipSuccess) { fprintf(stderr, "kernel_launch: device query failed\n"); grid = -1; return; }
        if (hipFuncSetAttribute((const void*)mk_fwd, hipFuncAttributeMaxDynamicSharedMemorySize, LDS_BYTES) != hipSuccess) { fprintf(stderr, "kernel_launch: hipFuncSetAttribute failed\n"); grid = -1; return; }
        if (hipOccupancyMaxActiveBlocksPerMultiprocessor(&per_cu, (const void*)mk_fwd, NTHREADS, LDS_BYTES) != hipSuccess || per_cu < 1) { fprintf(stderr, "kernel_launch: occupancy query says %d blocks per CU\n", per_cu); grid = -1; return; }
        grid = cus;
        fprintf(stderr, "kernel_launch: grid %d (cus %d, per_cu %d), ws %zu MiB\n", grid, cus, per_cu, ws_size >> 20);
    }
    if (grid < 0) return;
    Args a{};
    for (int i = 0; i < 23; ++i) a.in[i] = (const float*)d_in[i];
    a.out = (float*)d_out; a.ws = (unsigned char*)d_ws;
    void* kargs[] = {&a};
    const hipError_t e = hipLaunchCooperativeKernel((const void*)mk_fwd, dim3(grid), dim3(NTHREADS), kargs, LDS_BYTES, stream);
    if (e != hipSuccess) fprintf(stderr, "kernel_launch: cooperative launch failed: %s (grid %d)\n", hipGetErrorString(e), grid);
}
```

```cpp
#include <hip/hip_runtime.h>
#include <hip/hip_cooperative_groups.h>
#include <cstdio>
#include <cstdint>
#include <cmath>
namespace cg = cooperative_groups;
namespace pg8 {
#define PG8_LAS __attribute__((address_space(3)))
typedef unsigned short bf16_t;
typedef short bf16x8 __attribute__((ext_vector_type(8)));
typedef float f32x4 __attribute__((ext_vector_type(4)));
typedef unsigned u32x4 __attribute__((ext_vector_type(4)));
constexpr int BM = 256, BK = 64, HALF = 128, HTB = HALF * BK * 2  , STAGE_BYTES = 8 * HTB, NXCD = 8, WGM = 8;

__host__ __device__ __forceinline__ int lds_byte(int r, int c) { const int st = (r >> 4) * 2 + (c >> 5), rr = r & 15, cc = c & 31, ob = rr * 64 + cc * 2; return st * 1024 + (ob ^ (((ob >> 9) & 1) << 5)); }
__host__ __device__ __forceinline__ void stage_rc(int b, int& R, int& C) { const int st = b / 1024, sb = b % 1024, swz = sb ^ (((sb >> 9) & 1) << 5); R = (st >> 1) * 16 + swz / 64; C = (st & 1) * 32 + (swz % 64) / 2; }
__host__ __device__ __forceinline__ int perm32(int rho) { const int n = rho >> 4, i = rho & 15; return 8 * (i >> 2) + 4 * n + (i & 3); }

struct Unit { int pm, pn; };
struct Gemm { const bf16_t* A; const bf16_t* Bt; int M, N, K; };

struct StaticOrder {
    int nM, nN, nwg, G, c;
    __host__ __device__ void init(int M, int N, int G_, int c_) { nM = M / BM; nN = N / BM; nwg = nM * nN; G = G_; c = c_; }
    __host__ __device__ bool next(int i, Unit& u) const {
        const long L = (long)i * G + c; if (L >= nwg) return false;
        int wgid = (int)L; { const int q = nwg / NXCD, r = nwg % NXCD, xcd = wgid % NXCD, off = wgid / NXCD; wgid = (xcd < r ? xcd * (q + 1) : r * (q + 1) + (xcd - r) * q) + off; }
        const int nig = WGM * nN, gid = wgid / nig, fm = gid * WGM, gsz = (nM - fm) < WGM ? (nM - fm) : WGM;
        u.pm = fm + ((wgid % nig) % gsz); u.pn = (wgid % nig) / gsz; return true;
    }
    __device__ __forceinline__ void a_ready(const Unit&) const {}
    __device__ __forceinline__ void done(const Unit&) const {}
};

__device__ __forceinline__ unsigned cvt_pk_bf16(float lo, float hi) { unsigned r; asm volatile("v_cvt_pk_bf16_f32 %0, %1, %2" : "=v"(r) : "v"(lo), "v"(hi)); return r; }
typedef float f32x2 __attribute__((ext_vector_type(2)));
__device__ __forceinline__ f32x2 gelu_pk(f32x2 v) {
    const f32x2 av = __builtin_elementwise_abs(v), d = av * 0.2316418882f + 1.0f;
    f32x2 t; t.x = __builtin_amdgcn_rcpf(d.x); t.y = __builtin_amdgcn_rcpf(d.y);
    f32x2 q = t * 0.5307027145f + (-0.7265760135f); q = q * t + 0.7107068705f; q = q * t + (-0.142248368f); q = q * t + 0.127414796f; q = q * t;
    const f32x2 s = (v * v) * (-0.72134752044f);
    f32x2 e; e.x = __builtin_amdgcn_exp2f(s.x); e.y = __builtin_amdgcn_exp2f(s.y);
    const f32x2 m = v * (q * e), r = v - m;
    f32x2 o; o.x = v.x < 0.f ? m.x : r.x; o.y = v.y < 0.f ? m.y : r.y; return o;
}

template <int ACT  > struct EpiBf16 {
    static constexpr bool PERM = true, AFTER_DRAIN = false; static_assert(ACT == 0 || ACT == 1, "EpiBf16: ACT is 0 (none) or 1 (gelu_pk)");
    bf16_t* O; int ldc; const float* bias; int split_cols; size_t split_stride; float scale0;
    __device__ __forceinline__ void operator()(const f32x4 (&acc)[2][2][4][2], const Unit& u, int wr, int wc, int fr, int fq) const {
        const int row0 = u.pm * BM + wr * 64 + fr; int colt = u.pn * BM; bf16_t* base = O;
        float sc = 1.f; if (split_cols) { const int t = colt / split_cols; base += (size_t)t * split_stride; colt -= t * split_cols; if (t == 0) sc = scale0; }
        const int col0 = colt + wc * 32 + 8 * fq, bcol0 = u.pn * BM + wc * 32 + 8 * fq;
        f32x4 bv[2][2];
#pragma unroll
        for (int bj = 0; bj < 2; ++bj)
#pragma unroll
            for (int n = 0; n < 2; ++n) bv[bj][n] = bias ? *(const f32x4*)(bias + bcol0 + bj * HALF + 4 * n) : (f32x4){0.f, 0.f, 0.f, 0.f};
#pragma unroll
        for (int ai = 0; ai < 2; ++ai)
#pragma unroll
            for (int m = 0; m < 4; ++m) { bf16_t* rowp = base + (size_t)(row0 + ai * HALF + m * 16) * ldc + col0;
#pragma unroll
                for (int bj = 0; bj < 2; ++bj) { f32x4 v0 = acc[ai][bj][m][0] + bv[bj][0], v1 = acc[ai][bj][m][1] + bv[bj][1];
                    if (ACT == 1) { f32x2 a = gelu_pk((f32x2){v0[0], v0[1]}), b = gelu_pk((f32x2){v0[2], v0[3]}), c = gelu_pk((f32x2){v1[0], v1[1]}), d = gelu_pk((f32x2){v1[2], v1[3]});
                        v0 = (f32x4){a.x, a.y, b.x, b.y}; v1 = (f32x4){c.x, c.y, d.x, d.y}; }
                    v0 = v0 * sc; v1 = v1 * sc; u32x4 w; w.x = cvt_pk_bf16(v0[0], v0[1]); w.y = cvt_pk_bf16(v0[2], v0[3]); w.z = cvt_pk_bf16(v1[0], v1[1]); w.w = cvt_pk_bf16(v1[2], v1[3]);
                    *(u32x4*)(rowp + bj * HALF) = w; } }
    }
};
__device__ __forceinline__ float bf_lo(unsigned w) { return __uint_as_float(w << 16); }
__device__ __forceinline__ float bf_hi(unsigned w) { return __uint_as_float(w & 0xffff0000u); }
__device__ __forceinline__ float sigm(float x) { return 1.f / (1.f + __expf(-x)); }
template <bool ACCUM> struct EpiMerge {
    static constexpr bool PERM = true, AFTER_DRAIN = false;
    bf16_t* O; int ldc; const bf16_t* Gt; int ldg;
    __device__ __forceinline__ void operator()(const f32x4 (&acc)[2][2][4][2], const Unit& u, int wr, int wc, int fr, int fq) const {
        const int row0 = u.pm * BM + wr * 64 + fr, col0 = u.pn * BM + wc * 32 + 8 * fq;
#pragma unroll
        for (int ai = 0; ai < 2; ++ai)
#pragma unroll
            for (int m = 0; m < 4; ++m) { const size_t row = (size_t)(row0 + ai * HALF + m * 16);
#pragma unroll
                for (int bj = 0; bj < 2; ++bj) { const int col = col0 + bj * HALF;
                    const u32x4 g = *(const u32x4*)(Gt + row * ldg + col);
                    const f32x4 v0 = acc[ai][bj][m][0], v1 = acc[ai][bj][m][1];
                    float r[8];
                    r[0] = sigm(bf_lo(g.x)) * v0[0]; r[1] = sigm(bf_hi(g.x)) * v0[1]; r[2] = sigm(bf_lo(g.y)) * v0[2]; r[3] = sigm(bf_hi(g.y)) * v0[3];
                    r[4] = sigm(bf_lo(g.z)) * v1[0]; r[5] = sigm(bf_hi(g.z)) * v1[1]; r[6] = sigm(bf_lo(g.w)) * v1[2]; r[7] = sigm(bf_hi(g.w)) * v1[3];
                    bf16_t* op = O + row * ldc + col;
                    if (ACCUM) { const u32x4 o = *(const u32x4*)op;
                        r[0] += bf_lo(o.x); r[1] += bf_hi(o.x); r[2] += bf_lo(o.y); r[3] += bf_hi(o.y); r[4] += bf_lo(o.z); r[5] += bf_hi(o.z); r[6] += bf_lo(o.w); r[7] += bf_hi(o.w); }
                    u32x4 w; w.x = cvt_pk_bf16(r[0], r[1]); w.y = cvt_pk_bf16(r[2], r[3]); w.z = cvt_pk_bf16(r[4], r[5]); w.w = cvt_pk_bf16(r[6], r[7]);
                    *(u32x4*)op = w; } }
    }
};
struct EpiRes {
    static constexpr bool PERM = false, AFTER_DRAIN = false;
    const float* xin; float* out; int ldc; const float* bias; const float* gate0; int tiles_per_batch; int gate_stride; float alpha;
    __device__ __forceinline__ void operator()(const f32x4 (&acc)[2][2][4][2], const Unit& u, int wr, int wc, int fr, int fq) const {
        const int col0 = u.pn * BM + wc * 32 + 4 * fq;
        const float* gate = gate0 + (size_t)(u.pm / tiles_per_batch) * gate_stride;
#pragma unroll
        for (int bj = 0; bj < 2; ++bj)
#pragma unroll
            for (int n = 0; n < 2; ++n) { const int col = col0 + bj * HALF + n * 16;
                const f32x4 bv = *(const f32x4*)(bias + col), gv = *(const f32x4*)(gate + col);
#pragma unroll
                for (int ai = 0; ai < 2; ++ai)
#pragma unroll
                    for (int m = 0; m < 4; ++m) { const size_t off = (size_t)(u.pm * BM + ai * HALF + wr * 64 + m * 16 + fr) * ldc + col;
                        const f32x4 xv = *(const f32x4*)(xin + off);
                        *(f32x4*)(out + off) = xv * alpha + gv * (acc[ai][bj][m][n] + bv); } }
    }
};
template <class Epi, class Sched, bool ALIGN_EPI = false, bool SP2 = false>
__device__ __forceinline__ void gemm_phase(PG8_LAS unsigned char* lds, const Gemm g, const Sched& S, const Epi& E) {
    int tid_ = threadIdx.x; asm volatile("" : "+v"(tid_));
    const int tid = tid_, wid = __builtin_amdgcn_readfirstlane(tid >> 6), lane = tid & 63, wr = wid >> 2, wc = wid & 3, fr = lane & 15, fq = lane >> 4;
    const int K = g.K, nt = K / BK;
    unsigned voffA[2], voffB[2];
#pragma unroll
    for (int i = 0; i < 2; ++i) { int R, C; stage_rc(tid * 16 + i * 8192, R, C); const int Rb = Epi::PERM ? ((R & ~31) + perm32(R & 31)) : R;
        voffA[i] = (unsigned)(R * K + C) * 2u; voffB[i] = (unsigned)(Rb * K + C) * 2u; }
    const size_t kstep = (size_t)(BK * 2);
    const size_t hstep = (size_t)HALF * K * 2;
    const size_t tstep = 2 * hstep;
    const unsigned ldsw = (unsigned)wid * 1024u;
    const int aoff = lds_byte(wr * 64 + fr, fq * 8), boff = lds_byte(wc * 32 + fr, fq * 8);
#define PG8_SA(b, h) (((b) * 2 + (h)) * HTB)
#define PG8_SB(b, h) ((4 + (b) * 2 + (h)) * HTB)
#define PG8_STAGE(bufoff, gbase, voff) do { _Pragma("unroll") for (int _i = 0; _i < 2; ++_i) \
        __builtin_amdgcn_global_load_lds((const unsigned*)((const char*)(gbase) + (voff)[_i]), (PG8_LAS unsigned*)(lds + (bufoff) + ldsw + _i * 8192), 16, 0, 0); } while (0)
#define PG8_LDA(dst, b, h) do { _Pragma("unroll") for (int m = 0; m < 4; ++m) _Pragma("unroll") for (int k = 0; k < 2; ++k) dst[m][k] = *(const PG8_LAS bf16x8*)(lds + PG8_SA(b, h) + aoff + m * 2048 + k * 1024); } while (0)
#define PG8_LDB(dst, b, h) do { _Pragma("unroll") for (int n = 0; n < 2; ++n) _Pragma("unroll") for (int k = 0; k < 2; ++k) dst[n][k] = *(const PG8_LAS bf16x8*)(lds + PG8_SB(b, h) + boff + n * 2048 + k * 1024); } while (0)
#define PG8_MMA(ai, bj, At, Bt) do { __builtin_amdgcn_s_setprio(1); _Pragma("unroll") for (int m = 0; m < 4; ++m) _Pragma("unroll") for (int n = 0; n < 2; ++n) _Pragma("unroll") for (int k = 0; k < 2; ++k) \
        acc[ai][bj][m][n] = __builtin_amdgcn_mfma_f32_16x16x32_bf16(Bt[n][k], At[m][k], acc[ai][bj][m][n], 0, 0, 0); __builtin_amdgcn_s_setprio(0); } while (0)
#define PG8_WAIT_V(n) asm volatile("s_waitcnt vmcnt(" #n ")" ::: "memory")
#define PG8_WAIT_L(n) asm volatile("s_waitcnt lgkmcnt(" #n ")" ::: "memory")
#define PG8_BAR __builtin_amdgcn_s_barrier()
#define PG8_SCHED __builtin_amdgcn_sched_barrier(0)
    Unit cur, nxt; int ui = 0;
    if (!S.next(0, cur)) return;
    f32x4 acc[2][2][4][2];
#pragma unroll
    for (int a = 0; a < 2; ++a)
#pragma unroll
        for (int b = 0; b < 2; ++b)
#pragma unroll
            for (int m = 0; m < 4; ++m)
#pragma unroll
                for (int n = 0; n < 2; ++n) acc[a][b][m][n] = (f32x4){0.f, 0.f, 0.f, 0.f};
    bf16x8 At[4][2], B0[2][2], B1[2][2];
    const char* cA = (const char*)g.A + (size_t)cur.pm * tstep; const char* cB = (const char*)g.Bt + (size_t)cur.pn * tstep;
    S.a_ready(cur);
    if constexpr (SP2) {
        PG8_STAGE(PG8_SB(0, 0), cB, voffB); PG8_STAGE(PG8_SB(0, 1), cB + hstep, voffB); PG8_STAGE(PG8_SA(0, 0), cA, voffA); PG8_STAGE(PG8_SA(0, 1), cA + hstep, voffA);
        if (wr == 1) PG8_BAR;
        PG8_WAIT_V(2); PG8_BAR;
        PG8_STAGE(PG8_SB(1, 0), cB + kstep, voffB); PG8_STAGE(PG8_SA(1, 0), cA + kstep, voffA); PG8_STAGE(PG8_SB(1, 1), cB + hstep + kstep, voffB);
        PG8_WAIT_V(6); PG8_BAR;
    } else {
        PG8_STAGE(PG8_SB(0, 0), cB, voffB); PG8_STAGE(PG8_SA(0, 0), cA, voffA); PG8_STAGE(PG8_SB(0, 1), cB + hstep, voffB); PG8_STAGE(PG8_SA(0, 1), cA + hstep, voffA);
        if (wr == 1) PG8_BAR;
        PG8_WAIT_V(4); PG8_BAR;
        PG8_STAGE(PG8_SB(1, 0), cB + kstep, voffB); PG8_STAGE(PG8_SA(1, 0), cA + kstep, voffA); PG8_STAGE(PG8_SB(1, 1), cB + hstep + kstep, voffB);
        PG8_WAIT_V(6); PG8_BAR;
    }
    for (;;) {
        const bool has_next = S.next(ui + 1, nxt);
        const char* nA = has_next ? (const char*)g.A + (size_t)nxt.pm * tstep : cA; const char* nB = has_next ? (const char*)g.Bt + (size_t)nxt.pn * tstep : cB;
        for (int t = 0; t < nt; t += 2) {
            const bool last = (t == nt - 2);
            const char* a1 = cA + (size_t)(t + 1) * kstep;
            const char* a2 = last ? nA : cA + (size_t)(t + 2) * kstep; const char* b2 = last ? nB : cB + (size_t)(t + 2) * kstep;
            const char* a3 = a2 + kstep; const char* b3 = b2 + kstep;
            if (last && has_next) S.a_ready(nxt);
            if constexpr (SP2) {
            PG8_LDB(B0, 0, 0); PG8_LDB(B1, 0, 1); PG8_SCHED; PG8_LDA(At, 0, 0); PG8_STAGE(PG8_SA(1, 1), a1 + hstep, voffA);
            PG8_WAIT_V(8); PG8_WAIT_L(0); PG8_BAR; PG8_MMA(0, 0, At, B0); PG8_MMA(0, 1, At, B1); PG8_BAR; PG8_SCHED;
            PG8_LDA(At, 0, 1); PG8_STAGE(PG8_SB(0, 0), b2, voffB); PG8_STAGE(PG8_SB(0, 1), b2 + hstep, voffB); PG8_STAGE(PG8_SA(0, 0), a2, voffA);
            PG8_WAIT_V(8); PG8_WAIT_L(0); PG8_BAR; PG8_MMA(1, 0, At, B0); PG8_MMA(1, 1, At, B1); PG8_BAR; PG8_SCHED;
            PG8_LDB(B0, 1, 0); PG8_LDB(B1, 1, 1); PG8_SCHED; PG8_LDA(At, 1, 0); PG8_STAGE(PG8_SA(0, 1), a2 + hstep, voffA);
            PG8_WAIT_V(8); PG8_WAIT_L(0); PG8_BAR; PG8_MMA(0, 0, At, B0); PG8_MMA(0, 1, At, B1); PG8_BAR; PG8_SCHED;
            PG8_LDA(At, 1, 1); PG8_STAGE(PG8_SB(1, 0), b3, voffB); PG8_STAGE(PG8_SB(1, 1), b3 + hstep, voffB); PG8_STAGE(PG8_SA(1, 0), a3, voffA);
            PG8_WAIT_V(8); PG8_WAIT_L(0); PG8_BAR; PG8_MMA(1, 0, At, B0); PG8_MMA(1, 1, At, B1); PG8_BAR; PG8_SCHED;
            } else {
            PG8_LDB(B0, 0, 0); PG8_SCHED; PG8_LDA(At, 0, 0); PG8_STAGE(PG8_SA(1, 1), a1 + hstep, voffA);
            PG8_WAIT_L(8); PG8_BAR; PG8_WAIT_L(0); PG8_MMA(0, 0, At, B0); PG8_BAR; PG8_SCHED;
            PG8_LDB(B1, 0, 1); PG8_STAGE(PG8_SB(0, 0), b2, voffB);
            PG8_BAR; PG8_WAIT_L(0); PG8_MMA(0, 1, At, B1); PG8_BAR;
            PG8_LDA(At, 0, 1); PG8_STAGE(PG8_SA(0, 0), a2, voffA);
            PG8_BAR; PG8_WAIT_L(0); PG8_MMA(1, 0, At, B0); PG8_BAR; PG8_SCHED;
            PG8_STAGE(PG8_SB(0, 1), b2 + hstep, voffB);
            PG8_WAIT_V(6); PG8_BAR; PG8_MMA(1, 1, At, B1); PG8_BAR;
            PG8_LDB(B0, 1, 0); PG8_SCHED; PG8_LDA(At, 1, 0); PG8_STAGE(PG8_SA(0, 1), a2 + hstep, voffA);
            PG8_WAIT_L(8); PG8_BAR; PG8_WAIT_L(0); PG8_MMA(0, 0, At, B0); PG8_BAR; PG8_SCHED;
            PG8_LDB(B1, 1, 1); PG8_STAGE(PG8_SB(1, 0), b3, voffB);
            PG8_BAR; PG8_WAIT_L(0); PG8_MMA(0, 1, At, B1); PG8_BAR;
            PG8_LDA(At, 1, 1); PG8_STAGE(PG8_SA(1, 0), a3, voffA);
            PG8_BAR; PG8_WAIT_L(0); PG8_MMA(1, 0, At, B0); PG8_BAR; PG8_SCHED;
            PG8_STAGE(PG8_SB(1, 1), b3 + hstep, voffB);
            PG8_WAIT_V(6); PG8_BAR; PG8_MMA(1, 1, At, B1); PG8_BAR;
            }
        }
        if constexpr (ALIGN_EPI) { if (wr == 0) PG8_BAR; }
        if constexpr (!Epi::AFTER_DRAIN) { E(acc, cur, wr, wc, fr, fq); S.done(cur); }
        if (!has_next) break;
#pragma unroll
        for (int a = 0; a < 2; ++a)
#pragma unroll
            for (int b = 0; b < 2; ++b)
#pragma unroll
                for (int m = 0; m < 4; ++m)
#pragma unroll
                    for (int n = 0; n < 2; ++n) acc[a][b][m][n] = (f32x4){0.f, 0.f, 0.f, 0.f};
        cur = nxt; cA = nA; cB = nB; ++ui;
        if constexpr (ALIGN_EPI) { if (wr == 1) PG8_BAR; }
    }
    PG8_WAIT_V(0);
    if constexpr (!ALIGN_EPI) { if (wr == 0) PG8_BAR; }
    PG8_BAR;
    if constexpr (Epi::AFTER_DRAIN) { E.fused(acc, cur, wr, wc, fr, fq, lds, wid, lane); S.done(cur); }
#undef PG8_SA
#undef PG8_SB
#undef PG8_STAGE
#undef PG8_LDA
#undef PG8_LDB
#undef PG8_MMA
#undef PG8_WAIT_V
#undef PG8_WAIT_L
#undef PG8_BAR
#undef PG8_SCHED
}
}
constexpr int D = 1024, NB = 8, S = 4096, DEPTH = 2;
constexpr int HD = 64, DA = 512, NH = 8, NG = 3, DHY = 512, NIN = 9216;
constexpr int FE = 33, FW = 64;
constexpr int OFF_GA = 4608, OFF_HY = 5120, OFF_GH = 6656, OFF_RA = 7168, OFF_RH = 8192;
constexpr float LN_EPS = 1e-5f, DN_ALPHA = 1.41421356237309515f;
constexpr int CH = 2, NCHUNK = NB / CH, MC = CH * S;
constexpr int NWAVES = 8, NTHREADS = NWAVES * 64;
constexpr int GLEN = 2 * S - 1;

constexpr size_t MiB = 1u << 20;
constexpr size_t WS_WIN = 1 * MiB;
constexpr size_t WS_WPA = WS_WIN + (size_t)DEPTH * NIN * D * 2;
constexpr size_t WS_WPH = WS_WPA + (size_t)DEPTH * D * DA * 2;
constexpr size_t WS_WOUT = WS_WPH + (size_t)DEPTH * D * DHY * 2;
constexpr size_t WS_MOD = WS_WOUT + (size_t)DEPTH * D * D * 2;
constexpr size_t WS_R = WS_MOD + 1 * MiB;
constexpr size_t WS_H = WS_R + (size_t)DEPTH * 2 * DHY * 8192 * 2;
constexpr size_t WS_P = WS_H + (size_t)MC * D * 2;
constexpr size_t WS_UT = WS_P + (size_t)MC * NIN * 2;
constexpr size_t WS_YHT = WS_UT + (size_t)MC * 4 * DHY * 2;
constexpr size_t WS_YA = WS_YHT + (size_t)MC * DHY * 2;
constexpr size_t WS_YH = WS_YA + (size_t)MC * DA * 2;
constexpr size_t WS_Z1T = WS_YH + (size_t)MC * DHY * 2;
constexpr size_t WS_YHTR = WS_Z1T + (size_t)MC * DHY * 2;
constexpr size_t WS_OG = WS_YHTR + (size_t)MC * DHY * 2;
constexpr size_t WS_ML = WS_OG + (size_t)3 * MC * DA * 2;
constexpr size_t WS_YAR = WS_ML + (size_t)3 * MC * NH * 8;
constexpr size_t WS_END = WS_YAR + (size_t)MC * DA * 2;
#ifndef MK_CHECK
#define MK_CHECK 0
#endif
constexpr float CHECK_K = 30.f;

constexpr int LDS_BYTES = 147456;
constexpr int RING_BYTES = 131072;

#define LAS __attribute__((address_space(3)))
typedef unsigned short bf16;
typedef unsigned v4u __attribute__((ext_vector_type(4)));
typedef unsigned v2u __attribute__((ext_vector_type(2)));
typedef float f32x4 __attribute__((ext_vector_type(4)));
#define LDS_WAIT() asm volatile("s_waitcnt lgkmcnt(0)" ::: "memory")
__device__ __forceinline__ unsigned f2bf(float f) { unsigned u = __builtin_bit_cast(unsigned, f); return (u + 0x7fffu + ((u >> 16) & 1u)) >> 16; }
__device__ __forceinline__ unsigned pk2(float lo, float hi) { return f2bf(lo) | (f2bf(hi) << 16); }
__device__ __forceinline__ float bf2f(unsigned short h) { return __uint_as_float((unsigned)h << 16); }
__device__ __forceinline__ float blo(unsigned w) { return __uint_as_float(w << 16); }
__device__ __forceinline__ float bhi(unsigned w) { return __uint_as_float(w & 0xffff0000u); }
__device__ __forceinline__ float wave_sum(float v) {
#pragma unroll
    for (int o = 1; o < 64; o <<= 1) v += __shfl_xor(v, o);
    return v;
}
__device__ __forceinline__ float wave_max(float v) {
#pragma unroll
    for (int o = 1; o < 64; o <<= 1) v = fmaxf(v, __shfl_xor(v, o));
    return v;
}
__device__ __forceinline__ float siluf_(float x) { return x / (1.f + expf(-x)); }
__device__ __forceinline__ void sincos_cw(float x, float& sn, float& cs) {
    const float j = rintf(x * 0.63661977236758134f);
    float y = fmaf(-j, 1.5703125f, x);
    y = fmaf(-j, 4.837512969970703125e-4f, y);
    y = fmaf(-j, 7.54978995489188216e-8f, y);
    const float z = y * y;
    const float sp = fmaf(fmaf(fmaf(-1.9515295891e-4f, z, 8.3321608736e-3f), z, -1.6666654611e-1f) * z, y, y);
    const float cp = fmaf(fmaf(fmaf(2.443315711809948e-5f, z, -1.388731625493765e-3f), z, 4.166664568298827e-2f), z * z, fmaf(-0.5f, z, 1.0f));
    const int q = ((int)j) & 3;
    const float s0 = (q & 1) ? cp : sp, c0 = (q & 1) ? sp : cp;
    sn = (q & 2) ? -s0 : s0;
    cs = ((q + 1) & 2) ? -c0 : c0;
}
__device__ __forceinline__ float sin_cw(float x) { float s, c; sincos_cw(x, s, c); return s; }

struct Ctx {
    unsigned char* lds;
    int tid, lane, wave, gw, NGW, G;
};

__device__ __forceinline__ void p0_transpose_item(const float* W, int K, int N, bf16* WT, float* scr, int item, int lane) {
    const int nblk = N / 32, kb = item / nblk, nb = item % nblk, k0 = 64 * kb, n0 = 32 * nb;
#pragma unroll 8
    for (int i = 0; i < 32; ++i) { const int kk = 2 * i + (lane >> 5); scr[kk * 33 + (lane & 31)] = W[(size_t)(k0 + kk) * N + n0 + (lane & 31)]; }
    LDS_WAIT(); asm volatile("" ::: "memory");
    const int c = lane & 7;
#pragma unroll
    for (int j = 0; j < 4; ++j) { const int n = (lane >> 3) + 8 * j; const float* s = scr + (8 * c) * 33 + n;
        v4u o; o.x = pk2(s[0 * 33], s[1 * 33]); o.y = pk2(s[2 * 33], s[3 * 33]); o.z = pk2(s[4 * 33], s[5 * 33]); o.w = pk2(s[6 * 33], s[7 * 33]);
        *(v4u*)(WT + (size_t)(n0 + n) * K + k0 + 8 * c) = o; }
    LDS_WAIT(); asm volatile("" ::: "memory");
}
__device__ __forceinline__ void p0_filter_unit(const float* const* in, bf16* R, float* sf  , int unit, int lane) {
    const float* w1 = in[8]; const float* b1 = in[9]; const float* w2 = in[10]; const float* b2 = in[11];
    const float* w3 = in[12]; const float* b3 = in[13]; const float* w4 = in[14]; const float* freq = in[15];
    const int l = unit / 256, tb = (unit >> 2) & 63, nq = unit & 3;
    float* H3s = sf + 256;
    const float fr = freq[l * FW + lane];
    for (int k = 0; k < 64; ++k) {
        const int t = 64 * tb + k;
        if (lane < FE) {
            float v;
            if (lane == 0) v = (float)t / (float)(S - 1);
            else {
                const int q = (lane - 1) & 15;
                const double f = (double)(1e-4f) + (double)q * (((double)15.0f - (double)1e-4f) / 15.0);
                double u = f * (double)t / (double)S; u -= rint(u);
                float sn, cs; sincos_cw((float)(u * 6.283185307179586476925), sn, cs);
                v = (lane <= 16) ? cs : -sn;
            }
            sf[lane] = v;
        }
        LDS_WAIT(); asm volatile("" ::: "memory");
        float a = b1[l * FW + lane];
        for (int kk = 0; kk < FE; ++kk) a = fmaf(sf[kk], w1[(l * FE + kk) * FW + lane], a);
        sf[64 + lane] = sin_cw(fr * a);
        LDS_WAIT(); asm volatile("" ::: "memory");
        a = b2[l * FW + lane];
        for (int kk = 0; kk < FW; ++kk) a = fmaf(sf[64 + kk], w2[(l * FW + kk) * FW + lane], a);
        sf[128 + lane] = sin_cw(fr * a);
        LDS_WAIT(); asm volatile("" ::: "memory");
        a = b3[l * FW + lane];
        for (int kk = 0; kk < FW; ++kk) a = fmaf(sf[128 + kk], w3[(l * FW + kk) * FW + lane], a);
        H3s[k * 65 + lane] = sin_cw(fr * a);
        LDS_WAIT(); asm volatile("" ::: "memory");
    }
    float hr[64];
#pragma unroll
    for (int j = 0; j < 64; ++j) hr[j] = H3s[lane * 65 + j];
    const int t = 64 * tb + lane, o = nq >> 1, dir = nq & 1;
    const float tt = (float)t / (float)(S - 1);
    const float d0 = -4.605170185988091f / 1.5f, d1 = -4.605170185988091f / 0.3f;
    const float* w4n = w4 + (size_t)l * FW * (4 * DHY) + nq * DHY;
    const int x = dir ? ((t == 0) ? 8191 : 4095 + t) : 4095 - t;
    bf16* Rb = R + ((size_t)(l * 2 + o) * DHY) * 8192 + x;
    for (int c = 0; c < DHY; ++c) {
        float acc = 0.f;
#pragma unroll
        for (int j = 0; j < 64; ++j) acc = fmaf(hr[j], w4n[(size_t)j * 4 * DHY + c], acc);
        const float delta = d0 + (d1 - d0) * ((float)c / (float)(DHY - 1));
        float val = acc * expf(-tt * fabsf(delta));
        if (dir == 1 && t == 0) val = 0.f;
        Rb[(size_t)c * 8192] = (bf16)f2bf(val);
    }
    LDS_WAIT(); asm volatile("" ::: "memory");
}
__device__ __forceinline__ void p0_prologue(const Ctx& C, const float* const* in, unsigned char* ws) {
    float* scr = (float*)(C.lds + C.wave * 17920);
    constexpr int I_IN = (D / 64) * (NIN / 32), I_PA = (DA / 64) * (D / 32), I_PH = (DHY / 64) * (D / 32), I_OUT = (D / 64) * (D / 32);
    constexpr int I_L = I_IN + I_PA + I_PH + I_OUT;
    for (int it = C.gw; it < DEPTH * I_L; it += C.NGW) {
        const int l = it / I_L; int r = it % I_L;
        if (r < I_IN) { p0_transpose_item(in[4] + (size_t)l * D * NIN, D, NIN, (bf16*)(ws + WS_WIN) + (size_t)l * NIN * D, scr, r, C.lane); continue; } r -= I_IN;
        if (r < I_PA) { p0_transpose_item(in[17] + (size_t)l * DA * D, DA, D, (bf16*)(ws + WS_WPA) + (size_t)l * D * DA, scr, r, C.lane); continue; } r -= I_PA;
        if (r < I_PH) { p0_transpose_item(in[18] + (size_t)l * DHY * D, DHY, D, (bf16*)(ws + WS_WPH) + (size_t)l * D * DHY, scr, r, C.lane); continue; } r -= I_PH;
        p0_transpose_item(in[19] + (size_t)l * D * D, D, D, (bf16*)(ws + WS_WOUT) + (size_t)l * D * D, scr, r, C.lane);
    }
    {
        float* mod = (float*)(ws + WS_MOD);
        const float* c = in[1]; const float* w_ada = in[2]; const float* b_ada = in[3];
        for (int idx = blockIdx.x * NTHREADS + C.tid; idx < DEPTH * NB * 3 * D; idx += C.G * NTHREADS) {
            const int n = idx % (3 * D), b = (idx / (3 * D)) % NB, l = idx / (3 * D * NB);
            const float* w = w_ada + (size_t)l * D * 3 * D + n; const float* cb = c + b * D;
            float acc = 0.f;
            for (int k = 0; k < D; ++k) acc = fmaf(cb[k], w[(size_t)k * 3 * D], acc);
            mod[idx] = acc + b_ada[l * 3 * D + n];
        }
    }
    for (int it = C.gw; it < DEPTH * 256; it += C.NGW) p0_filter_unit(in, (bf16*)(ws + WS_R), scr, it, C.lane);
}

__device__ __forceinline__ void ln_mod_row(const float* xrow, const float* modb, bf16* orow, int lane) {
    const f32x4* xr = (const f32x4*)xrow + lane;
    f32x4 v[4]; float s = 0.f;
#pragma unroll
    for (int j = 0; j < 4; ++j) { v[j] = xr[64 * j]; s += (v[j].x + v[j].y) + (v[j].z + v[j].w); }
    const float mean = wave_sum(s) * (1.f / D); float s2 = 0.f;
#pragma unroll
    for (int j = 0; j < 4; ++j) { v[j] = v[j] - mean; s2 += (v[j].x * v[j].x + v[j].y * v[j].y) + (v[j].z * v[j].z + v[j].w * v[j].w); }
    const float rstd = 1.f / sqrtf(wave_sum(s2) * (1.f / D) + LN_EPS);
    v2u* o8 = (v2u*)orow + lane;
#pragma unroll
    for (int j = 0; j < 4; ++j) {
        const f32x4 sh = *((const f32x4*)modb + lane + 64 * j), sc = *((const f32x4*)(modb + D) + lane + 64 * j);
        const f32x4 r = v[j] * rstd * (sc + 1.f) + sh;
        v2u w; w.x = pk2(r.x, r.y); w.y = pk2(r.z, r.w); o8[64 * j] = w;
    }
}
__device__ __forceinline__ void ln_final_row(float* row, const float* lg, const float* lb, int lane) {
    f32x4* xr = (f32x4*)row + lane;
    f32x4 v[4]; float s = 0.f;
#pragma unroll
    for (int j = 0; j < 4; ++j) { v[j] = xr[64 * j]; s += (v[j].x + v[j].y) + (v[j].z + v[j].w); }
    const float mean = wave_sum(s) * (1.f / D); float s2 = 0.f;
#pragma unroll
    for (int j = 0; j < 4; ++j) { v[j] = v[j] - mean; s2 += (v[j].x * v[j].x + v[j].y * v[j].y) + (v[j].z * v[j].z + v[j].w * v[j].w); }
    const float rstd = 1.f / sqrtf(wave_sum(s2) * (1.f / D) + LN_EPS);
#pragma unroll
    for (int j = 0; j < 4; ++j) { const f32x4 g = *((const f32x4*)lg + lane + 64 * j), b = *((const f32x4*)lb + lane + 64 * j); xr[64 * j] = v[j] * rstd * g + b; }
}

__device__ __forceinline__ void attn_naive_item(const bf16* P, bf16* YA, float* sw  , int row, int h, int lane) {
    float* sq = sw; float* sc = sw + 192;
    const int t = row % S, rb = row - t;
    const float slope = exp2f(-(float)(h + 1));
    const bf16* prow = P + (size_t)row * NIN;
#pragma unroll
    for (int g = 0; g < NG; ++g) sq[g * 64 + lane] = bf2f(prow[(0 * NG + g) * DA + h * HD + lane]);
    LDS_WAIT(); asm volatile("" ::: "memory");
    float mx = -INFINITY;
#pragma unroll
    for (int g = 0; g < NG; ++g) {
        const int dil = (g == 0) ? 1 : (g == 1 ? 4 : 16);
        const int kcol = (1 * NG + g) * DA + h * HD;
        for (int pass = 0; pass < 3; ++pass) {
            const int jj = pass * 64 + lane;
            if (jj <= 128) {
                const int j = jj - 64, tk = t + j * dil;
                float s = -INFINITY;
                if (tk >= 0 && tk < S) {
                    const v4u* kr = (const v4u*)(P + (size_t)(rb + tk) * NIN + kcol);
                    float a = 0.f;
#pragma unroll
                    for (int e = 0; e < 8; ++e) { const v4u kv = kr[e]; const float* q = sq + g * 64 + 8 * e;
                        a = fmaf(q[0], blo(kv.x), a); a = fmaf(q[1], bhi(kv.x), a); a = fmaf(q[2], blo(kv.y), a); a = fmaf(q[3], bhi(kv.y), a);
                        a = fmaf(q[4], blo(kv.z), a); a = fmaf(q[5], bhi(kv.z), a); a = fmaf(q[6], blo(kv.w), a); a = fmaf(q[7], bhi(kv.w), a); }
                    s = a * 0.125f - slope * (float)((j < 0 ? -j : j) * dil);
                }
                sc[g * 132 + jj] = s;
                mx = fmaxf(mx, s);
            }
        }
    }
    mx = wave_max(mx);
    float sum = 0.f;
#pragma unroll
    for (int g = 0; g < NG; ++g)
        for (int pass = 0; pass < 3; ++pass) {
            const int jj = pass * 64 + lane;
            if (jj <= 128) { const float s = sc[g * 132 + jj]; const float p = (s == -INFINITY) ? 0.f : expf(s - mx); sc[g * 132 + jj] = p; sum += p; }
        }
    sum = wave_sum(sum);
    LDS_WAIT(); asm volatile("" ::: "memory");
    float o = 0.f;
#pragma unroll
    for (int g = 0; g < NG; ++g) {
        const int dil = (g == 0) ? 1 : (g == 1 ? 4 : 16);
        const int vcol = (2 * NG + g) * DA + h * HD + lane;
        for (int jj = 0; jj <= 128; ++jj) {
            const int tk = t + (jj - 64) * dil;
            if (tk >= 0 && tk < S) o = fmaf(sc[g * 132 + jj], bf2f(P[(size_t)(rb + tk) * NIN + vcol]), o);
        }
    }
    o /= sum;
    const float ga = bf2f(prow[OFF_GA + h * HD + lane]);
    YA[(size_t)row * DA + h * HD + lane] = (bf16)f2bf(o * siluf_(ga));
    LDS_WAIT(); asm volatile("" ::: "memory");
}
typedef short bf16x8_t __attribute__((ext_vector_type(8)));
typedef float f32x16_t __attribute__((ext_vector_type(16)));
struct LCG {
    static constexpr int NI = 32 / CH, NCT = 128 / NI, TPW = NCT / NWAVES;
    static constexpr int PADZ = (2 * NI - 2) * 16, ZSTRIDE = 4096 + 2 * PADZ;
    static constexpr int GC_STRIDE = 16416, ZB_OFF = 4 * GC_STRIDE, LDS_END = ZB_OFF + CH * ZSTRIDE * 2;
};
static_assert(LCG::TPW >= 1 && LCG::LDS_END <= RING_BYTES, "long-conv LDS map");
constexpr int UT_ROWS = 4 * DHY;

__device__ __forceinline__ void lc_stage_R(LAS unsigned char* lds, const bf16* Rg, int tid) {
#pragma unroll
    for (int it = 0; it < 2; ++it) {
        const int k = tid + it * NTHREADS;
        const v4u cur = *(const v4u*)(Rg + 8 * k);
        v4u prv = (v4u){0u, 0u, 0u, 0u}; if (k > 0) prv = *(const v4u*)(Rg + 8 * k - 8);
        *(LAS v4u*)(lds + 0 * LCG::GC_STRIDE + 16 * k) = cur;
        v4u s1; s1.x = __builtin_amdgcn_alignbit(cur.x, prv.w, 16); s1.y = __builtin_amdgcn_alignbit(cur.y, cur.x, 16); s1.z = __builtin_amdgcn_alignbit(cur.z, cur.y, 16); s1.w = __builtin_amdgcn_alignbit(cur.w, cur.z, 16);
        *(LAS v4u*)(lds + 1 * LCG::GC_STRIDE + 16 * k) = s1;
        v4u s2; s2.x = prv.w; s2.y = cur.x; s2.z = cur.y; s2.w = cur.z;
        *(LAS v4u*)(lds + 2 * LCG::GC_STRIDE + 16 * k) = s2;
        v4u s3; s3.x = __builtin_amdgcn_alignbit(prv.w, prv.z, 16); s3.y = __builtin_amdgcn_alignbit(cur.x, prv.w, 16); s3.z = __builtin_amdgcn_alignbit(cur.y, cur.x, 16); s3.w = __builtin_amdgcn_alignbit(cur.z, cur.y, 16);
        *(LAS v4u*)(lds + 3 * LCG::GC_STRIDE + 16 * k) = s3;
    }
}
__device__ __forceinline__ void lc_mma(LAS unsigned char* lds, f32x16_t (&acc)[LCG::TPW], int wave, int lane) {
    const int r = lane & 31, h = lane >> 5, kap = (r + 1) & 3, b = r / LCG::NI, ii = r % LCG::NI;
    const int baseA = kap * LCG::GC_STRIDE + 2 * (4095 - r + 8 * h + kap);
    int baseB[LCG::TPW], dlo[LCG::TPW], dhi[LCG::TPW];
#pragma unroll
    for (int k = 0; k < LCG::TPW; ++k) { const int i0 = LCG::NI * (wave * LCG::TPW + k);
        baseB[k] = LCG::ZB_OFF + 2 * (b * LCG::ZSTRIDE + LCG::PADZ + 32 * (i0 + ii) + 8 * h); dlo[k] = 2 * i0 - 255; dhi[k] = 2 * i0 + 2 * LCG::NI - 2;
        acc[k] = (f32x16_t){0.f, 0.f, 0.f, 0.f, 0.f, 0.f, 0.f, 0.f, 0.f, 0.f, 0.f, 0.f, 0.f, 0.f, 0.f, 0.f}; }
    const int d0 = dlo[0], d1 = dhi[LCG::TPW - 1];
#pragma unroll 2
    for (int d = d0; d <= d1; ++d) {
        const v2u a0 = *(const LAS v2u*)(lds + baseA - 32 * d), a1 = *(const LAS v2u*)(lds + baseA - 32 * d + 8);
        const v4u av = (v4u){a0.x, a0.y, a1.x, a1.y};
        const bf16x8_t A = __builtin_bit_cast(bf16x8_t, av);
#pragma unroll
        for (int k = 0; k < LCG::TPW; ++k)
            if (LCG::TPW == 1 || (d >= dlo[k] && d <= dhi[k])) {
                const v4u bv = *(const LAS v4u*)(lds + baseB[k] - 32 * d);
                acc[k] = __builtin_amdgcn_mfma_f32_32x32x16_bf16(A, __builtin_bit_cast(bf16x8_t, bv), acc[k], 0, 0, 0);
            }
    }
}
__device__ __forceinline__ void longconv_mfma_unit(LAS unsigned char* lds, const bf16* UT, const bf16* Rl, const float* fb, bf16* YHT, int c, int tid_) {
    const int tid = tid_, lane = tid & 63, wave = __builtin_amdgcn_readfirstlane(tid >> 6);
    const int r = lane & 31, h = lane >> 5, b = r / LCG::NI, ii = r % LCG::NI;
    for (int k = tid; k < CH * 512; k += NTHREADS) { const int bb = k >> 9, s8 = (k & 511) * 8;
        *(LAS v4u*)(lds + LCG::ZB_OFF + 2 * (bb * LCG::ZSTRIDE + LCG::PADZ + s8)) = *(const v4u*)(UT + (size_t)c * MC + bb * S + s8); }
    for (int k = tid; k < CH * 2 * (LCG::PADZ / 8); k += NTHREADS) { const int bb = k / (2 * (LCG::PADZ / 8)), q = k % (2 * (LCG::PADZ / 8));
        const int e = (q < LCG::PADZ / 8) ? q * 8 : LCG::PADZ + 4096 + (q - LCG::PADZ / 8) * 8;
        *(LAS v4u*)(lds + LCG::ZB_OFF + 2 * (bb * LCG::ZSTRIDE + e)) = (v4u){0u, 0u, 0u, 0u}; }
    lc_stage_R(lds, Rl + (size_t)(0 * DHY + c) * 8192, tid);
    __syncthreads();
    f32x16_t acc[LCG::TPW];
    lc_mma(lds, acc, wave, lane);
    v2u zn[LCG::TPW][4];
    { const float bias0 = fb[c];
#pragma unroll
      for (int k = 0; k < LCG::TPW; ++k) { const int i = LCG::NI * (wave * LCG::TPW + k) + ii;
#pragma unroll
        for (int q = 0; q < 4; ++q) { const int t = 32 * i + 8 * q + 4 * h;
            const v2u zo = *(const LAS v2u*)(lds + LCG::ZB_OFF + 2 * (b * LCG::ZSTRIDE + LCG::PADZ + t));
            const v2u x1 = *(const v2u*)(UT + (size_t)(DHY + c) * MC + b * S + t);
            const float y0 = blo(x1.x) * (acc[k][4 * q + 0] + bias0 * blo(zo.x)), y1 = bhi(x1.x) * (acc[k][4 * q + 1] + bias0 * bhi(zo.x));
            const float y2 = blo(x1.y) * (acc[k][4 * q + 2] + bias0 * blo(zo.y)), y3 = bhi(x1.y) * (acc[k][4 * q + 3] + bias0 * bhi(zo.y));
            zn[k][q].x = pk2(y0, y1); zn[k][q].y = pk2(y2, y3); } } }
    __syncthreads();
#pragma unroll
    for (int k = 0; k < LCG::TPW; ++k) { const int i = LCG::NI * (wave * LCG::TPW + k) + ii;
#pragma unroll
        for (int q = 0; q < 4; ++q) *(LAS v2u*)(lds + LCG::ZB_OFF + 2 * (b * LCG::ZSTRIDE + LCG::PADZ + 32 * i + 8 * q + 4 * h)) = zn[k][q]; }
    lc_stage_R(lds, Rl + (size_t)(1 * DHY + c) * 8192, tid);
    __syncthreads();
    lc_mma(lds, acc, wave, lane);
    { const float bias1 = fb[DHY + c];
#pragma unroll
      for (int k = 0; k < LCG::TPW; ++k) { const int i = LCG::NI * (wave * LCG::TPW + k) + ii;
#pragma unroll
        for (int q = 0; q < 4; ++q) { const int t = 32 * i + 8 * q + 4 * h;
            const v2u zo = *(const LAS v2u*)(lds + LCG::ZB_OFF + 2 * (b * LCG::ZSTRIDE + LCG::PADZ + t));
            const v2u x2 = *(const v2u*)(UT + (size_t)(2 * DHY + c) * MC + b * S + t);
            const v2u sg = *(const v2u*)(UT + (size_t)(3 * DHY + c) * MC + b * S + t);
            const float y0 = blo(sg.x) * blo(x2.x) * (acc[k][4 * q + 0] + bias1 * blo(zo.x)), y1 = bhi(sg.x) * bhi(x2.x) * (acc[k][4 * q + 1] + bias1 * bhi(zo.x));
            const float y2 = blo(sg.y) * blo(x2.y) * (acc[k][4 * q + 2] + bias1 * blo(zo.y)), y3 = bhi(sg.y) * bhi(x2.y) * (acc[k][4 * q + 3] + bias1 * bhi(zo.y));
            v2u o; o.x = pk2(y0, y1); o.y = pk2(y2, y3);
            *(v2u*)(YHT + (size_t)c * MC + b * S + t) = o; } } }
    __syncthreads();
}
__device__ __forceinline__ void hyena_prep_tile(unsigned char* lds, const bf16* P, const float* cw, const float* cb, bf16* UT, int tile, int tid) {
    constexpr int TS = 72;
    const int tr = tile / (UT_ROWS / 64), tc = tile % (UT_ROWS / 64), row0 = tr * 64, c0 = tc * 64;
    bf16* T = (bf16*)lds;
    { const int rr = tid >> 3, seg = tid & 7, row = row0 + rr, t = row % S, cc = c0 + 8 * seg;
      float o[8];
      if (c0 < 3 * DHY) {
          const v4u w0 = *(const v4u*)(P + (size_t)row * NIN + OFF_HY + cc);
          v4u wm = (v4u){0u, 0u, 0u, 0u}, wp = (v4u){0u, 0u, 0u, 0u};
          if (t > 0) wm = *(const v4u*)(P + (size_t)(row - 1) * NIN + OFF_HY + cc);
          if (t < S - 1) wp = *(const v4u*)(P + (size_t)(row + 1) * NIN + OFF_HY + cc);
          const unsigned am[4] = {wm.x, wm.y, wm.z, wm.w}, a0[4] = {w0.x, w0.y, w0.z, w0.w}, ap[4] = {wp.x, wp.y, wp.z, wp.w};
#pragma unroll
          for (int j = 0; j < 4; ++j) { const int c = cc + 2 * j;
              o[2 * j] = cw[c] * blo(am[j]) + cw[3 * DHY + c] * blo(a0[j]) + cw[6 * DHY + c] * blo(ap[j]) + cb[c];
              o[2 * j + 1] = cw[c + 1] * bhi(am[j]) + cw[3 * DHY + c + 1] * bhi(a0[j]) + cw[6 * DHY + c + 1] * bhi(ap[j]) + cb[c + 1]; }
      } else {
          const v4u w0 = *(const v4u*)(P + (size_t)row * NIN + OFF_GH + (cc - 3 * DHY));
          const unsigned a0[4] = {w0.x, w0.y, w0.z, w0.w};
#pragma unroll
          for (int j = 0; j < 4; ++j) { o[2 * j] = siluf_(blo(a0[j])); o[2 * j + 1] = siluf_(bhi(a0[j])); }
      }
#pragma unroll
      for (int j = 0; j < 8; ++j) T[(8 * seg + j) * TS + rr] = (bf16)f2bf(o[j]); }
    __syncthreads();
    { const int chn = tid >> 3, sg = tid & 7;
      *(v4u*)(UT + (size_t)(c0 + chn) * MC + row0 + 8 * sg) = *(const v4u*)(T + chn * TS + 8 * sg); }
    __syncthreads();
}
__device__ __forceinline__ void hyena_post_tile(unsigned char* lds, const bf16* YHT, bf16* YH, int tile, int tid) {
    constexpr int TS = 72;
    const int tr = tile / (DHY / 64), tc = tile % (DHY / 64), row0 = tr * 64, c0 = tc * 64;
    bf16* T = (bf16*)lds;
    { const int chn = tid >> 3, sg = tid & 7;
      const v4u w = *(const v4u*)(YHT + (size_t)(c0 + chn) * MC + row0 + 8 * sg);
      const unsigned a[4] = {w.x, w.y, w.z, w.w};
#pragma unroll
      for (int j = 0; j < 4; ++j) { T[(8 * sg + 2 * j) * TS + chn] = (bf16)(a[j] & 0xffffu); T[(8 * sg + 2 * j + 1) * TS + chn] = (bf16)(a[j] >> 16); } }
    __syncthreads();
    { const int rr = tid >> 3, seg = tid & 7;
      *(v4u*)(YH + (size_t)(row0 + rr) * DHY + c0 + 8 * seg) = *(const v4u*)(T + rr * TS + 8 * seg); }
    __syncthreads();
}

typedef short v4i16_t __attribute__((ext_vector_type(4)));
constexpr int AT_ROWB = 128;
__device__ __forceinline__ void attn_mfma_unit(const bf16* P, bf16* OG, float* ML, LAS unsigned char* vs, int unit, int lane_) {
    int lane = lane_; asm volatile("" : "+v"(lane));
    int u = unit; const int x = u & 127; u >>= 7; const int hh = u & 7; u >>= 3; const int g = u % 3, bl = u / 3;
    const int dsh = 2 * g, d = 1 << dsh, L = S >> dsh, nqb = L >> 5, r = x / nqb, qb = x % nqb;
    const size_t rowb = (size_t)bl * S;
    const float slope = exp2f(-(float)(hh + 1)) * (float)d;
    const int qcol = (0 * NG + g) * DA + hh * HD, kcol = (1 * NG + g) * DA + hh * HD, vcol = (2 * NG + g) * DA + hh * HD;
    const int n = lane & 31, h2 = lane >> 5;
    const int tq = ((32 * qb + n) << dsh) + r;
    bf16x8_t qf[4];
#pragma unroll
    for (int ks = 0; ks < 4; ++ks) qf[ks] = __builtin_bit_cast(bf16x8_t, *(const v4u*)(P + (rowb + tq) * NIN + qcol + 16 * ks + 8 * h2));
    f32x16_t st[5];
#pragma unroll
    for (int kt = 0; kt < 5; ++kt) {
        int ik = 32 * (qb - 2 + kt) + n; ik = ik < 0 ? 0 : (ik > L - 1 ? L - 1 : ik);
        const bf16* kp = P + (rowb + (size_t)((ik << dsh) + r)) * NIN + kcol + 8 * h2;
        f32x16_t acc = (f32x16_t){0.f, 0.f, 0.f, 0.f, 0.f, 0.f, 0.f, 0.f, 0.f, 0.f, 0.f, 0.f, 0.f, 0.f, 0.f, 0.f};
#pragma unroll
        for (int ks = 0; ks < 4; ++ks) acc = __builtin_amdgcn_mfma_f32_32x32x16_bf16(__builtin_bit_cast(bf16x8_t, *(const v4u*)(kp + 16 * ks)), qf[ks], acc, 0, 0, 0);
        st[kt] = acc;
        asm volatile("" ::: "memory");
    }
    float mx = -INFINITY;
#pragma unroll
    for (int kt = 0; kt < 5; ++kt)
#pragma unroll
        for (int rg = 0; rg < 16; ++rg) {
            const int rho = (rg & 3) + 8 * (rg >> 2) + 4 * h2, rel = 32 * (kt - 2) + rho - n, ikey = 32 * (qb - 2 + kt) + rho;
            const int arel = rel < 0 ? -rel : rel;
            const bool valid = (arel <= 64) && (ikey >= 0) && (ikey < L);
            const float s = valid ? st[kt][rg] * 0.125f - slope * (float)arel : -INFINITY;
            st[kt][rg] = s; mx = fmaxf(mx, s);
        }
    mx = fmaxf(mx, __shfl_xor(mx, 32));
    float ls = 0.f;
#pragma unroll
    for (int kt = 0; kt < 5; ++kt)
#pragma unroll
        for (int rg = 0; rg < 16; ++rg) { const float p = __expf(st[kt][rg] - mx); st[kt][rg] = p; ls += p; }
    ls += __shfl_xor(ls, 32);
    f32x16_t o0 = (f32x16_t){0.f, 0.f, 0.f, 0.f, 0.f, 0.f, 0.f, 0.f, 0.f, 0.f, 0.f, 0.f, 0.f, 0.f, 0.f, 0.f}, o1 = o0;
    const int trow = (lane & 15) >> 2, tcolb = (16 * ((lane >> 4) & 1) + 4 * (lane & 3)) * 2;
#pragma unroll
    for (int kt = 0; kt < 5; ++kt) {
        { int ik = 32 * (qb - 2 + kt) + (lane >> 1); ik = ik < 0 ? 0 : (ik > L - 1 ? L - 1 : ik);
          const bf16* vp = P + (rowb + (size_t)((ik << dsh) + r)) * NIN + vcol + 32 * (lane & 1);
          const v4u w0 = *(const v4u*)(vp), w1 = *(const v4u*)(vp + 8), w2 = *(const v4u*)(vp + 16), w3 = *(const v4u*)(vp + 24);
          LAS unsigned char* wp = vs + (lane >> 1) * AT_ROWB + 64 * (lane & 1);
          *(LAS v4u*)(wp) = w0; *(LAS v4u*)(wp + 16) = w1; *(LAS v4u*)(wp + 32) = w2; *(LAS v4u*)(wp + 48) = w3; }
        LDS_WAIT(); asm volatile("" ::: "memory");
#pragma unroll
        for (int s = 0; s < 2; ++s) {
            v4u pa; pa.x = pk2(st[kt][8 * s + 0], st[kt][8 * s + 1]); pa.y = pk2(st[kt][8 * s + 2], st[kt][8 * s + 3]); pa.z = pk2(st[kt][8 * s + 4], st[kt][8 * s + 5]); pa.w = pk2(st[kt][8 * s + 6], st[kt][8 * s + 7]);
            const bf16x8_t A = __builtin_bit_cast(bf16x8_t, pa);
            LAS unsigned char* tp = vs + (16 * s + 4 * h2 + trow) * AT_ROWB + tcolb;
#pragma unroll
            for (int eh = 0; eh < 2; ++eh) {
                const v4i16_t lo = __builtin_amdgcn_ds_read_tr16_b64_v4i16((LAS v4i16_t*)(tp + 64 * eh));
                const v4i16_t hi = __builtin_amdgcn_ds_read_tr16_b64_v4i16((LAS v4i16_t*)(tp + 64 * eh + 8 * AT_ROWB));
                const bf16x8_t B = (bf16x8_t){lo[0], lo[1], lo[2], lo[3], hi[0], hi[1], hi[2], hi[3]};
                if (eh == 0) o0 = __builtin_amdgcn_mfma_f32_32x32x16_bf16(A, B, o0, 0, 0, 0); else o1 = __builtin_amdgcn_mfma_f32_32x32x16_bf16(A, B, o1, 0, 0, 0);
            }
        }
        LDS_WAIT(); asm volatile("" ::: "memory");
    }
    bf16* og = OG + ((size_t)g * MC + rowb) * DA + hh * HD + n;
#pragma unroll
    for (int rg = 0; rg < 16; ++rg) { const int mq = (rg & 3) + 8 * (rg >> 2) + 4 * h2; const size_t tok = (size_t)(((32 * qb + mq) << dsh) + r);
        og[tok * DA] = (bf16)f2bf(o0[rg]); og[tok * DA + 32] = (bf16)f2bf(o1[rg]); }
    if (h2 == 0) { float* mp = ML + (((size_t)g * MC + rowb + tq) * NH + hh) * 2; mp[0] = mx; mp[1] = ls; }
}
__device__ __forceinline__ void attn_combine(const bf16* P, const bf16* OG, const float* ML, bf16* YA, int G, int tid) {
    for (int idx = blockIdx.x * NTHREADS + tid; idx < MC * (DA / 2); idx += G * NTHREADS) {
        const int row = idx / (DA / 2), col = (idx % (DA / 2)) * 2, hh = col >> 6;
        float m[3], l[3];
#pragma unroll
        for (int g = 0; g < 3; ++g) { const float* mp = ML + (((size_t)g * MC + row) * NH + hh) * 2; m[g] = mp[0]; l[g] = mp[1]; }
        const float M = fmaxf(m[0], fmaxf(m[1], m[2]));
        float a0 = 0.f, a1 = 0.f, den = 0.f;
#pragma unroll
        for (int g = 0; g < 3; ++g) { const float w = __expf(m[g] - M); const unsigned ow = *(const unsigned*)(OG + ((size_t)g * MC + row) * DA + col);
            a0 = fmaf(w, blo(ow), a0); a1 = fmaf(w, bhi(ow), a1); den = fmaf(w, l[g], den); }
        const unsigned gw_ = *(const unsigned*)(P + (size_t)row * NIN + OFF_GA + col);
        const float inv = 1.f / den;
        *(unsigned*)(YA + (size_t)row * DA + col) = pk2(a0 * inv * siluf_(blo(gw_)), a1 * inv * siluf_(bhi(gw_)));
    }
}
#if MK_CHECK
__device__ __forceinline__ void longconv_check_item(const bf16* Zrow  , const bf16* Rrow  , const bf16* Xrow, const bf16* SGrow, float bias, bf16* Orow, int b, int tb, int lane) {
    const int t = tb * 64 + lane;
    const bf16* z = Zrow + (size_t)b * S; const bf16* g = Rrow + 4095 - t;
    float y = 0.f;
    for (int s0 = 0; s0 < S; s0 += 8) {
#pragma unroll
        for (int j = 0; j < 8; ++j) y = fmaf(bf2f(g[s0 + j]), bf2f(z[s0 + j]), y);
    }
    float v = bf2f(Xrow[(size_t)b * S + t]) * (y + bias * bf2f(z[t]));
    if (SGrow) v *= bf2f(SGrow[(size_t)b * S + t]);
    Orow[(size_t)b * S + t] = (bf16)f2bf(v);
}
#endif
struct Args { const float* in[23]; float* out; unsigned char* ws; int pad0, pad1; };
#ifndef PG8_SP2
#define PG8_SP2 true
#endif
#ifndef PG8_ALIGN
#define PG8_ALIGN true
#endif
#ifndef PHM
#define PHM 0xFF
#endif
__global__ void __launch_bounds__(NTHREADS, 2) mk_fwd(Args args) {
    extern __shared__ __attribute__((aligned(16))) unsigned char lds[];
    cg::grid_group grid = cg::this_grid();
    Ctx C; C.lds = lds; C.tid = threadIdx.x; C.lane = C.tid & 63; C.wave = __builtin_amdgcn_readfirstlane(C.tid >> 6);
    C.G = gridDim.x; C.gw = blockIdx.x * NWAVES + C.wave; C.NGW = C.G * NWAVES;
    unsigned char* ws = args.ws;
    const float* const* in = args.in;
    float* out = args.out;
    bf16* Hb = (bf16*)(ws + WS_H); bf16* Pb = (bf16*)(ws + WS_P); bf16* UT = (bf16*)(ws + WS_UT); bf16* YHT = (bf16*)(ws + WS_YHT);
    bf16* YA = (bf16*)(ws + WS_YA); bf16* YH = (bf16*)(ws + WS_YH); bf16* MG = Hb;
    const float* MOD = (const float*)(ws + WS_MOD); const bf16* Rg = (const bf16*)(ws + WS_R);
    float* ERR = (float*)ws;
    if (MK_CHECK && blockIdx.x == 0 && threadIdx.x == 0) { ERR[0] = 0.f; ERR[1] = 0.f; }
    PG8_LAS unsigned char* ldsl = (PG8_LAS unsigned char*)lds;

    if (PHM & 1) p0_prologue(C, in, ws);
    grid.sync();

    int pend_l = -1, pend_ch = 0;
    for (int l = 0; l < DEPTH; ++l) {
        const float* xin = (l == 0) ? in[0] : out;
        for (int ch = 0; ch < NCHUNK; ++ch) {
            const float* xc = xin + (size_t)ch * MC * D; float* oc = out + (size_t)ch * MC * D;
            { int ln_ = threadIdx.x & 63; asm volatile("" : "+v"(ln_));
            if (pend_l >= 0) { float* pr = out + (size_t)pend_ch * MC * D;
                for (int m = C.gw; m < MC; m += C.NGW) ln_final_row(pr + (size_t)m * D, in[21] + (size_t)pend_l * D, in[22] + (size_t)pend_l * D, ln_); }
            for (int m = C.gw; m < MC; m += C.NGW) ln_mod_row(xc + (size_t)m * D, MOD + ((size_t)l * NB + ch * CH + m / S) * 3 * D, Hb + (size_t)m * D, ln_); }
            grid.sync();
            if (PHM & 2) { pg8::Gemm g{Hb, (const bf16*)(ws + WS_WIN) + (size_t)l * NIN * D, MC, NIN, D}; pg8::StaticOrder So; So.init(MC, NIN, C.G, (int)blockIdx.x);
              pg8::EpiBf16<0> E{Pb, NIN, in[5] + (size_t)l * NIN, 0, 0, 1.f};
              pg8::gemm_phase<pg8::EpiBf16<0>, pg8::StaticOrder, PG8_ALIGN, PG8_SP2>(ldsl, g, So, E); }
            grid.sync();
            if (PHM & 4) { float* sw = (float*)(lds + C.wave * 2560); int ln_ = threadIdx.x & 63; asm volatile("" : "+v"(ln_));
              if (MK_CHECK == 2) { for (int it = C.gw; it < MC * NH; it += C.NGW) attn_naive_item(Pb, (bf16*)(ws + WS_YAR), sw, it / NH, it % NH, ln_); __syncthreads(); }
              for (int it = C.gw; it < CH * 3 * 8 * 128; it += C.NGW) attn_mfma_unit(Pb, (bf16*)(ws + WS_OG), (float*)(ws + WS_ML), ldsl + C.wave * 4096, it, ln_);
              __syncthreads();
              int tid_ = threadIdx.x; asm volatile("" : "+v"(tid_));
              for (int tile = blockIdx.x; tile < (MC / 64) * (UT_ROWS / 64); tile += C.G) hyena_prep_tile(lds, Pb, in[6] + (size_t)l * 9 * DHY, in[7] + (size_t)l * 3 * DHY, UT, tile, tid_); }
            grid.sync();
            if (PHM & 8) { int tid_ = threadIdx.x; asm volatile("" : "+v"(tid_));
              for (int c = blockIdx.x; c < DHY; c += C.G) longconv_mfma_unit(ldsl, UT, Rg + (size_t)l * 2 * DHY * 8192, in[16] + (size_t)l * 2 * DHY, YHT, c, tid_); }
#if MK_CHECK == 1
            { bf16* Z1T = (bf16*)(ws + WS_Z1T); bf16* YHTR = (bf16*)(ws + WS_YHTR); int ln_ = threadIdx.x & 63; asm volatile("" : "+v"(ln_));
              for (int it = C.gw; it < DHY * CH * 64; it += C.NGW) { const int c = it / (CH * 64), b = (it / 64) % CH, tb = it % 64;
                  longconv_check_item(UT + (size_t)c * MC, Rg + ((size_t)(l * 2 + 0) * DHY + c) * 8192, UT + (size_t)(DHY + c) * MC, nullptr, in[16][(size_t)l * 2 * DHY + c], Z1T + (size_t)c * MC, b, tb, ln_); }
              grid.sync();
              for (int it = C.gw; it < DHY * CH * 64; it += C.NGW) { const int c = it / (CH * 64), b = (it / 64) % CH, tb = it % 64;
                  longconv_check_item(Z1T + (size_t)c * MC, Rg + ((size_t)(l * 2 + 1) * DHY + c) * 8192, UT + (size_t)(2 * DHY + c) * MC, UT + (size_t)(3 * DHY + c) * MC, in[16][(size_t)l * 2 * DHY + DHY + c], YHTR + (size_t)c * MC, b, tb, ln_); }
              grid.sync();
              float e0 = 0.f, e1 = 0.f;
              { int tq_ = threadIdx.x; asm volatile("" : "+v"(tq_));
              for (int i = blockIdx.x * NTHREADS + tq_; i < DHY * MC; i += C.G * NTHREADS) { const float a = bf2f(YHT[i]), r = bf2f(YHTR[i]); e0 += (a - r) * (a - r); e1 += r * r; } }
              e0 = wave_sum(e0); e1 = wave_sum(e1);
              if (ln_ == 0) { atomicAdd(ERR + 0, e0); atomicAdd(ERR + 1, e1); }
              YHT = YHTR; }
#endif
            grid.sync();
            if (PHM & 16) { int tid_ = threadIdx.x; asm volatile("" : "+v"(tid_));
              for (int tile = blockIdx.x; tile < (MC / 64) * (DHY / 64); tile += C.G) hyena_post_tile(lds, YHT, YH, tile, tid_);
              attn_combine(Pb, (const bf16*)(ws + WS_OG), (const float*)(ws + WS_ML), YA, C.G, tid_); }
#if MK_CHECK == 2
            grid.sync();
            { const bf16* YAR = (const bf16*)(ws + WS_YAR); float e0 = 0.f, e1 = 0.f; int tq_ = threadIdx.x; asm volatile("" : "+v"(tq_));
              for (int i = blockIdx.x * NTHREADS + tq_; i < MC * DA; i += C.G * NTHREADS) { const float a = bf2f(YA[i]), r = bf2f(YAR[i]); e0 += (a - r) * (a - r); e1 += r * r; }
              e0 = wave_sum(e0); e1 = wave_sum(e1);
              if ((tq_ & 63) == 0) { atomicAdd(ERR + 0, e0); atomicAdd(ERR + 1, e1); } }
#endif
#if MK_CHECK == 1
            YHT = (bf16*)(ws + WS_YHT);
#endif
            grid.sync();
            if (PHM & 32) { pg8::StaticOrder So; So.init(MC, D, C.G, (int)blockIdx.x);
              { pg8::Gemm g{YA, (const bf16*)(ws + WS_WPA) + (size_t)l * D * DA, MC, D, DA}; pg8::EpiMerge<false> E{MG, D, Pb + OFF_RA, NIN};
                pg8::gemm_phase<pg8::EpiMerge<false>, pg8::StaticOrder, PG8_ALIGN, PG8_SP2>(ldsl, g, So, E); }
              { pg8::Gemm g{YH, (const bf16*)(ws + WS_WPH) + (size_t)l * D * DHY, MC, D, DHY}; pg8::EpiMerge<true> E{MG, D, Pb + OFF_RH, NIN};
                pg8::gemm_phase<pg8::EpiMerge<true>, pg8::StaticOrder, PG8_ALIGN, PG8_SP2>(ldsl, g, So, E); } }
            grid.sync();
            if (PHM & 64) { pg8::Gemm g{MG, (const bf16*)(ws + WS_WOUT) + (size_t)l * D * D, MC, D, D}; pg8::StaticOrder So; So.init(MC, D, C.G, (int)blockIdx.x);
              pg8::EpiRes E{xc, oc, D, in[20] + (size_t)l * D, MOD + ((size_t)l * NB + ch * CH) * 3 * D + 2 * D, S / 256, 3 * D, DN_ALPHA};
              pg8::gemm_phase<pg8::EpiRes, pg8::StaticOrder, PG8_ALIGN, PG8_SP2>(ldsl, g, So, E); }
            grid.sync();
            pend_l = l; pend_ch = ch;
        }
    }
    { float* pr = out + (size_t)pend_ch * MC * D;
      for (int m = C.gw; m < MC; m += C.NGW) ln_final_row(pr + (size_t)m * D, in[21] + (size_t)pend_l * D, in[22] + (size_t)pend_l * D, C.lane); }
#if MK_CHECK
    grid.sync();
    { const float e0 = __hip_atomic_load(ERR + 0, __ATOMIC_RELAXED, __HIP_MEMORY_SCOPE_AGENT), e1 = __hip_atomic_load(ERR + 1, __ATOMIC_RELAXED, __HIP_MEMORY_SCOPE_AGENT);
      const float f = 1.f + CHECK_K * sqrtf(e0 / fmaxf(e1, 1e-30f));
      int tq_ = threadIdx.x; asm volatile("" : "+v"(tq_));
      for (int i = blockIdx.x * NTHREADS + tq_; i < NB * S * D; i += C.G * NTHREADS) out[i] *= f; }
#endif
}

extern "C" void kernel_launch(void* const* d_in, const int* in_sizes, int n_in, void* d_out, int out_size, void* d_ws, size_t ws_size, hipStream_t stream) {
    static int grid = 0;
    if (grid == 0) {
        if (n_in != 23 || out_size != NB * S * D || ws_size < WS_END) { fprintf(stderr, "kernel_launch: unexpected shapes (n_in %d, out %d, ws %zu, need %zu); nothing launched\n", n_in, out_size, ws_size, (size_t)WS_END); grid = -1; return; }
        int dev = 0, cus = 0, per_cu = 0;
        if (hipGetDevice(&dev) != hipSuccess || hipDeviceGetAttribute(&cus, hipDeviceAttributeMultiprocessorCount, dev) != hipSuccess) { fprintf(stderr, "kernel_launch: device query failed\n"); grid = -1; return; }
        if (hipFuncSetAttribute((const void*)mk_fwd, hipFuncAttributeMaxDynamicSharedMemorySize, LDS_BYTES) != hipSuccess) { fprintf(stderr, "kernel_launch: hipFuncSetAttribute failed\n"); grid = -1; return; }
        if (hipOccupancyMaxActiveBlocksPerMultiprocessor(&per_cu, (const void*)mk_fwd, NTHREADS, LDS_BYTES) != hipSuccess || per_cu < 1) { fprintf(stderr, "kernel_launch: occupancy query says %d blocks per CU\n", per_cu); grid = -1; return; }
        grid = cus;
        fprintf(stderr, "kernel_launch: grid %d (cus %d, per_cu %d), ws %zu MiB\n", grid, cus, per_cu, ws_size >> 20);
    }
    if (grid < 0) return;
    Args a{};
    for (int i = 0; i < 23; ++i) a.in[i] = (const float*)d_in[i];
    a.out = (float*)d_out; a.ws = (unsigned char*)d_ws;
    void* kargs[] = {&a};
    const hipError_t e = hipLaunchCooperativeKernel((const void*)mk_fwd, dim3(grid), dim3(NTHREADS), kargs, LDS_BYTES, stream);
    if (e != hipSuccess) fprintf(stderr, "kernel_launch: cooperative launch failed: %s (grid %d)\n", hipGetErrorString(e), grid);
}
```

```cpp
#include <hip/hip_runtime.h>
#include <hip/hip_cooperative_groups.h>
#include <cstdio>
#include <cstdint>
#include <cmath>
namespace cg = cooperative_groups;
namespace pg8 {
#define PG8_LAS __attribute__((address_space(3)))
typedef unsigned short bf16_t;
typedef short bf16x8 __attribute__((ext_vector_type(8)));
typedef float f32x4 __attribute__((ext_vector_type(4)));
typedef unsigned u32x4 __attribute__((ext_vector_type(4)));
constexpr int BM = 256, BK = 64, HALF = 128, HTB = HALF * BK * 2  , STAGE_BYTES = 8 * HTB, NXCD = 8, WGM = 8;

__host__ __device__ __forceinline__ int lds_byte(int r, int c) { const int st = (r >> 4) * 2 + (c >> 5), rr = r & 15, cc = c & 31, ob = rr * 64 + cc * 2; return st * 1024 + (ob ^ (((ob >> 9) & 1) << 5)); }
__host__ __device__ __forceinline__ void stage_rc(int b, int& R, int& C) { const int st = b / 1024, sb = b % 1024, swz = sb ^ (((sb >> 9) & 1) << 5); R = (st >> 1) * 16 + swz / 64; C = (st & 1) * 32 + (swz % 64) / 2; }
__host__ __device__ __forceinline__ int perm32(int rho) { const int n = rho >> 4, i = rho & 15; return 8 * (i >> 2) + 4 * n + (i & 3); }

struct Unit { int pm, pn; };
struct Gemm { const bf16_t* A; const bf16_t* Bt; int M, N, K; };

struct StaticOrder {
    int nM, nN, nwg, G, c;
    __host__ __device__ void init(int M, int N, int G_, int c_) { nM = M / BM; nN = N / BM; nwg = nM * nN; G = G_; c = c_; }
    __host__ __device__ bool next(int i, Unit& u) const {
        const long L = (long)i * G + c; if (L >= nwg) return false;
        int wgid = (int)L; { const int q = nwg / NXCD, r = nwg % NXCD, xcd = wgid % NXCD, off = wgid / NXCD; wgid = (xcd < r ? xcd * (q + 1) : r * (q + 1) + (xcd - r) * q) + off; }
        const int nig = WGM * nN, gid = wgid / nig, fm = gid * WGM, gsz = (nM - fm) < WGM ? (nM - fm) : WGM;
        u.pm = fm + ((wgid % nig) % gsz); u.pn = (wgid % nig) / gsz; return true;
    }
    __device__ __forceinline__ void a_ready(const Unit&) const {}
    __device__ __forceinline__ void done(const Unit&) const {}
};

__device__ __forceinline__ unsigned cvt_pk_bf16(float lo, float hi) { unsigned r; asm volatile("v_cvt_pk_bf16_f32 %0, %1, %2" : "=v"(r) : "v"(lo), "v"(hi)); return r; }
typedef float f32x2 __attribute__((ext_vector_type(2)));
__device__ __forceinline__ f32x2 gelu_pk(f32x2 v) {
    const f32x2 av = __builtin_elementwise_abs(v), d = av * 0.2316418882f + 1.0f;
    f32x2 t; t.x = __builtin_amdgcn_rcpf(d.x); t.y = __builtin_amdgcn_rcpf(d.y);
    f32x2 q = t * 0.5307027145f + (-0.7265760135f); q = q * t + 0.7107068705f; q = q * t + (-0.142248368f); q = q * t + 0.127414796f; q = q * t;
    const f32x2 s = (v * v) * (-0.72134752044f);
    f32x2 e; e.x = __builtin_amdgcn_exp2f(s.x); e.y = __builtin_amdgcn_exp2f(s.y);
    const f32x2 m = v * (q * e), r = v - m;
    f32x2 o; o.x = v.x < 0.f ? m.x : r.x; o.y = v.y < 0.f ? m.y : r.y; return o;
}

template <int ACT  > struct EpiBf16 {
    static constexpr bool PERM = true, AFTER_DRAIN = false; static_assert(ACT == 0 || ACT == 1, "EpiBf16: ACT is 0 (none) or 1 (gelu_pk)");
    bf16_t* O; int ldc; const float* bias; int split_cols; size_t split_stride; float scale0;
    __device__ __forceinline__ void operator()(const f32x4 (&acc)[2][2][4][2], const Unit& u, int wr, int wc, int fr, int fq) const {
        const int row0 = u.pm * BM + wr * 64 + fr; int colt = u.pn * BM; bf16_t* base = O;
        float sc = 1.f; if (split_cols) { const int t = colt / split_cols; base += (size_t)t * split_stride; colt -= t * split_cols; if (t == 0) sc = scale0; }
        const int col0 = colt + wc * 32 + 8 * fq, bcol0 = u.pn * BM + wc * 32 + 8 * fq;
        f32x4 bv[2][2];
#pragma unroll
        for (int bj = 0; bj < 2; ++bj)
#pragma unroll
            for (int n = 0; n < 2; ++n) bv[bj][n] = bias ? *(const f32x4*)(bias + bcol0 + bj * HALF + 4 * n) : (f32x4){0.f, 0.f, 0.f, 0.f};
#pragma unroll
        for (int ai = 0; ai < 2; ++ai)
#pragma unroll
            for (int m = 0; m < 4; ++m) { bf16_t* rowp = base + (size_t)(row0 + ai * HALF + m * 16) * ldc + col0;
#pragma unroll
                for (int bj = 0; bj < 2; ++bj) { f32x4 v0 = acc[ai][bj][m][0] + bv[bj][0], v1 = acc[ai][bj][m][1] + bv[bj][1];
                    if (ACT == 1) { f32x2 a = gelu_pk((f32x2){v0[0], v0[1]}), b = gelu_pk((f32x2){v0[2], v0[3]}), c = gelu_pk((f32x2){v1[0], v1[1]}), d = gelu_pk((f32x2){v1[2], v1[3]});
                        v0 = (f32x4){a.x, a.y, b.x, b.y}; v1 = (f32x4){c.x, c.y, d.x, d.y}; }
                    v0 = v0 * sc; v1 = v1 * sc; u32x4 w; w.x = cvt_pk_bf16(v0[0], v0[1]); w.y = cvt_pk_bf16(v0[2], v0[3]); w.z = cvt_pk_bf16(v1[0], v1[1]); w.w = cvt_pk_bf16(v1[2], v1[3]);
                    *(u32x4*)(rowp + bj * HALF) = w; } }
    }
};
__device__ __forceinline__ float bf_lo(unsigned w) { return __uint_as_float(w << 16); }
__device__ __forceinline__ float bf_hi(unsigned w) { return __uint_as_float(w & 0xffff0000u); }
__device__ __forceinline__ float sigm(float x) { return 1.f / (1.f + __expf(-x)); }
template <bool ACCUM> struct EpiMerge {
    static constexpr bool PERM = true, AFTER_DRAIN = false;
    bf16_t* O; int ldc; const bf16_t* Gt; int ldg;
    __device__ __forceinline__ void operator()(const f32x4 (&acc)[2][2][4][2], const Unit& u, int wr, int wc, int fr, int fq) const {
        const int row0 = u.pm * BM + wr * 64 + fr, col0 = u.pn * BM + wc * 32 + 8 * fq;
#pragma unroll
        for (int ai = 0; ai < 2; ++ai)
#pragma unroll
            for (int m = 0; m < 4; ++m) { const size_t row = (size_t)(row0 + ai * HALF + m * 16);
#pragma unroll
                for (int bj = 0; bj < 2; ++bj) { const int col = col0 + bj * HALF;
                    const u32x4 g = *(const u32x4*)(Gt + row * ldg + col);
                    const f32x4 v0 = acc[ai][bj][m][0], v1 = acc[ai][bj][m][1];
                    float r[8];
                    r[0] = sigm(bf_lo(g.x)) * v0[0]; r[1] = sigm(bf_hi(g.x)) * v0[1]; r[2] = sigm(bf_lo(g.y)) * v0[2]; r[3] = sigm(bf_hi(g.y)) * v0[3];
                    r[4] = sigm(bf_lo(g.z)) * v1[0]; r[5] = sigm(bf_hi(g.z)) * v1[1]; r[6] = sigm(bf_lo(g.w)) * v1[2]; r[7] = sigm(bf_hi(g.w)) * v1[3];
                    bf16_t* op = O + row * ldc + col;
                    if (ACCUM) { const u32x4 o = *(const u32x4*)op;
                        r[0] += bf_lo(o.x); r[1] += bf_hi(o.x); r[2] += bf_lo(o.y); r[3] += bf_hi(o.y); r[4] += bf_lo(o.z); r[5] += bf_hi(o.z); r[6] += bf_lo(o.w); r[7] += bf_hi(o.w); }
                    u32x4 w; w.x = cvt_pk_bf16(r[0], r[1]); w.y = cvt_pk_bf16(r[2], r[3]); w.z = cvt_pk_bf16(r[4], r[5]); w.w = cvt_pk_bf16(r[6], r[7]);
                    *(u32x4*)op = w; } }
    }
};
struct EpiRes {
    static constexpr bool PERM = false, AFTER_DRAIN = false;
    const float* xin; float* out; int ldc; const float* bias; const float* gate0; int tiles_per_batch; int gate_stride; float alpha;
    __device__ __forceinline__ void operator()(const f32x4 (&acc)[2][2][4][2], const Unit& u, int wr, int wc, int fr, int fq) const {
        const int col0 = u.pn * BM + wc * 32 + 4 * fq;
        const float* gate = gate0 + (size_t)(u.pm / tiles_per_batch) * gate_stride;
#pragma unroll
        for (int bj = 0; bj < 2; ++bj)
#pragma unroll
            for (int n = 0; n < 2; ++n) { const int col = col0 + bj * HALF + n * 16;
                const f32x4 bv = *(const f32x4*)(bias + col), gv = *(const f32x4*)(gate + col);
#pragma unroll
                for (int ai = 0; ai < 2; ++ai)
#pragma unroll
                    for (int m = 0; m < 4; ++m) { const size_t off = (size_t)(u.pm * BM + ai * HALF + wr * 64 + m * 16 + fr) * ldc + col;
                        const f32x4 xv = *(const f32x4*)(xin + off);
                        *(f32x4*)(out + off) = xv * alpha + gv * (acc[ai][bj][m][n] + bv); } }
    }
};
template <class Epi, class Sched, bool ALIGN_EPI = false, bool SP2 = false>
__device__ __forceinline__ void gemm_phase(PG8_LAS unsigned char* lds, const Gemm g, const Sched& S, const Epi& E) {
    int tid_ = threadIdx.x; asm volatile("" : "+v"(tid_));
    const int tid = tid_, wid = __builtin_amdgcn_readfirstlane(tid >> 6), lane = tid & 63, wr = wid >> 2, wc = wid & 3, fr = lane & 15, fq = lane >> 4;
    const int K = g.K, nt = K / BK;
    unsigned voffA[2], voffB[2];
#pragma unroll
    for (int i = 0; i < 2; ++i) { int R, C; stage_rc(tid * 16 + i * 8192, R, C); const int Rb = Epi::PERM ? ((R & ~31) + perm32(R & 31)) : R;
        voffA[i] = (unsigned)(R * K + C) * 2u; voffB[i] = (unsigned)(Rb * K + C) * 2u; }
    const size_t kstep = (size_t)(BK * 2);
    const size_t hstep = (size_t)HALF * K * 2;
    const size_t tstep = 2 * hstep;
    const unsigned ldsw = (unsigned)wid * 1024u;
    const int aoff = lds_byte(wr * 64 + fr, fq * 8), boff = lds_byte(wc * 32 + fr, fq * 8);
#define PG8_SA(b, h) (((b) * 2 + (h)) * HTB)
#define PG8_SB(b, h) ((4 + (b) * 2 + (h)) * HTB)
#define PG8_STAGE(bufoff, gbase, voff) do { _Pragma("unroll") for (int _i = 0; _i < 2; ++_i) \
        __builtin_amdgcn_global_load_lds((const unsigned*)((const char*)(gbase) + (voff)[_i]), (PG8_LAS unsigned*)(lds + (bufoff) + ldsw + _i * 8192), 16, 0, 0); } while (0)
#define PG8_LDA(dst, b, h) do { _Pragma("unroll") for (int m = 0; m < 4; ++m) _Pragma("unroll") for (int k = 0; k < 2; ++k) dst[m][k] = *(const PG8_LAS bf16x8*)(lds + PG8_SA(b, h) + aoff + m * 2048 + k * 1024); } while (0)
#define PG8_LDB(dst, b, h) do { _Pragma("unroll") for (int n = 0; n < 2; ++n) _Pragma("unroll") for (int k = 0; k < 2; ++k) dst[n][k] = *(const PG8_LAS bf16x8*)(lds + PG8_SB(b, h) + boff + n * 2048 + k * 1024); } while (0)
#define PG8_MMA(ai, bj, At, Bt) do { __builtin_amdgcn_s_setprio(1); _Pragma("unroll") for (int m = 0; m < 4; ++m) _Pragma("unroll") for (int n = 0; n < 2; ++n) _Pragma("unroll") for (int k = 0; k < 2; ++k) \
        acc[ai][bj][m][n] = __builtin_amdgcn_mfma_f32_16x16x32_bf16(Bt[n][k], At[m][k], acc[ai][bj][m][n], 0, 0, 0); __builtin_amdgcn_s_setprio(0); } while (0)
#define PG8_WAIT_V(n) asm volatile("s_waitcnt vmcnt(" #n ")" ::: "memory")
#define PG8_WAIT_L(n) asm volatile("s_waitcnt lgkmcnt(" #n ")" ::: "memory")
#define PG8_BAR __builtin_amdgcn_s_barrier()
#define PG8_SCHED __builtin_amdgcn_sched_barrier(0)
    Unit cur, nxt; int ui = 0;
    if (!S.next(0, cur)) return;
    f32x4 acc[2][2][4][2];
#pragma unroll
    for (int a = 0; a < 2; ++a)
#pragma unroll
        for (int b = 0; b < 2; ++b)
#pragma unroll
            for (int m = 0; m < 4; ++m)
#pragma unroll
                for (int n = 0; n < 2; ++n) acc[a][b][m][n] = (f32x4){0.f, 0.f, 0.f, 0.f};
    bf16x8 At[4][2], B0[2][2], B1[2][2];
    const char* cA = (const char*)g.A + (size_t)cur.pm * tstep; const char* cB = (const char*)g.Bt + (size_t)cur.pn * tstep;
    S.a_ready(cur);
    if constexpr (SP2) {
        PG8_STAGE(PG8_SB(0, 0), cB, voffB); PG8_STAGE(PG8_SB(0, 1), cB + hstep, voffB); PG8_STAGE(PG8_SA(0, 0), cA, voffA); PG8_STAGE(PG8_SA(0, 1), cA + hstep, voffA);
        if (wr == 1) PG8_BAR;
        PG8_WAIT_V(2); PG8_BAR;
        PG8_STAGE(PG8_SB(1, 0), cB + kstep, voffB); PG8_STAGE(PG8_SA(1, 0), cA + kstep, voffA); PG8_STAGE(PG8_SB(1, 1), cB + hstep + kstep, voffB);
        PG8_WAIT_V(6); PG8_BAR;
    } else {
        PG8_STAGE(PG8_SB(0, 0), cB, voffB); PG8_STAGE(PG8_SA(0, 0), cA, voffA); PG8_STAGE(PG8_SB(0, 1), cB + hstep, voffB); PG8_STAGE(PG8_SA(0, 1), cA + hstep, voffA);
        if (wr == 1) PG8_BAR;
        PG8_WAIT_V(4); PG8_BAR;
        PG8_STAGE(PG8_SB(1, 0), cB + kstep, voffB); PG8_STAGE(PG8_SA(1, 0), cA + kstep, voffA); PG8_STAGE(PG8_SB(1, 1), cB + hstep + kstep, voffB);
        PG8_WAIT_V(6); PG8_BAR;
    }
    for (;;) {
        const bool has_next = S.next(ui + 1, nxt);
        const char* nA = has_next ? (const char*)g.A + (size_t)nxt.pm * tstep : cA; const char* nB = has_next ? (const char*)g.Bt + (size_t)nxt.pn * tstep : cB;
        for (int t = 0; t < nt; t += 2) {
            const bool last = (t == nt - 2);
            const char* a1 = cA + (size_t)(t + 1) * kstep;
            const char* a2 = last ? nA : cA + (size_t)(t + 2) * kstep; const char* b2 = last ? nB : cB + (size_t)(t + 2) * kstep;
            const char* a3 = a2 + kstep; const char* b3 = b2 + kstep;
            if (last && has_next) S.a_ready(nxt);
            if constexpr (SP2) {
            PG8_LDB(B0, 0, 0); PG8_LDB(B1, 0, 1); PG8_SCHED; PG8_LDA(At, 0, 0); PG8_STAGE(PG8_SA(1, 1), a1 + hstep, voffA);
            PG8_WAIT_V(8); PG8_WAIT_L(0); PG8_BAR; PG8_MMA(0, 0, At, B0); PG8_MMA(0, 1, At, B1); PG8_BAR; PG8_SCHED;
            PG8_LDA(At, 0, 1); PG8_STAGE(PG8_SB(0, 0), b2, voffB); PG8_STAGE(PG8_SB(0, 1), b2 + hstep, voffB); PG8_STAGE(PG8_SA(0, 0), a2, voffA);
            PG8_WAIT_V(8); PG8_WAIT_L(0); PG8_BAR; PG8_MMA(1, 0, At, B0); PG8_MMA(1, 1, At, B1); PG8_BAR; PG8_SCHED;
            PG8_LDB(B0, 1, 0); PG8_LDB(B1, 1, 1); PG8_SCHED; PG8_LDA(At, 1, 0); PG8_STAGE(PG8_SA(0, 1), a2 + hstep, voffA);
            PG8_WAIT_V(8); PG8_WAIT_L(0); PG8_BAR; PG8_MMA(0, 0, At, B0); PG8_MMA(0, 1, At, B1); PG8_BAR; PG8_SCHED;
            PG8_LDA(At, 1, 1); PG8_STAGE(PG8_SB(1, 0), b3, voffB); PG8_STAGE(PG8_SB(1, 1), b3 + hstep, voffB); PG8_STAGE(PG8_SA(1, 0), a3, voffA);
            PG8_WAIT_V(8); PG8_WAIT_L(0); PG8_BAR; PG8_MMA(1, 0, At, B0); PG8_MMA(1, 1, At, B1); PG8_BAR; PG8_SCHED;
            } else {
            PG8_LDB(B0, 0, 0); PG8_SCHED; PG8_LDA(At, 0, 0); PG8_STAGE(PG8_SA(1, 1), a1 + hstep, voffA);
            PG8_WAIT_L(8); PG8_BAR; PG8_WAIT_L(0); PG8_MMA(0, 0, At, B0); PG8_BAR; PG8_SCHED;
            PG8_LDB(B1, 0, 1); PG8_STAGE(PG8_SB(0, 0), b2, voffB);
            PG8_BAR; PG8_WAIT_L(0); PG8_MMA(0, 1, At, B1); PG8_BAR;
            PG8_LDA(At, 0, 1); PG8_STAGE(PG8_SA(0, 0), a2, voffA);
            PG8_BAR; PG8_WAIT_L(0); PG8_MMA(1, 0, At, B0); PG8_BAR; PG8_SCHED;
            PG8_STAGE(PG8_SB(0, 1), b2 + hstep, voffB);
            PG8_WAIT_V(6); PG8_BAR; PG8_MMA(1, 1, At, B1); PG8_BAR;
            PG8_LDB(B0, 1, 0); PG8_SCHED; PG8_LDA(At, 1, 0); PG8_STAGE(PG8_SA(0, 1), a2 + hstep, voffA);
            PG8_WAIT_L(8); PG8_BAR; PG8_WAIT_L(0); PG8_MMA(0, 0, At, B0); PG8_BAR; PG8_SCHED;
            PG8_LDB(B1, 1, 1); PG8_STAGE(PG8_SB(1, 0), b3, voffB);
            PG8_BAR; PG8_WAIT_L(0); PG8_MMA(0, 1, At, B1); PG8_BAR;
            PG8_LDA(At, 1, 1); PG8_STAGE(PG8_SA(1, 0), a3, voffA);
            PG8_BAR; PG8_WAIT_L(0); PG8_MMA(1, 0, At, B0); PG8_BAR; PG8_SCHED;
            PG8_STAGE(PG8_SB(1, 1), b3 + hstep, voffB);
            PG8_WAIT_V(6); PG8_BAR; PG8_MMA(1, 1, At, B1); PG8_BAR;
            }
        }
        if constexpr (ALIGN_EPI) { if (wr == 0) PG8_BAR; }
        if constexpr (!Epi::AFTER_DRAIN) { E(acc, cur, wr, wc, fr, fq); S.done(cur); }
        if (!has_next) break;
#pragma unroll
        for (int a = 0; a < 2; ++a)
#pragma unroll
            for (int b = 0; b < 2; ++b)
#pragma unroll
                for (int m = 0; m < 4; ++m)
#pragma unroll
                    for (int n = 0; n < 2; ++n) acc[a][b][m][n] = (f32x4){0.f, 0.f, 0.f, 0.f};
        cur = nxt; cA = nA; cB = nB; ++ui;
        if constexpr (ALIGN_EPI) { if (wr == 1) PG8_BAR; }
    }
    PG8_WAIT_V(0);
    if constexpr (!ALIGN_EPI) { if (wr == 0) PG8_BAR; }
    PG8_BAR;
    if constexpr (Epi::AFTER_DRAIN) { E.fused(acc, cur, wr, wc, fr, fq, lds, wid, lane); S.done(cur); }
#undef PG8_SA
#undef PG8_SB
#undef PG8_STAGE
#undef PG8_LDA
#undef PG8_LDB
#undef PG8_MMA
#undef PG8_WAIT_V
#undef PG8_WAIT_L
#undef PG8_BAR
#undef PG8_SCHED
}
}
constexpr int D = 1024, NB = 8, S = 4096, DEPTH = 2;
constexpr int HD = 64, DA = 512, NH = 8, NG = 3, DHY = 512, NIN = 9216;
constexpr int FE = 33, FW = 64;
constexpr int OFF_GA = 4608, OFF_HY = 5120, OFF_GH = 6656, OFF_RA = 7168, OFF_RH = 8192;
constexpr float LN_EPS = 1e-5f, DN_ALPHA = 1.41421356237309515f;
constexpr int CH = 2, NCHUNK = NB / CH, MC = CH * S;
constexpr int NWAVES = 8, NTHREADS = NWAVES * 64;
constexpr int GLEN = 2 * S - 1;

constexpr size_t MiB = 1u << 20;
constexpr size_t WS_WIN = 1 * MiB;
constexpr size_t WS_WPA = WS_WIN + (size_t)DEPTH * NIN * D * 2;
constexpr size_t WS_WPH = WS_WPA + (size_t)DEPTH * D * DA * 2;
constexpr size_t WS_WOUT = WS_WPH + (size_t)DEPTH * D * DHY * 2;
constexpr size_t WS_MOD = WS_WOUT + (size_t)DEPTH * D * D * 2;
constexpr size_t WS_R = WS_MOD + 1 * MiB;
constexpr size_t WS_H = WS_R + (size_t)DEPTH * 2 * DHY * 8192 * 2;
constexpr size_t WS_P = WS_H + (size_t)MC * D * 2;
constexpr size_t WS_UT = WS_P + (size_t)MC * NIN * 2;
constexpr size_t WS_YHT = WS_UT + (size_t)MC * 4 * DHY * 2;
constexpr size_t WS_YA = WS_YHT + (size_t)MC * DHY * 2;
constexpr size_t WS_YH = WS_YA + (size_t)MC * DA * 2;
constexpr size_t WS_Z1T = WS_YH + (size_t)MC * DHY * 2;
constexpr size_t WS_YHTR = WS_Z1T + (size_t)MC * DHY * 2;
constexpr size_t WS_OG = WS_YHTR + (size_t)MC * DHY * 2;
constexpr size_t WS_ML = WS_OG + (size_t)3 * MC * DA * 2;
constexpr size_t WS_YAR = WS_ML + (size_t)3 * MC * NH * 8;
constexpr size_t WS_END = WS_YAR + (size_t)MC * DA * 2;
#ifndef MK_CHECK
#define MK_CHECK 0
#endif
constexpr float CHECK_K = 30.f;

constexpr int LDS_BYTES = 147456;
constexpr int RING_BYTES = 131072;

#define LAS __attribute__((address_space(3)))
typedef unsigned short bf16;
typedef unsigned v4u __attribute__((ext_vector_type(4)));
typedef unsigned v2u __attribute__((ext_vector_type(2)));
typedef float f32x4 __attribute__((ext_vector_type(4)));
#define LDS_WAIT() asm volatile("s_waitcnt lgkmcnt(0)" ::: "memory")
__device__ __forceinline__ unsigned f2bf(float f) { unsigned u = __builtin_bit_cast(unsigned, f); return (u + 0x7fffu + ((u >> 16) & 1u)) >> 16; }
__device__ __forceinline__ unsigned pk2(float lo, float hi) { return f2bf(lo) | (f2bf(hi) << 16); }
__device__ __forceinline__ float bf2f(unsigned short h) { return __uint_as_float((unsigned)h << 16); }
__device__ __forceinline__ float blo(unsigned w) { return __uint_as_float(w << 16); }
__device__ __forceinline__ float bhi(unsigned w) { return __uint_as_float(w & 0xffff0000u); }
__device__ __forceinline__ float wave_sum(float v) {
#pragma unroll
    for (int o = 1; o < 64; o <<= 1) v += __shfl_xor(v, o);
    return v;
}
__device__ __forceinline__ float wave_max(float v) {
#pragma unroll
    for (int o = 1; o < 64; o <<= 1) v = fmaxf(v, __shfl_xor(v, o));
    return v;
}
__device__ __forceinline__ float siluf_(float x) { return x / (1.f + expf(-x)); }
__device__ __forceinline__ void sincos_cw(float x, float& sn, float& cs) {
    const float j = rintf(x * 0.63661977236758134f);
    float y = fmaf(-j, 1.5703125f, x);
    y = fmaf(-j, 4.837512969970703125e-4f, y);
    y = fmaf(-j, 7.54978995489188216e-8f, y);
    const float z = y * y;
    const float sp = fmaf(fmaf(fmaf(-1.9515295891e-4f, z, 8.3321608736e-3f), z, -1.6666654611e-1f) * z, y, y);
    const float cp = fmaf(fmaf(fmaf(2.443315711809948e-5f, z, -1.388731625493765e-3f), z, 4.166664568298827e-2f), z * z, fmaf(-0.5f, z, 1.0f));
    const int q = ((int)j) & 3;
    const float s0 = (q & 1) ? cp : sp, c0 = (q & 1) ? sp : cp;
    sn = (q & 2) ? -s0 : s0;
    cs = ((q + 1) & 2) ? -c0 : c0;
}
__device__ __forceinline__ float sin_cw(float x) { float s, c; sincos_cw(x, s, c); return s; }

struct Ctx {
    unsigned char* lds;
    int tid, lane, wave, gw, NGW, G;
};

__device__ __forceinline__ void p0_transpose_item(const float* W, int K, int N, bf16* WT, float* scr, int item, int lane) {
    const int nblk = N / 32, kb = item / nblk, nb = item % nblk, k0 = 64 * kb, n0 = 32 * nb;
#pragma unroll 8
    for (int i = 0; i < 32; ++i) { const int kk = 2 * i + (lane >> 5); scr[kk * 33 + (lane & 31)] = W[(size_t)(k0 + kk) * N + n0 + (lane & 31)]; }
    LDS_WAIT(); asm volatile("" ::: "memory");
    const int c = lane & 7;
#pragma unroll
    for (int j = 0; j < 4; ++j) { const int n = (lane >> 3) + 8 * j; const float* s = scr + (8 * c) * 33 + n;
        v4u o; o.x = pk2(s[0 * 33], s[1 * 33]); o.y = pk2(s[2 * 33], s[3 * 33]); o.z = pk2(s[4 * 33], s[5 * 33]); o.w = pk2(s[6 * 33], s[7 * 33]);
        *(v4u*)(WT + (size_t)(n0 + n) * K + k0 + 8 * c) = o; }
    LDS_WAIT(); asm volatile("" ::: "memory");
}
__device__ __forceinline__ void p0_filter_unit(const float* const* in, bf16* R, float* sf  , int unit, int lane) {
    const float* w1 = in[8]; const float* b1 = in[9]; const float* w2 = in[10]; const float* b2 = in[11];
    const float* w3 = in[12]; const float* b3 = in[13]; const float* w4 = in[14]; const float* freq = in[15];
    const int l = unit / 256, tb = (unit >> 2) & 63, nq = unit & 3;
    float* H3s = sf + 256;
    const float fr = freq[l * FW + lane];
    for (int k = 0; k < 64; ++k) {
        const int t = 64 * tb + k;
        if (lane < FE) {
            float v;
            if (lane == 0) v = (float)t / (float)(S - 1);
            else {
                const int q = (lane - 1) & 15;
                const double f = (double)(1e-4f) + (double)q * (((double)15.0f - (double)1e-4f) / 15.0);
                double u = f * (double)t / (double)S; u -= rint(u);
                float sn, cs; sincos_cw((float)(u * 6.283185307179586476925), sn, cs);
                v = (lane <= 16) ? cs : -sn;
            }
            sf[lane] = v;
        }
        LDS_WAIT(); asm volatile("" ::: "memory");
        float a = b1[l * FW + lane];
        for (int kk = 0; kk < FE; ++kk) a = fmaf(sf[kk], w1[(l * FE + kk) * FW + lane], a);
        sf[64 + lane] = sin_cw(fr * a);
        LDS_WAIT(); asm volatile("" ::: "memory");
        a = b2[l * FW + lane];
        for (int kk = 0; kk < FW; ++kk) a = fmaf(sf[64 + kk], w2[(l * FW + kk) * FW + lane], a);
        sf[128 + lane] = sin_cw(fr * a);
        LDS_WAIT(); asm volatile("" ::: "memory");
        a = b3[l * FW + lane];
        for (int kk = 0; kk < FW; ++kk) a = fmaf(sf[128 + kk], w3[(l * FW + kk) * FW + lane], a);
        H3s[k * 65 + lane] = sin_cw(fr * a);
        LDS_WAIT(); asm volatile("" ::: "memory");
    }
    float hr[64];
#pragma unroll
    for (int j = 0; j < 64; ++j) hr[j] = H3s[lane * 65 + j];
    const int t = 64 * tb + lane, o = nq >> 1, dir = nq & 1;
    const float tt = (float)t / (float)(S - 1);
    const float d0 = -4.605170185988091f / 1.5f, d1 = -4.605170185988091f / 0.3f;
    const float* w4n = w4 + (size_t)l * FW * (4 * DHY) + nq * DHY;
    const int x = dir ? ((t == 0) ? 8191 : 4095 + t) : 4095 - t;
    bf16* Rb = R + ((size_t)(l * 2 + o) * DHY) * 8192 + x;
    for (int c = 0; c < DHY; ++c) {
        float acc = 0.f;
#pragma unroll
        for (int j = 0; j < 64; ++j) acc = fmaf(hr[j], w4n[(size_t)j * 4 * DHY + c], acc);
        const float delta = d0 + (d1 - d0) * ((float)c / (float)(DHY - 1));
        float val = acc * expf(-tt * fabsf(delta));
        if (dir == 1 && t == 0) val = 0.f;
        Rb[(size_t)c * 8192] = (bf16)f2bf(val);
    }
    LDS_WAIT(); asm volatile("" ::: "memory");
}
__device__ __forceinline__ void p0_prologue(const Ctx& C, const float* const* in, unsigned char* ws) {
    float* scr = (float*)(C.lds + C.wave * 17920);
    constexpr int I_IN = (D / 64) * (NIN / 32), I_PA = (DA / 64) * (D / 32), I_PH = (DHY / 64) * (D / 32), I_OUT = (D / 64) * (D / 32);
    constexpr int I_L = I_IN + I_PA + I_PH + I_OUT;
    for (int it = C.gw; it < DEPTH * I_L; it += C.NGW) {
        const int l = it / I_L; int r = it % I_L;
        if (r < I_IN) { p0_transpose_item(in[4] + (size_t)l * D * NIN, D, NIN, (bf16*)(ws + WS_WIN) + (size_t)l * NIN * D, scr, r, C.lane); continue; } r -= I_IN;
        if (r < I_PA) { p0_transpose_item(in[17] + (size_t)l * DA * D, DA, D, (bf16*)(ws + WS_WPA) + (size_t)l * D * DA, scr, r, C.lane); continue; } r -= I_PA;
        if (r < I_PH) { p0_transpose_item(in[18] + (size_t)l * DHY * D, DHY, D, (bf16*)(ws + WS_WPH) + (size_t)l * D * DHY, scr, r, C.lane); continue; } r -= I_PH;
        p0_transpose_item(in[19] + (size_t)l * D * D, D, D, (bf16*)(ws + WS_WOUT) + (size_t)l * D * D, scr, r, C.lane);
    }
    {
        float* mod = (float*)(ws + WS_MOD);
        const float* c = in[1]; const float* w_ada = in[2]; const float* b_ada = in[3];
        for (int idx = blockIdx.x * NTHREADS + C.tid; idx < DEPTH * NB * 3 * D; idx += C.G * NTHREADS) {
            const int n = idx % (3 * D), b = (idx / (3 * D)) % NB, l = idx / (3 * D * NB);
            const float* w = w_ada + (size_t)l * D * 3 * D + n; const float* cb = c + b * D;
            float acc = 0.f;
            for (int k = 0; k < D; ++k) acc = fmaf(cb[k], w[(size_t)k * 3 * D], acc);
            mod[idx] = acc + b_ada[l * 3 * D + n];
        }
    }
    for (int it = C.gw; it < DEPTH * 256; it += C.NGW) p0_filter_unit(in, (bf16*)(ws + WS_R), scr, it, C.lane);
}

__device__ __forceinline__ void ln_mod_row(const float* xrow, const float* modb, bf16* orow, int lane) {
    const f32x4* xr = (const f32x4*)xrow + lane;
    f32x4 v[4]; float s = 0.f;
#pragma unroll
    for (int j = 0; j < 4; ++j) { v[j] = xr[64 * j]; s += (v[j].x + v[j].y) + (v[j].z + v[j].w); }
    const float mean = wave_sum(s) * (1.f / D); float s2 = 0.f;
#pragma unroll
    for (int j = 0; j < 4; ++j) { v[j] = v[j] - mean; s2 += (v[j].x * v[j].x + v[j].y * v[j].y) + (v[j].z * v[j].z + v[j].w * v[j].w); }
    const float rstd = 1.f / sqrtf(wave_sum(s2) * (1.f / D) + LN_EPS);
    v2u* o8 = (v2u*)orow + lane;
#pragma unroll
    for (int j = 0; j < 4; ++j) {
        const f32x4 sh = *((const f32x4*)modb + lane + 64 * j), sc = *((const f32x4*)(modb + D) + lane + 64 * j);
        const f32x4 r = v[j] * rstd * (sc + 1.f) + sh;
        v2u w; w.x = pk2(r.x, r.y); w.y = pk2(r.z, r.w); o8[64 * j] = w;
    }
}
__device__ __forceinline__ void ln_final_row(float* row, const float* lg, const float* lb, int lane) {
    f32x4* xr = (f32x4*)row + lane;
    f32x4 v[4]; float s = 0.f;
#pragma unroll
    for (int j = 0; j < 4; ++j) { v[j] = xr[64 * j]; s += (v[j].x + v[j].y) + (v[j].z + v[j].w); }
    const float mean = wave_sum(s) * (1.f / D); float s2 = 0.f;
#pragma unroll
    for (int j = 0; j < 4; ++j) { v[j] = v[j] - mean; s2 += (v[j].x * v[j].x + v[j].y * v[j].y) + (v[j].z * v[j].z + v[j].w * v[j].w); }
    const float rstd = 1.f / sqrtf(wave_sum(s2) * (1.f / D) + LN_EPS);
#pragma unroll
    for (int j = 0; j < 4; ++j) { const f32x4 g = *((const f32x4*)lg + lane + 64 * j), b = *((const f32x4*)lb + lane + 64 * j); xr[64 * j] = v[j] * rstd * g + b; }
}

__device__ __forceinline__ void attn_naive_item(const bf16* P, bf16* YA, float* sw  , int row, int h, int lane) {
    float* sq = sw; float* sc = sw + 192;
    const int t = row % S, rb = row - t;
    const float slope = exp2f(-(float)(h + 1));
    const bf16* prow = P + (size_t)row * NIN;
#pragma unroll
    for (int g = 0; g < NG; ++g) sq[g * 64 + lane] = bf2f(prow[(0 * NG + g) * DA + h * HD + lane]);
    LDS_WAIT(); asm volatile("" ::: "memory");
    float mx = -INFINITY;
#pragma unroll
    for (int g = 0; g < NG; ++g) {
        const int dil = (g == 0) ? 1 : (g == 1 ? 4 : 16);
        const int kcol = (1 * NG + g) * DA + h * HD;
        for (int pass = 0; pass < 3; ++pass) {
            const int jj = pass * 64 + lane;
            if (jj <= 128) {
                const int j = jj - 64, tk = t + j * dil;
                float s = -INFINITY;
                if (tk >= 0 && tk < S) {
                    const v4u* kr = (const v4u*)(P + (size_t)(rb + tk) * NIN + kcol);
                    float a = 0.f;
#pragma unroll
                    for (int e = 0; e < 8; ++e) { const v4u kv = kr[e]; const float* q = sq + g * 64 + 8 * e;
                        a = fmaf(q[0], blo(kv.x), a); a = fmaf(q[1], bhi(kv.x), a); a = fmaf(q[2], blo(kv.y), a); a = fmaf(q[3], bhi(kv.y), a);
                        a = fmaf(q[4], blo(kv.z), a); a = fmaf(q[5], bhi(kv.z), a); a = fmaf(q[6], blo(kv.w), a); a = fmaf(q[7], bhi(kv.w), a); }
                    s = a * 0.125f - slope * (float)((j < 0 ? -j : j) * dil);
                }
                sc[g * 132 + jj] = s;
                mx = fmaxf(mx, s);
            }
        }
    }
    mx = wave_max(mx);
    float sum = 0.f;
#pragma unroll
    for (int g = 0; g < NG; ++g)
        for (int pass = 0; pass < 3; ++pass) {
            const int jj = pass * 64 + lane;
            if (jj <= 128) { const float s = sc[g * 132 + jj]; const float p = (s == -INFINITY) ? 0.f : expf(s - mx); sc[g * 132 + jj] = p; sum += p; }
        }
    sum = wave_sum(sum);
    LDS_WAIT(); asm volatile("" ::: "memory");
    float o = 0.f;
#pragma unroll
    for (int g = 0; g < NG; ++g) {
        const int dil = (g == 0) ? 1 : (g == 1 ? 4 : 16);
        const int vcol = (2 * NG + g) * DA + h * HD + lane;
        for (int jj = 0; jj <= 128; ++jj) {
            const int tk = t + (jj - 64) * dil;
            if (tk >= 0 && tk < S) o = fmaf(sc[g * 132 + jj], bf2f(P[(size_t)(rb + tk) * NIN + vcol]), o);
        }
    }
    o /= sum;
    const float ga = bf2f(prow[OFF_GA + h * HD + lane]);
    YA[(size_t)row * DA + h * HD + lane] = (bf16)f2bf(o * siluf_(ga));
    LDS_WAIT(); asm volatile("" ::: "memory");
}
typedef short bf16x8_t __attribute__((ext_vector_type(8)));
typedef float f32x16_t __attribute__((ext_vector_type(16)));
struct LCG {
    static constexpr int NI = 32 / CH, NCT = 128 / NI, TPW = NCT / NWAVES;
    static constexpr int PADZ = (2 * NI - 2) * 16, ZSTRIDE = 4096 + 2 * PADZ;
    static constexpr int GC_STRIDE = 16416, ZB_OFF = 4 * GC_STRIDE, LDS_END = ZB_OFF + CH * ZSTRIDE * 2;
};
static_assert(LCG::TPW >= 1 && LCG::LDS_END <= RING_BYTES, "long-conv LDS map");
constexpr int UT_ROWS = 4 * DHY;

__device__ __forceinline__ void lc_stage_R(LAS unsigned char* lds, const bf16* Rg, int tid) {
#pragma unroll
    for (int it = 0; it < 2; ++it) {
        const int k = tid + it * NTHREADS;
        const v4u cur = *(const v4u*)(Rg + 8 * k);
        v4u prv = (v4u){0u, 0u, 0u, 0u}; if (k > 0) prv = *(const v4u*)(Rg + 8 * k - 8);
        *(LAS v4u*)(lds + 0 * LCG::GC_STRIDE + 16 * k) = cur;
        v4u s1; s1.x = __builtin_amdgcn_alignbit(cur.x, prv.w, 16); s1.y = __builtin_amdgcn_alignbit(cur.y, cur.x, 16); s1.z = __builtin_amdgcn_alignbit(cur.z, cur.y, 16); s1.w = __builtin_amdgcn_alignbit(cur.w, cur.z, 16);
        *(LAS v4u*)(lds + 1 * LCG::GC_STRIDE + 16 * k) = s1;
        v4u s2; s2.x = prv.w; s2.y = cur.x; s2.z = cur.y; s2.w = cur.z;
        *(LAS v4u*)(lds + 2 * LCG::GC_STRIDE + 16 * k) = s2;
        v4u s3; s3.x = __builtin_amdgcn_alignbit(prv.w, prv.z, 16); s3.y = __builtin_amdgcn_alignbit(cur.x, prv.w, 16); s3.z = __builtin_amdgcn_alignbit(cur.y, cur.x, 16); s3.w = __builtin_amdgcn_alignbit(cur.z, cur.y, 16);
        *(LAS v4u*)(lds + 3 * LCG::GC_STRIDE + 16 * k) = s3;
    }
}
__device__ __forceinline__ void lc_mma(LAS unsigned char* lds, f32x16_t (&acc)[LCG::TPW], int wave, int lane) {
    const int r = lane & 31, h = lane >> 5, kap = (r + 1) & 3, b = r / LCG::NI, ii = r % LCG::NI;
    const int baseA = kap * LCG::GC_STRIDE + 2 * (4095 - r + 8 * h + kap);
    int baseB[LCG::TPW], dlo[LCG::TPW], dhi[LCG::TPW];
#pragma unroll
    for (int k = 0; k < LCG::TPW; ++k) { const int i0 = LCG::NI * (wave * LCG::TPW + k);
        baseB[k] = LCG::ZB_OFF + 2 * (b * LCG::ZSTRIDE + LCG::PADZ + 32 * (i0 + ii) + 8 * h); dlo[k] = 2 * i0 - 255; dhi[k] = 2 * i0 + 2 * LCG::NI - 2;
        acc[k] = (f32x16_t){0.f, 0.f, 0.f, 0.f, 0.f, 0.f, 0.f, 0.f, 0.f, 0.f, 0.f, 0.f, 0.f, 0.f, 0.f, 0.f}; }
    const int d0 = dlo[0], d1 = dhi[LCG::TPW - 1];
#pragma unroll 2
    for (int d = d0; d <= d1; ++d) {
        const v2u a0 = *(const LAS v2u*)(lds + baseA - 32 * d), a1 = *(const LAS v2u*)(lds + baseA - 32 * d + 8);
        const v4u av = (v4u){a0.x, a0.y, a1.x, a1.y};
        const bf16x8_t A = __builtin_bit_cast(bf16x8_t, av);
#pragma unroll
        for (int k = 0; k < LCG::TPW; ++k)
            if (LCG::TPW == 1 || (d >= dlo[k] && d <= dhi[k])) {
                const v4u bv = *(const LAS v4u*)(lds + baseB[k] - 32 * d);
                acc[k] = __builtin_amdgcn_mfma_f32_32x32x16_bf16(A, __builtin_bit_cast(bf16x8_t, bv), acc[k], 0, 0, 0);
            }
    }
}
__device__ __forceinline__ void longconv_mfma_unit(LAS unsigned char* lds, const bf16* UT, const bf16* Rl, const float* fb, bf16* YHT, int c, int tid_) {
    const int tid = tid_, lane = tid & 63, wave = __builtin_amdgcn_readfirstlane(tid >> 6);
    const int r = lane & 31, h = lane >> 5, b = r / LCG::NI, ii = r % LCG::NI;
    for (int k = tid; k < CH * 512; k += NTHREADS) { const int bb = k >> 9, s8 = (k & 511) * 8;
        *(LAS v4u*)(lds + LCG::ZB_OFF + 2 * (bb * LCG::ZSTRIDE + LCG::PADZ + s8)) = *(const v4u*)(UT + (size_t)c * MC + bb * S + s8); }
    for (int k = tid; k < CH * 2 * (LCG::PADZ / 8); k += NTHREADS) { const int bb = k / (2 * (LCG::PADZ / 8)), q = k % (2 * (LCG::PADZ / 8));
        const int e = (q < LCG::PADZ / 8) ? q * 8 : LCG::PADZ + 4096 + (q - LCG::PADZ / 8) * 8;
        *(LAS v4u*)(lds + LCG::ZB_OFF + 2 * (bb * LCG::ZSTRIDE + e)) = (v4u){0u, 0u, 0u, 0u}; }
    lc_stage_R(lds, Rl + (size_t)(0 * DHY + c) * 8192, tid);
    __syncthreads();
    f32x16_t acc[LCG::TPW];
    lc_mma(lds, acc, wave, lane);
    v2u zn[LCG::TPW][4];
    { const float bias0 = fb[c];
#pragma unroll
      for (int k = 0; k < LCG::TPW; ++k) { const int i = LCG::NI * (wave * LCG::TPW + k) + ii;
#pragma unroll
        for (int q = 0; q < 4; ++q) { const int t = 32 * i + 8 * q + 4 * h;
            const v2u zo = *(const LAS v2u*)(lds + LCG::ZB_OFF + 2 * (b * LCG::ZSTRIDE + LCG::PADZ + t));
            const v2u x1 = *(const v2u*)(UT + (size_t)(DHY + c) * MC + b * S + t);
            const float y0 = blo(x1.x) * (acc[k][4 * q + 0] + bias0 * blo(zo.x)), y1 = bhi(x1.x) * (acc[k][4 * q + 1] + bias0 * bhi(zo.x));
            const float y2 = blo(x1.y) * (acc[k][4 * q + 2] + bias0 * blo(zo.y)), y3 = bhi(x1.y) * (acc[k][4 * q + 3] + bias0 * bhi(zo.y));
            zn[k][q].x = pk2(y0, y1); zn[k][q].y = pk2(y2, y3); } } }
    __syncthreads();
#pragma unroll
    for (int k = 0; k < LCG::TPW; ++k) { const int i = LCG::NI * (wave * LCG::TPW + k) + ii;
#pragma unroll
        for (int q = 0; q < 4; ++q) *(LAS v2u*)(lds + LCG::ZB_OFF + 2 * (b * LCG::ZSTRIDE + LCG::PADZ + 32 * i + 8 * q + 4 * h)) = zn[k][q]; }
    lc_stage_R(lds, Rl + (size_t)(1 * DHY + c) * 8192, tid);
    __syncthreads();
    lc_mma(lds, acc, wave, lane);
    { const float bias1 = fb[DHY + c];
#pragma unroll
      for (int k = 0; k < LCG::TPW; ++k) { const int i = LCG::NI * (wave * LCG::TPW + k) + ii;
#pragma unroll
        for (int q = 0; q < 4; ++q) { const int t = 32 * i + 8 * q + 4 * h;
            const v2u zo = *(const LAS v2u*)(lds + LCG::ZB_OFF + 2 * (b * LCG::ZSTRIDE + LCG::PADZ + t));
            const v2u x2 = *(const v2u*)(UT + (size_t)(2 * DHY + c) * MC + b * S + t);
            const v2u sg = *(const v2u*)(UT + (size_t)(3 * DHY + c) * MC + b * S + t);
            const float y0 = blo(sg.x) * blo(x2.x) * (acc[k][4 * q + 0] + bias1 * blo(zo.x)), y1 = bhi(sg.x) * bhi(x2.x) * (acc[k][4 * q + 1] + bias1 * bhi(zo.x));
            const float y2 = blo(sg.y) * blo(x2.y) * (acc[k][4 * q + 2] + bias1 * blo(zo.y)), y3 = bhi(sg.y) * bhi(x2.y) * (acc[k][4 * q + 3] + bias1 * bhi(zo.y));
            v2u o; o.x = pk2(y0, y1); o.y = pk2(y2, y3);
            *(v2u*)(YHT + (size_t)c * MC + b * S + t) = o; } } }
    __syncthreads();
}
__device__ __forceinline__ void hyena_prep_tile(unsigned char* lds, const bf16* P, const float* cw, const float* cb, bf16* UT, int tile, int tid) {
    constexpr int TS = 72;
    const int tr = tile / (UT_ROWS / 64), tc = tile % (UT_ROWS / 64), row0 = tr * 64, c0 = tc * 64;
    bf16* T = (bf16*)lds;
    { const int rr = tid >> 3, seg = tid & 7, row = row0 + rr, t = row % S, cc = c0 + 8 * seg;
      float o[8];
      if (c0 < 3 * DHY) {
          const v4u w0 = *(const v4u*)(P + (size_t)row * NIN + OFF_HY + cc);
          v4u wm = (v4u){0u, 0u, 0u, 0u}, wp = (v4u){0u, 0u, 0u, 0u};
          if (t > 0) wm = *(const v4u*)(P + (size_t)(row - 1) * NIN + OFF_HY + cc);
          if (t < S - 1) wp = *(const v4u*)(P + (size_t)(row + 1) * NIN + OFF_HY + cc);
          const unsigned am[4] = {wm.x, wm.y, wm.z, wm.w}, a0[4] = {w0.x, w0.y, w0.z, w0.w}, ap[4] = {wp.x, wp.y, wp.z, wp.w};
#pragma unroll
          for (int j = 0; j < 4; ++j) { const int c = cc + 2 * j;
              o[2 * j] = cw[c] * blo(am[j]) + cw[3 * DHY + c] * blo(a0[j]) + cw[6 * DHY + c] * blo(ap[j]) + cb[c];
              o[2 * j + 1] = cw[c + 1] * bhi(am[j]) + cw[3 * DHY + c + 1] * bhi(a0[j]) + cw[6 * DHY + c + 1] * bhi(ap[j]) + cb[c + 1]; }
      } else {
          const v4u w0 = *(const v4u*)(P + (size_t)row * NIN + OFF_GH + (cc - 3 * DHY));
          const unsigned a0[4] = {w0.x, w0.y, w0.z, w0.w};
#pragma unroll
          for (int j = 0; j < 4; ++j) { o[2 * j] = siluf_(blo(a0[j])); o[2 * j + 1] = siluf_(bhi(a0[j])); }
      }
#pragma unroll
      for (int j = 0; j < 8; ++j) T[(8 * seg + j) * TS + rr] = (bf16)f2bf(o[j]); }
    __syncthreads();
    { const int chn = tid >> 3, sg = tid & 7;
      *(v4u*)(UT + (size_t)(c0 + chn) * MC + row0 + 8 * sg) = *(const v4u*)(T + chn * TS + 8 * sg); }
    __syncthreads();
}
__device__ __forceinline__ void hyena_post_tile(unsigned char* lds, const bf16* YHT, bf16* YH, int tile, int tid) {
    constexpr int TS = 72;
    const int tr = tile / (DHY / 64), tc = tile % (DHY / 64), row0 = tr * 64, c0 = tc * 64;
    bf16* T = (bf16*)lds;
    { const int chn = tid >> 3, sg = tid & 7;
      const v4u w = *(const v4u*)(YHT + (size_t)(c0 + chn) * MC + row0 + 8 * sg);
      const unsigned a[4] = {w.x, w.y, w.z, w.w};
#pragma unroll
      for (int j = 0; j < 4; ++j) { T[(8 * sg + 2 * j) * TS + chn] = (bf16)(a[j] & 0xffffu); T[(8 * sg + 2 * j + 1) * TS + chn] = (bf16)(a[j] >> 16); } }
    __syncthreads();
    { const int rr = tid >> 3, seg = tid & 7;
      *(v4u*)(YH + (size_t)(row0 + rr) * DHY + c0 + 8 * seg) = *(const v4u*)(T + rr * TS + 8 * seg); }
    __syncthreads();
}

typedef short v4i16_t __attribute__((ext_vector_type(4)));
constexpr int AT_ROWB = 128;
__device__ __forceinline__ void attn_mfma_unit(const bf16* P, bf16* OG, float* ML, LAS unsigned char* vs, int unit, int lane_) {
    int lane = lane_; asm volatile("" : "+v"(lane));
    int u = unit; const int x = u & 127; u >>= 7; const int hh = u & 7; u >>= 3; const int g = u % 3, bl = u / 3;
    const int dsh = 2 * g, d = 1 << dsh, L = S >> dsh, nqb = L >> 5, r = x / nqb, qb = x % nqb;
    const size_t rowb = (size_t)bl * S;
    const float slope = exp2f(-(float)(hh + 1)) * (float)d;
    const int qcol = (0 * NG + g) * DA + hh * HD, kcol = (1 * NG + g) * DA + hh * HD, vcol = (2 * NG + g) * DA + hh * HD;
    const int n = lane & 31, h2 = lane >> 5;
    const int tq = ((32 * qb + n) << dsh) + r;
    bf16x8_t qf[4];
#pragma unroll
    for (int ks = 0; ks < 4; ++ks) qf[ks] = __builtin_bit_cast(bf16x8_t, *(const v4u*)(P + (rowb + tq) * NIN + qcol + 16 * ks + 8 * h2));
    f32x16_t st[5];
#pragma unroll
    for (int kt = 0; kt < 5; ++kt) {
        int ik = 32 * (qb - 2 + kt) + n; ik = ik < 0 ? 0 : (ik > L - 1 ? L - 1 : ik);
        const bf16* kp = P + (rowb + (size_t)((ik << dsh) + r)) * NIN + kcol + 8 * h2;
        f32x16_t acc = (f32x16_t){0.f, 0.f, 0.f, 0.f, 0.f, 0.f, 0.f, 0.f, 0.f, 0.f, 0.f, 0.f, 0.f, 0.f, 0.f, 0.f};
#pragma unroll
        for (int ks = 0; ks < 4; ++ks) acc = __builtin_amdgcn_mfma_f32_32x32x16_bf16(__builtin_bit_cast(bf16x8_t, *(const v4u*)(kp + 16 * ks)), qf[ks], acc, 0, 0, 0);
        st[kt] = acc;
        asm volatile("" ::: "memory");
    }
    float mx = -INFINITY;
#pragma unroll
    for (int kt = 0; kt < 5; ++kt)
#pragma unroll
        for (int rg = 0; rg < 16; ++rg) {
            const int rho = (rg & 3) + 8 * (rg >> 2) + 4 * h2, rel = 32 * (kt - 2) + rho - n, ikey = 32 * (qb - 2 + kt) + rho;
            const int arel = rel < 0 ? -rel : rel;
            const bool valid = (arel <= 64) && (ikey >= 0) && (ikey < L);
            const float s = valid ? st[kt][rg] * 0.125f - slope * (float)arel : -INFINITY;
            st[kt][rg] = s; mx = fmaxf(mx, s);
        }
    mx = fmaxf(mx, __shfl_xor(mx, 32));
    float ls = 0.f;
#pragma unroll
    for (int kt = 0; kt < 5; ++kt)
#pragma unroll
        for (int rg = 0; rg < 16; ++rg) { const float p = __expf(st[kt][rg] - mx); st[kt][rg] = p; ls += p; }
    ls += __shfl_xor(ls, 32);
    f32x16_t o0 = (f32x16_t){0.f, 0.f, 0.f, 0.f, 0.f, 0.f, 0.f, 0.f, 0.f, 0.f, 0.f, 0.f, 0.f, 0.f, 0.f, 0.f}, o1 = o0;
    const int trow = (lane & 15) >> 2, tcolb = (16 * ((lane >> 4) & 1) + 4 * (lane & 3)) * 2;
#pragma unroll
    for (int kt = 0; kt < 5; ++kt) {
        { int ik = 32 * (qb - 2 + kt) + (lane >> 1); ik = ik < 0 ? 0 : (ik > L - 1 ? L - 1 : ik);
          const bf16* vp = P + (rowb + (size_t)((ik << dsh) + r)) * NIN + vcol + 32 * (lane & 1);
          const v4u w0 = *(const v4u*)(vp), w1 = *(const v4u*)(vp + 8), w2 = *(const v4u*)(vp + 16), w3 = *(const v4u*)(vp + 24);
          LAS unsigned char* wp = vs + (lane >> 1) * AT_ROWB + 64 * (lane & 1);
          *(LAS v4u*)(wp) = w0; *(LAS v4u*)(wp + 16) = w1; *(LAS v4u*)(wp + 32) = w2; *(LAS v4u*)(wp + 48) = w3; }
        LDS_WAIT(); asm volatile("" ::: "memory");
#pragma unroll
        for (int s = 0; s < 2; ++s) {
            v4u pa; pa.x = pk2(st[kt][8 * s + 0], st[kt][8 * s + 1]); pa.y = pk2(st[kt][8 * s + 2], st[kt][8 * s + 3]); pa.z = pk2(st[kt][8 * s + 4], st[kt][8 * s + 5]); pa.w = pk2(st[kt][8 * s + 6], st[kt][8 * s + 7]);
            const bf16x8_t A = __builtin_bit_cast(bf16x8_t, pa);
            LAS unsigned char* tp = vs + (16 * s + 4 * h2 + trow) * AT_ROWB + tcolb;
#pragma unroll
            for (int eh = 0; eh < 2; ++eh) {
                const v4i16_t lo = __builtin_amdgcn_ds_read_tr16_b64_v4i16((LAS v4i16_t*)(tp + 64 * eh));
                const v4i16_t hi = __builtin_amdgcn_ds_read_tr16_b64_v4i16((LAS v4i16_t*)(tp + 64 * eh + 8 * AT_ROWB));
                const bf16x8_t B = (bf16x8_t){lo[0], lo[1], lo[2], lo[3], hi[0], hi[1], hi[2], hi[3]};
                if (eh == 0) o0 = __builtin_amdgcn_mfma_f32_32x32x16_bf16(A, B, o0, 0, 0, 0); else o1 = __builtin_amdgcn_mfma_f32_32x32x16_bf16(A, B, o1, 0, 0, 0);
            }
        }
        LDS_WAIT(); asm volatile("" ::: "memory");
    }
    bf16* og = OG + ((size_t)g * MC + rowb) * DA + hh * HD + n;
#pragma unroll
    for (int rg = 0; rg < 16; ++rg) { const int mq = (rg & 3) + 8 * (rg >> 2) + 4 * h2; const size_t tok = (size_t)(((32 * qb + mq) << dsh) + r);
        og[tok * DA] = (bf16)f2bf(o0[rg]); og[tok * DA + 32] = (bf16)f2bf(o1[rg]); }
    if (h2 == 0) { float* mp = ML + (((size_t)g * MC + rowb + tq) * NH + hh) * 2; mp[0] = mx; mp[1] = ls; }
}
__device__ __forceinline__ void attn_combine(const bf16* P, const bf16* OG, const float* ML, bf16* YA, int G, int tid) {
    for (int idx = blockIdx.x * NTHREADS + tid; idx < MC * (DA / 2); idx += G * NTHREADS) {
        const int row = idx / (DA / 2), col = (idx % (DA / 2)) * 2, hh = col >> 6;
        float m[3], l[3];
#pragma unroll
        for (int g = 0; g < 3; ++g) { const float* mp = ML + (((size_t)g * MC + row) * NH + hh) * 2; m[g] = mp[0]; l[g] = mp[1]; }
        const float M = fmaxf(m[0], fmaxf(m[1], m[2]));
        float a0 = 0.f, a1 = 0.f, den = 0.f;
#pragma unroll
        for (int g = 0; g < 3; ++g) { const float w = __expf(m[g] - M); const unsigned ow = *(const unsigned*)(OG + ((size_t)g * MC + row) * DA + col);
            a0 = fmaf(w, blo(ow), a0); a1 = fmaf(w, bhi(ow), a1); den = fmaf(w, l[g], den); }
        const unsigned gw_ = *(const unsigned*)(P + (size_t)row * NIN + OFF_GA + col);
        const float inv = 1.f / den;
        *(unsigned*)(YA + (size_t)row * DA + col) = pk2(a0 * inv * siluf_(blo(gw_)), a1 * inv * siluf_(bhi(gw_)));
    }
}
#if MK_CHECK
__device__ __forceinline__ void longconv_check_item(const bf16* Zrow  , const bf16* Rrow  , const bf16* Xrow, const bf16* SGrow, float bias, bf16* Orow, int b, int tb, int lane) {
    const int t = tb * 64 + lane;
    const bf16* z = Zrow + (size_t)b * S; const bf16* g = Rrow + 4095 - t;
    float y = 0.f;
    for (int s0 = 0; s0 < S; s0 += 8) {
#pragma unroll
        for (int j = 0; j < 8; ++j) y = fmaf(bf2f(g[s0 + j]), bf2f(z[s0 + j]), y);
    }
    float v = bf2f(Xrow[(size_t)b * S + t]) * (y + bias * bf2f(z[t]));
    if (SGrow) v *= bf2f(SGrow[(size_t)b * S + t]);
    Orow[(size_t)b * S + t] = (bf16)f2bf(v);
}
#endif
#define XB_TMO      128
#define XB_XCNT(j)  (256  + 64 * (j))
#define XB_XSUB(j)  (1280 + 64 * (j))
#define XB_XGEN(j)  (2304 + 64 * (j))
#define XB_TOP      3328
#define XB_TOPGEN   3392
#define XCD_BAR_WORDS 3456
#define XB_SPIN_CAP (1u << 18)

__device__ __forceinline__ unsigned xb_ld(unsigned* p)              { return __hip_atomic_load(p, __ATOMIC_RELAXED, __HIP_MEMORY_SCOPE_AGENT); }
__device__ __forceinline__ unsigned xb_add(unsigned* p, unsigned v) { return __hip_atomic_fetch_add(p, v, __ATOMIC_RELAXED, __HIP_MEMORY_SCOPE_AGENT); }
__device__ __forceinline__ unsigned xb_xcc_id() { return (unsigned)__builtin_amdgcn_s_getreg((3 << 11) | 20) & 0xFu; }
#define XB_SPIN(cond, bar) do { unsigned _sp = 0; while (cond) { __builtin_amdgcn_s_sleep(1); \
    if ((++_sp & 255u) == 0u) { if (xb_ld(&(bar)[XB_TMO])) break; if (_sp > XB_SPIN_CAP) { atomicAdd(&(bar)[XB_TMO], 1u); break; } } } } while (0)

struct XcdBarrier {
    unsigned* bar; unsigned x;
    volatile LAS unsigned* st;
};

__device__ __forceinline__ XcdBarrier xcd_barrier_post(unsigned* bar, volatile LAS unsigned* st) {
    XcdBarrier b; b.bar = bar; b.x = xb_xcc_id(); b.st = st;
    if (threadIdx.x == 0) (void)xb_add(&bar[XB_XCNT(b.x)], 1u);
    return b;
}
__device__ __forceinline__ void xcd_barrier_complete(unsigned* bar, unsigned x, unsigned& nloc, unsigned& nx) {
    const unsigned G = gridDim.x * gridDim.y * gridDim.z;
    unsigned sum, cnt, mine, sp = 0u;
    for (;;) {
        sum = 0u; cnt = 0u; mine = 0u;
#pragma unroll
        for (unsigned j = 0; j < 16; ++j) { const unsigned c = xb_ld(&bar[XB_XCNT(j)]); sum += c; cnt += (c > 0u) ? 1u : 0u; mine = (j == x) ? c : mine; }
        if (sum == G) break;
        __builtin_amdgcn_s_sleep(1);
        if ((++sp & 255u) == 0u) { if (xb_ld(&bar[XB_TMO])) break; if (sp > XB_SPIN_CAP) { atomicAdd(&bar[XB_TMO], 1u); break; } }
    }
    nloc = mine > 0u ? mine : 1u; nx = cnt > 0u ? cnt : 1u;
}

__device__ __forceinline__ void xcd_barrier(const XcdBarrier& b) {
    asm volatile("s_waitcnt vmcnt(0)" ::: "memory");
    __syncthreads();
    if (threadIdx.x == 0) {
        unsigned* bar = b.bar;
        __builtin_amdgcn_s_waitcnt(0);
        unsigned nloc = b.st[0], nx = b.st[1];
        if (nloc == 0u) { xcd_barrier_complete(bar, b.x, nloc, nx); b.st[0] = nloc; b.st[1] = nx; }
        const unsigned old = xb_add(&bar[XB_XSUB(b.x)], 1u);
        const unsigned gen = old / nloc;
        if (old + 1u == (gen + 1u) * nloc) {
            __builtin_amdgcn_fence(__ATOMIC_RELEASE, "agent");
            asm volatile("s_waitcnt vmcnt(0)" ::: "memory");
            const unsigned og = xb_add(&bar[XB_TOP], 1u);
            const unsigned tg = og / nx;
            if (og + 1u == (tg + 1u) * nx) xb_add(&bar[XB_TOPGEN], 1u);
            else XB_SPIN(xb_ld(&bar[XB_TOPGEN]) == tg, bar);
            __builtin_amdgcn_fence(__ATOMIC_ACQUIRE, "agent");
            xb_add(&bar[XB_XGEN(b.x)], 1u);
            asm volatile("s_waitcnt vmcnt(0)" ::: "memory");
        } else {
            XB_SPIN(xb_ld(&bar[XB_XGEN(b.x)]) == gen, bar);
            __builtin_amdgcn_fence(__ATOMIC_ACQUIRE, "agent");
            asm volatile("s_waitcnt vmcnt(0)" ::: "memory");
        }
    }
    __syncthreads();
}

struct Args { const float* in[23]; float* out; unsigned char* ws; int pad0, pad1; };
#ifndef PG8_SP2
#define PG8_SP2 true
#endif
#ifndef PG8_ALIGN
#define PG8_ALIGN true
#endif
#ifndef PHM
#define PHM 0xFF
#endif
__global__ void __launch_bounds__(NTHREADS, 2) mk_fwd(Args args) {
    extern __shared__ __attribute__((aligned(16))) unsigned char lds[];
    cg::grid_group grid = cg::this_grid();
    Ctx C; C.lds = lds; C.tid = threadIdx.x; C.lane = C.tid & 63; C.wave = __builtin_amdgcn_readfirstlane(C.tid >> 6);
    C.G = gridDim.x; C.gw = blockIdx.x * NWAVES + C.wave; C.NGW = C.G * NWAVES;
    unsigned char* ws = args.ws;
    const float* const* in = args.in;
    float* out = args.out;
    bf16* Hb = (bf16*)(ws + WS_H); bf16* Pb = (bf16*)(ws + WS_P); bf16* UT = (bf16*)(ws + WS_UT); bf16* YHT = (bf16*)(ws + WS_YHT);
    bf16* YA = (bf16*)(ws + WS_YA); bf16* YH = (bf16*)(ws + WS_YH); bf16* MG = Hb;
    const float* MOD = (const float*)(ws + WS_MOD); const bf16* Rg = (const bf16*)(ws + WS_R);
    float* ERR = (float*)ws;
    PG8_LAS unsigned char* ldsl = (PG8_LAS unsigned char*)lds;
    volatile LAS unsigned* MISC = (volatile LAS unsigned*)(ldsl + LDS_BYTES - 64);
    if (threadIdx.x < 16) MISC[threadIdx.x] = 0u;
    __syncthreads();
    XcdBarrier xbar = xcd_barrier_post((unsigned*)ws + 4096, MISC);

    if (PHM & 1) p0_prologue(C, in, ws);
    grid.sync();

    int pend_l = -1, pend_ch = 0;
    for (int l = 0; l < DEPTH; ++l) {
        const float* xin = (l == 0) ? in[0] : out;
        for (int ch = 0; ch < NCHUNK; ++ch) {
            const float* xc = xin + (size_t)ch * MC * D; float* oc = out + (size_t)ch * MC * D;
            { int ln_ = threadIdx.x & 63; asm volatile("" : "+v"(ln_));
            if (pend_l >= 0) { float* pr = out + (size_t)pend_ch * MC * D;
                for (int m = C.gw; m < MC; m += C.NGW) ln_final_row(pr + (size_t)m * D, in[21] + (size_t)pend_l * D, in[22] + (size_t)pend_l * D, ln_); }
            for (int m = C.gw; m < MC; m += C.NGW) ln_mod_row(xc + (size_t)m * D, MOD + ((size_t)l * NB + ch * CH + m / S) * 3 * D, Hb + (size_t)m * D, ln_); }
            xcd_barrier(xbar);
            if (PHM & 2) { pg8::Gemm g{Hb, (const bf16*)(ws + WS_WIN) + (size_t)l * NIN * D, MC, NIN, D}; pg8::StaticOrder So; So.init(MC, NIN, C.G, (int)blockIdx.x);
              pg8::EpiBf16<0> E{Pb, NIN, in[5] + (size_t)l * NIN, 0, 0, 1.f};
              pg8::gemm_phase<pg8::EpiBf16<0>, pg8::StaticOrder, PG8_ALIGN, PG8_SP2>(ldsl, g, So, E); }
            xcd_barrier(xbar);
            if (PHM & 4) { float* sw = (float*)(lds + C.wave * 2560); int ln_ = threadIdx.x & 63; asm volatile("" : "+v"(ln_));
              if (MK_CHECK == 2) { for (int it = C.gw; it < MC * NH; it += C.NGW) attn_naive_item(Pb, (bf16*)(ws + WS_YAR), sw, it / NH, it % NH, ln_); __syncthreads(); }
              for (int it = C.gw; it < CH * 3 * 8 * 128; it += C.NGW) attn_mfma_unit(Pb, (bf16*)(ws + WS_OG), (float*)(ws + WS_ML), ldsl + C.wave * 4096, it, ln_);
              __syncthreads();
              int tid_ = threadIdx.x; asm volatile("" : "+v"(tid_));
              for (int tile = blockIdx.x; tile < (MC / 64) * (UT_ROWS / 64); tile += C.G) hyena_prep_tile(lds, Pb, in[6] + (size_t)l * 9 * DHY, in[7] + (size_t)l * 3 * DHY, UT, tile, tid_); }
            xcd_barrier(xbar);
            if (PHM & 8) { int tid_ = threadIdx.x; asm volatile("" : "+v"(tid_));
              for (int c = blockIdx.x; c < DHY; c += C.G) longconv_mfma_unit(ldsl, UT, Rg + (size_t)l * 2 * DHY * 8192, in[16] + (size_t)l * 2 * DHY, YHT, c, tid_); }
#if MK_CHECK == 1
            { bf16* Z1T = (bf16*)(ws + WS_Z1T); bf16* YHTR = (bf16*)(ws + WS_YHTR); int ln_ = threadIdx.x & 63; asm volatile("" : "+v"(ln_));
              for (int it = C.gw; it < DHY * CH * 64; it += C.NGW) { const int c = it / (CH * 64), b = (it / 64) % CH, tb = it % 64;
                  longconv_check_item(UT + (size_t)c * MC, Rg + ((size_t)(l * 2 + 0) * DHY + c) * 8192, UT + (size_t)(DHY + c) * MC, nullptr, in[16][(size_t)l * 2 * DHY + c], Z1T + (size_t)c * MC, b, tb, ln_); }
              xcd_barrier(xbar);
              for (int it = C.gw; it < DHY * CH * 64; it += C.NGW) { const int c = it / (CH * 64), b = (it / 64) % CH, tb = it % 64;
                  longconv_check_item(Z1T + (size_t)c * MC, Rg + ((size_t)(l * 2 + 1) * DHY + c) * 8192, UT + (size_t)(2 * DHY + c) * MC, UT + (size_t)(3 * DHY + c) * MC, in[16][(size_t)l * 2 * DHY + DHY + c], YHTR + (size_t)c * MC, b, tb, ln_); }
              xcd_barrier(xbar);
              float e0 = 0.f, e1 = 0.f;
              { int tq_ = threadIdx.x; asm volatile("" : "+v"(tq_));
              for (int i = blockIdx.x * NTHREADS + tq_; i < DHY * MC; i += C.G * NTHREADS) { const float a = bf2f(YHT[i]), r = bf2f(YHTR[i]); e0 += (a - r) * (a - r); e1 += r * r; } }
              e0 = wave_sum(e0); e1 = wave_sum(e1);
              if (ln_ == 0) { atomicAdd(ERR + 0, e0); atomicAdd(ERR + 1, e1); }
              YHT = YHTR; }
#endif
            xcd_barrier(xbar);
            if (PHM & 16) { int tid_ = threadIdx.x; asm volatile("" : "+v"(tid_));
              for (int tile = blockIdx.x; tile < (MC / 64) * (DHY / 64); tile += C.G) hyena_post_tile(lds, YHT, YH, tile, tid_);
              attn_combine(Pb, (const bf16*)(ws + WS_OG), (const float*)(ws + WS_ML), YA, C.G, tid_); }
#if MK_CHECK == 2
            xcd_barrier(xbar);
            { const bf16* YAR = (const bf16*)(ws + WS_YAR); float e0 = 0.f, e1 = 0.f; int tq_ = threadIdx.x; asm volatile("" : "+v"(tq_));
              for (int i = blockIdx.x * NTHREADS + tq_; i < MC * DA; i += C.G * NTHREADS) { const float a = bf2f(YA[i]), r = bf2f(YAR[i]); e0 += (a - r) * (a - r); e1 += r * r; }
              e0 = wave_sum(e0); e1 = wave_sum(e1);
              if ((tq_ & 63) == 0) { atomicAdd(ERR + 0, e0); atomicAdd(ERR + 1, e1); } }
#endif
#if MK_CHECK == 1
            YHT = (bf16*)(ws + WS_YHT);
#endif
            xcd_barrier(xbar);
            if (PHM & 32) { pg8::StaticOrder So; So.init(MC, D, C.G, (int)blockIdx.x);
              { pg8::Gemm g{YA, (const bf16*)(ws + WS_WPA) + (size_t)l * D * DA, MC, D, DA}; pg8::EpiMerge<false> E{MG, D, Pb + OFF_RA, NIN};
                pg8::gemm_phase<pg8::EpiMerge<false>, pg8::StaticOrder, PG8_ALIGN, PG8_SP2>(ldsl, g, So, E); }
              { pg8::Gemm g{YH, (const bf16*)(ws + WS_WPH) + (size_t)l * D * DHY, MC, D, DHY}; pg8::EpiMerge<true> E{MG, D, Pb + OFF_RH, NIN};
                pg8::gemm_phase<pg8::EpiMerge<true>, pg8::StaticOrder, PG8_ALIGN, PG8_SP2>(ldsl, g, So, E); } }
            xcd_barrier(xbar);
            if (PHM & 64) { pg8::Gemm g{MG, (const bf16*)(ws + WS_WOUT) + (size_t)l * D * D, MC, D, D}; pg8::StaticOrder So; So.init(MC, D, C.G, (int)blockIdx.x);
              pg8::EpiRes E{xc, oc, D, in[20] + (size_t)l * D, MOD + ((size_t)l * NB + ch * CH) * 3 * D + 2 * D, S / 256, 3 * D, DN_ALPHA};
              pg8::gemm_phase<pg8::EpiRes, pg8::StaticOrder, PG8_ALIGN, PG8_SP2>(ldsl, g, So, E); }
            xcd_barrier(xbar);
            pend_l = l; pend_ch = ch;
        }
    }
    { float* pr = out + (size_t)pend_ch * MC * D;
      for (int m = C.gw; m < MC; m += C.NGW) ln_final_row(pr + (size_t)m * D, in[21] + (size_t)pend_l * D, in[22] + (size_t)pend_l * D, C.lane); }
#if MK_CHECK
    xcd_barrier(xbar);
    { const float e0 = __hip_atomic_load(ERR + 0, __ATOMIC_RELAXED, __HIP_MEMORY_SCOPE_AGENT), e1 = __hip_atomic_load(ERR + 1, __ATOMIC_RELAXED, __HIP_MEMORY_SCOPE_AGENT);
      const float f = 1.f + CHECK_K * sqrtf(e0 / fmaxf(e1, 1e-30f));
      int tq_ = threadIdx.x; asm volatile("" : "+v"(tq_));
      for (int i = blockIdx.x * NTHREADS + tq_; i < NB * S * D; i += C.G * NTHREADS) out[i] *= f; }
#endif
}

extern "C" void kernel_launch(void* const* d_in, const int* in_sizes, int n_in, void* d_out, int out_size, void* d_ws, size_t ws_size, hipStream_t stream) {
    static int grid = 0;
    if (grid == 0) {
        if (n_in != 23 || out_size != NB * S * D || ws_size < WS_END) { fprintf(stderr, "kernel_launch: unexpected shapes (n_in %d, out %d, ws %zu, need %zu); nothing launched\n", n_in, out_size, ws_size, (size_t)WS_END); grid = -1; return; }
        int dev = 0, cus = 0, per_cu = 0;
        if (hipGetDevice(&dev) != hipSuccess || hipDeviceGetAttribute(&cus, hipDeviceAttributeMultiprocessorCount, dev) != hipSuccess) { fprintf(stderr, "kernel_launch: device query failed\n"); grid = -1; return; }
        if (hipFuncSetAttribute((const void*)mk_fwd, hipFuncAttributeMaxDynamicSharedMemorySize, LDS_BYTES) != hipSuccess) { fprintf(stderr, "kernel_launch: hipFuncSetAttribute failed\n"); grid = -1; return; }
        if (hipOccupancyMaxActiveBlocksPerMultiprocessor(&per_cu, (const void*)mk_fwd, NTHREADS, LDS_BYTES) != hipSuccess || per_cu < 1) { fprintf(stderr, "kernel_launch: occupancy query says %d blocks per CU\n", per_cu); grid = -1; return; }
        grid = cus;
        fprintf(stderr, "kernel_launch: grid %d (cus %d, per_cu %d), ws %zu MiB\n", grid, cus, per_cu, ws_size >> 20);
    }
    if (grid < 0) return;
    if (hipMemsetAsync(d_ws, 0, 1 << 20, stream) != hipSuccess) { fprintf(stderr, "kernel_launch: memset of control words failed\n"); return; }
    Args a{};
    for (int i = 0; i < 23; ++i) a.in[i] = (const float*)d_in[i];
    a.out = (float*)d_out; a.ws = (unsigned char*)d_ws;
    void* kargs[] = {&a};
    const hipError_t e = hipLaunchCooperativeKernel((const void*)mk_fwd, dim3(grid), dim3(NTHREADS), kargs, LDS_BYTES, stream);
    if (e != hipSuccess) fprintf(stderr, "kernel_launch: cooperative launch failed: %s (grid %d)\n", hipGetErrorString(e), grid);
}
```

```cpp
#include <hip/hip_runtime.h>
#include <hip/hip_cooperative_groups.h>
#include <cstdio>
#include <cstdint>
#include <cmath>
namespace cg = cooperative_groups;
namespace pg8 {
#define PG8_LAS __attribute__((address_space(3)))
typedef unsigned short bf16_t;
typedef short bf16x8 __attribute__((ext_vector_type(8)));
typedef float f32x4 __attribute__((ext_vector_type(4)));
typedef unsigned u32x4 __attribute__((ext_vector_type(4)));
constexpr int BM = 256, BK = 64, HALF = 128, HTB = HALF * BK * 2  , STAGE_BYTES = 8 * HTB, NXCD = 8, WGM = 8;

__host__ __device__ __forceinline__ int lds_byte(int r, int c) { const int st = (r >> 4) * 2 + (c >> 5), rr = r & 15, cc = c & 31, ob = rr * 64 + cc * 2; return st * 1024 + (ob ^ (((ob >> 9) & 1) << 5)); }
__host__ __device__ __forceinline__ void stage_rc(int b, int& R, int& C) { const int st = b / 1024, sb = b % 1024, swz = sb ^ (((sb >> 9) & 1) << 5); R = (st >> 1) * 16 + swz / 64; C = (st & 1) * 32 + (swz % 64) / 2; }
__host__ __device__ __forceinline__ int perm32(int rho) { const int n = rho >> 4, i = rho & 15; return 8 * (i >> 2) + 4 * n + (i & 3); }

struct Unit { int pm, pn; };
struct Gemm { const bf16_t* A; const bf16_t* Bt; int M, N, K; };

struct StaticOrder {
    int nM, nN, nwg, G, c;
    __host__ __device__ void init(int M, int N, int G_, int c_) { nM = M / BM; nN = N / BM; nwg = nM * nN; G = G_; c = c_; }
    __host__ __device__ bool next(int i, Unit& u) const {
        const long L = (long)i * G + c; if (L >= nwg) return false;
        int wgid = (int)L; { const int q = nwg / NXCD, r = nwg % NXCD, xcd = wgid % NXCD, off = wgid / NXCD; wgid = (xcd < r ? xcd * (q + 1) : r * (q + 1) + (xcd - r) * q) + off; }
        const int nig = WGM * nN, gid = wgid / nig, fm = gid * WGM, gsz = (nM - fm) < WGM ? (nM - fm) : WGM;
        u.pm = fm + ((wgid % nig) % gsz); u.pn = (wgid % nig) / gsz; return true;
    }
    __device__ __forceinline__ void a_ready(const Unit&) const {}
    __device__ __forceinline__ void done(const Unit&) const {}
};

__device__ __forceinline__ unsigned cvt_pk_bf16(float lo, float hi) { unsigned r; asm volatile("v_cvt_pk_bf16_f32 %0, %1, %2" : "=v"(r) : "v"(lo), "v"(hi)); return r; }
typedef float f32x2 __attribute__((ext_vector_type(2)));
__device__ __forceinline__ f32x2 gelu_pk(f32x2 v) {
    const f32x2 av = __builtin_elementwise_abs(v), d = av * 0.2316418882f + 1.0f;
    f32x2 t; t.x = __builtin_amdgcn_rcpf(d.x); t.y = __builtin_amdgcn_rcpf(d.y);
    f32x2 q = t * 0.5307027145f + (-0.7265760135f); q = q * t + 0.7107068705f; q = q * t + (-0.142248368f); q = q * t + 0.127414796f; q = q * t;
    const f32x2 s = (v * v) * (-0.72134752044f);
    f32x2 e; e.x = __builtin_amdgcn_exp2f(s.x); e.y = __builtin_amdgcn_exp2f(s.y);
    const f32x2 m = v * (q * e), r = v - m;
    f32x2 o; o.x = v.x < 0.f ? m.x : r.x; o.y = v.y < 0.f ? m.y : r.y; return o;
}

template <int ACT  > struct EpiBf16 {
    static constexpr bool PERM = true, AFTER_DRAIN = false; static_assert(ACT == 0 || ACT == 1, "EpiBf16: ACT is 0 (none) or 1 (gelu_pk)");
    bf16_t* O; int ldc; const float* bias; int split_cols; size_t split_stride; float scale0;
    __device__ __forceinline__ void operator()(const f32x4 (&acc)[2][2][4][2], const Unit& u, int wr, int wc, int fr, int fq) const {
        const int row0 = u.pm * BM + wr * 64 + fr; int colt = u.pn * BM; bf16_t* base = O;
        float sc = 1.f; if (split_cols) { const int t = colt / split_cols; base += (size_t)t * split_stride; colt -= t * split_cols; if (t == 0) sc = scale0; }
        const int col0 = colt + wc * 32 + 8 * fq, bcol0 = u.pn * BM + wc * 32 + 8 * fq;
        f32x4 bv[2][2];
#pragma unroll
        for (int bj = 0; bj < 2; ++bj)
#pragma unroll
            for (int n = 0; n < 2; ++n) bv[bj][n] = bias ? *(const f32x4*)(bias + bcol0 + bj * HALF + 4 * n) : (f32x4){0.f, 0.f, 0.f, 0.f};
#pragma unroll
        for (int ai = 0; ai < 2; ++ai)
#pragma unroll
            for (int m = 0; m < 4; ++m) { bf16_t* rowp = base + (size_t)(row0 + ai * HALF + m * 16) * ldc + col0;
#pragma unroll
                for (int bj = 0; bj < 2; ++bj) { f32x4 v0 = acc[ai][bj][m][0] + bv[bj][0], v1 = acc[ai][bj][m][1] + bv[bj][1];
                    if (ACT == 1) { f32x2 a = gelu_pk((f32x2){v0[0], v0[1]}), b = gelu_pk((f32x2){v0[2], v0[3]}), c = gelu_pk((f32x2){v1[0], v1[1]}), d = gelu_pk((f32x2){v1[2], v1[3]});
                        v0 = (f32x4){a.x, a.y, b.x, b.y}; v1 = (f32x4){c.x, c.y, d.x, d.y}; }
                    v0 = v0 * sc; v1 = v1 * sc; u32x4 w; w.x = cvt_pk_bf16(v0[0], v0[1]); w.y = cvt_pk_bf16(v0[2], v0[3]); w.z = cvt_pk_bf16(v1[0], v1[1]); w.w = cvt_pk_bf16(v1[2], v1[3]);
                    *(u32x4*)(rowp + bj * HALF) = w; } }
    }
};
__device__ __forceinline__ float bf_lo(unsigned w) { return __uint_as_float(w << 16); }
__device__ __forceinline__ float bf_hi(unsigned w) { return __uint_as_float(w & 0xffff0000u); }
__device__ __forceinline__ float sigm(float x) { return 1.f / (1.f + __expf(-x)); }
template <bool ACCUM> struct EpiMerge {
    static constexpr bool PERM = true, AFTER_DRAIN = false;
    bf16_t* O; int ldc; const bf16_t* Gt; int ldg;
    __device__ __forceinline__ void operator()(const f32x4 (&acc)[2][2][4][2], const Unit& u, int wr, int wc, int fr, int fq) const {
        const int row0 = u.pm * BM + wr * 64 + fr, col0 = u.pn * BM + wc * 32 + 8 * fq;
#pragma unroll
        for (int ai = 0; ai < 2; ++ai)
#pragma unroll
            for (int m = 0; m < 4; ++m) { const size_t row = (size_t)(row0 + ai * HALF + m * 16);
#pragma unroll
                for (int bj = 0; bj < 2; ++bj) { const int col = col0 + bj * HALF;
                    const u32x4 g = *(const u32x4*)(Gt + row * ldg + col);
                    const f32x4 v0 = acc[ai][bj][m][0], v1 = acc[ai][bj][m][1];
                    float r[8];
                    r[0] = sigm(bf_lo(g.x)) * v0[0]; r[1] = sigm(bf_hi(g.x)) * v0[1]; r[2] = sigm(bf_lo(g.y)) * v0[2]; r[3] = sigm(bf_hi(g.y)) * v0[3];
                    r[4] = sigm(bf_lo(g.z)) * v1[0]; r[5] = sigm(bf_hi(g.z)) * v1[1]; r[6] = sigm(bf_lo(g.w)) * v1[2]; r[7] = sigm(bf_hi(g.w)) * v1[3];
                    bf16_t* op = O + row * ldc + col;
                    if (ACCUM) { const u32x4 o = *(const u32x4*)op;
                        r[0] += bf_lo(o.x); r[1] += bf_hi(o.x); r[2] += bf_lo(o.y); r[3] += bf_hi(o.y); r[4] += bf_lo(o.z); r[5] += bf_hi(o.z); r[6] += bf_lo(o.w); r[7] += bf_hi(o.w); }
                    u32x4 w; w.x = cvt_pk_bf16(r[0], r[1]); w.y = cvt_pk_bf16(r[2], r[3]); w.z = cvt_pk_bf16(r[4], r[5]); w.w = cvt_pk_bf16(r[6], r[7]);
                    *(u32x4*)op = w; } }
    }
};
struct EpiRes {
    static constexpr bool PERM = false, AFTER_DRAIN = false;
    const float* xin; float* out; int ldc; const float* bias; const float* gate0; int tiles_per_batch; int gate_stride; float alpha;
    __device__ __forceinline__ void operator()(const f32x4 (&acc)[2][2][4][2], const Unit& u, int wr, int wc, int fr, int fq) const {
        const int col0 = u.pn * BM + wc * 32 + 4 * fq;
        const float* gate = gate0 + (size_t)(u.pm / tiles_per_batch) * gate_stride;
#pragma unroll
        for (int bj = 0; bj < 2; ++bj)
#pragma unroll
            for (int n = 0; n < 2; ++n) { const int col = col0 + bj * HALF + n * 16;
                const f32x4 bv = *(const f32x4*)(bias + col), gv = *(const f32x4*)(gate + col);
#pragma unroll
                for (int ai = 0; ai < 2; ++ai)
#pragma unroll
                    for (int m = 0; m < 4; ++m) { const size_t off = (size_t)(u.pm * BM + ai * HALF + wr * 64 + m * 16 + fr) * ldc + col;
                        const f32x4 xv = *(const f32x4*)(xin + off);
                        *(f32x4*)(out + off) = xv * alpha + gv * (acc[ai][bj][m][n] + bv); } }
    }
};
template <class Epi, class Sched, bool ALIGN_EPI = false, bool SP2 = false>
__device__ __forceinline__ void gemm_phase(PG8_LAS unsigned char* lds, const Gemm g, const Sched& S, const Epi& E) {
    int tid_ = threadIdx.x; asm volatile("" : "+v"(tid_));
    const int tid = tid_, wid = __builtin_amdgcn_readfirstlane(tid >> 6), lane = tid & 63, wr = wid >> 2, wc = wid & 3, fr = lane & 15, fq = lane >> 4;
    const int K = g.K, nt = K / BK;
    unsigned voffA[2], voffB[2];
#pragma unroll
    for (int i = 0; i < 2; ++i) { int R, C; stage_rc(tid * 16 + i * 8192, R, C); const int Rb = Epi::PERM ? ((R & ~31) + perm32(R & 31)) : R;
        voffA[i] = (unsigned)(R * K + C) * 2u; voffB[i] = (unsigned)(Rb * K + C) * 2u; }
    const size_t kstep = (size_t)(BK * 2);
    const size_t hstep = (size_t)HALF * K * 2;
    const size_t tstep = 2 * hstep;
    const unsigned ldsw = (unsigned)wid * 1024u;
    const int aoff = lds_byte(wr * 64 + fr, fq * 8), boff = lds_byte(wc * 32 + fr, fq * 8);
#define PG8_SA(b, h) (((b) * 2 + (h)) * HTB)
#define PG8_SB(b, h) ((4 + (b) * 2 + (h)) * HTB)
#define PG8_STAGE(bufoff, gbase, voff) do { _Pragma("unroll") for (int _i = 0; _i < 2; ++_i) \
        __builtin_amdgcn_global_load_lds((const unsigned*)((const char*)(gbase) + (voff)[_i]), (PG8_LAS unsigned*)(lds + (bufoff) + ldsw + _i * 8192), 16, 0, 0); } while (0)
#define PG8_LDA(dst, b, h) do { _Pragma("unroll") for (int m = 0; m < 4; ++m) _Pragma("unroll") for (int k = 0; k < 2; ++k) dst[m][k] = *(const PG8_LAS bf16x8*)(lds + PG8_SA(b, h) + aoff + m * 2048 + k * 1024); } while (0)
#define PG8_LDB(dst, b, h) do { _Pragma("unroll") for (int n = 0; n < 2; ++n) _Pragma("unroll") for (int k = 0; k < 2; ++k) dst[n][k] = *(const PG8_LAS bf16x8*)(lds + PG8_SB(b, h) + boff + n * 2048 + k * 1024); } while (0)
#define PG8_MMA(ai, bj, At, Bt) do { __builtin_amdgcn_s_setprio(1); _Pragma("unroll") for (int m = 0; m < 4; ++m) _Pragma("unroll") for (int n = 0; n < 2; ++n) _Pragma("unroll") for (int k = 0; k < 2; ++k) \
        acc[ai][bj][m][n] = __builtin_amdgcn_mfma_f32_16x16x32_bf16(Bt[n][k], At[m][k], acc[ai][bj][m][n], 0, 0, 0); __builtin_amdgcn_s_setprio(0); } while (0)
#define PG8_WAIT_V(n) asm volatile("s_waitcnt vmcnt(" #n ")" ::: "memory")
#define PG8_WAIT_L(n) asm volatile("s_waitcnt lgkmcnt(" #n ")" ::: "memory")
#define PG8_BAR __builtin_amdgcn_s_barrier()
#define PG8_SCHED __builtin_amdgcn_sched_barrier(0)
    Unit cur, nxt; int ui = 0;
    if (!S.next(0, cur)) return;
    f32x4 acc[2][2][4][2];
#pragma unroll
    for (int a = 0; a < 2; ++a)
#pragma unroll
        for (int b = 0; b < 2; ++b)
#pragma unroll
            for (int m = 0; m < 4; ++m)
#pragma unroll
                for (int n = 0; n < 2; ++n) acc[a][b][m][n] = (f32x4){0.f, 0.f, 0.f, 0.f};
    bf16x8 At[4][2], B0[2][2], B1[2][2];
    const char* cA = (const char*)g.A + (size_t)cur.pm * tstep; const char* cB = (const char*)g.Bt + (size_t)cur.pn * tstep;
    S.a_ready(cur);
    if constexpr (SP2) {
        PG8_STAGE(PG8_SB(0, 0), cB, voffB); PG8_STAGE(PG8_SB(0, 1), cB + hstep, voffB); PG8_STAGE(PG8_SA(0, 0), cA, voffA); PG8_STAGE(PG8_SA(0, 1), cA + hstep, voffA);
        if (wr == 1) PG8_BAR;
        PG8_WAIT_V(2); PG8_BAR;
        PG8_STAGE(PG8_SB(1, 0), cB + kstep, voffB); PG8_STAGE(PG8_SA(1, 0), cA + kstep, voffA); PG8_STAGE(PG8_SB(1, 1), cB + hstep + kstep, voffB);
        PG8_WAIT_V(6); PG8_BAR;
    } else {
        PG8_STAGE(PG8_SB(0, 0), cB, voffB); PG8_STAGE(PG8_SA(0, 0), cA, voffA); PG8_STAGE(PG8_SB(0, 1), cB + hstep, voffB); PG8_STAGE(PG8_SA(0, 1), cA + hstep, voffA);
        if (wr == 1) PG8_BAR;
        PG8_WAIT_V(4); PG8_BAR;
        PG8_STAGE(PG8_SB(1, 0), cB + kstep, voffB); PG8_STAGE(PG8_SA(1, 0), cA + kstep, voffA); PG8_STAGE(PG8_SB(1, 1), cB + hstep + kstep, voffB);
        PG8_WAIT_V(6); PG8_BAR;
    }
    for (;;) {
        const bool has_next = S.next(ui + 1, nxt);
        const char* nA = has_next ? (const char*)g.A + (size_t)nxt.pm * tstep : cA; const char* nB = has_next ? (const char*)g.Bt + (size_t)nxt.pn * tstep : cB;
        for (int t = 0; t < nt; t += 2) {
            const bool last = (t == nt - 2);
            const char* a1 = cA + (size_t)(t + 1) * kstep;
            const char* a2 = last ? nA : cA + (size_t)(t + 2) * kstep; const char* b2 = last ? nB : cB + (size_t)(t + 2) * kstep;
            const char* a3 = a2 + kstep; const char* b3 = b2 + kstep;
            if (last && has_next) S.a_ready(nxt);
            if constexpr (SP2) {
            PG8_LDB(B0, 0, 0); PG8_LDB(B1, 0, 1); PG8_SCHED; PG8_LDA(At, 0, 0); PG8_STAGE(PG8_SA(1, 1), a1 + hstep, voffA);
            PG8_WAIT_V(8); PG8_WAIT_L(0); PG8_BAR; PG8_MMA(0, 0, At, B0); PG8_MMA(0, 1, At, B1); PG8_BAR; PG8_SCHED;
            PG8_LDA(At, 0, 1); PG8_STAGE(PG8_SB(0, 0), b2, voffB); PG8_STAGE(PG8_SB(0, 1), b2 + hstep, voffB); PG8_STAGE(PG8_SA(0, 0), a2, voffA);
            PG8_WAIT_V(8); PG8_WAIT_L(0); PG8_BAR; PG8_MMA(1, 0, At, B0); PG8_MMA(1, 1, At, B1); PG8_BAR; PG8_SCHED;
            PG8_LDB(B0, 1, 0); PG8_LDB(B1, 1, 1); PG8_SCHED; PG8_LDA(At, 1, 0); PG8_STAGE(PG8_SA(0, 1), a2 + hstep, voffA);
            PG8_WAIT_V(8); PG8_WAIT_L(0); PG8_BAR; PG8_MMA(0, 0, At, B0); PG8_MMA(0, 1, At, B1); PG8_BAR; PG8_SCHED;
            PG8_LDA(At, 1, 1); PG8_STAGE(PG8_SB(1, 0), b3, voffB); PG8_STAGE(PG8_SB(1, 1), b3 + hstep, voffB); PG8_STAGE(PG8_SA(1, 0), a3, voffA);
            PG8_WAIT_V(8); PG8_WAIT_L(0); PG8_BAR; PG8_MMA(1, 0, At, B0); PG8_MMA(1, 1, At, B1); PG8_BAR; PG8_SCHED;
            } else {
            PG8_LDB(B0, 0, 0); PG8_SCHED; PG8_LDA(At, 0, 0); PG8_STAGE(PG8_SA(1, 1), a1 + hstep, voffA);
            PG8_WAIT_L(8); PG8_BAR; PG8_WAIT_L(0); PG8_MMA(0, 0, At, B0); PG8_BAR; PG8_SCHED;
            PG8_LDB(B1, 0, 1); PG8_STAGE(PG8_SB(0, 0), b2, voffB);
            PG8_BAR; PG8_WAIT_L(0); PG8_MMA(0, 1, At, B1); PG8_BAR;
            PG8_LDA(At, 0, 1); PG8_STAGE(PG8_SA(0, 0), a2, voffA);
            PG8_BAR; PG8_WAIT_L(0); PG8_MMA(1, 0, At, B0); PG8_BAR; PG8_SCHED;
            PG8_STAGE(PG8_SB(0, 1), b2 + hstep, voffB);
            PG8_WAIT_V(6); PG8_BAR; PG8_MMA(1, 1, At, B1); PG8_BAR;
            PG8_LDB(B0, 1, 0); PG8_SCHED; PG8_LDA(At, 1, 0); PG8_STAGE(PG8_SA(0, 1), a2 + hstep, voffA);
            PG8_WAIT_L(8); PG8_BAR; PG8_WAIT_L(0); PG8_MMA(0, 0, At, B0); PG8_BAR; PG8_SCHED;
            PG8_LDB(B1, 1, 1); PG8_STAGE(PG8_SB(1, 0), b3, voffB);
            PG8_BAR; PG8_WAIT_L(0); PG8_MMA(0, 1, At, B1); PG8_BAR;
            PG8_LDA(At, 1, 1); PG8_STAGE(PG8_SA(1, 0), a3, voffA);
            PG8_BAR; PG8_WAIT_L(0); PG8_MMA(1, 0, At, B0); PG8_BAR; PG8_SCHED;
            PG8_STAGE(PG8_SB(1, 1), b3 + hstep, voffB);
            PG8_WAIT_V(6); PG8_BAR; PG8_MMA(1, 1, At, B1); PG8_BAR;
            }
        }
        if constexpr (ALIGN_EPI) { if (wr == 0) PG8_BAR; }
        if constexpr (!Epi::AFTER_DRAIN) { E(acc, cur, wr, wc, fr, fq); S.done(cur); }
        if (!has_next) break;
#pragma unroll
        for (int a = 0; a < 2; ++a)
#pragma unroll
            for (int b = 0; b < 2; ++b)
#pragma unroll
                for (int m = 0; m < 4; ++m)
#pragma unroll
                    for (int n = 0; n < 2; ++n) acc[a][b][m][n] = (f32x4){0.f, 0.f, 0.f, 0.f};
        cur = nxt; cA = nA; cB = nB; ++ui;
        if constexpr (ALIGN_EPI) { if (wr == 1) PG8_BAR; }
    }
    PG8_WAIT_V(0);
    if constexpr (!ALIGN_EPI) { if (wr == 0) PG8_BAR; }
    PG8_BAR;
    if constexpr (Epi::AFTER_DRAIN) { E.fused(acc, cur, wr, wc, fr, fq, lds, wid, lane); S.done(cur); }
#undef PG8_SA
#undef PG8_SB
#undef PG8_STAGE
#undef PG8_LDA
#undef PG8_LDB
#undef PG8_MMA
#undef PG8_WAIT_V
#undef PG8_WAIT_L
#undef PG8_BAR
#undef PG8_SCHED
}
}
constexpr int D = 1024, NB = 8, S = 4096, DEPTH = 2;
constexpr int HD = 64, DA = 512, NH = 8, NG = 3, DHY = 512, NIN = 9216;
constexpr int FE = 33, FW = 64;
constexpr int OFF_GA = 4608, OFF_HY = 5120, OFF_GH = 6656, OFF_RA = 7168, OFF_RH = 8192;
constexpr float LN_EPS = 1e-5f, DN_ALPHA = 1.41421356237309515f;
constexpr int CH = 2, NCHUNK = NB / CH, MC = CH * S;
constexpr int NWAVES = 8, NTHREADS = NWAVES * 64;
constexpr int GLEN = 2 * S - 1;

constexpr size_t MiB = 1u << 20;
constexpr size_t WS_WIN = 1 * MiB;
constexpr size_t WS_WPA = WS_WIN + (size_t)DEPTH * NIN * D * 2;
constexpr size_t WS_WPH = WS_WPA + (size_t)DEPTH * D * DA * 2;
constexpr size_t WS_WOUT = WS_WPH + (size_t)DEPTH * D * DHY * 2;
constexpr size_t WS_MOD = WS_WOUT + (size_t)DEPTH * D * D * 2;
constexpr size_t WS_H3 = WS_MOD + 1 * MiB;
constexpr size_t WS_R = WS_H3 + 2 * MiB;
constexpr size_t WS_H = WS_R + (size_t)DEPTH * 2 * DHY * 8192 * 2;
constexpr size_t WS_P = WS_H + (size_t)MC * D * 2;
constexpr size_t WS_UT = WS_P + (size_t)MC * NIN * 2;
constexpr size_t WS_YHT = WS_UT + (size_t)MC * 4 * DHY * 2;
constexpr size_t WS_YA = WS_YHT + (size_t)MC * DHY * 2;
constexpr size_t WS_YH = WS_YA + (size_t)MC * DA * 2;
constexpr size_t WS_Z1T = WS_YH + (size_t)MC * DHY * 2;
constexpr size_t WS_YHTR = WS_Z1T + (size_t)MC * DHY * 2;
constexpr size_t WS_OG = WS_YHTR + (size_t)MC * DHY * 2;
constexpr size_t WS_ML = WS_OG + (size_t)3 * MC * DA * 2;
constexpr size_t WS_YAR = WS_ML + (size_t)3 * MC * NH * 8;
constexpr size_t WS_END = WS_YAR + (size_t)MC * DA * 2;
#ifndef MK_CHECK
#define MK_CHECK 0
#endif
constexpr float CHECK_K = 30.f;

#ifndef PHM
#define PHM 0xFF
#endif
#ifndef MK_REP
#define MK_REP 0
#endif
#define REPS(k) (1 + (MK_REP == (k)))
constexpr int LDS_BYTES = 147456;
constexpr int RING_BYTES = 131072;

#define LAS __attribute__((address_space(3)))
typedef unsigned short bf16;
typedef unsigned v4u __attribute__((ext_vector_type(4)));
typedef unsigned v2u __attribute__((ext_vector_type(2)));
typedef float f32x4 __attribute__((ext_vector_type(4)));
#define LDS_WAIT() asm volatile("s_waitcnt lgkmcnt(0)" ::: "memory")
__device__ __forceinline__ unsigned f2bf(float f) { unsigned u = __builtin_bit_cast(unsigned, f); return (u + 0x7fffu + ((u >> 16) & 1u)) >> 16; }
__device__ __forceinline__ unsigned pk2(float lo, float hi) { return f2bf(lo) | (f2bf(hi) << 16); }
__device__ __forceinline__ float bf2f(unsigned short h) { return __uint_as_float((unsigned)h << 16); }
__device__ __forceinline__ float blo(unsigned w) { return __uint_as_float(w << 16); }
__device__ __forceinline__ float bhi(unsigned w) { return __uint_as_float(w & 0xffff0000u); }
__device__ __forceinline__ float wave_sum(float v) {
#pragma unroll
    for (int o = 1; o < 64; o <<= 1) v += __shfl_xor(v, o);
    return v;
}
__device__ __forceinline__ float wave_max(float v) {
#pragma unroll
    for (int o = 1; o < 64; o <<= 1) v = fmaxf(v, __shfl_xor(v, o));
    return v;
}
__device__ __forceinline__ float siluf_(float x) { return x / (1.f + expf(-x)); }
__device__ __forceinline__ void sincos_cw(float x, float& sn, float& cs) {
    const float j = rintf(x * 0.63661977236758134f);
    float y = fmaf(-j, 1.5703125f, x);
    y = fmaf(-j, 4.837512969970703125e-4f, y);
    y = fmaf(-j, 7.54978995489188216e-8f, y);
    const float z = y * y;
    const float sp = fmaf(fmaf(fmaf(-1.9515295891e-4f, z, 8.3321608736e-3f), z, -1.6666654611e-1f) * z, y, y);
    const float cp = fmaf(fmaf(fmaf(2.443315711809948e-5f, z, -1.388731625493765e-3f), z, 4.166664568298827e-2f), z * z, fmaf(-0.5f, z, 1.0f));
    const int q = ((int)j) & 3;
    const float s0 = (q & 1) ? cp : sp, c0 = (q & 1) ? sp : cp;
    sn = (q & 2) ? -s0 : s0;
    cs = ((q + 1) & 2) ? -c0 : c0;
}
__device__ __forceinline__ float sin_cw(float x) { float s, c; sincos_cw(x, s, c); return s; }

struct Ctx {
    unsigned char* lds;
    int tid, lane, wave, gw, NGW, G;
};

__device__ __forceinline__ void p0_transpose_item(const float* W, int K, int N, bf16* WT, float* scr, int item, int lane) {
    const int nblk = N / 32, kb = item / nblk, nb = item % nblk, k0 = 64 * kb, n0 = 32 * nb;
#pragma unroll 8
    for (int i = 0; i < 32; ++i) { const int kk = 2 * i + (lane >> 5); scr[kk * 33 + (lane & 31)] = W[(size_t)(k0 + kk) * N + n0 + (lane & 31)]; }
    LDS_WAIT(); asm volatile("" ::: "memory");
    const int c = lane & 7;
#pragma unroll
    for (int j = 0; j < 4; ++j) { const int n = (lane >> 3) + 8 * j; const float* s = scr + (8 * c) * 33 + n;
        v4u o; o.x = pk2(s[0 * 33], s[1 * 33]); o.y = pk2(s[2 * 33], s[3 * 33]); o.z = pk2(s[4 * 33], s[5 * 33]); o.w = pk2(s[6 * 33], s[7 * 33]);
        *(v4u*)(WT + (size_t)(n0 + n) * K + k0 + 8 * c) = o; }
    LDS_WAIT(); asm volatile("" ::: "memory");
}
__device__ __forceinline__ void p0_trunk_item(const float* const* in, float* H3, float* sf  , int l, int t, int lane) {
    const float* w1 = in[8]; const float* b1 = in[9]; const float* w2 = in[10]; const float* b2 = in[11];
    const float* w3 = in[12]; const float* b3 = in[13]; const float* freq = in[15];
    if (lane < FE) {
        float v;
        if (lane == 0) v = (float)t / (float)(S - 1);
        else {
            const int q = (lane - 1) & 15;
            const double f = (double)(1e-4f) + (double)q * (((double)15.0f - (double)1e-4f) / 15.0);
            double u = f * (double)t / (double)S; u -= rint(u);
            float sn, cs; sincos_cw((float)(u * 6.283185307179586476925), sn, cs);
            v = (lane <= 16) ? cs : -sn;
        }
        sf[lane] = v;
    }
    LDS_WAIT(); asm volatile("" ::: "memory");
    const float fr = freq[l * FW + lane];
    float a0 = b1[l * FW + lane], a1 = 0.f;
    for (int kk = 0; kk < 32; kk += 2) { a0 = fmaf(sf[kk], w1[(l * FE + kk) * FW + lane], a0); a1 = fmaf(sf[kk + 1], w1[(l * FE + kk + 1) * FW + lane], a1); }
    a0 = fmaf(sf[32], w1[(l * FE + 32) * FW + lane], a0);
    sf[64 + lane] = sin_cw(fr * (a0 + a1));
    LDS_WAIT(); asm volatile("" ::: "memory");
    a0 = b2[l * FW + lane]; a1 = 0.f;
    for (int kk = 0; kk < FW; kk += 2) { a0 = fmaf(sf[64 + kk], w2[(l * FW + kk) * FW + lane], a0); a1 = fmaf(sf[64 + kk + 1], w2[(l * FW + kk + 1) * FW + lane], a1); }
    sf[128 + lane] = sin_cw(fr * (a0 + a1));
    LDS_WAIT(); asm volatile("" ::: "memory");
    a0 = b3[l * FW + lane]; a1 = 0.f;
    for (int kk = 0; kk < FW; kk += 2) { a0 = fmaf(sf[128 + kk], w3[(l * FW + kk) * FW + lane], a0); a1 = fmaf(sf[128 + kk + 1], w3[(l * FW + kk + 1) * FW + lane], a1); }
    H3[((size_t)l * S + t) * FW + lane] = sin_cw(fr * (a0 + a1));
    LDS_WAIT(); asm volatile("" ::: "memory");
}
__device__ __forceinline__ void p0_rgen_item(const float* const* in, const float* H3, bf16* R, unsigned char* lds, int item, int tid) {
    const int l = item >> 7, tg = (item >> 4) & 7, nb = item & 15, lane = tid & 63, wave = tid >> 6;
    float* Wl = (float*)lds;
    const float* w4l = in[14] + (size_t)l * FW * (4 * DHY) + 128 * nb;
    for (int e = tid; e < 64 * 128; e += NTHREADS) { const int j = e >> 7, i = e & 127; Wl[i * 68 + j] = w4l[(size_t)j * 4 * DHY + i]; }
    const int t = 512 * tg + 64 * wave + lane;
    float hr[64];
    { const f32x4* hp = (const f32x4*)(H3 + ((size_t)l * S + t) * FW);
#pragma unroll
      for (int q = 0; q < 16; ++q) { const f32x4 v = hp[q]; hr[4 * q] = v.x; hr[4 * q + 1] = v.y; hr[4 * q + 2] = v.z; hr[4 * q + 3] = v.w; } }
    __syncthreads();
    const int nq = nb >> 2, o = nq >> 1, dir = nq & 1, cbase = (128 * nb) & 511;
    const float tt = (float)t / (float)(S - 1);
    const float d0 = -4.605170185988091f / 1.5f, d1 = -4.605170185988091f / 0.3f;
    const int x = dir ? ((t == 0) ? 8191 : 4095 + t) : 4095 - t;
    bf16* Rb = R + ((size_t)(l * 2 + o) * DHY + cbase) * 8192 + x;
    for (int i = 0; i < 128; ++i) {
        const f32x4* wp = (const f32x4*)(Wl + i * 68);
        float a0 = 0.f, a1 = 0.f, a2 = 0.f, a3 = 0.f;
#pragma unroll
        for (int q = 0; q < 16; ++q) { const f32x4 w = wp[q]; a0 = fmaf(hr[4 * q], w.x, a0); a1 = fmaf(hr[4 * q + 1], w.y, a1); a2 = fmaf(hr[4 * q + 2], w.z, a2); a3 = fmaf(hr[4 * q + 3], w.w, a3); }
        const float delta = d0 + (d1 - d0) * ((float)(cbase + i) / (float)(DHY - 1));
        float val = ((a0 + a1) + (a2 + a3)) * __expf(-tt * fabsf(delta));
        if (dir == 1 && t == 0) val = 0.f;
        Rb[(size_t)i * 8192] = (bf16)f2bf(val);
    }
    __syncthreads();
}
__device__ __forceinline__ void p0_mod_item(const float* const* in, float* mod, unsigned char* lds, int item, int tid) {
    const int l = item / 48, n = (item % 48) * 64 + (tid & 63), wave = tid >> 6, lane = tid & 63;
    const float* w = in[2] + (size_t)l * D * 3 * D + (size_t)(128 * wave) * 3 * D + n; const float* c = in[1] + 128 * wave;
    float acc[NB];
#pragma unroll
    for (int b = 0; b < NB; ++b) acc[b] = 0.f;
#pragma unroll 4
    for (int k = 0; k < 128; ++k) { const float wv = w[(size_t)k * 3 * D];
#pragma unroll
        for (int b = 0; b < NB; ++b) acc[b] = fmaf(c[b * D + k], wv, acc[b]); }
    float* red = (float*)lds;
#pragma unroll
    for (int b = 0; b < NB; ++b) red[(wave * NB + b) * 64 + lane] = acc[b];
    __syncthreads();
    { float s = in[3][l * 3 * D + n];
#pragma unroll
      for (int q = 0; q < NWAVES; ++q) s += red[(q * NB + wave) * 64 + lane];
      mod[((size_t)l * NB + wave) * 3 * D + n] = s; }
    __syncthreads();
}
__device__ __forceinline__ void p0_prologue_a(const Ctx& C, const float* const* in, unsigned char* ws) {
    float* scr = (float*)(C.lds + C.wave * 16384);
    constexpr int I_IN = (D / 64) * (NIN / 32), I_PA = (DA / 64) * (D / 32), I_PH = (DHY / 64) * (D / 32), I_OUT = (D / 64) * (D / 32);
    constexpr int I_L = I_IN + I_PA + I_PH + I_OUT;
    for (int it = C.gw; it < DEPTH * I_L; it += C.NGW) {
        const int l = it / I_L; int r = it % I_L;
        if (r < I_IN) { p0_transpose_item(in[4] + (size_t)l * D * NIN, D, NIN, (bf16*)(ws + WS_WIN) + (size_t)l * NIN * D, scr, r, C.lane); continue; } r -= I_IN;
        if (r < I_PA) { p0_transpose_item(in[17] + (size_t)l * DA * D, DA, D, (bf16*)(ws + WS_WPA) + (size_t)l * D * DA, scr, r, C.lane); continue; } r -= I_PA;
        if (r < I_PH) { p0_transpose_item(in[18] + (size_t)l * DHY * D, DHY, D, (bf16*)(ws + WS_WPH) + (size_t)l * D * DHY, scr, r, C.lane); continue; } r -= I_PH;
        p0_transpose_item(in[19] + (size_t)l * D * D, D, D, (bf16*)(ws + WS_WOUT) + (size_t)l * D * D, scr, r, C.lane);
    }
    for (int it = C.gw; it < DEPTH * S; it += C.NGW) p0_trunk_item(in, (float*)(ws + WS_H3), scr, it / S, it % S, C.lane);
    __syncthreads();
    for (int it = blockIdx.x; it < DEPTH * 48; it += C.G) p0_mod_item(in, (float*)(ws + WS_MOD), C.lds, it, C.tid);
}
__device__ __forceinline__ void p0_prologue_b(const Ctx& C, const float* const* in, unsigned char* ws) {
    for (int it = blockIdx.x; it < DEPTH * 128; it += C.G) p0_rgen_item(in, (const float*)(ws + WS_H3), (bf16*)(ws + WS_R), C.lds, it, C.tid);
}

__device__ __forceinline__ void ln_mod_row(const float* xrow, const float* modb, bf16* orow, int lane) {
    const f32x4* xr = (const f32x4*)xrow + lane;
    f32x4 v[4]; float s = 0.f;
#pragma unroll
    for (int j = 0; j < 4; ++j) { v[j] = xr[64 * j]; s += (v[j].x + v[j].y) + (v[j].z + v[j].w); }
    const float mean = wave_sum(s) * (1.f / D); float s2 = 0.f;
#pragma unroll
    for (int j = 0; j < 4; ++j) { v[j] = v[j] - mean; s2 += (v[j].x * v[j].x + v[j].y * v[j].y) + (v[j].z * v[j].z + v[j].w * v[j].w); }
    const float rstd = 1.f / sqrtf(wave_sum(s2) * (1.f / D) + LN_EPS);
    v2u* o8 = (v2u*)orow + lane;
#pragma unroll
    for (int j = 0; j < 4; ++j) {
        const f32x4 sh = *((const f32x4*)modb + lane + 64 * j), sc = *((const f32x4*)(modb + D) + lane + 64 * j);
        const f32x4 r = v[j] * rstd * (sc + 1.f) + sh;
        v2u w; w.x = pk2(r.x, r.y); w.y = pk2(r.z, r.w); o8[64 * j] = w;
    }
}
__device__ __forceinline__ void ln_final_row(float* row, const float* lg, const float* lb, int lane) {
    f32x4* xr = (f32x4*)row + lane;
    f32x4 v[4]; float s = 0.f;
#pragma unroll
    for (int j = 0; j < 4; ++j) { v[j] = xr[64 * j]; s += (v[j].x + v[j].y) + (v[j].z + v[j].w); }
    const float mean = wave_sum(s) * (1.f / D); float s2 = 0.f;
#pragma unroll
    for (int j = 0; j < 4; ++j) { v[j] = v[j] - mean; s2 += (v[j].x * v[j].x + v[j].y * v[j].y) + (v[j].z * v[j].z + v[j].w * v[j].w); }
    const float rstd = 1.f / sqrtf(wave_sum(s2) * (1.f / D) + LN_EPS);
#pragma unroll
    for (int j = 0; j < 4; ++j) { const f32x4 g = *((const f32x4*)lg + lane + 64 * j), b = *((const f32x4*)lb + lane + 64 * j); xr[64 * j] = v[j] * rstd * g + b; }
}

__device__ __forceinline__ void attn_naive_item(const bf16* P, bf16* YA, float* sw  , int row, int h, int lane) {
    float* sq = sw; float* sc = sw + 192;
    const int t = row % S, rb = row - t;
    const float slope = exp2f(-(float)(h + 1));
    const bf16* prow = P + (size_t)row * NIN;
#pragma unroll
    for (int g = 0; g < NG; ++g) sq[g * 64 + lane] = bf2f(prow[(0 * NG + g) * DA + h * HD + lane]);
    LDS_WAIT(); asm volatile("" ::: "memory");
    float mx = -INFINITY;
#pragma unroll
    for (int g = 0; g < NG; ++g) {
        const int dil = (g == 0) ? 1 : (g == 1 ? 4 : 16);
        const int kcol = (1 * NG + g) * DA + h * HD;
        for (int pass = 0; pass < 3; ++pass) {
            const int jj = pass * 64 + lane;
            if (jj <= 128) {
                const int j = jj - 64, tk = t + j * dil;
                float s = -INFINITY;
                if (tk >= 0 && tk < S) {
                    const v4u* kr = (const v4u*)(P + (size_t)(rb + tk) * NIN + kcol);
                    float a = 0.f;
#pragma unroll
                    for (int e = 0; e < 8; ++e) { const v4u kv = kr[e]; const float* q = sq + g * 64 + 8 * e;
                        a = fmaf(q[0], blo(kv.x), a); a = fmaf(q[1], bhi(kv.x), a); a = fmaf(q[2], blo(kv.y), a); a = fmaf(q[3], bhi(kv.y), a);
                        a = fmaf(q[4], blo(kv.z), a); a = fmaf(q[5], bhi(kv.z), a); a = fmaf(q[6], blo(kv.w), a); a = fmaf(q[7], bhi(kv.w), a); }
                    s = a * 0.125f - slope * (float)((j < 0 ? -j : j) * dil);
                }
                sc[g * 132 + jj] = s;
                mx = fmaxf(mx, s);
            }
        }
    }
    mx = wave_max(mx);
    float sum = 0.f;
#pragma unroll
    for (int g = 0; g < NG; ++g)
        for (int pass = 0; pass < 3; ++pass) {
            const int jj = pass * 64 + lane;
            if (jj <= 128) { const float s = sc[g * 132 + jj]; const float p = (s == -INFINITY) ? 0.f : expf(s - mx); sc[g * 132 + jj] = p; sum += p; }
        }
    sum = wave_sum(sum);
    LDS_WAIT(); asm volatile("" ::: "memory");
    float o = 0.f;
#pragma unroll
    for (int g = 0; g < NG; ++g) {
        const int dil = (g == 0) ? 1 : (g == 1 ? 4 : 16);
        const int vcol = (2 * NG + g) * DA + h * HD + lane;
        for (int jj = 0; jj <= 128; ++jj) {
            const int tk = t + (jj - 64) * dil;
            if (tk >= 0 && tk < S) o = fmaf(sc[g * 132 + jj], bf2f(P[(size_t)(rb + tk) * NIN + vcol]), o);
        }
    }
    o /= sum;
    const float ga = bf2f(prow[OFF_GA + h * HD + lane]);
    YA[(size_t)row * DA + h * HD + lane] = (bf16)f2bf(o * siluf_(ga));
    LDS_WAIT(); asm volatile("" ::: "memory");
}
typedef short bf16x8_t __attribute__((ext_vector_type(8)));
typedef float f32x16_t __attribute__((ext_vector_type(16)));
struct LCG {
    static constexpr int NI = 32 / CH, NCT = 128 / NI, TPW = NCT / NWAVES;
    static constexpr int PADZ = (2 * NI - 2) * 16, ZSTRIDE = 4096 + 2 * PADZ;
    static constexpr int GC_STRIDE = 16416, ZB_OFF = 4 * GC_STRIDE, LDS_END = ZB_OFF + CH * ZSTRIDE * 2;
};
static_assert(LCG::TPW >= 1 && LCG::LDS_END <= RING_BYTES, "long-conv LDS map");
constexpr int UT_ROWS = 4 * DHY;

__device__ __forceinline__ void lc_stage_R(LAS unsigned char* lds, const bf16* Rg, int tid) {
#pragma unroll
    for (int it = 0; it < 2; ++it) {
        const int k = tid + it * NTHREADS;
        const v4u cur = *(const v4u*)(Rg + 8 * k);
        v4u prv = (v4u){0u, 0u, 0u, 0u}; if (k > 0) prv = *(const v4u*)(Rg + 8 * k - 8);
        *(LAS v4u*)(lds + 0 * LCG::GC_STRIDE + 16 * k) = cur;
        v4u s1; s1.x = __builtin_amdgcn_alignbit(cur.x, prv.w, 16); s1.y = __builtin_amdgcn_alignbit(cur.y, cur.x, 16); s1.z = __builtin_amdgcn_alignbit(cur.z, cur.y, 16); s1.w = __builtin_amdgcn_alignbit(cur.w, cur.z, 16);
        *(LAS v4u*)(lds + 1 * LCG::GC_STRIDE + 16 * k) = s1;
        v4u s2; s2.x = prv.w; s2.y = cur.x; s2.z = cur.y; s2.w = cur.z;
        *(LAS v4u*)(lds + 2 * LCG::GC_STRIDE + 16 * k) = s2;
        v4u s3; s3.x = __builtin_amdgcn_alignbit(prv.w, prv.z, 16); s3.y = __builtin_amdgcn_alignbit(cur.x, prv.w, 16); s3.z = __builtin_amdgcn_alignbit(cur.y, cur.x, 16); s3.w = __builtin_amdgcn_alignbit(cur.z, cur.y, 16);
        *(LAS v4u*)(lds + 3 * LCG::GC_STRIDE + 16 * k) = s3;
    }
}
__device__ __forceinline__ void lc_mma(LAS unsigned char* lds, f32x16_t (&acc)[LCG::TPW], int wave, int lane) {
    const int r = lane & 31, h = lane >> 5, kap = (r + 1) & 3, b = r / LCG::NI, ii = r % LCG::NI;
    const int baseA = kap * LCG::GC_STRIDE + 2 * (4095 - r + 8 * h + kap);
    int baseB[LCG::TPW], dlo[LCG::TPW], dhi[LCG::TPW];
#pragma unroll
    for (int k = 0; k < LCG::TPW; ++k) { const int i0 = LCG::NI * (wave * LCG::TPW + k);
        baseB[k] = LCG::ZB_OFF + 2 * (b * LCG::ZSTRIDE + LCG::PADZ + 32 * (i0 + ii) + 8 * h); dlo[k] = 2 * i0 - 255; dhi[k] = 2 * i0 + 2 * LCG::NI - 2;
        acc[k] = (f32x16_t){0.f, 0.f, 0.f, 0.f, 0.f, 0.f, 0.f, 0.f, 0.f, 0.f, 0.f, 0.f, 0.f, 0.f, 0.f, 0.f}; }
    const int d0 = dlo[0], d1 = dhi[LCG::TPW - 1];
#pragma unroll 2
    for (int d = d0; d <= d1; ++d) {
        const v2u a0 = *(const LAS v2u*)(lds + baseA - 32 * d), a1 = *(const LAS v2u*)(lds + baseA - 32 * d + 8);
        const v4u av = (v4u){a0.x, a0.y, a1.x, a1.y};
        const bf16x8_t A = __builtin_bit_cast(bf16x8_t, av);
#pragma unroll
        for (int k = 0; k < LCG::TPW; ++k)
            if (LCG::TPW == 1 || (d >= dlo[k] && d <= dhi[k])) {
                const v4u bv = *(const LAS v4u*)(lds + baseB[k] - 32 * d);
                acc[k] = __builtin_amdgcn_mfma_f32_32x32x16_bf16(A, __builtin_bit_cast(bf16x8_t, bv), acc[k], 0, 0, 0);
            }
    }
}
__device__ __forceinline__ void longconv_mfma_unit(LAS unsigned char* lds, const bf16* UT, const bf16* Rl, const float* fb, bf16* YHT, int c, int tid_) {
    const int tid = tid_, lane = tid & 63, wave = __builtin_amdgcn_readfirstlane(tid >> 6);
    const int r = lane & 31, h = lane >> 5, b = r / LCG::NI, ii = r % LCG::NI;
    for (int k = tid; k < CH * 512; k += NTHREADS) { const int bb = k >> 9, s8 = (k & 511) * 8;
        *(LAS v4u*)(lds + LCG::ZB_OFF + 2 * (bb * LCG::ZSTRIDE + LCG::PADZ + s8)) = *(const v4u*)(UT + (size_t)c * MC + bb * S + s8); }
    for (int k = tid; k < CH * 2 * (LCG::PADZ / 8); k += NTHREADS) { const int bb = k / (2 * (LCG::PADZ / 8)), q = k % (2 * (LCG::PADZ / 8));
        const int e = (q < LCG::PADZ / 8) ? q * 8 : LCG::PADZ + 4096 + (q - LCG::PADZ / 8) * 8;
        *(LAS v4u*)(lds + LCG::ZB_OFF + 2 * (bb * LCG::ZSTRIDE + e)) = (v4u){0u, 0u, 0u, 0u}; }
    lc_stage_R(lds, Rl + (size_t)(0 * DHY + c) * 8192, tid);
    __syncthreads();
    f32x16_t acc[LCG::TPW];
    lc_mma(lds, acc, wave, lane);
    v2u zn[LCG::TPW][4];
    { const float bias0 = fb[c];
#pragma unroll
      for (int k = 0; k < LCG::TPW; ++k) { const int i = LCG::NI * (wave * LCG::TPW + k) + ii;
#pragma unroll
        for (int q = 0; q < 4; ++q) { const int t = 32 * i + 8 * q + 4 * h;
            const v2u zo = *(const LAS v2u*)(lds + LCG::ZB_OFF + 2 * (b * LCG::ZSTRIDE + LCG::PADZ + t));
            const v2u x1 = *(const v2u*)(UT + (size_t)(DHY + c) * MC + b * S + t);
            const float y0 = blo(x1.x) * (acc[k][4 * q + 0] + bias0 * blo(zo.x)), y1 = bhi(x1.x) * (acc[k][4 * q + 1] + bias0 * bhi(zo.x));
            const float y2 = blo(x1.y) * (acc[k][4 * q + 2] + bias0 * blo(zo.y)), y3 = bhi(x1.y) * (acc[k][4 * q + 3] + bias0 * bhi(zo.y));
            zn[k][q].x = pk2(y0, y1); zn[k][q].y = pk2(y2, y3); } } }
    __syncthreads();
#pragma unroll
    for (int k = 0; k < LCG::TPW; ++k) { const int i = LCG::NI * (wave * LCG::TPW + k) + ii;
#pragma unroll
        for (int q = 0; q < 4; ++q) *(LAS v2u*)(lds + LCG::ZB_OFF + 2 * (b * LCG::ZSTRIDE + LCG::PADZ + 32 * i + 8 * q + 4 * h)) = zn[k][q]; }
    lc_stage_R(lds, Rl + (size_t)(1 * DHY + c) * 8192, tid);
    __syncthreads();
    lc_mma(lds, acc, wave, lane);
    { const float bias1 = fb[DHY + c];
#pragma unroll
      for (int k = 0; k < LCG::TPW; ++k) { const int i = LCG::NI * (wave * LCG::TPW + k) + ii;
#pragma unroll
        for (int q = 0; q < 4; ++q) { const int t = 32 * i + 8 * q + 4 * h;
            const v2u zo = *(const LAS v2u*)(lds + LCG::ZB_OFF + 2 * (b * LCG::ZSTRIDE + LCG::PADZ + t));
            const v2u x2 = *(const v2u*)(UT + (size_t)(2 * DHY + c) * MC + b * S + t);
            const v2u sg = *(const v2u*)(UT + (size_t)(3 * DHY + c) * MC + b * S + t);
            const float y0 = blo(sg.x) * blo(x2.x) * (acc[k][4 * q + 0] + bias1 * blo(zo.x)), y1 = bhi(sg.x) * bhi(x2.x) * (acc[k][4 * q + 1] + bias1 * bhi(zo.x));
            const float y2 = blo(sg.y) * blo(x2.y) * (acc[k][4 * q + 2] + bias1 * blo(zo.y)), y3 = bhi(sg.y) * bhi(x2.y) * (acc[k][4 * q + 3] + bias1 * bhi(zo.y));
            v2u o; o.x = pk2(y0, y1); o.y = pk2(y2, y3);
            *(v2u*)(YHT + (size_t)c * MC + b * S + t) = o; } } }
    __syncthreads();
}
__device__ __forceinline__ void hyena_prep_tile(unsigned char* lds, const bf16* P, const float* cw, const float* cb, bf16* UT, int tile, int tid) {
    constexpr int TS = 72;
    const int tr = tile / (UT_ROWS / 64), tc = tile % (UT_ROWS / 64), row0 = tr * 64, c0 = tc * 64;
    bf16* T = (bf16*)lds;
    { const int rr = tid >> 3, seg = tid & 7, row = row0 + rr, t = row % S, cc = c0 + 8 * seg;
      float o[8];
      if (c0 < 3 * DHY) {
          const v4u w0 = *(const v4u*)(P + (size_t)row * NIN + OFF_HY + cc);
          v4u wm = (v4u){0u, 0u, 0u, 0u}, wp = (v4u){0u, 0u, 0u, 0u};
          if (t > 0) wm = *(const v4u*)(P + (size_t)(row - 1) * NIN + OFF_HY + cc);
          if (t < S - 1) wp = *(const v4u*)(P + (size_t)(row + 1) * NIN + OFF_HY + cc);
          const unsigned am[4] = {wm.x, wm.y, wm.z, wm.w}, a0[4] = {w0.x, w0.y, w0.z, w0.w}, ap[4] = {wp.x, wp.y, wp.z, wp.w};
#pragma unroll
          for (int j = 0; j < 4; ++j) { const int c = cc + 2 * j;
              o[2 * j] = cw[c] * blo(am[j]) + cw[3 * DHY + c] * blo(a0[j]) + cw[6 * DHY + c] * blo(ap[j]) + cb[c];
              o[2 * j + 1] = cw[c + 1] * bhi(am[j]) + cw[3 * DHY + c + 1] * bhi(a0[j]) + cw[6 * DHY + c + 1] * bhi(ap[j]) + cb[c + 1]; }
      } else {
          const v4u w0 = *(const v4u*)(P + (size_t)row * NIN + OFF_GH + (cc - 3 * DHY));
          const unsigned a0[4] = {w0.x, w0.y, w0.z, w0.w};
#pragma unroll
          for (int j = 0; j < 4; ++j) { o[2 * j] = siluf_(blo(a0[j])); o[2 * j + 1] = siluf_(bhi(a0[j])); }
      }
#pragma unroll
      for (int j = 0; j < 8; ++j) T[(8 * seg + j) * TS + rr] = (bf16)f2bf(o[j]); }
    __syncthreads();
    { const int chn = tid >> 3, sg = tid & 7;
      *(v4u*)(UT + (size_t)(c0 + chn) * MC + row0 + 8 * sg) = *(const v4u*)(T + chn * TS + 8 * sg); }
    __syncthreads();
}
__device__ __forceinline__ void hyena_post_tile(unsigned char* lds, const bf16* YHT, bf16* YH, int tile, int tid) {
    constexpr int TS = 72;
    const int tr = tile / (DHY / 64), tc = tile % (DHY / 64), row0 = tr * 64, c0 = tc * 64;
    bf16* T = (bf16*)lds;
    { const int chn = tid >> 3, sg = tid & 7;
      const v4u w = *(const v4u*)(YHT + (size_t)(c0 + chn) * MC + row0 + 8 * sg);
      const unsigned a[4] = {w.x, w.y, w.z, w.w};
#pragma unroll
      for (int j = 0; j < 4; ++j) { T[(8 * sg + 2 * j) * TS + chn] = (bf16)(a[j] & 0xffffu); T[(8 * sg + 2 * j + 1) * TS + chn] = (bf16)(a[j] >> 16); } }
    __syncthreads();
    { const int rr = tid >> 3, seg = tid & 7;
      *(v4u*)(YH + (size_t)(row0 + rr) * DHY + c0 + 8 * seg) = *(const v4u*)(T + rr * TS + 8 * seg); }
    __syncthreads();
}

typedef short v4i16_t __attribute__((ext_vector_type(4)));
constexpr int AT_ROWB = 128;
__device__ __forceinline__ void attn_mfma_unit(const bf16* P, bf16* OG, float* ML, LAS unsigned char* vs, int unit, int lane_) {
    int lane = lane_; asm volatile("" : "+v"(lane));
    int u = unit; const int x = u & 127; u >>= 7; const int hh = u & 7; u >>= 3; const int g = u % 3, bl = u / 3;
    const int dsh = 2 * g, d = 1 << dsh, L = S >> dsh, nqb = L >> 5, r = x / nqb, qb = x % nqb;
    const size_t rowb = (size_t)bl * S;
    const float slope = exp2f(-(float)(hh + 1)) * (float)d;
    const int qcol = (0 * NG + g) * DA + hh * HD, kcol = (1 * NG + g) * DA + hh * HD, vcol = (2 * NG + g) * DA + hh * HD;
    const int n = lane & 31, h2 = lane >> 5;
    const int tq = ((32 * qb + n) << dsh) + r;
    bf16x8_t qf[4];
#pragma unroll
    for (int ks = 0; ks < 4; ++ks) qf[ks] = __builtin_bit_cast(bf16x8_t, *(const v4u*)(P + (rowb + tq) * NIN + qcol + 16 * ks + 8 * h2));
    f32x16_t st[5];
#pragma unroll
    for (int kt = 0; kt < 5; ++kt) {
        int ik = 32 * (qb - 2 + kt) + n; ik = ik < 0 ? 0 : (ik > L - 1 ? L - 1 : ik);
        const bf16* kp = P + (rowb + (size_t)((ik << dsh) + r)) * NIN + kcol + 8 * h2;
        f32x16_t acc = (f32x16_t){0.f, 0.f, 0.f, 0.f, 0.f, 0.f, 0.f, 0.f, 0.f, 0.f, 0.f, 0.f, 0.f, 0.f, 0.f, 0.f};
#pragma unroll
        for (int ks = 0; ks < 4; ++ks) acc = __builtin_amdgcn_mfma_f32_32x32x16_bf16(__builtin_bit_cast(bf16x8_t, *(const v4u*)(kp + 16 * ks)), qf[ks], acc, 0, 0, 0);
        st[kt] = acc;
        asm volatile("" ::: "memory");
    }
    float mx = -INFINITY;
#pragma unroll
    for (int kt = 0; kt < 5; ++kt)
#pragma unroll
        for (int rg = 0; rg < 16; ++rg) {
            const int rho = (rg & 3) + 8 * (rg >> 2) + 4 * h2, rel = 32 * (kt - 2) + rho - n, ikey = 32 * (qb - 2 + kt) + rho;
            const int arel = rel < 0 ? -rel : rel;
            const bool valid = (arel <= 64) && (ikey >= 0) && (ikey < L);
            const float s = valid ? st[kt][rg] * 0.125f - slope * (float)arel : -INFINITY;
            st[kt][rg] = s; mx = fmaxf(mx, s);
        }
    mx = fmaxf(mx, __shfl_xor(mx, 32));
    float ls = 0.f;
#pragma unroll
    for (int kt = 0; kt < 5; ++kt)
#pragma unroll
        for (int rg = 0; rg < 16; ++rg) { const float p = __expf(st[kt][rg] - mx); st[kt][rg] = p; ls += p; }
    ls += __shfl_xor(ls, 32);
    f32x16_t o0 = (f32x16_t){0.f, 0.f, 0.f, 0.f, 0.f, 0.f, 0.f, 0.f, 0.f, 0.f, 0.f, 0.f, 0.f, 0.f, 0.f, 0.f}, o1 = o0;
    const int trow = (lane & 15) >> 2, tcolb = (16 * ((lane >> 4) & 1) + 4 * (lane & 3)) * 2;
#pragma unroll
    for (int kt = 0; kt < 5; ++kt) {
        { int ik = 32 * (qb - 2 + kt) + (lane >> 1); ik = ik < 0 ? 0 : (ik > L - 1 ? L - 1 : ik);
          const bf16* vp = P + (rowb + (size_t)((ik << dsh) + r)) * NIN + vcol + 32 * (lane & 1);
          const v4u w0 = *(const v4u*)(vp), w1 = *(const v4u*)(vp + 8), w2 = *(const v4u*)(vp + 16), w3 = *(const v4u*)(vp + 24);
          LAS unsigned char* wp = vs + (lane >> 1) * AT_ROWB + 64 * (lane & 1);
          *(LAS v4u*)(wp) = w0; *(LAS v4u*)(wp + 16) = w1; *(LAS v4u*)(wp + 32) = w2; *(LAS v4u*)(wp + 48) = w3; }
        LDS_WAIT(); asm volatile("" ::: "memory");
#pragma unroll
        for (int s = 0; s < 2; ++s) {
            v4u pa; pa.x = pk2(st[kt][8 * s + 0], st[kt][8 * s + 1]); pa.y = pk2(st[kt][8 * s + 2], st[kt][8 * s + 3]); pa.z = pk2(st[kt][8 * s + 4], st[kt][8 * s + 5]); pa.w = pk2(st[kt][8 * s + 6], st[kt][8 * s + 7]);
            const bf16x8_t A = __builtin_bit_cast(bf16x8_t, pa);
            LAS unsigned char* tp = vs + (16 * s + 4 * h2 + trow) * AT_ROWB + tcolb;
#pragma unroll
            for (int eh = 0; eh < 2; ++eh) {
                const v4i16_t lo = __builtin_amdgcn_ds_read_tr16_b64_v4i16((LAS v4i16_t*)(tp + 64 * eh));
                const v4i16_t hi = __builtin_amdgcn_ds_read_tr16_b64_v4i16((LAS v4i16_t*)(tp + 64 * eh + 8 * AT_ROWB));
                const bf16x8_t B = (bf16x8_t){lo[0], lo[1], lo[2], lo[3], hi[0], hi[1], hi[2], hi[3]};
                if (eh == 0) o0 = __builtin_amdgcn_mfma_f32_32x32x16_bf16(A, B, o0, 0, 0, 0); else o1 = __builtin_amdgcn_mfma_f32_32x32x16_bf16(A, B, o1, 0, 0, 0);
            }
        }
        LDS_WAIT(); asm volatile("" ::: "memory");
    }
    bf16* og = OG + ((size_t)g * MC + rowb) * DA + hh * HD + n;
#pragma unroll
    for (int rg = 0; rg < 16; ++rg) { const int mq = (rg & 3) + 8 * (rg >> 2) + 4 * h2; const size_t tok = (size_t)(((32 * qb + mq) << dsh) + r);
        og[tok * DA] = (bf16)f2bf(o0[rg]); og[tok * DA + 32] = (bf16)f2bf(o1[rg]); }
    if (h2 == 0) { float* mp = ML + (((size_t)g * MC + rowb + tq) * NH + hh) * 2; mp[0] = mx; mp[1] = ls; }
}
__device__ __forceinline__ void attn_combine(const bf16* P, const bf16* OG, const float* ML, bf16* YA, int G, int tid) {
    for (int idx = blockIdx.x * NTHREADS + tid; idx < MC * (DA / 2); idx += G * NTHREADS) {
        const int row = idx / (DA / 2), col = (idx % (DA / 2)) * 2, hh = col >> 6;
        float m[3], l[3];
#pragma unroll
        for (int g = 0; g < 3; ++g) { const float* mp = ML + (((size_t)g * MC + row) * NH + hh) * 2; m[g] = mp[0]; l[g] = mp[1]; }
        const float M = fmaxf(m[0], fmaxf(m[1], m[2]));
        float a0 = 0.f, a1 = 0.f, den = 0.f;
#pragma unroll
        for (int g = 0; g < 3; ++g) { const float w = __expf(m[g] - M); const unsigned ow = *(const unsigned*)(OG + ((size_t)g * MC + row) * DA + col);
            a0 = fmaf(w, blo(ow), a0); a1 = fmaf(w, bhi(ow), a1); den = fmaf(w, l[g], den); }
        const unsigned gw_ = *(const unsigned*)(P + (size_t)row * NIN + OFF_GA + col);
        const float inv = 1.f / den;
        *(unsigned*)(YA + (size_t)row * DA + col) = pk2(a0 * inv * siluf_(blo(gw_)), a1 * inv * siluf_(bhi(gw_)));
    }
}
#if MK_CHECK
__device__ __forceinline__ void longconv_check_item(const bf16* Zrow  , const bf16* Rrow  , const bf16* Xrow, const bf16* SGrow, float bias, bf16* Orow, int b, int tb, int lane) {
    const int t = tb * 64 + lane;
    const bf16* z = Zrow + (size_t)b * S; const bf16* g = Rrow + 4095 - t;
    float y = 0.f;
    for (int s0 = 0; s0 < S; s0 += 8) {
#pragma unroll
        for (int j = 0; j < 8; ++j) y = fmaf(bf2f(g[s0 + j]), bf2f(z[s0 + j]), y);
    }
    float v = bf2f(Xrow[(size_t)b * S + t]) * (y + bias * bf2f(z[t]));
    if (SGrow) v *= bf2f(SGrow[(size_t)b * S + t]);
    Orow[(size_t)b * S + t] = (bf16)f2bf(v);
}
#endif
#define XB_TMO      128
#define XB_XCNT(j)  (256  + 64 * (j))
#define XB_XSUB(j)  (1280 + 64 * (j))
#define XB_XGEN(j)  (2304 + 64 * (j))
#define XB_TOP      3328
#define XB_TOPGEN   3392
#define XCD_BAR_WORDS 3456
#define XB_SPIN_CAP (1u << 18)

__device__ __forceinline__ unsigned xb_ld(unsigned* p)              { return __hip_atomic_load(p, __ATOMIC_RELAXED, __HIP_MEMORY_SCOPE_AGENT); }
__device__ __forceinline__ unsigned xb_add(unsigned* p, unsigned v) { return __hip_atomic_fetch_add(p, v, __ATOMIC_RELAXED, __HIP_MEMORY_SCOPE_AGENT); }
__device__ __forceinline__ unsigned xb_xcc_id() { return (unsigned)__builtin_amdgcn_s_getreg((3 << 11) | 20) & 0xFu; }
#define XB_SPIN(cond, bar) do { unsigned _sp = 0; while (cond) { __builtin_amdgcn_s_sleep(1); \
    if ((++_sp & 255u) == 0u) { if (xb_ld(&(bar)[XB_TMO])) break; if (_sp > XB_SPIN_CAP) { atomicAdd(&(bar)[XB_TMO], 1u); break; } } } } while (0)

struct XcdBarrier {
    unsigned* bar; unsigned x;
    volatile LAS unsigned* st;
};

__device__ __forceinline__ XcdBarrier xcd_barrier_post(unsigned* bar, volatile LAS unsigned* st) {
    XcdBarrier b; b.bar = bar; b.x = xb_xcc_id(); b.st = st;
    if (threadIdx.x == 0) (void)xb_add(&bar[XB_XCNT(b.x)], 1u);
    return b;
}
__device__ __forceinline__ void xcd_barrier_complete(unsigned* bar, unsigned x, unsigned& nloc, unsigned& nx) {
    const unsigned G = gridDim.x * gridDim.y * gridDim.z;
    unsigned sum, cnt, mine, sp = 0u;
    for (;;) {
        sum = 0u; cnt = 0u; mine = 0u;
#pragma unroll
        for (unsigned j = 0; j < 16; ++j) { const unsigned c = xb_ld(&bar[XB_XCNT(j)]); sum += c; cnt += (c > 0u) ? 1u : 0u; mine = (j == x) ? c : mine; }
        if (sum == G) break;
        __builtin_amdgcn_s_sleep(1);
        if ((++sp & 255u) == 0u) { if (xb_ld(&bar[XB_TMO])) break; if (sp > XB_SPIN_CAP) { atomicAdd(&bar[XB_TMO], 1u); break; } }
    }
    nloc = mine > 0u ? mine : 1u; nx = cnt > 0u ? cnt : 1u;
}

__device__ __forceinline__ void xcd_barrier(const XcdBarrier& b) {
    asm volatile("s_waitcnt vmcnt(0)" ::: "memory");
    __syncthreads();
    if (threadIdx.x == 0) {
        unsigned* bar = b.bar;
        __builtin_amdgcn_s_waitcnt(0);
        unsigned nloc = b.st[0], nx = b.st[1];
        if (nloc == 0u) { xcd_barrier_complete(bar, b.x, nloc, nx); b.st[0] = nloc; b.st[1] = nx; }
        const unsigned old = xb_add(&bar[XB_XSUB(b.x)], 1u);
        const unsigned gen = old / nloc;
        if (old + 1u == (gen + 1u) * nloc) {
            __builtin_amdgcn_fence(__ATOMIC_RELEASE, "agent");
            asm volatile("s_waitcnt vmcnt(0)" ::: "memory");
            const unsigned og = xb_add(&bar[XB_TOP], 1u);
            const unsigned tg = og / nx;
            if (og + 1u == (tg + 1u) * nx) xb_add(&bar[XB_TOPGEN], 1u);
            else XB_SPIN(xb_ld(&bar[XB_TOPGEN]) == tg, bar);
            __builtin_amdgcn_fence(__ATOMIC_ACQUIRE, "agent");
            xb_add(&bar[XB_XGEN(b.x)], 1u);
            asm volatile("s_waitcnt vmcnt(0)" ::: "memory");
        } else {
            XB_SPIN(xb_ld(&bar[XB_XGEN(b.x)]) == gen, bar);
            __builtin_amdgcn_fence(__ATOMIC_ACQUIRE, "agent");
            asm volatile("s_waitcnt vmcnt(0)" ::: "memory");
        }
    }
    __syncthreads();
}

#define XBAR() do { xcd_barrier(xbar); if (MK_REP == 10) xcd_barrier(xbar); } while (0)
struct Args { const float* in[23]; float* out; unsigned char* ws; int pad0, pad1; };
#ifndef PG8_SP2
#define PG8_SP2 true
#endif
#ifndef PG8_ALIGN
#define PG8_ALIGN true
#endif

__global__ void __launch_bounds__(NTHREADS, 2) mk_fwd(Args args) {
    extern __shared__ __attribute__((aligned(16))) unsigned char lds[];
    cg::grid_group grid = cg::this_grid();
    Ctx C; C.lds = lds; C.tid = threadIdx.x; C.lane = C.tid & 63; C.wave = __builtin_amdgcn_readfirstlane(C.tid >> 6);
    C.G = gridDim.x; C.gw = blockIdx.x * NWAVES + C.wave; C.NGW = C.G * NWAVES;
    unsigned char* ws = args.ws;
    const float* const* in = args.in;
    float* out = args.out;
    bf16* Hb = (bf16*)(ws + WS_H); bf16* Pb = (bf16*)(ws + WS_P); bf16* UT = (bf16*)(ws + WS_UT); bf16* YHT = (bf16*)(ws + WS_YHT);
    bf16* YA = (bf16*)(ws + WS_YA); bf16* YH = (bf16*)(ws + WS_YH); bf16* MG = Hb;
    const float* MOD = (const float*)(ws + WS_MOD); const bf16* Rg = (const bf16*)(ws + WS_R);
    float* ERR = (float*)ws;
    PG8_LAS unsigned char* ldsl = (PG8_LAS unsigned char*)lds;
    volatile LAS unsigned* MISC = (volatile LAS unsigned*)(ldsl + LDS_BYTES - 64);
    if (threadIdx.x < 16) MISC[threadIdx.x] = 0u;
    __syncthreads();
    XcdBarrier xbar = xcd_barrier_post((unsigned*)ws + 4096, MISC);

    p0_prologue_a(C, in, ws);
    grid.sync();
    p0_prologue_b(C, in, ws);
    XBAR();

    int pend_l = -1, pend_ch = 0;
    for (int l = 0; l < DEPTH; ++l) {
        const float* xin = (l == 0) ? in[0] : out;
        for (int ch = 0; ch < NCHUNK; ++ch) {
            const float* xc = xin + (size_t)ch * MC * D; float* oc = out + (size_t)ch * MC * D;
            { int ln_ = threadIdx.x & 63; asm volatile("" : "+v"(ln_));
            if (pend_l >= 0) { float* pr = out + (size_t)pend_ch * MC * D;
                for (int m = C.gw; m < MC; m += C.NGW) ln_final_row(pr + (size_t)m * D, in[21] + (size_t)pend_l * D, in[22] + (size_t)pend_l * D, ln_); }
            for (int rp_ = 0; rp_ < REPS(9); ++rp_) for (int m = C.gw; m < MC; m += C.NGW) ln_mod_row(xc + (size_t)m * D, MOD + ((size_t)l * NB + ch * CH + m / S) * 3 * D, Hb + (size_t)m * D, ln_); }
            XBAR();
            for (int rp_ = 0; rp_ < REPS(2); ++rp_) { pg8::Gemm g{Hb, (const bf16*)(ws + WS_WIN) + (size_t)l * NIN * D, MC, NIN, D}; pg8::StaticOrder So; So.init(MC, NIN, C.G, (int)blockIdx.x);
              pg8::EpiBf16<0> E{Pb, NIN, in[5] + (size_t)l * NIN, 0, 0, 1.f};
              pg8::gemm_phase<pg8::EpiBf16<0>, pg8::StaticOrder, PG8_ALIGN, PG8_SP2>(ldsl, g, So, E); }
            XBAR();
            if (PHM & 4) { float* sw = (float*)(lds + C.wave * 2560); int ln_ = threadIdx.x & 63; asm volatile("" : "+v"(ln_));
              if (MK_CHECK == 2) { for (int it = C.gw; it < MC * NH; it += C.NGW) attn_naive_item(Pb, (bf16*)(ws + WS_YAR), sw, it / NH, it % NH, ln_); __syncthreads(); }
              for (int rp_ = 0; rp_ < REPS(3); ++rp_) for (int it = C.gw; it < CH * 3 * 8 * 128; it += C.NGW) attn_mfma_unit(Pb, (bf16*)(ws + WS_OG), (float*)(ws + WS_ML), ldsl + C.wave * 4096, it, ln_);
              __syncthreads();
              int tid_ = threadIdx.x; asm volatile("" : "+v"(tid_));
              for (int rp_ = 0; rp_ < REPS(4); ++rp_) for (int tile = blockIdx.x; tile < (MC / 64) * (UT_ROWS / 64); tile += C.G) hyena_prep_tile(lds, Pb, in[6] + (size_t)l * 9 * DHY, in[7] + (size_t)l * 3 * DHY, UT, tile, tid_); }
            XBAR();
            if (PHM & 8) { int tid_ = threadIdx.x; asm volatile("" : "+v"(tid_));
              for (int rp_ = 0; rp_ < REPS(5); ++rp_) for (int c = blockIdx.x; c < DHY; c += C.G) longconv_mfma_unit(ldsl, UT, Rg + (size_t)l * 2 * DHY * 8192, in[16] + (size_t)l * 2 * DHY, YHT, c, tid_); }
#if MK_CHECK == 1
            { bf16* Z1T = (bf16*)(ws + WS_Z1T); bf16* YHTR = (bf16*)(ws + WS_YHTR); int ln_ = threadIdx.x & 63; asm volatile("" : "+v"(ln_));
              for (int it = C.gw; it < DHY * CH * 64; it += C.NGW) { const int c = it / (CH * 64), b = (it / 64) % CH, tb = it % 64;
                  longconv_check_item(UT + (size_t)c * MC, Rg + ((size_t)(l * 2 + 0) * DHY + c) * 8192, UT + (size_t)(DHY + c) * MC, nullptr, in[16][(size_t)l * 2 * DHY + c], Z1T + (size_t)c * MC, b, tb, ln_); }
              XBAR();
              for (int it = C.gw; it < DHY * CH * 64; it += C.NGW) { const int c = it / (CH * 64), b = (it / 64) % CH, tb = it % 64;
                  longconv_check_item(Z1T + (size_t)c * MC, Rg + ((size_t)(l * 2 + 1) * DHY + c) * 8192, UT + (size_t)(2 * DHY + c) * MC, UT + (size_t)(3 * DHY + c) * MC, in[16][(size_t)l * 2 * DHY + DHY + c], YHTR + (size_t)c * MC, b, tb, ln_); }
              XBAR();
              float e0 = 0.f, e1 = 0.f;
              { int tq_ = threadIdx.x; asm volatile("" : "+v"(tq_));
              for (int i = blockIdx.x * NTHREADS + tq_; i < DHY * MC; i += C.G * NTHREADS) { const float a = bf2f(YHT[i]), r = bf2f(YHTR[i]); e0 += (a - r) * (a - r); e1 += r * r; } }
              e0 = wave_sum(e0); e1 = wave_sum(e1);
              if (ln_ == 0) { atomicAdd(ERR + 0, e0); atomicAdd(ERR + 1, e1); }
              YHT = YHTR; }
#endif
            XBAR();
            if (PHM & 16) { int tid_ = threadIdx.x; asm volatile("" : "+v"(tid_));
              for (int rp_ = 0; rp_ < REPS(6); ++rp_) { for (int tile = blockIdx.x; tile < (MC / 64) * (DHY / 64); tile += C.G) hyena_post_tile(lds, YHT, YH, tile, tid_);
              attn_combine(Pb, (const bf16*)(ws + WS_OG), (const float*)(ws + WS_ML), YA, C.G, tid_); } }
#if MK_CHECK == 2
            XBAR();
            { const bf16* YAR = (const bf16*)(ws + WS_YAR); float e0 = 0.f, e1 = 0.f; int tq_ = threadIdx.x; asm volatile("" : "+v"(tq_));
              for (int i = blockIdx.x * NTHREADS + tq_; i < MC * DA; i += C.G * NTHREADS) { const float a = bf2f(YA[i]), r = bf2f(YAR[i]); e0 += (a - r) * (a - r); e1 += r * r; }
              e0 = wave_sum(e0); e1 = wave_sum(e1);
              if ((tq_ & 63) == 0) { atomicAdd(ERR + 0, e0); atomicAdd(ERR + 1, e1); } }
#endif
#if MK_CHECK == 1
            YHT = (bf16*)(ws + WS_YHT);
#endif
            XBAR();
            for (int rp_ = 0; rp_ < REPS(7); ++rp_) { pg8::StaticOrder So; So.init(MC, D, C.G, (int)blockIdx.x);
              { pg8::Gemm g{YA, (const bf16*)(ws + WS_WPA) + (size_t)l * D * DA, MC, D, DA}; pg8::EpiMerge<false> E{MG, D, Pb + OFF_RA, NIN};
                pg8::gemm_phase<pg8::EpiMerge<false>, pg8::StaticOrder, PG8_ALIGN, PG8_SP2>(ldsl, g, So, E); }
              { pg8::Gemm g{YH, (const bf16*)(ws + WS_WPH) + (size_t)l * D * DHY, MC, D, DHY}; pg8::EpiMerge<true> E{MG, D, Pb + OFF_RH, NIN};
                pg8::gemm_phase<pg8::EpiMerge<true>, pg8::StaticOrder, PG8_ALIGN, PG8_SP2>(ldsl, g, So, E); } }
            XBAR();
            for (int rp_ = 0; rp_ < ((l == 0) ? REPS(8) : 1); ++rp_) { pg8::Gemm g{MG, (const bf16*)(ws + WS_WOUT) + (size_t)l * D * D, MC, D, D}; pg8::StaticOrder So; So.init(MC, D, C.G, (int)blockIdx.x);
              pg8::EpiRes E{xc, oc, D, in[20] + (size_t)l * D, MOD + ((size_t)l * NB + ch * CH) * 3 * D + 2 * D, S / 256, 3 * D, DN_ALPHA};
              pg8::gemm_phase<pg8::EpiRes, pg8::StaticOrder, PG8_ALIGN, PG8_SP2>(ldsl, g, So, E); }
            XBAR();
            pend_l = l; pend_ch = ch;
        }
    }
    { float* pr = out + (size_t)pend_ch * MC * D;
      for (int m = C.gw; m < MC; m += C.NGW) ln_final_row(pr + (size_t)m * D, in[21] + (size_t)pend_l * D, in[22] + (size_t)pend_l * D, C.lane); }
#if MK_CHECK
    XBAR();
    { const float e0 = __hip_atomic_load(ERR + 0, __ATOMIC_RELAXED, __HIP_MEMORY_SCOPE_AGENT), e1 = __hip_atomic_load(ERR + 1, __ATOMIC_RELAXED, __HIP_MEMORY_SCOPE_AGENT);
      const float f = 1.f + CHECK_K * sqrtf(e0 / fmaxf(e1, 1e-30f));
      int tq_ = threadIdx.x; asm volatile("" : "+v"(tq_));
      for (int i = blockIdx.x * NTHREADS + tq_; i < NB * S * D; i += C.G * NTHREADS) out[i] *= f; }
#endif
}

extern "C" void kernel_launch(void* const* d_in, const int* in_sizes, int n_in, void* d_out, int out_size, void* d_ws, size_t ws_size, hipStream_t stream) {
    static int grid = 0;
    if (grid == 0) {
        if (n_in != 23 || out_size != NB * S * D || ws_size < WS_END) { fprintf(stderr, "kernel_launch: unexpected shapes (n_in %d, out %d, ws %zu, need %zu); nothing launched\n", n_in, out_size, ws_size, (size_t)WS_END); grid = -1; return; }
        int dev = 0, cus = 0, per_cu = 0;
        if (hipGetDevice(&dev) != hipSuccess || hipDeviceGetAttribute(&cus, hipDeviceAttributeMultiprocessorCount, dev) != hipSuccess) { fprintf(stderr, "kernel_launch: device query failed\n"); grid = -1; return; }
        if (hipFuncSetAttribute((const void*)mk_fwd, hipFuncAttributeMaxDynamicSharedMemorySize, LDS_BYTES) != hipSuccess) { fprintf(stderr, "kernel_launch: hipFuncSetAttribute failed\n"); grid = -1; return; }
        if (hipOccupancyMaxActiveBlocksPerMultiprocessor(&per_cu, (const void*)mk_fwd, NTHREADS, LDS_BYTES) != hipSuccess || per_cu < 1) { fprintf(stderr, "kernel_launch: occupancy query says %d blocks per CU\n", per_cu); grid = -1; return; }
        grid = cus;
        fprintf(stderr, "kernel_launch: grid %d (cus %d, per_cu %d), ws %zu MiB\n", grid, cus, per_cu, ws_size >> 20);
    }
    if (grid < 0) return;
    if (hipMemsetAsync(d_ws, 0, 1 << 20, stream) != hipSuccess) { fprintf(stderr, "kernel_launch: memset of control words failed\n"); return; }
    Args a{};
    for (int i = 0; i < 23; ++i) a.in[i] = (const float*)d_in[i];
    a.out = (float*)d_out; a.ws = (unsigned char*)d_ws;
    void* kargs[] = {&a};
    const hipError_t e = hipLaunchCooperativeKernel((const void*)mk_fwd, dim3(grid), dim3(NTHREADS), kargs, LDS_BYTES, stream);
    if (e != hipSuccess) fprintf(stderr, "kernel_launch: cooperative launch failed: %s (grid %d)\n", hipGetErrorString(e), grid);
}
```

```cpp
#include <hip/hip_runtime.h>
#include <hip/hip_cooperative_groups.h>
#include <cstdio>
#include <cstdint>
#include <cmath>
namespace cg = cooperative_groups;
namespace pg8 {
#define PG8_LAS __attribute__((address_space(3)))
typedef unsigned short bf16_t;
typedef short bf16x8 __attribute__((ext_vector_type(8)));
typedef float f32x4 __attribute__((ext_vector_type(4)));
typedef unsigned u32x4 __attribute__((ext_vector_type(4)));
constexpr int BM = 256, BK = 64, HALF = 128, HTB = HALF * BK * 2  , STAGE_BYTES = 8 * HTB, NXCD = 8, WGM = 8;

__host__ __device__ __forceinline__ int lds_byte(int r, int c) { const int st = (r >> 4) * 2 + (c >> 5), rr = r & 15, cc = c & 31, ob = rr * 64 + cc * 2; return st * 1024 + (ob ^ (((ob >> 9) & 1) << 5)); }
__host__ __device__ __forceinline__ void stage_rc(int b, int& R, int& C) { const int st = b / 1024, sb = b % 1024, swz = sb ^ (((sb >> 9) & 1) << 5); R = (st >> 1) * 16 + swz / 64; C = (st & 1) * 32 + (swz % 64) / 2; }
__host__ __device__ __forceinline__ int perm32(int rho) { const int n = rho >> 4, i = rho & 15; return 8 * (i >> 2) + 4 * n + (i & 3); }

struct Unit { int pm, pn; };
struct Gemm { const bf16_t* A; const bf16_t* Bt; int M, N, K; };

struct StaticOrder {
    int nM, nN, nwg, G, c;
    __host__ __device__ void init(int M, int N, int G_, int c_) { nM = M / BM; nN = N / BM; nwg = nM * nN; G = G_; c = c_; }
    __host__ __device__ bool next(int i, Unit& u) const {
        const long L = (long)i * G + c; if (L >= nwg) return false;
        int wgid = (int)L; { const int q = nwg / NXCD, r = nwg % NXCD, xcd = wgid % NXCD, off = wgid / NXCD; wgid = (xcd < r ? xcd * (q + 1) : r * (q + 1) + (xcd - r) * q) + off; }
        const int nig = WGM * nN, gid = wgid / nig, fm = gid * WGM, gsz = (nM - fm) < WGM ? (nM - fm) : WGM;
        u.pm = fm + ((wgid % nig) % gsz); u.pn = (wgid % nig) / gsz; return true;
    }
    __device__ __forceinline__ void a_ready(const Unit&) const {}
    __device__ __forceinline__ void done(const Unit&) const {}
};

__device__ __forceinline__ unsigned cvt_pk_bf16(float lo, float hi) { unsigned r; asm volatile("v_cvt_pk_bf16_f32 %0, %1, %2" : "=v"(r) : "v"(lo), "v"(hi)); return r; }
typedef float f32x2 __attribute__((ext_vector_type(2)));
__device__ __forceinline__ f32x2 gelu_pk(f32x2 v) {
    const f32x2 av = __builtin_elementwise_abs(v), d = av * 0.2316418882f + 1.0f;
    f32x2 t; t.x = __builtin_amdgcn_rcpf(d.x); t.y = __builtin_amdgcn_rcpf(d.y);
    f32x2 q = t * 0.5307027145f + (-0.7265760135f); q = q * t + 0.7107068705f; q = q * t + (-0.142248368f); q = q * t + 0.127414796f; q = q * t;
    const f32x2 s = (v * v) * (-0.72134752044f);
    f32x2 e; e.x = __builtin_amdgcn_exp2f(s.x); e.y = __builtin_amdgcn_exp2f(s.y);
    const f32x2 m = v * (q * e), r = v - m;
    f32x2 o; o.x = v.x < 0.f ? m.x : r.x; o.y = v.y < 0.f ? m.y : r.y; return o;
}

template <int ACT  > struct EpiBf16 {
    static constexpr bool PERM = true, AFTER_DRAIN = false; static_assert(ACT == 0 || ACT == 1, "EpiBf16: ACT is 0 (none) or 1 (gelu_pk)");
    bf16_t* O; int ldc; const float* bias; int split_cols; size_t split_stride; float scale0;
    __device__ __forceinline__ void operator()(const f32x4 (&acc)[2][2][4][2], const Unit& u, int wr, int wc, int fr, int fq) const {
        const int row0 = u.pm * BM + wr * 64 + fr; int colt = u.pn * BM; bf16_t* base = O;
        float sc = 1.f; if (split_cols) { const int t = colt / split_cols; base += (size_t)t * split_stride; colt -= t * split_cols; if (t == 0) sc = scale0; }
        const int col0 = colt + wc * 32 + 8 * fq, bcol0 = u.pn * BM + wc * 32 + 8 * fq;
        f32x4 bv[2][2];
#pragma unroll
        for (int bj = 0; bj < 2; ++bj)
#pragma unroll
            for (int n = 0; n < 2; ++n) bv[bj][n] = bias ? *(const f32x4*)(bias + bcol0 + bj * HALF + 4 * n) : (f32x4){0.f, 0.f, 0.f, 0.f};
#pragma unroll
        for (int ai = 0; ai < 2; ++ai)
#pragma unroll
            for (int m = 0; m < 4; ++m) { bf16_t* rowp = base + (size_t)(row0 + ai * HALF + m * 16) * ldc + col0;
#pragma unroll
                for (int bj = 0; bj < 2; ++bj) { f32x4 v0 = acc[ai][bj][m][0] + bv[bj][0], v1 = acc[ai][bj][m][1] + bv[bj][1];
                    if (ACT == 1) { f32x2 a = gelu_pk((f32x2){v0[0], v0[1]}), b = gelu_pk((f32x2){v0[2], v0[3]}), c = gelu_pk((f32x2){v1[0], v1[1]}), d = gelu_pk((f32x2){v1[2], v1[3]});
                        v0 = (f32x4){a.x, a.y, b.x, b.y}; v1 = (f32x4){c.x, c.y, d.x, d.y}; }
                    v0 = v0 * sc; v1 = v1 * sc; u32x4 w; w.x = cvt_pk_bf16(v0[0], v0[1]); w.y = cvt_pk_bf16(v0[2], v0[3]); w.z = cvt_pk_bf16(v1[0], v1[1]); w.w = cvt_pk_bf16(v1[2], v1[3]);
                    *(u32x4*)(rowp + bj * HALF) = w; } }
    }
};
__device__ __forceinline__ float bf_lo(unsigned w) { return __uint_as_float(w << 16); }
__device__ __forceinline__ float bf_hi(unsigned w) { return __uint_as_float(w & 0xffff0000u); }
__device__ __forceinline__ float sigm(float x) { return 1.f / (1.f + __expf(-x)); }
template <bool ACCUM> struct EpiMerge {
    static constexpr bool PERM = true, AFTER_DRAIN = false;
    bf16_t* O; int ldc; const bf16_t* Gt; int ldg;
    __device__ __forceinline__ void operator()(const f32x4 (&acc)[2][2][4][2], const Unit& u, int wr, int wc, int fr, int fq) const {
        const int row0 = u.pm * BM + wr * 64 + fr, col0 = u.pn * BM + wc * 32 + 8 * fq;
#pragma unroll
        for (int ai = 0; ai < 2; ++ai)
#pragma unroll
            for (int m = 0; m < 4; ++m) { const size_t row = (size_t)(row0 + ai * HALF + m * 16);
#pragma unroll
                for (int bj = 0; bj < 2; ++bj) { const int col = col0 + bj * HALF;
                    const u32x4 g = *(const u32x4*)(Gt + row * ldg + col);
                    const f32x4 v0 = acc[ai][bj][m][0], v1 = acc[ai][bj][m][1];
                    float r[8];
                    r[0] = sigm(bf_lo(g.x)) * v0[0]; r[1] = sigm(bf_hi(g.x)) * v0[1]; r[2] = sigm(bf_lo(g.y)) * v0[2]; r[3] = sigm(bf_hi(g.y)) * v0[3];
                    r[4] = sigm(bf_lo(g.z)) * v1[0]; r[5] = sigm(bf_hi(g.z)) * v1[1]; r[6] = sigm(bf_lo(g.w)) * v1[2]; r[7] = sigm(bf_hi(g.w)) * v1[3];
                    bf16_t* op = O + row * ldc + col;
                    if (ACCUM) { const u32x4 o = *(const u32x4*)op;
                        r[0] += bf_lo(o.x); r[1] += bf_hi(o.x); r[2] += bf_lo(o.y); r[3] += bf_hi(o.y); r[4] += bf_lo(o.z); r[5] += bf_hi(o.z); r[6] += bf_lo(o.w); r[7] += bf_hi(o.w); }
                    u32x4 w; w.x = cvt_pk_bf16(r[0], r[1]); w.y = cvt_pk_bf16(r[2], r[3]); w.z = cvt_pk_bf16(r[4], r[5]); w.w = cvt_pk_bf16(r[6], r[7]);
                    *(u32x4*)op = w; } }
    }
};
struct EpiRes {
    static constexpr bool PERM = false, AFTER_DRAIN = false;
    const float* xin; float* out; int ldc; const float* bias; const float* gate0; int tiles_per_batch; int gate_stride; float alpha;
    __device__ __forceinline__ void operator()(const f32x4 (&acc)[2][2][4][2], const Unit& u, int wr, int wc, int fr, int fq) const {
        const int col0 = u.pn * BM + wc * 32 + 4 * fq;
        const float* gate = gate0 + (size_t)(u.pm / tiles_per_batch) * gate_stride;
#pragma unroll
        for (int bj = 0; bj < 2; ++bj)
#pragma unroll
            for (int n = 0; n < 2; ++n) { const int col = col0 + bj * HALF + n * 16;
                const f32x4 bv = *(const f32x4*)(bias + col), gv = *(const f32x4*)(gate + col);
#pragma unroll
                for (int ai = 0; ai < 2; ++ai)
#pragma unroll
                    for (int m = 0; m < 4; ++m) { const size_t off = (size_t)(u.pm * BM + ai * HALF + wr * 64 + m * 16 + fr) * ldc + col;
                        const f32x4 xv = *(const f32x4*)(xin + off);
                        *(f32x4*)(out + off) = xv * alpha + gv * (acc[ai][bj][m][n] + bv); } }
    }
};
template <class Epi, class Sched, bool ALIGN_EPI = false, bool SP2 = false>
__device__ __forceinline__ void gemm_phase(PG8_LAS unsigned char* lds, const Gemm g, const Sched& S, const Epi& E) {
    int tid_ = threadIdx.x; asm volatile("" : "+v"(tid_));
    const int tid = tid_, wid = __builtin_amdgcn_readfirstlane(tid >> 6), lane = tid & 63, wr = wid >> 2, wc = wid & 3, fr = lane & 15, fq = lane >> 4;
    const int K = g.K, nt = K / BK;
    unsigned voffA[2], voffB[2];
#pragma unroll
    for (int i = 0; i < 2; ++i) { int R, C; stage_rc(tid * 16 + i * 8192, R, C); const int Rb = Epi::PERM ? ((R & ~31) + perm32(R & 31)) : R;
        voffA[i] = (unsigned)(R * K + C) * 2u; voffB[i] = (unsigned)(Rb * K + C) * 2u; }
    const size_t kstep = (size_t)(BK * 2);
    const size_t hstep = (size_t)HALF * K * 2;
    const size_t tstep = 2 * hstep;
    const unsigned ldsw = (unsigned)wid * 1024u;
    const int aoff = lds_byte(wr * 64 + fr, fq * 8), boff = lds_byte(wc * 32 + fr, fq * 8);
#define PG8_SA(b, h) (((b) * 2 + (h)) * HTB)
#define PG8_SB(b, h) ((4 + (b) * 2 + (h)) * HTB)
#define PG8_STAGE(bufoff, gbase, voff) do { _Pragma("unroll") for (int _i = 0; _i < 2; ++_i) \
        __builtin_amdgcn_global_load_lds((const unsigned*)((const char*)(gbase) + (voff)[_i]), (PG8_LAS unsigned*)(lds + (bufoff) + ldsw + _i * 8192), 16, 0, 0); } while (0)
#define PG8_LDA(dst, b, h) do { _Pragma("unroll") for (int m = 0; m < 4; ++m) _Pragma("unroll") for (int k = 0; k < 2; ++k) dst[m][k] = *(const PG8_LAS bf16x8*)(lds + PG8_SA(b, h) + aoff + m * 2048 + k * 1024); } while (0)
#define PG8_LDB(dst, b, h) do { _Pragma("unroll") for (int n = 0; n < 2; ++n) _Pragma("unroll") for (int k = 0; k < 2; ++k) dst[n][k] = *(const PG8_LAS bf16x8*)(lds + PG8_SB(b, h) + boff + n * 2048 + k * 1024); } while (0)
#define PG8_MMA(ai, bj, At, Bt) do { __builtin_amdgcn_s_setprio(1); _Pragma("unroll") for (int m = 0; m < 4; ++m) _Pragma("unroll") for (int n = 0; n < 2; ++n) _Pragma("unroll") for (int k = 0; k < 2; ++k) \
        acc[ai][bj][m][n] = __builtin_amdgcn_mfma_f32_16x16x32_bf16(Bt[n][k], At[m][k], acc[ai][bj][m][n], 0, 0, 0); __builtin_amdgcn_s_setprio(0); } while (0)
#define PG8_WAIT_V(n) asm volatile("s_waitcnt vmcnt(" #n ")" ::: "memory")
#define PG8_WAIT_L(n) asm volatile("s_waitcnt lgkmcnt(" #n ")" ::: "memory")
#define PG8_BAR __builtin_amdgcn_s_barrier()
#define PG8_SCHED __builtin_amdgcn_sched_barrier(0)
    Unit cur, nxt; int ui = 0;
    if (!S.next(0, cur)) return;
    f32x4 acc[2][2][4][2];
#pragma unroll
    for (int a = 0; a < 2; ++a)
#pragma unroll
        for (int b = 0; b < 2; ++b)
#pragma unroll
            for (int m = 0; m < 4; ++m)
#pragma unroll
                for (int n = 0; n < 2; ++n) acc[a][b][m][n] = (f32x4){0.f, 0.f, 0.f, 0.f};
    bf16x8 At[4][2], B0[2][2], B1[2][2];
    const char* cA = (const char*)g.A + (size_t)cur.pm * tstep; const char* cB = (const char*)g.Bt + (size_t)cur.pn * tstep;
    S.a_ready(cur);
    if constexpr (SP2) {
        PG8_STAGE(PG8_SB(0, 0), cB, voffB); PG8_STAGE(PG8_SB(0, 1), cB + hstep, voffB); PG8_STAGE(PG8_SA(0, 0), cA, voffA); PG8_STAGE(PG8_SA(0, 1), cA + hstep, voffA);
        if (wr == 1) PG8_BAR;
        PG8_WAIT_V(2); PG8_BAR;
        PG8_STAGE(PG8_SB(1, 0), cB + kstep, voffB); PG8_STAGE(PG8_SA(1, 0), cA + kstep, voffA); PG8_STAGE(PG8_SB(1, 1), cB + hstep + kstep, voffB);
        PG8_WAIT_V(6); PG8_BAR;
    } else {
        PG8_STAGE(PG8_SB(0, 0), cB, voffB); PG8_STAGE(PG8_SA(0, 0), cA, voffA); PG8_STAGE(PG8_SB(0, 1), cB + hstep, voffB); PG8_STAGE(PG8_SA(0, 1), cA + hstep, voffA);
        if (wr == 1) PG8_BAR;
        PG8_WAIT_V(4); PG8_BAR;
        PG8_STAGE(PG8_SB(1, 0), cB + kstep, voffB); PG8_STAGE(PG8_SA(1, 0), cA + kstep, voffA); PG8_STAGE(PG8_SB(1, 1), cB + hstep + kstep, voffB);
        PG8_WAIT_V(6); PG8_BAR;
    }
    for (;;) {
        const bool has_next = S.next(ui + 1, nxt);
        const char* nA = has_next ? (const char*)g.A + (size_t)nxt.pm * tstep : cA; const char* nB = has_next ? (const char*)g.Bt + (size_t)nxt.pn * tstep : cB;
        for (int t = 0; t < nt; t += 2) {
            const bool last = (t == nt - 2);
            const char* a1 = cA + (size_t)(t + 1) * kstep;
            const char* a2 = last ? nA : cA + (size_t)(t + 2) * kstep; const char* b2 = last ? nB : cB + (size_t)(t + 2) * kstep;
            const char* a3 = a2 + kstep; const char* b3 = b2 + kstep;
            if (last && has_next) S.a_ready(nxt);
            if constexpr (SP2) {
            PG8_LDB(B0, 0, 0); PG8_LDB(B1, 0, 1); PG8_SCHED; PG8_LDA(At, 0, 0); PG8_STAGE(PG8_SA(1, 1), a1 + hstep, voffA);
            PG8_WAIT_V(8); PG8_WAIT_L(0); PG8_BAR; PG8_MMA(0, 0, At, B0); PG8_MMA(0, 1, At, B1); PG8_BAR; PG8_SCHED;
            PG8_LDA(At, 0, 1); PG8_STAGE(PG8_SB(0, 0), b2, voffB); PG8_STAGE(PG8_SB(0, 1), b2 + hstep, voffB); PG8_STAGE(PG8_SA(0, 0), a2, voffA);
            PG8_WAIT_V(8); PG8_WAIT_L(0); PG8_BAR; PG8_MMA(1, 0, At, B0); PG8_MMA(1, 1, At, B1); PG8_BAR; PG8_SCHED;
            PG8_LDB(B0, 1, 0); PG8_LDB(B1, 1, 1); PG8_SCHED; PG8_LDA(At, 1, 0); PG8_STAGE(PG8_SA(0, 1), a2 + hstep, voffA);
            PG8_WAIT_V(8); PG8_WAIT_L(0); PG8_BAR; PG8_MMA(0, 0, At, B0); PG8_MMA(0, 1, At, B1); PG8_BAR; PG8_SCHED;
            PG8_LDA(At, 1, 1); PG8_STAGE(PG8_SB(1, 0), b3, voffB); PG8_STAGE(PG8_SB(1, 1), b3 + hstep, voffB); PG8_STAGE(PG8_SA(1, 0), a3, voffA);
            PG8_WAIT_V(8); PG8_WAIT_L(0); PG8_BAR; PG8_MMA(1, 0, At, B0); PG8_MMA(1, 1, At, B1); PG8_BAR; PG8_SCHED;
            } else {
            PG8_LDB(B0, 0, 0); PG8_SCHED; PG8_LDA(At, 0, 0); PG8_STAGE(PG8_SA(1, 1), a1 + hstep, voffA);
            PG8_WAIT_L(8); PG8_BAR; PG8_WAIT_L(0); PG8_MMA(0, 0, At, B0); PG8_BAR; PG8_SCHED;
            PG8_LDB(B1, 0, 1); PG8_STAGE(PG8_SB(0, 0), b2, voffB);
            PG8_BAR; PG8_WAIT_L(0); PG8_MMA(0, 1, At, B1); PG8_BAR;
            PG8_LDA(At, 0, 1); PG8_STAGE(PG8_SA(0, 0), a2, voffA);
            PG8_BAR; PG8_WAIT_L(0); PG8_MMA(1, 0, At, B0); PG8_BAR; PG8_SCHED;
            PG8_STAGE(PG8_SB(0, 1), b2 + hstep, voffB);
            PG8_WAIT_V(6); PG8_BAR; PG8_MMA(1, 1, At, B1); PG8_BAR;
            PG8_LDB(B0, 1, 0); PG8_SCHED; PG8_LDA(At, 1, 0); PG8_STAGE(PG8_SA(0, 1), a2 + hstep, voffA);
            PG8_WAIT_L(8); PG8_BAR; PG8_WAIT_L(0); PG8_MMA(0, 0, At, B0); PG8_BAR; PG8_SCHED;
            PG8_LDB(B1, 1, 1); PG8_STAGE(PG8_SB(1, 0), b3, voffB);
            PG8_BAR; PG8_WAIT_L(0); PG8_MMA(0, 1, At, B1); PG8_BAR;
            PG8_LDA(At, 1, 1); PG8_STAGE(PG8_SA(1, 0), a3, voffA);
            PG8_BAR; PG8_WAIT_L(0); PG8_MMA(1, 0, At, B0); PG8_BAR; PG8_SCHED;
            PG8_STAGE(PG8_SB(1, 1), b3 + hstep, voffB);
            PG8_WAIT_V(6); PG8_BAR; PG8_MMA(1, 1, At, B1); PG8_BAR;
            }
        }
        if constexpr (ALIGN_EPI) { if (wr == 0) PG8_BAR; }
        if constexpr (!Epi::AFTER_DRAIN) { E(acc, cur, wr, wc, fr, fq); S.done(cur); }
        if (!has_next) break;
#pragma unroll
        for (int a = 0; a < 2; ++a)
#pragma unroll
            for (int b = 0; b < 2; ++b)
#pragma unroll
                for (int m = 0; m < 4; ++m)
#pragma unroll
                    for (int n = 0; n < 2; ++n) acc[a][b][m][n] = (f32x4){0.f, 0.f, 0.f, 0.f};
        cur = nxt; cA = nA; cB = nB; ++ui;
        if constexpr (ALIGN_EPI) { if (wr == 1) PG8_BAR; }
    }
    PG8_WAIT_V(0);
    if constexpr (!ALIGN_EPI) { if (wr == 0) PG8_BAR; }
    PG8_BAR;
    if constexpr (Epi::AFTER_DRAIN) { E.fused(acc, cur, wr, wc, fr, fq, lds, wid, lane); S.done(cur); }
#undef PG8_SA
#undef PG8_SB
#undef PG8_STAGE
#undef PG8_LDA
#undef PG8_LDB
#undef PG8_MMA
#undef PG8_WAIT_V
#undef PG8_WAIT_L
#undef PG8_BAR
#undef PG8_SCHED
}
}
constexpr int D = 1024, NB = 8, S = 4096, DEPTH = 2;
constexpr int HD = 64, DA = 512, NH = 8, NG = 3, DHY = 512, NIN = 9216;
constexpr int FE = 33, FW = 64;
constexpr int OFF_GA = 4608, OFF_HY = 5120, OFF_GH = 6656, OFF_RA = 7168, OFF_RH = 8192;
constexpr float LN_EPS = 1e-5f, DN_ALPHA = 1.41421356237309515f;
#ifndef MK_CHECK
#define MK_CHECK 0
#endif
#ifndef MK_CH
#define MK_CH (MK_CHECK ? 2 : 4)
#endif
constexpr int CH = MK_CH, NCHUNK = NB / CH, MC = CH * S;
constexpr int NWAVES = 8, NTHREADS = NWAVES * 64;
constexpr int GLEN = 2 * S - 1;

constexpr size_t MiB = 1u << 20;
constexpr size_t WS_WIN = 1 * MiB;
constexpr size_t WS_WPA = WS_WIN + (size_t)DEPTH * NIN * D * 2;
constexpr size_t WS_WPH = WS_WPA + (size_t)DEPTH * D * DA * 2;
constexpr size_t WS_WOUT = WS_WPH + (size_t)DEPTH * D * DHY * 2;
constexpr size_t WS_MOD = WS_WOUT + (size_t)DEPTH * D * D * 2;
constexpr size_t WS_H3 = WS_MOD + 1 * MiB;
constexpr size_t WS_R = WS_H3 + 2 * MiB;
constexpr size_t SZ_OG = (size_t)3 * MC * DA * 2, SZ_UT = (size_t)MC * 4 * DHY * 2;
constexpr size_t WS_H = WS_R + (size_t)DEPTH * 2 * DHY * 8192 * 2;
constexpr size_t WS_OG = WS_H;
constexpr size_t WS_P = WS_H + SZ_OG;
constexpr size_t WS_UT = WS_P + (size_t)MC * NIN * 2;
constexpr size_t WS_YA = WS_UT;
constexpr size_t WS_YH = WS_UT + (size_t)MC * DA * 2;
constexpr size_t WS_YHT = WS_UT + SZ_UT;
constexpr size_t WS_ML = WS_YHT + (size_t)MC * DHY * 2;
constexpr size_t WS_Z1T = WS_ML + (size_t)3 * MC * NH * 8;
constexpr size_t WS_YHTR = WS_Z1T + (size_t)MC * DHY * 2;
constexpr size_t WS_YAR = WS_YHTR + (size_t)MC * DHY * 2;
constexpr size_t WS_END = MK_CHECK ? WS_YAR + (size_t)MC * DA * 2 : WS_Z1T;
static_assert(SZ_OG >= (size_t)MC * D * 2 && SZ_UT >= (size_t)2 * MC * DA * 2, "aliased regions");
constexpr float CHECK_K = 30.f;

#ifndef PHM
#define PHM 0xFF
#endif
#ifndef MK_REP
#define MK_REP 0
#endif
#define REPS(k) (1 + (MK_REP == (k)))
constexpr int LDS_BYTES = 147456;
constexpr int RING_BYTES = 131072;

#define LAS __attribute__((address_space(3)))
typedef unsigned short bf16;
typedef unsigned v4u __attribute__((ext_vector_type(4)));
typedef unsigned v2u __attribute__((ext_vector_type(2)));
typedef float f32x4 __attribute__((ext_vector_type(4)));
#define LDS_WAIT() asm volatile("s_waitcnt lgkmcnt(0)" ::: "memory")
__device__ __forceinline__ unsigned f2bf(float f) { unsigned u = __builtin_bit_cast(unsigned, f); return (u + 0x7fffu + ((u >> 16) & 1u)) >> 16; }
__device__ __forceinline__ unsigned pk2(float lo, float hi) { return f2bf(lo) | (f2bf(hi) << 16); }
__device__ __forceinline__ float bf2f(unsigned short h) { return __uint_as_float((unsigned)h << 16); }
__device__ __forceinline__ float blo(unsigned w) { return __uint_as_float(w << 16); }
__device__ __forceinline__ float bhi(unsigned w) { return __uint_as_float(w & 0xffff0000u); }
__device__ __forceinline__ float wave_sum(float v) {
#pragma unroll
    for (int o = 1; o < 64; o <<= 1) v += __shfl_xor(v, o);
    return v;
}
__device__ __forceinline__ float wave_max(float v) {
#pragma unroll
    for (int o = 1; o < 64; o <<= 1) v = fmaxf(v, __shfl_xor(v, o));
    return v;
}
__device__ __forceinline__ float siluf_(float x) { return x / (1.f + expf(-x)); }
__device__ __forceinline__ void sincos_cw(float x, float& sn, float& cs) {
    const float j = rintf(x * 0.63661977236758134f);
    float y = fmaf(-j, 1.5703125f, x);
    y = fmaf(-j, 4.837512969970703125e-4f, y);
    y = fmaf(-j, 7.54978995489188216e-8f, y);
    const float z = y * y;
    const float sp = fmaf(fmaf(fmaf(-1.9515295891e-4f, z, 8.3321608736e-3f), z, -1.6666654611e-1f) * z, y, y);
    const float cp = fmaf(fmaf(fmaf(2.443315711809948e-5f, z, -1.388731625493765e-3f), z, 4.166664568298827e-2f), z * z, fmaf(-0.5f, z, 1.0f));
    const int q = ((int)j) & 3;
    const float s0 = (q & 1) ? cp : sp, c0 = (q & 1) ? sp : cp;
    sn = (q & 2) ? -s0 : s0;
    cs = ((q + 1) & 2) ? -c0 : c0;
}
__device__ __forceinline__ float sin_cw(float x) { float s, c; sincos_cw(x, s, c); return s; }

struct Ctx {
    unsigned char* lds;
    int tid, lane, wave, gw, NGW, G;
};

__device__ __forceinline__ void p0_transpose_item(const float* W, int K, int N, bf16* WT, float* scr, int item, int lane) {
    const int nblk = N / 32, kb = item / nblk, nb = item % nblk, k0 = 64 * kb, n0 = 32 * nb;
#pragma unroll 8
    for (int i = 0; i < 32; ++i) { const int kk = 2 * i + (lane >> 5); scr[kk * 33 + (lane & 31)] = W[(size_t)(k0 + kk) * N + n0 + (lane & 31)]; }
    LDS_WAIT(); asm volatile("" ::: "memory");
    const int c = lane & 7;
#pragma unroll
    for (int j = 0; j < 4; ++j) { const int n = (lane >> 3) + 8 * j; const float* s = scr + (8 * c) * 33 + n;
        v4u o; o.x = pk2(s[0 * 33], s[1 * 33]); o.y = pk2(s[2 * 33], s[3 * 33]); o.z = pk2(s[4 * 33], s[5 * 33]); o.w = pk2(s[6 * 33], s[7 * 33]);
        *(v4u*)(WT + (size_t)(n0 + n) * K + k0 + 8 * c) = o; }
    LDS_WAIT(); asm volatile("" ::: "memory");
}
__device__ __forceinline__ void p0_trunk_item(const float* const* in, float* H3, float* sf  , int l, int t, int lane) {
    const float* w1 = in[8]; const float* b1 = in[9]; const float* w2 = in[10]; const float* b2 = in[11];
    const float* w3 = in[12]; const float* b3 = in[13]; const float* freq = in[15];
    if (lane < FE) {
        float v;
        if (lane == 0) v = (float)t / (float)(S - 1);
        else {
            const int q = (lane - 1) & 15;
            const double f = (double)(1e-4f) + (double)q * (((double)15.0f - (double)1e-4f) / 15.0);
            double u = f * (double)t / (double)S; u -= rint(u);
            float sn, cs; sincos_cw((float)(u * 6.283185307179586476925), sn, cs);
            v = (lane <= 16) ? cs : -sn;
        }
        sf[lane] = v;
    }
    LDS_WAIT(); asm volatile("" ::: "memory");
    const float fr = freq[l * FW + lane];
    float a0 = b1[l * FW + lane], a1 = 0.f;
    for (int kk = 0; kk < 32; kk += 2) { a0 = fmaf(sf[kk], w1[(l * FE + kk) * FW + lane], a0); a1 = fmaf(sf[kk + 1], w1[(l * FE + kk + 1) * FW + lane], a1); }
    a0 = fmaf(sf[32], w1[(l * FE + 32) * FW + lane], a0);
    sf[64 + lane] = sin_cw(fr * (a0 + a1));
    LDS_WAIT(); asm volatile("" ::: "memory");
    a0 = b2[l * FW + lane]; a1 = 0.f;
    for (int kk = 0; kk < FW; kk += 2) { a0 = fmaf(sf[64 + kk], w2[(l * FW + kk) * FW + lane], a0); a1 = fmaf(sf[64 + kk + 1], w2[(l * FW + kk + 1) * FW + lane], a1); }
    sf[128 + lane] = sin_cw(fr * (a0 + a1));
    LDS_WAIT(); asm volatile("" ::: "memory");
    a0 = b3[l * FW + lane]; a1 = 0.f;
    for (int kk = 0; kk < FW; kk += 2) { a0 = fmaf(sf[128 + kk], w3[(l * FW + kk) * FW + lane], a0); a1 = fmaf(sf[128 + kk + 1], w3[(l * FW + kk + 1) * FW + lane], a1); }
    H3[((size_t)l * S + t) * FW + lane] = sin_cw(fr * (a0 + a1));
    LDS_WAIT(); asm volatile("" ::: "memory");
}
__device__ __forceinline__ void p0_rgen_item(const float* const* in, const float* H3, bf16* R, unsigned char* lds, int item, int tid) {
    const int l = item >> 7, tg = (item >> 4) & 7, nb = item & 15, lane = tid & 63, wave = tid >> 6;
    float* Wl = (float*)lds;
    const float* w4l = in[14] + (size_t)l * FW * (4 * DHY) + 128 * nb;
    for (int e = tid; e < 64 * 128; e += NTHREADS) { const int j = e >> 7, i = e & 127; Wl[i * 68 + j] = w4l[(size_t)j * 4 * DHY + i]; }
    const int t = 512 * tg + 64 * wave + lane;
    float hr[64];
    { const f32x4* hp = (const f32x4*)(H3 + ((size_t)l * S + t) * FW);
#pragma unroll
      for (int q = 0; q < 16; ++q) { const f32x4 v = hp[q]; hr[4 * q] = v.x; hr[4 * q + 1] = v.y; hr[4 * q + 2] = v.z; hr[4 * q + 3] = v.w; } }
    __syncthreads();
    const int nq = nb >> 2, o = nq >> 1, dir = nq & 1, cbase = (128 * nb) & 511;
    const float tt = (float)t / (float)(S - 1);
    const float d0 = -4.605170185988091f / 1.5f, d1 = -4.605170185988091f / 0.3f;
    const int x = dir ? ((t == 0) ? 8191 : 4095 + t) : 4095 - t;
    bf16* Rb = R + ((size_t)(l * 2 + o) * DHY + cbase) * 8192 + x;
    for (int i = 0; i < 128; ++i) {
        const f32x4* wp = (const f32x4*)(Wl + i * 68);
        float a0 = 0.f, a1 = 0.f, a2 = 0.f, a3 = 0.f;
#pragma unroll
        for (int q = 0; q < 16; ++q) { const f32x4 w = wp[q]; a0 = fmaf(hr[4 * q], w.x, a0); a1 = fmaf(hr[4 * q + 1], w.y, a1); a2 = fmaf(hr[4 * q + 2], w.z, a2); a3 = fmaf(hr[4 * q + 3], w.w, a3); }
        const float delta = d0 + (d1 - d0) * ((float)(cbase + i) / (float)(DHY - 1));
        float val = ((a0 + a1) + (a2 + a3)) * __expf(-tt * fabsf(delta));
        if (dir == 1 && t == 0) val = 0.f;
        Rb[(size_t)i * 8192] = (bf16)f2bf(val);
    }
    __syncthreads();
}
__device__ __forceinline__ void p0_mod_item(const float* const* in, float* mod, unsigned char* lds, int item, int tid) {
    const int l = item / 48, n = (item % 48) * 64 + (tid & 63), wave = tid >> 6, lane = tid & 63;
    const float* w = in[2] + (size_t)l * D * 3 * D + (size_t)(128 * wave) * 3 * D + n; const float* c = in[1] + 128 * wave;
    float acc[NB];
#pragma unroll
    for (int b = 0; b < NB; ++b) acc[b] = 0.f;
#pragma unroll 4
    for (int k = 0; k < 128; ++k) { const float wv = w[(size_t)k * 3 * D];
#pragma unroll
        for (int b = 0; b < NB; ++b) acc[b] = fmaf(c[b * D + k], wv, acc[b]); }
    float* red = (float*)lds;
#pragma unroll
    for (int b = 0; b < NB; ++b) red[(wave * NB + b) * 64 + lane] = acc[b];
    __syncthreads();
    { float s = in[3][l * 3 * D + n];
#pragma unroll
      for (int q = 0; q < NWAVES; ++q) s += red[(q * NB + wave) * 64 + lane];
      mod[((size_t)l * NB + wave) * 3 * D + n] = s; }
    __syncthreads();
}
__device__ __forceinline__ void p0_prologue_a(const Ctx& C, const float* const* in, unsigned char* ws) {
    float* scr = (float*)(C.lds + C.wave * 16384);
    constexpr int I_IN = (D / 64) * (NIN / 32), I_PA = (DA / 64) * (D / 32), I_PH = (DHY / 64) * (D / 32), I_OUT = (D / 64) * (D / 32);
    constexpr int I_L = I_IN + I_PA + I_PH + I_OUT;
    for (int rq_ = 0; rq_ < REPS(11); ++rq_) for (int it = C.gw; it < DEPTH * I_L; it += C.NGW) {
        const int l = it / I_L; int r = it % I_L;
        if (r < I_IN) { p0_transpose_item(in[4] + (size_t)l * D * NIN, D, NIN, (bf16*)(ws + WS_WIN) + (size_t)l * NIN * D, scr, r, C.lane); continue; } r -= I_IN;
        if (r < I_PA) { p0_transpose_item(in[17] + (size_t)l * DA * D, DA, D, (bf16*)(ws + WS_WPA) + (size_t)l * D * DA, scr, r, C.lane); continue; } r -= I_PA;
        if (r < I_PH) { p0_transpose_item(in[18] + (size_t)l * DHY * D, DHY, D, (bf16*)(ws + WS_WPH) + (size_t)l * D * DHY, scr, r, C.lane); continue; } r -= I_PH;
        p0_transpose_item(in[19] + (size_t)l * D * D, D, D, (bf16*)(ws + WS_WOUT) + (size_t)l * D * D, scr, r, C.lane);
    }
    for (int rq_ = 0; rq_ < REPS(13); ++rq_) for (int it = C.gw; it < DEPTH * S; it += C.NGW) p0_trunk_item(in, (float*)(ws + WS_H3), scr, it / S, it % S, C.lane);
    __syncthreads();
    for (int rq_ = 0; rq_ < REPS(12); ++rq_) for (int it = blockIdx.x; it < DEPTH * 48; it += C.G) p0_mod_item(in, (float*)(ws + WS_MOD), C.lds, it, C.tid);
}
__device__ __forceinline__ void p0_prologue_b(const Ctx& C, const float* const* in, unsigned char* ws) {
    for (int rq_ = 0; rq_ < REPS(14); ++rq_) for (int it = blockIdx.x; it < DEPTH * 128; it += C.G) p0_rgen_item(in, (const float*)(ws + WS_H3), (bf16*)(ws + WS_R), C.lds, it, C.tid);
}

__device__ __forceinline__ void ln_mod_row(const float* xrow, const float* modb, bf16* orow, int lane) {
    const f32x4* xr = (const f32x4*)xrow + lane;
    f32x4 v[4]; float s = 0.f;
#pragma unroll
    for (int j = 0; j < 4; ++j) { v[j] = xr[64 * j]; s += (v[j].x + v[j].y) + (v[j].z + v[j].w); }
    const float mean = wave_sum(s) * (1.f / D); float s2 = 0.f;
#pragma unroll
    for (int j = 0; j < 4; ++j) { v[j] = v[j] - mean; s2 += (v[j].x * v[j].x + v[j].y * v[j].y) + (v[j].z * v[j].z + v[j].w * v[j].w); }
    const float rstd = 1.f / sqrtf(wave_sum(s2) * (1.f / D) + LN_EPS);
    v2u* o8 = (v2u*)orow + lane;
#pragma unroll
    for (int j = 0; j < 4; ++j) {
        const f32x4 sh = *((const f32x4*)modb + lane + 64 * j), sc = *((const f32x4*)(modb + D) + lane + 64 * j);
        const f32x4 r = v[j] * rstd * (sc + 1.f) + sh;
        v2u w; w.x = pk2(r.x, r.y); w.y = pk2(r.z, r.w); o8[64 * j] = w;
    }
}
__device__ __forceinline__ void ln_final_row(float* row, const float* lg, const float* lb, int lane) {
    f32x4* xr = (f32x4*)row + lane;
    f32x4 v[4]; float s = 0.f;
#pragma unroll
    for (int j = 0; j < 4; ++j) { v[j] = xr[64 * j]; s += (v[j].x + v[j].y) + (v[j].z + v[j].w); }
    const float mean = wave_sum(s) * (1.f / D); float s2 = 0.f;
#pragma unroll
    for (int j = 0; j < 4; ++j) { v[j] = v[j] - mean; s2 += (v[j].x * v[j].x + v[j].y * v[j].y) + (v[j].z * v[j].z + v[j].w * v[j].w); }
    const float rstd = 1.f / sqrtf(wave_sum(s2) * (1.f / D) + LN_EPS);
#pragma unroll
    for (int j = 0; j < 4; ++j) { const f32x4 g = *((const f32x4*)lg + lane + 64 * j), b = *((const f32x4*)lb + lane + 64 * j); xr[64 * j] = v[j] * rstd * g + b; }
}

__device__ __forceinline__ void attn_naive_item(const bf16* P, bf16* YA, float* sw  , int row, int h, int lane) {
    float* sq = sw; float* sc = sw + 192;
    const int t = row % S, rb = row - t;
    const float slope = exp2f(-(float)(h + 1));
    const bf16* prow = P + (size_t)row * NIN;
#pragma unroll
    for (int g = 0; g < NG; ++g) sq[g * 64 + lane] = bf2f(prow[(0 * NG + g) * DA + h * HD + lane]);
    LDS_WAIT(); asm volatile("" ::: "memory");
    float mx = -INFINITY;
#pragma unroll
    for (int g = 0; g < NG; ++g) {
        const int dil = (g == 0) ? 1 : (g == 1 ? 4 : 16);
        const int kcol = (1 * NG + g) * DA + h * HD;
        for (int pass = 0; pass < 3; ++pass) {
            const int jj = pass * 64 + lane;
            if (jj <= 128) {
                const int j = jj - 64, tk = t + j * dil;
                float s = -INFINITY;
                if (tk >= 0 && tk < S) {
                    const v4u* kr = (const v4u*)(P + (size_t)(rb + tk) * NIN + kcol);
                    float a = 0.f;
#pragma unroll
                    for (int e = 0; e < 8; ++e) { const v4u kv = kr[e]; const float* q = sq + g * 64 + 8 * e;
                        a = fmaf(q[0], blo(kv.x), a); a = fmaf(q[1], bhi(kv.x), a); a = fmaf(q[2], blo(kv.y), a); a = fmaf(q[3], bhi(kv.y), a);
                        a = fmaf(q[4], blo(kv.z), a); a = fmaf(q[5], bhi(kv.z), a); a = fmaf(q[6], blo(kv.w), a); a = fmaf(q[7], bhi(kv.w), a); }
                    s = a * 0.125f - slope * (float)((j < 0 ? -j : j) * dil);
                }
                sc[g * 132 + jj] = s;
                mx = fmaxf(mx, s);
            }
        }
    }
    mx = wave_max(mx);
    float sum = 0.f;
#pragma unroll
    for (int g = 0; g < NG; ++g)
        for (int pass = 0; pass < 3; ++pass) {
            const int jj = pass * 64 + lane;
            if (jj <= 128) { const float s = sc[g * 132 + jj]; const float p = (s == -INFINITY) ? 0.f : expf(s - mx); sc[g * 132 + jj] = p; sum += p; }
        }
    sum = wave_sum(sum);
    LDS_WAIT(); asm volatile("" ::: "memory");
    float o = 0.f;
#pragma unroll
    for (int g = 0; g < NG; ++g) {
        const int dil = (g == 0) ? 1 : (g == 1 ? 4 : 16);
        const int vcol = (2 * NG + g) * DA + h * HD + lane;
        for (int jj = 0; jj <= 128; ++jj) {
            const int tk = t + (jj - 64) * dil;
            if (tk >= 0 && tk < S) o = fmaf(sc[g * 132 + jj], bf2f(P[(size_t)(rb + tk) * NIN + vcol]), o);
        }
    }
    o /= sum;
    const float ga = bf2f(prow[OFF_GA + h * HD + lane]);
    YA[(size_t)row * DA + h * HD + lane] = (bf16)f2bf(o * siluf_(ga));
    LDS_WAIT(); asm volatile("" ::: "memory");
}
typedef short bf16x8_t __attribute__((ext_vector_type(8)));
typedef float f32x16_t __attribute__((ext_vector_type(16)));
struct LCG {
    static constexpr int NI = 32 / CH, NCT = 64 / NI;
    static constexpr int PADZ = 64 * (NI - 1), ZSTRIDE = 4096 + 2 * PADZ + 32;
    static constexpr int GC_STRIDE = 16448, ZB_OFF = 4 * GC_STRIDE, LDS_END = ZB_OFF + CH * ZSTRIDE * 2;
};
static_assert(LCG::NCT <= NWAVES && (LCG::ZSTRIDE / 8) % 16 == 4 && LCG::ZSTRIDE % 8 == 0 && LCG::LDS_END <= RING_BYTES, "long-conv LDS map");
constexpr int UT_ROWS = 4 * DHY;
__device__ __forceinline__ int zsw(int e) { const int c = e >> 3; return (((c ^ ((c >> 3) & 7)) << 3) | (e & 7)) * 2; }

__device__ __forceinline__ void lc_stage_R(LAS unsigned char* lds, const bf16* Rg, int tid) {
#pragma unroll
    for (int it = 0; it < 2; ++it) {
        const int k = tid + it * NTHREADS;
        const v4u cur = *(const v4u*)(Rg + 8 * k);
        v4u prv = (v4u){0u, 0u, 0u, 0u}; if (k > 0) prv = *(const v4u*)(Rg + 8 * k - 8);
        *(LAS v4u*)(lds + 0 * LCG::GC_STRIDE + 16 * k) = cur;
        v4u s1; s1.x = __builtin_amdgcn_alignbit(cur.x, prv.w, 16); s1.y = __builtin_amdgcn_alignbit(cur.y, cur.x, 16); s1.z = __builtin_amdgcn_alignbit(cur.z, cur.y, 16); s1.w = __builtin_amdgcn_alignbit(cur.w, cur.z, 16);
        *(LAS v4u*)(lds + 1 * LCG::GC_STRIDE + 16 * k) = s1;
        v4u s2; s2.x = prv.w; s2.y = cur.x; s2.z = cur.y; s2.w = cur.z;
        *(LAS v4u*)(lds + 2 * LCG::GC_STRIDE + 16 * k) = s2;
        v4u s3; s3.x = __builtin_amdgcn_alignbit(prv.w, prv.z, 16); s3.y = __builtin_amdgcn_alignbit(cur.x, prv.w, 16); s3.z = __builtin_amdgcn_alignbit(cur.y, cur.x, 16); s3.w = __builtin_amdgcn_alignbit(cur.z, cur.y, 16);
        *(LAS v4u*)(lds + 3 * LCG::GC_STRIDE + 16 * k) = s3;
    }
}
__device__ __forceinline__ bf16x8_t lc_ldA(LAS unsigned char* lds, int baseA, int d) {
    const v2u a0 = *(const LAS v2u*)(lds + baseA - 32 * d), a1 = *(const LAS v2u*)(lds + baseA - 32 * d + 8);
    return __builtin_bit_cast(bf16x8_t, (v4u){a0.x, a0.y, a1.x, a1.y});
}
__device__ __forceinline__ bf16x8_t lc_ldB(LAS unsigned char* lds, int rowB, int cB, int d) {
    const int c = cB - 2 * d;
    return __builtin_bit_cast(bf16x8_t, *(const LAS v4u*)(lds + rowB + ((c ^ ((c >> 3) & 7)) << 4)));
}
__device__ __forceinline__ void lc_mma(LAS unsigned char* lds, f32x16_t& acc1, f32x16_t& acc2, int wave, int lane) {
    const int r = lane & 31, h = lane >> 5, kap = (r + 1) & 3, b = r / LCG::NI, ii = r % LCG::NI;
    const int baseA = kap * LCG::GC_STRIDE + 2 * (4095 - r + 8 * h + kap);
    const int i0 = LCG::NI * wave;
    const int rowB = LCG::ZB_OFF + b * LCG::ZSTRIDE * 2, cB = (LCG::PADZ + 64 * (i0 + ii) + 8 * h) >> 3;
    const int dlo = 4 * i0 - 255, dhi = 4 * i0 + 4 * (LCG::NI - 1);
    acc1 = (f32x16_t){0.f, 0.f, 0.f, 0.f, 0.f, 0.f, 0.f, 0.f, 0.f, 0.f, 0.f, 0.f, 0.f, 0.f, 0.f, 0.f}; acc2 = acc1;
    bf16x8_t Ae = lc_ldA(lds, baseA, dlo), Ao = lc_ldA(lds, baseA, dlo + 1);
    for (int d = dlo; d <= dhi; d += 2) {
        const bf16x8_t An = lc_ldA(lds, baseA, d + 2), B0 = lc_ldB(lds, rowB, cB, d);
        const bf16x8_t Am = lc_ldA(lds, baseA, d + 3), B1 = lc_ldB(lds, rowB, cB, d + 1);
        acc1 = __builtin_amdgcn_mfma_f32_32x32x16_bf16(Ae, B0, acc1, 0, 0, 0);
        acc2 = __builtin_amdgcn_mfma_f32_32x32x16_bf16(An, B0, acc2, 0, 0, 0);
        acc1 = __builtin_amdgcn_mfma_f32_32x32x16_bf16(Ao, B1, acc1, 0, 0, 0);
        acc2 = __builtin_amdgcn_mfma_f32_32x32x16_bf16(Am, B1, acc2, 0, 0, 0);
        Ae = An; Ao = Am;
    }
}
__device__ __forceinline__ void longconv_mfma_unit(LAS unsigned char* lds, const bf16* UT, const bf16* Rl, const float* fb, bf16* YHT, int c, int tid_) {
    const int tid = tid_, lane = tid & 63, wave = __builtin_amdgcn_readfirstlane(tid >> 6);
    const int r = lane & 31, h = lane >> 5, b = r / LCG::NI, ii = r % LCG::NI;
    const bool active = wave < LCG::NCT;
    for (int k = tid; k < CH * 512; k += NTHREADS) { const int bb = k >> 9, s8 = (k & 511) * 8;
        *(LAS v4u*)(lds + LCG::ZB_OFF + bb * LCG::ZSTRIDE * 2 + zsw(LCG::PADZ + s8)) = *(const v4u*)(UT + (size_t)c * MC + bb * S + s8); }
    for (int k = tid; k < CH * 2 * (LCG::PADZ / 8); k += NTHREADS) { const int bb = k / (2 * (LCG::PADZ / 8)), q = k % (2 * (LCG::PADZ / 8));
        const int e = (q < LCG::PADZ / 8) ? q * 8 : LCG::PADZ + 4096 + (q - LCG::PADZ / 8) * 8;
        *(LAS v4u*)(lds + LCG::ZB_OFF + bb * LCG::ZSTRIDE * 2 + zsw(e)) = (v4u){0u, 0u, 0u, 0u}; }
    lc_stage_R(lds, Rl + (size_t)(0 * DHY + c) * 8192, tid);
    __syncthreads();
    f32x16_t acc1, acc2;
    const int i = LCG::NI * wave + ii;
    if (active) lc_mma(lds, acc1, acc2, wave, lane);
    v2u zn[2][4];
    if (active) { const float bias0 = fb[c];
#pragma unroll
      for (int hf = 0; hf < 2; ++hf)
#pragma unroll
        for (int q = 0; q < 4; ++q) { const int t = 64 * i + 32 * hf + 8 * q + 4 * h; const f32x16_t& ac = hf ? acc2 : acc1;
            const v2u zo = *(const LAS v2u*)(lds + LCG::ZB_OFF + b * LCG::ZSTRIDE * 2 + zsw(LCG::PADZ + t));
            const v2u x1 = *(const v2u*)(UT + (size_t)(DHY + c) * MC + b * S + t);
            const float y0 = blo(x1.x) * (ac[4 * q + 0] + bias0 * blo(zo.x)), y1 = bhi(x1.x) * (ac[4 * q + 1] + bias0 * bhi(zo.x));
            const float y2 = blo(x1.y) * (ac[4 * q + 2] + bias0 * blo(zo.y)), y3 = bhi(x1.y) * (ac[4 * q + 3] + bias0 * bhi(zo.y));
            zn[hf][q].x = pk2(y0, y1); zn[hf][q].y = pk2(y2, y3); } }
    __syncthreads();
    if (active) {
#pragma unroll
      for (int hf = 0; hf < 2; ++hf)
#pragma unroll
        for (int q = 0; q < 4; ++q) *(LAS v2u*)(lds + LCG::ZB_OFF + b * LCG::ZSTRIDE * 2 + zsw(LCG::PADZ + 64 * i + 32 * hf + 8 * q + 4 * h)) = zn[hf][q]; }
    lc_stage_R(lds, Rl + (size_t)(1 * DHY + c) * 8192, tid);
    __syncthreads();
    if (active) { lc_mma(lds, acc1, acc2, wave, lane);
      const float bias1 = fb[DHY + c];
#pragma unroll
      for (int hf = 0; hf < 2; ++hf)
#pragma unroll
        for (int q = 0; q < 4; ++q) { const int t = 64 * i + 32 * hf + 8 * q + 4 * h; const f32x16_t& ac = hf ? acc2 : acc1;
            const v2u zo = *(const LAS v2u*)(lds + LCG::ZB_OFF + b * LCG::ZSTRIDE * 2 + zsw(LCG::PADZ + t));
            const v2u x2 = *(const v2u*)(UT + (size_t)(2 * DHY + c) * MC + b * S + t);
            const v2u sg = *(const v2u*)(UT + (size_t)(3 * DHY + c) * MC + b * S + t);
            const float y0 = blo(sg.x) * blo(x2.x) * (ac[4 * q + 0] + bias1 * blo(zo.x)), y1 = bhi(sg.x) * bhi(x2.x) * (ac[4 * q + 1] + bias1 * bhi(zo.x));
            const float y2 = blo(sg.y) * blo(x2.y) * (ac[4 * q + 2] + bias1 * blo(zo.y)), y3 = bhi(sg.y) * bhi(x2.y) * (ac[4 * q + 3] + bias1 * bhi(zo.y));
            v2u o; o.x = pk2(y0, y1); o.y = pk2(y2, y3);
            *(v2u*)(YHT + (size_t)c * MC + b * S + t) = o; } }
    __syncthreads();
}
__device__ __forceinline__ void hyena_prep_tile(unsigned char* lds, const bf16* P, const float* cw, const float* cb, bf16* UT, int tile, int tid) {
    constexpr int TS = 72;
    const int tr = tile / (UT_ROWS / 64), tc = tile % (UT_ROWS / 64), row0 = tr * 64, c0 = tc * 64;
    bf16* T = (bf16*)lds;
    { const int rr = tid >> 3, seg = tid & 7, row = row0 + rr, t = row % S, cc = c0 + 8 * seg;
      float o[8];
      if (c0 < 3 * DHY) {
          const v4u w0 = *(const v4u*)(P + (size_t)row * NIN + OFF_HY + cc);
          v4u wm = (v4u){0u, 0u, 0u, 0u}, wp = (v4u){0u, 0u, 0u, 0u};
          if (t > 0) wm = *(const v4u*)(P + (size_t)(row - 1) * NIN + OFF_HY + cc);
          if (t < S - 1) wp = *(const v4u*)(P + (size_t)(row + 1) * NIN + OFF_HY + cc);
          const unsigned am[4] = {wm.x, wm.y, wm.z, wm.w}, a0[4] = {w0.x, w0.y, w0.z, w0.w}, ap[4] = {wp.x, wp.y, wp.z, wp.w};
#pragma unroll
          for (int j = 0; j < 4; ++j) { const int c = cc + 2 * j;
              o[2 * j] = cw[c] * blo(am[j]) + cw[3 * DHY + c] * blo(a0[j]) + cw[6 * DHY + c] * blo(ap[j]) + cb[c];
              o[2 * j + 1] = cw[c + 1] * bhi(am[j]) + cw[3 * DHY + c + 1] * bhi(a0[j]) + cw[6 * DHY + c + 1] * bhi(ap[j]) + cb[c + 1]; }
      } else {
          const v4u w0 = *(const v4u*)(P + (size_t)row * NIN + OFF_GH + (cc - 3 * DHY));
          const unsigned a0[4] = {w0.x, w0.y, w0.z, w0.w};
#pragma unroll
          for (int j = 0; j < 4; ++j) { o[2 * j] = siluf_(blo(a0[j])); o[2 * j + 1] = siluf_(bhi(a0[j])); }
      }
#pragma unroll
      for (int j = 0; j < 8; ++j) T[(8 * seg + j) * TS + rr] = (bf16)f2bf(o[j]); }
    __syncthreads();
    { const int chn = tid >> 3, sg = tid & 7;
      *(v4u*)(UT + (size_t)(c0 + chn) * MC + row0 + 8 * sg) = *(const v4u*)(T + chn * TS + 8 * sg); }
    __syncthreads();
}
__device__ __forceinline__ void hyena_post_tile(unsigned char* lds, const bf16* YHT, bf16* YH, int tile, int tid) {
    constexpr int TS = 72;
    const int tr = tile / (DHY / 64), tc = tile % (DHY / 64), row0 = tr * 64, c0 = tc * 64;
    bf16* T = (bf16*)lds;
    { const int chn = tid >> 3, sg = tid & 7;
      const v4u w = *(const v4u*)(YHT + (size_t)(c0 + chn) * MC + row0 + 8 * sg);
      const unsigned a[4] = {w.x, w.y, w.z, w.w};
#pragma unroll
      for (int j = 0; j < 4; ++j) { T[(8 * sg + 2 * j) * TS + chn] = (bf16)(a[j] & 0xffffu); T[(8 * sg + 2 * j + 1) * TS + chn] = (bf16)(a[j] >> 16); } }
    __syncthreads();
    { const int rr = tid >> 3, seg = tid & 7;
      *(v4u*)(YH + (size_t)(row0 + rr) * DHY + c0 + 8 * seg) = *(const v4u*)(T + rr * TS + 8 * seg); }
    __syncthreads();
}
typedef short v4i16_t __attribute__((ext_vector_type(4)));
constexpr int AT_ROWB = 128;
__device__ __forceinline__ void attn_mfma_unit(const bf16* P, bf16* OG, float* ML, LAS unsigned char* vs, int unit, int lane_) {
    int lane = lane_; asm volatile("" : "+v"(lane));
    int u = unit; const int x = u & 127; u >>= 7; const int hh = u & 7; u >>= 3; const int g = u % 3, bl = u / 3;
    const int dsh = 2 * g, d = 1 << dsh, L = S >> dsh, nqb = L >> 5, r = x / nqb, qb = x % nqb;
    const size_t rowb = (size_t)bl * S;
    const float slope = exp2f(-(float)(hh + 1)) * (float)d;
    const int qcol = (0 * NG + g) * DA + hh * HD, kcol = (1 * NG + g) * DA + hh * HD, vcol = (2 * NG + g) * DA + hh * HD;
    const int n = lane & 31, h2 = lane >> 5;
    const int tq = ((32 * qb + n) << dsh) + r;
    bf16x8_t qf[4];
#pragma unroll
    for (int ks = 0; ks < 4; ++ks) qf[ks] = __builtin_bit_cast(bf16x8_t, *(const v4u*)(P + (rowb + tq) * NIN + qcol + 16 * ks + 8 * h2));
    f32x16_t st[5];
#pragma unroll
    for (int kt = 0; kt < 5; ++kt) {
        int ik = 32 * (qb - 2 + kt) + n; ik = ik < 0 ? 0 : (ik > L - 1 ? L - 1 : ik);
        const bf16* kp = P + (rowb + (size_t)((ik << dsh) + r)) * NIN + kcol + 8 * h2;
        f32x16_t acc = (f32x16_t){0.f, 0.f, 0.f, 0.f, 0.f, 0.f, 0.f, 0.f, 0.f, 0.f, 0.f, 0.f, 0.f, 0.f, 0.f, 0.f};
#pragma unroll
        for (int ks = 0; ks < 4; ++ks) acc = __builtin_amdgcn_mfma_f32_32x32x16_bf16(__builtin_bit_cast(bf16x8_t, *(const v4u*)(kp + 16 * ks)), qf[ks], acc, 0, 0, 0);
        st[kt] = acc;
        asm volatile("" ::: "memory");
    }
    float mx = -INFINITY;
#pragma unroll
    for (int kt = 0; kt < 5; ++kt)
#pragma unroll
        for (int rg = 0; rg < 16; ++rg) {
            const int rho = (rg & 3) + 8 * (rg >> 2) + 4 * h2, rel = 32 * (kt - 2) + rho - n, ikey = 32 * (qb - 2 + kt) + rho;
            const int arel = rel < 0 ? -rel : rel;
            const bool valid = (arel <= 64) && (ikey >= 0) && (ikey < L);
            const float s = valid ? st[kt][rg] * 0.125f - slope * (float)arel : -INFINITY;
            st[kt][rg] = s; mx = fmaxf(mx, s);
        }
    mx = fmaxf(mx, __shfl_xor(mx, 32));
    float ls = 0.f;
#pragma unroll
    for (int kt = 0; kt < 5; ++kt)
#pragma unroll
        for (int rg = 0; rg < 16; ++rg) { const float p = __expf(st[kt][rg] - mx); st[kt][rg] = p; ls += p; }
    ls += __shfl_xor(ls, 32);
    f32x16_t o0 = (f32x16_t){0.f, 0.f, 0.f, 0.f, 0.f, 0.f, 0.f, 0.f, 0.f, 0.f, 0.f, 0.f, 0.f, 0.f, 0.f, 0.f}, o1 = o0;
    const int trow = (lane & 15) >> 2, tcolb = (16 * ((lane >> 4) & 1) + 4 * (lane & 3)) * 2;
#pragma unroll
    for (int kt = 0; kt < 5; ++kt) {
        { int ik = 32 * (qb - 2 + kt) + (lane >> 1); ik = ik < 0 ? 0 : (ik > L - 1 ? L - 1 : ik);
          const bf16* vp = P + (rowb + (size_t)((ik << dsh) + r)) * NIN + vcol + 32 * (lane & 1);
          const v4u w0 = *(const v4u*)(vp), w1 = *(const v4u*)(vp + 8), w2 = *(const v4u*)(vp + 16), w3 = *(const v4u*)(vp + 24);
          LAS unsigned char* wp = vs + (lane >> 1) * AT_ROWB + 64 * (lane & 1);
          *(LAS v4u*)(wp) = w0; *(LAS v4u*)(wp + 16) = w1; *(LAS v4u*)(wp + 32) = w2; *(LAS v4u*)(wp + 48) = w3; }
        LDS_WAIT(); asm volatile("" ::: "memory");
#pragma unroll
        for (int s = 0; s < 2; ++s) {
            v4u pa; pa.x = pk2(st[kt][8 * s + 0], st[kt][8 * s + 1]); pa.y = pk2(st[kt][8 * s + 2], st[kt][8 * s + 3]); pa.z = pk2(st[kt][8 * s + 4], st[kt][8 * s + 5]); pa.w = pk2(st[kt][8 * s + 6], st[kt][8 * s + 7]);
            const bf16x8_t A = __builtin_bit_cast(bf16x8_t, pa);
            LAS unsigned char* tp = vs + (16 * s + 4 * h2 + trow) * AT_ROWB + tcolb;
#pragma unroll
            for (int eh = 0; eh < 2; ++eh) {
                const v4i16_t lo = __builtin_amdgcn_ds_read_tr16_b64_v4i16((LAS v4i16_t*)(tp + 64 * eh));
                const v4i16_t hi = __builtin_amdgcn_ds_read_tr16_b64_v4i16((LAS v4i16_t*)(tp + 64 * eh + 8 * AT_ROWB));
                const bf16x8_t B = (bf16x8_t){lo[0], lo[1], lo[2], lo[3], hi[0], hi[1], hi[2], hi[3]};
                if (eh == 0) o0 = __builtin_amdgcn_mfma_f32_32x32x16_bf16(A, B, o0, 0, 0, 0); else o1 = __builtin_amdgcn_mfma_f32_32x32x16_bf16(A, B, o1, 0, 0, 0);
            }
        }
        LDS_WAIT(); asm volatile("" ::: "memory");
    }
    bf16* og = OG + ((size_t)g * MC + rowb) * DA + hh * HD + n;
#pragma unroll
    for (int rg = 0; rg < 16; ++rg) { const int mq = (rg & 3) + 8 * (rg >> 2) + 4 * h2; const size_t tok = (size_t)(((32 * qb + mq) << dsh) + r);
        og[tok * DA] = (bf16)f2bf(o0[rg]); og[tok * DA + 32] = (bf16)f2bf(o1[rg]); }
    if (h2 == 0) { float* mp = ML + (((size_t)g * MC + rowb + tq) * NH + hh) * 2; mp[0] = mx; mp[1] = ls; }
}
__device__ __forceinline__ void attn_combine(const bf16* P, const bf16* OG, const float* ML, bf16* YA, int G, int tid) {
    for (int idx = blockIdx.x * NTHREADS + tid; idx < MC * (DA / 2); idx += G * NTHREADS) {
        const int row = idx / (DA / 2), col = (idx % (DA / 2)) * 2, hh = col >> 6;
        float m[3], l[3];
#pragma unroll
        for (int g = 0; g < 3; ++g) { const float* mp = ML + (((size_t)g * MC + row) * NH + hh) * 2; m[g] = mp[0]; l[g] = mp[1]; }
        const float M = fmaxf(m[0], fmaxf(m[1], m[2]));
        float a0 = 0.f, a1 = 0.f, den = 0.f;
#pragma unroll
        for (int g = 0; g < 3; ++g) { const float w = __expf(m[g] - M); const unsigned ow = *(const unsigned*)(OG + ((size_t)g * MC + row) * DA + col);
            a0 = fmaf(w, blo(ow), a0); a1 = fmaf(w, bhi(ow), a1); den = fmaf(w, l[g], den); }
        const unsigned gw_ = *(const unsigned*)(P + (size_t)row * NIN + OFF_GA + col);
        const float inv = 1.f / den;
        *(unsigned*)(YA + (size_t)row * DA + col) = pk2(a0 * inv * siluf_(blo(gw_)), a1 * inv * siluf_(bhi(gw_)));
    }
}
#if MK_CHECK
__device__ __forceinline__ void longconv_check_item(const bf16* Zrow  , const bf16* Rrow  , const bf16* Xrow, const bf16* SGrow, float bias, bf16* Orow, int b, int tb, int lane) {
    const int t = tb * 64 + lane;
    const bf16* z = Zrow + (size_t)b * S; const bf16* g = Rrow + 4095 - t;
    float y = 0.f;
    for (int s0 = 0; s0 < S; s0 += 8) {
#pragma unroll
        for (int j = 0; j < 8; ++j) y = fmaf(bf2f(g[s0 + j]), bf2f(z[s0 + j]), y);
    }
    float v = bf2f(Xrow[(size_t)b * S + t]) * (y + bias * bf2f(z[t]));
    if (SGrow) v *= bf2f(SGrow[(size_t)b * S + t]);
    Orow[(size_t)b * S + t] = (bf16)f2bf(v);
}
#endif
#define XB_TMO      128
#define XB_XCNT(j)  (256  + 64 * (j))
#define XB_XSUB(j)  (1280 + 64 * (j))
#define XB_XGEN(j)  (2304 + 64 * (j))
#define XB_TOP      3328
#define XB_TOPGEN   3392
#define XCD_BAR_WORDS 3456
#define XB_SPIN_CAP (1u << 18)

__device__ __forceinline__ unsigned xb_ld(unsigned* p)              { return __hip_atomic_load(p, __ATOMIC_RELAXED, __HIP_MEMORY_SCOPE_AGENT); }
__device__ __forceinline__ unsigned xb_add(unsigned* p, unsigned v) { return __hip_atomic_fetch_add(p, v, __ATOMIC_RELAXED, __HIP_MEMORY_SCOPE_AGENT); }
__device__ __forceinline__ unsigned xb_xcc_id() { return (unsigned)__builtin_amdgcn_s_getreg((3 << 11) | 20) & 0xFu; }
#define XB_SPIN(cond, bar) do { unsigned _sp = 0; while (cond) { __builtin_amdgcn_s_sleep(1); \
    if ((++_sp & 255u) == 0u) { if (xb_ld(&(bar)[XB_TMO])) break; if (_sp > XB_SPIN_CAP) { atomicAdd(&(bar)[XB_TMO], 1u); break; } } } } while (0)

struct XcdBarrier {
    unsigned* bar; unsigned x;
    volatile LAS unsigned* st;
};

__device__ __forceinline__ XcdBarrier xcd_barrier_post(unsigned* bar, volatile LAS unsigned* st) {
    XcdBarrier b; b.bar = bar; b.x = xb_xcc_id(); b.st = st;
    if (threadIdx.x == 0) (void)xb_add(&bar[XB_XCNT(b.x)], 1u);
    return b;
}
__device__ __forceinline__ void xcd_barrier_complete(unsigned* bar, unsigned x, unsigned& nloc, unsigned& nx) {
    const unsigned G = gridDim.x * gridDim.y * gridDim.z;
    unsigned sum, cnt, mine, sp = 0u;
    for (;;) {
        sum = 0u; cnt = 0u; mine = 0u;
#pragma unroll
        for (unsigned j = 0; j < 16; ++j) { const unsigned c = xb_ld(&bar[XB_XCNT(j)]); sum += c; cnt += (c > 0u) ? 1u : 0u; mine = (j == x) ? c : mine; }
        if (sum == G) break;
        __builtin_amdgcn_s_sleep(1);
        if ((++sp & 255u) == 0u) { if (xb_ld(&bar[XB_TMO])) break; if (sp > XB_SPIN_CAP) { atomicAdd(&bar[XB_TMO], 1u); break; } }
    }
    nloc = mine > 0u ? mine : 1u; nx = cnt > 0u ? cnt : 1u;
}

__device__ __forceinline__ void xcd_barrier(const XcdBarrier& b) {
    asm volatile("s_waitcnt vmcnt(0)" ::: "memory");
    __syncthreads();
    if (threadIdx.x == 0) {
        unsigned* bar = b.bar;
        __builtin_amdgcn_s_waitcnt(0);
        unsigned nloc = b.st[0], nx = b.st[1];
        if (nloc == 0u) { xcd_barrier_complete(bar, b.x, nloc, nx); b.st[0] = nloc; b.st[1] = nx; }
        const unsigned old = xb_add(&bar[XB_XSUB(b.x)], 1u);
        const unsigned gen = old / nloc;
        if (old + 1u == (gen + 1u) * nloc) {
            __builtin_amdgcn_fence(__ATOMIC_RELEASE, "agent");
            asm volatile("s_waitcnt vmcnt(0)" ::: "memory");
            const unsigned og = xb_add(&bar[XB_TOP], 1u);
            const unsigned tg = og / nx;
            if (og + 1u == (tg + 1u) * nx) xb_add(&bar[XB_TOPGEN], 1u);
            else XB_SPIN(xb_ld(&bar[XB_TOPGEN]) == tg, bar);
            __builtin_amdgcn_fence(__ATOMIC_ACQUIRE, "agent");
            xb_add(&bar[XB_XGEN(b.x)], 1u);
            asm volatile("s_waitcnt vmcnt(0)" ::: "memory");
        } else {
            XB_SPIN(xb_ld(&bar[XB_XGEN(b.x)]) == gen, bar);
            __builtin_amdgcn_fence(__ATOMIC_ACQUIRE, "agent");
            asm volatile("s_waitcnt vmcnt(0)" ::: "memory");
        }
    }
    __syncthreads();
}

#define XBAR() do { xcd_barrier(xbar); if (MK_REP == 10) xcd_barrier(xbar); } while (0)
struct Args { const float* in[23]; float* out; unsigned char* ws; int pad0, pad1; };
#ifndef PG8_SP2
#define PG8_SP2 true
#endif
#ifndef PG8_ALIGN
#define PG8_ALIGN true
#endif

__global__ void __launch_bounds__(NTHREADS, 2) mk_fwd(Args args) {
    extern __shared__ __attribute__((aligned(16))) unsigned char lds[];
    cg::grid_group grid = cg::this_grid();
    Ctx C; C.lds = lds; C.tid = threadIdx.x; C.lane = C.tid & 63; C.wave = __builtin_amdgcn_readfirstlane(C.tid >> 6);
    C.G = gridDim.x; C.gw = blockIdx.x * NWAVES + C.wave; C.NGW = C.G * NWAVES;
    unsigned char* ws = args.ws;
    const float* const* in = args.in;
    float* out = args.out;
    bf16* Hb = (bf16*)(ws + WS_H); bf16* Pb = (bf16*)(ws + WS_P); bf16* UT = (bf16*)(ws + WS_UT); bf16* YHT = (bf16*)(ws + WS_YHT);
    bf16* YA = (bf16*)(ws + WS_YA); bf16* YH = (bf16*)(ws + WS_YH); bf16* MG = Hb;
    const float* MOD = (const float*)(ws + WS_MOD); const bf16* Rg = (const bf16*)(ws + WS_R);
    float* ERR = (float*)ws;
    PG8_LAS unsigned char* ldsl = (PG8_LAS unsigned char*)lds;
    volatile LAS unsigned* MISC = (volatile LAS unsigned*)(ldsl + LDS_BYTES - 64);
    if (threadIdx.x < 16) MISC[threadIdx.x] = 0u;
    __syncthreads();
    XcdBarrier xbar = xcd_barrier_post((unsigned*)ws + 4096, MISC);

    p0_prologue_a(C, in, ws);
    grid.sync();
    p0_prologue_b(C, in, ws);
    XBAR();

    int pend_l = -1, pend_ch = 0;
    for (int l = 0; l < DEPTH; ++l) {
        const float* xin = (l == 0) ? in[0] : out;
        for (int ch = 0; ch < NCHUNK; ++ch) {
            const float* xc = xin + (size_t)ch * MC * D; float* oc = out + (size_t)ch * MC * D;
            { int ln_ = threadIdx.x & 63; asm volatile("" : "+v"(ln_));
            if (pend_l >= 0) { float* pr = out + (size_t)pend_ch * MC * D;
                for (int m = C.gw; m < MC; m += C.NGW) ln_final_row(pr + (size_t)m * D, in[21] + (size_t)pend_l * D, in[22] + (size_t)pend_l * D, ln_); }
            for (int rp_ = 0; rp_ < REPS(9); ++rp_) for (int m = C.gw; m < MC; m += C.NGW) ln_mod_row(xc + (size_t)m * D, MOD + ((size_t)l * NB + ch * CH + m / S) * 3 * D, Hb + (size_t)m * D, ln_); }
            XBAR();
            for (int rp_ = 0; rp_ < REPS(2); ++rp_) { pg8::Gemm g{Hb, (const bf16*)(ws + WS_WIN) + (size_t)l * NIN * D, MC, NIN, D}; pg8::StaticOrder So; So.init(MC, NIN, C.G, (int)blockIdx.x);
              pg8::EpiBf16<0> E{Pb, NIN, in[5] + (size_t)l * NIN, 0, 0, 1.f};
              pg8::gemm_phase<pg8::EpiBf16<0>, pg8::StaticOrder, PG8_ALIGN, PG8_SP2>(ldsl, g, So, E); }
            XBAR();
            if (PHM & 4) { float* sw = (float*)(lds + C.wave * 2560); int ln_ = threadIdx.x & 63; asm volatile("" : "+v"(ln_));
              if (MK_CHECK == 2) { for (int it = C.gw; it < MC * NH; it += C.NGW) attn_naive_item(Pb, (bf16*)(ws + WS_YAR), sw, it / NH, it % NH, ln_); __syncthreads(); }
              for (int rp_ = 0; rp_ < REPS(3); ++rp_) for (int it = C.gw; it < CH * 3 * 8 * 128; it += C.NGW) attn_mfma_unit(Pb, (bf16*)(ws + WS_OG), (float*)(ws + WS_ML), ldsl + C.wave * 4096, it, ln_);
              __syncthreads();
              int tid_ = threadIdx.x; asm volatile("" : "+v"(tid_));
              for (int rp_ = 0; rp_ < REPS(4); ++rp_) for (int tile = blockIdx.x; tile < (MC / 64) * (UT_ROWS / 64); tile += C.G) hyena_prep_tile(lds, Pb, in[6] + (size_t)l * 9 * DHY, in[7] + (size_t)l * 3 * DHY, UT, tile, tid_); }
            XBAR();
            if (PHM & 8) { int tid_ = threadIdx.x; asm volatile("" : "+v"(tid_));
              for (int rp_ = 0; rp_ < REPS(5); ++rp_) for (int c = blockIdx.x; c < DHY; c += C.G) longconv_mfma_unit(ldsl, UT, Rg + (size_t)l * 2 * DHY * 8192, in[16] + (size_t)l * 2 * DHY, YHT, c, tid_); }
#if MK_CHECK == 1
            { bf16* Z1T = (bf16*)(ws + WS_Z1T); bf16* YHTR = (bf16*)(ws + WS_YHTR); int ln_ = threadIdx.x & 63; asm volatile("" : "+v"(ln_));
              for (int it = C.gw; it < DHY * CH * 64; it += C.NGW) { const int c = it / (CH * 64), b = (it / 64) % CH, tb = it % 64;
                  longconv_check_item(UT + (size_t)c * MC, Rg + ((size_t)(l * 2 + 0) * DHY + c) * 8192, UT + (size_t)(DHY + c) * MC, nullptr, in[16][(size_t)l * 2 * DHY + c], Z1T + (size_t)c * MC, b, tb, ln_); }
              XBAR();
              for (int it = C.gw; it < DHY * CH * 64; it += C.NGW) { const int c = it / (CH * 64), b = (it / 64) % CH, tb = it % 64;
                  longconv_check_item(Z1T + (size_t)c * MC, Rg + ((size_t)(l * 2 + 1) * DHY + c) * 8192, UT + (size_t)(2 * DHY + c) * MC, UT + (size_t)(3 * DHY + c) * MC, in[16][(size_t)l * 2 * DHY + DHY + c], YHTR + (size_t)c * MC, b, tb, ln_); }
              XBAR();
              float e0 = 0.f, e1 = 0.f;
              { int tq_ = threadIdx.x; asm volatile("" : "+v"(tq_));
              for (int i = blockIdx.x * NTHREADS + tq_; i < DHY * MC; i += C.G * NTHREADS) { const float a = bf2f(YHT[i]), r = bf2f(YHTR[i]); e0 += (a - r) * (a - r); e1 += r * r; } }
              e0 = wave_sum(e0); e1 = wave_sum(e1);
              if (ln_ == 0) { atomicAdd(ERR + 0, e0); atomicAdd(ERR + 1, e1); }
              YHT = YHTR; }
#endif
            XBAR();
            if (PHM & 16) { int tid_ = threadIdx.x; asm volatile("" : "+v"(tid_));
              for (int rp_ = 0; rp_ < REPS(6); ++rp_) { for (int tile = blockIdx.x; tile < (MC / 64) * (DHY / 64); tile += C.G) hyena_post_tile(lds, YHT, YH, tile, tid_);
              attn_combine(Pb, (const bf16*)(ws + WS_OG), (const float*)(ws + WS_ML), YA, C.G, tid_); } }
#if MK_CHECK == 2
            XBAR();
            { const bf16* YAR = (const bf16*)(ws + WS_YAR); float e0 = 0.f, e1 = 0.f; int tq_ = threadIdx.x; asm volatile("" : "+v"(tq_));
              for (int i = blockIdx.x * NTHREADS + tq_; i < MC * DA; i += C.G * NTHREADS) { const float a = bf2f(YA[i]), r = bf2f(YAR[i]); e0 += (a - r) * (a - r); e1 += r * r; }
              e0 = wave_sum(e0); e1 = wave_sum(e1);
              if ((tq_ & 63) == 0) { atomicAdd(ERR + 0, e0); atomicAdd(ERR + 1, e1); } }
#endif
#if MK_CHECK == 1
            YHT = (bf16*)(ws + WS_YHT);
#endif
            XBAR();
            for (int rp_ = 0; rp_ < REPS(7); ++rp_) { pg8::StaticOrder So; So.init(MC, D, C.G, (int)blockIdx.x);
              { pg8::Gemm g{YA, (const bf16*)(ws + WS_WPA) + (size_t)l * D * DA, MC, D, DA}; pg8::EpiMerge<false> E{MG, D, Pb + OFF_RA, NIN};
                pg8::gemm_phase<pg8::EpiMerge<false>, pg8::StaticOrder, PG8_ALIGN, PG8_SP2>(ldsl, g, So, E); }
              { pg8::Gemm g{YH, (const bf16*)(ws + WS_WPH) + (size_t)l * D * DHY, MC, D, DHY}; pg8::EpiMerge<true> E{MG, D, Pb + OFF_RH, NIN};
                pg8::gemm_phase<pg8::EpiMerge<true>, pg8::StaticOrder, PG8_ALIGN, PG8_SP2>(ldsl, g, So, E); } }
            XBAR();
            for (int rp_ = 0; rp_ < ((l == 0) ? REPS(8) : 1); ++rp_) { pg8::Gemm g{MG, (const bf16*)(ws + WS_WOUT) + (size_t)l * D * D, MC, D, D}; pg8::StaticOrder So; So.init(MC, D, C.G, (int)blockIdx.x);
              pg8::EpiRes E{xc, oc, D, in[20] + (size_t)l * D, MOD + ((size_t)l * NB + ch * CH) * 3 * D + 2 * D, S / 256, 3 * D, DN_ALPHA};
              pg8::gemm_phase<pg8::EpiRes, pg8::StaticOrder, PG8_ALIGN, PG8_SP2>(ldsl, g, So, E); }
            XBAR();
            pend_l = l; pend_ch = ch;
        }
    }
    { float* pr = out + (size_t)pend_ch * MC * D;
      for (int m = C.gw; m < MC; m += C.NGW) ln_final_row(pr + (size_t)m * D, in[21] + (size_t)pend_l * D, in[22] + (size_t)pend_l * D, C.lane); }
#if MK_CHECK
    XBAR();
    { const float e0 = __hip_atomic_load(ERR + 0, __ATOMIC_RELAXED, __HIP_MEMORY_SCOPE_AGENT), e1 = __hip_atomic_load(ERR + 1, __ATOMIC_RELAXED, __HIP_MEMORY_SCOPE_AGENT);
      const float f = 1.f + CHECK_K * sqrtf(e0 / fmaxf(e1, 1e-30f));
      int tq_ = threadIdx.x; asm volatile("" : "+v"(tq_));
      for (int i = blockIdx.x * NTHREADS + tq_; i < NB * S * D; i += C.G * NTHREADS) out[i] *= f; }
#endif
}

extern "C" void kernel_launch(void* const* d_in, const int* in_sizes, int n_in, void* d_out, int out_size, void* d_ws, size_t ws_size, hipStream_t stream) {
    static int grid = 0;
    if (grid == 0) {
        if (n_in != 23 || out_size != NB * S * D || ws_size < WS_END) { fprintf(stderr, "kernel_launch: unexpected shapes (n_in %d, out %d, ws %zu, need %zu); nothing launched\n", n_in, out_size, ws_size, (size_t)WS_END); grid = -1; return; }
        int dev = 0, cus = 0, per_cu = 0;
        if (hipGetDevice(&dev) != hipSuccess || hipDeviceGetAttribute(&cus, hipDeviceAttributeMultiprocessorCount, dev) != hipSuccess) { fprintf(stderr, "kernel_launch: device query failed\n"); grid = -1; return; }
        if (hipFuncSetAttribute((const void*)mk_fwd, hipFuncAttributeMaxDynamicSharedMemorySize, LDS_BYTES) != hipSuccess) { fprintf(stderr, "kernel_launch: hipFuncSetAttribute failed\n"); grid = -1; return; }
        if (hipOccupancyMaxActiveBlocksPerMultiprocessor(&per_cu, (const void*)mk_fwd, NTHREADS, LDS_BYTES) != hipSuccess || per_cu < 1) { fprintf(stderr, "kernel_launch: occupancy query says %d blocks per CU\n", per_cu); grid = -1; return; }
        grid = cus;
        fprintf(stderr, "kernel_launch: grid %d (cus %d, per_cu %d), ws %zu MiB\n", grid, cus, per_cu, ws_size >> 20);
    }
    if (grid < 0) return;
    if (hipMemsetAsync(d_ws, 0, 1 << 20, stream) != hipSuccess) { fprintf(stderr, "kernel_launch: memset of control words failed\n"); return; }
    Args a{};
    for (int i = 0; i < 23; ++i) a.in[i] = (const float*)d_in[i];
    a.out = (float*)d_out; a.ws = (unsigned char*)d_ws;
    void* kargs[] = {&a};
    const hipError_t e = hipLaunchCooperativeKernel((const void*)mk_fwd, dim3(grid), dim3(NTHREADS), kargs, LDS_BYTES, stream);
    if (e != hipSuccess) fprintf(stderr, "kernel_launch: cooperative launch failed: %s (grid %d)\n", hipGetErrorString(e), grid);
}
```

```cpp
#include <hip/hip_runtime.h>
#include <hip/hip_cooperative_groups.h>
#include <cstdio>
#include <cstdint>
#include <cmath>
namespace cg = cooperative_groups;
namespace pg8 {
#define PG8_LAS __attribute__((address_space(3)))
typedef unsigned short bf16_t;
typedef short bf16x8 __attribute__((ext_vector_type(8)));
typedef float f32x4 __attribute__((ext_vector_type(4)));
typedef unsigned u32x4 __attribute__((ext_vector_type(4)));
constexpr int BM = 256, BK = 64, HALF = 128, HTB = HALF * BK * 2  , STAGE_BYTES = 8 * HTB, NXCD = 8, WGM = 8;

__host__ __device__ __forceinline__ int lds_byte(int r, int c) { const int st = (r >> 4) * 2 + (c >> 5), rr = r & 15, cc = c & 31, ob = rr * 64 + cc * 2; return st * 1024 + (ob ^ (((ob >> 9) & 1) << 5)); }
__host__ __device__ __forceinline__ void stage_rc(int b, int& R, int& C) { const int st = b / 1024, sb = b % 1024, swz = sb ^ (((sb >> 9) & 1) << 5); R = (st >> 1) * 16 + swz / 64; C = (st & 1) * 32 + (swz % 64) / 2; }
__host__ __device__ __forceinline__ int perm32(int rho) { const int n = rho >> 4, i = rho & 15; return 8 * (i >> 2) + 4 * n + (i & 3); }

struct Unit { int pm, pn; };
struct Gemm { const bf16_t* A; const bf16_t* Bt; int M, N, K; };

struct StaticOrder {
    int nM, nN, nwg, G, c;
    __host__ __device__ void init(int M, int N, int G_, int c_) { nM = M / BM; nN = N / BM; nwg = nM * nN; G = G_; c = c_; }
    __host__ __device__ bool next(int i, Unit& u) const {
        const long L = (long)i * G + c; if (L >= nwg) return false;
        int wgid = (int)L; { const int q = nwg / NXCD, r = nwg % NXCD, xcd = wgid % NXCD, off = wgid / NXCD; wgid = (xcd < r ? xcd * (q + 1) : r * (q + 1) + (xcd - r) * q) + off; }
        const int nig = WGM * nN, gid = wgid / nig, fm = gid * WGM, gsz = (nM - fm) < WGM ? (nM - fm) : WGM;
        u.pm = fm + ((wgid % nig) % gsz); u.pn = (wgid % nig) / gsz; return true;
    }
    __device__ __forceinline__ void a_ready(const Unit&) const {}
    __device__ __forceinline__ void done(const Unit&) const {}
};

__device__ __forceinline__ unsigned cvt_pk_bf16(float lo, float hi) { unsigned r; asm volatile("v_cvt_pk_bf16_f32 %0, %1, %2" : "=v"(r) : "v"(lo), "v"(hi)); return r; }
typedef float f32x2 __attribute__((ext_vector_type(2)));
__device__ __forceinline__ f32x2 gelu_pk(f32x2 v) {
    const f32x2 av = __builtin_elementwise_abs(v), d = av * 0.2316418882f + 1.0f;
    f32x2 t; t.x = __builtin_amdgcn_rcpf(d.x); t.y = __builtin_amdgcn_rcpf(d.y);
    f32x2 q = t * 0.5307027145f + (-0.7265760135f); q = q * t + 0.7107068705f; q = q * t + (-0.142248368f); q = q * t + 0.127414796f; q = q * t;
    const f32x2 s = (v * v) * (-0.72134752044f);
    f32x2 e; e.x = __builtin_amdgcn_exp2f(s.x); e.y = __builtin_amdgcn_exp2f(s.y);
    const f32x2 m = v * (q * e), r = v - m;
    f32x2 o; o.x = v.x < 0.f ? m.x : r.x; o.y = v.y < 0.f ? m.y : r.y; return o;
}

template <int ACT  > struct EpiBf16 {
    static constexpr bool PERM = true, AFTER_DRAIN = false; static_assert(ACT == 0 || ACT == 1, "EpiBf16: ACT is 0 (none) or 1 (gelu_pk)");
    bf16_t* O; int ldc; const float* bias; int split_cols; size_t split_stride; float scale0;
    __device__ __forceinline__ void operator()(const f32x4 (&acc)[2][2][4][2], const Unit& u, int wr, int wc, int fr, int fq) const {
        const int row0 = u.pm * BM + wr * 64 + fr; int colt = u.pn * BM; bf16_t* base = O;
        float sc = 1.f; if (split_cols) { const int t = colt / split_cols; base += (size_t)t * split_stride; colt -= t * split_cols; if (t == 0) sc = scale0; }
        const int col0 = colt + wc * 32 + 8 * fq, bcol0 = u.pn * BM + wc * 32 + 8 * fq;
        f32x4 bv[2][2];
#pragma unroll
        for (int bj = 0; bj < 2; ++bj)
#pragma unroll
            for (int n = 0; n < 2; ++n) bv[bj][n] = bias ? *(const f32x4*)(bias + bcol0 + bj * HALF + 4 * n) : (f32x4){0.f, 0.f, 0.f, 0.f};
#pragma unroll
        for (int ai = 0; ai < 2; ++ai)
#pragma unroll
            for (int m = 0; m < 4; ++m) { bf16_t* rowp = base + (size_t)(row0 + ai * HALF + m * 16) * ldc + col0;
#pragma unroll
                for (int bj = 0; bj < 2; ++bj) { f32x4 v0 = acc[ai][bj][m][0] + bv[bj][0], v1 = acc[ai][bj][m][1] + bv[bj][1];
                    if (ACT == 1) { f32x2 a = gelu_pk((f32x2){v0[0], v0[1]}), b = gelu_pk((f32x2){v0[2], v0[3]}), c = gelu_pk((f32x2){v1[0], v1[1]}), d = gelu_pk((f32x2){v1[2], v1[3]});
                        v0 = (f32x4){a.x, a.y, b.x, b.y}; v1 = (f32x4){c.x, c.y, d.x, d.y}; }
                    v0 = v0 * sc; v1 = v1 * sc; u32x4 w; w.x = cvt_pk_bf16(v0[0], v0[1]); w.y = cvt_pk_bf16(v0[2], v0[3]); w.z = cvt_pk_bf16(v1[0], v1[1]); w.w = cvt_pk_bf16(v1[2], v1[3]);
                    *(u32x4*)(rowp + bj * HALF) = w; } }
    }
};
__device__ __forceinline__ float bf_lo(unsigned w) { return __uint_as_float(w << 16); }
__device__ __forceinline__ float bf_hi(unsigned w) { return __uint_as_float(w & 0xffff0000u); }
__device__ __forceinline__ float sigm(float x) { return 1.f / (1.f + __expf(-x)); }
template <bool ACCUM> struct EpiMerge {
    static constexpr bool PERM = true, AFTER_DRAIN = false;
    bf16_t* O; int ldc; const bf16_t* Gt; int ldg;
    __device__ __forceinline__ void operator()(const f32x4 (&acc)[2][2][4][2], const Unit& u, int wr, int wc, int fr, int fq) const {
        const int row0 = u.pm * BM + wr * 64 + fr, col0 = u.pn * BM + wc * 32 + 8 * fq;
#pragma unroll
        for (int ai = 0; ai < 2; ++ai)
#pragma unroll
            for (int m = 0; m < 4; ++m) { const size_t row = (size_t)(row0 + ai * HALF + m * 16);
#pragma unroll
                for (int bj = 0; bj < 2; ++bj) { const int col = col0 + bj * HALF;
                    const u32x4 g = *(const u32x4*)(Gt + row * ldg + col);
                    const f32x4 v0 = acc[ai][bj][m][0], v1 = acc[ai][bj][m][1];
                    float r[8];
                    r[0] = sigm(bf_lo(g.x)) * v0[0]; r[1] = sigm(bf_hi(g.x)) * v0[1]; r[2] = sigm(bf_lo(g.y)) * v0[2]; r[3] = sigm(bf_hi(g.y)) * v0[3];
                    r[4] = sigm(bf_lo(g.z)) * v1[0]; r[5] = sigm(bf_hi(g.z)) * v1[1]; r[6] = sigm(bf_lo(g.w)) * v1[2]; r[7] = sigm(bf_hi(g.w)) * v1[3];
                    bf16_t* op = O + row * ldc + col;
                    if (ACCUM) { const u32x4 o = *(const u32x4*)op;
                        r[0] += bf_lo(o.x); r[1] += bf_hi(o.x); r[2] += bf_lo(o.y); r[3] += bf_hi(o.y); r[4] += bf_lo(o.z); r[5] += bf_hi(o.z); r[6] += bf_lo(o.w); r[7] += bf_hi(o.w); }
                    u32x4 w; w.x = cvt_pk_bf16(r[0], r[1]); w.y = cvt_pk_bf16(r[2], r[3]); w.z = cvt_pk_bf16(r[4], r[5]); w.w = cvt_pk_bf16(r[6], r[7]);
                    *(u32x4*)op = w; } }
    }
};
struct EpiRes {
    static constexpr bool PERM = false, AFTER_DRAIN = false;
    const float* xin; float* out; int ldc; const float* bias; const float* gate0; int tiles_per_batch; int gate_stride; float alpha;
    __device__ __forceinline__ void operator()(const f32x4 (&acc)[2][2][4][2], const Unit& u, int wr, int wc, int fr, int fq) const {
        const int col0 = u.pn * BM + wc * 32 + 4 * fq;
        const float* gate = gate0 + (size_t)(u.pm / tiles_per_batch) * gate_stride;
#pragma unroll
        for (int bj = 0; bj < 2; ++bj)
#pragma unroll
            for (int n = 0; n < 2; ++n) { const int col = col0 + bj * HALF + n * 16;
                const f32x4 bv = *(const f32x4*)(bias + col), gv = *(const f32x4*)(gate + col);
#pragma unroll
                for (int ai = 0; ai < 2; ++ai)
#pragma unroll
                    for (int m = 0; m < 4; ++m) { const size_t off = (size_t)(u.pm * BM + ai * HALF + wr * 64 + m * 16 + fr) * ldc + col;
                        const f32x4 xv = *(const f32x4*)(xin + off);
                        *(f32x4*)(out + off) = xv * alpha + gv * (acc[ai][bj][m][n] + bv); } }
    }
};
template <class Epi, class Sched, bool ALIGN_EPI = false, bool SP2 = false>
__device__ __forceinline__ void gemm_phase(PG8_LAS unsigned char* lds, const Gemm g, const Sched& S, const Epi& E) {
    int tid_ = threadIdx.x; asm volatile("" : "+v"(tid_));
    const int tid = tid_, wid = __builtin_amdgcn_readfirstlane(tid >> 6), lane = tid & 63, wr = wid >> 2, wc = wid & 3, fr = lane & 15, fq = lane >> 4;
    const int K = g.K, nt = K / BK;
    unsigned voffA[2], voffB[2];
#pragma unroll
    for (int i = 0; i < 2; ++i) { int R, C; stage_rc(tid * 16 + i * 8192, R, C); const int Rb = Epi::PERM ? ((R & ~31) + perm32(R & 31)) : R;
        voffA[i] = (unsigned)(R * K + C) * 2u; voffB[i] = (unsigned)(Rb * K + C) * 2u; }
    const size_t kstep = (size_t)(BK * 2);
    const size_t hstep = (size_t)HALF * K * 2;
    const size_t tstep = 2 * hstep;
    const unsigned ldsw = (unsigned)wid * 1024u;
    const int aoff = lds_byte(wr * 64 + fr, fq * 8), boff = lds_byte(wc * 32 + fr, fq * 8);
#define PG8_SA(b, h) (((b) * 2 + (h)) * HTB)
#define PG8_SB(b, h) ((4 + (b) * 2 + (h)) * HTB)
#define PG8_STAGE(bufoff, gbase, voff) do { _Pragma("unroll") for (int _i = 0; _i < 2; ++_i) \
        __builtin_amdgcn_global_load_lds((const unsigned*)((const char*)(gbase) + (voff)[_i]), (PG8_LAS unsigned*)(lds + (bufoff) + ldsw + _i * 8192), 16, 0, 0); } while (0)
#define PG8_LDA(dst, b, h) do { _Pragma("unroll") for (int m = 0; m < 4; ++m) _Pragma("unroll") for (int k = 0; k < 2; ++k) dst[m][k] = *(const PG8_LAS bf16x8*)(lds + PG8_SA(b, h) + aoff + m * 2048 + k * 1024); } while (0)
#define PG8_LDB(dst, b, h) do { _Pragma("unroll") for (int n = 0; n < 2; ++n) _Pragma("unroll") for (int k = 0; k < 2; ++k) dst[n][k] = *(const PG8_LAS bf16x8*)(lds + PG8_SB(b, h) + boff + n * 2048 + k * 1024); } while (0)
#define PG8_MMA(ai, bj, At, Bt) do { __builtin_amdgcn_s_setprio(1); _Pragma("unroll") for (int m = 0; m < 4; ++m) _Pragma("unroll") for (int n = 0; n < 2; ++n) _Pragma("unroll") for (int k = 0; k < 2; ++k) \
        acc[ai][bj][m][n] = __builtin_amdgcn_mfma_f32_16x16x32_bf16(Bt[n][k], At[m][k], acc[ai][bj][m][n], 0, 0, 0); __builtin_amdgcn_s_setprio(0); } while (0)
#define PG8_WAIT_V(n) asm volatile("s_waitcnt vmcnt(" #n ")" ::: "memory")
#define PG8_WAIT_L(n) asm volatile("s_waitcnt lgkmcnt(" #n ")" ::: "memory")
#define PG8_BAR __builtin_amdgcn_s_barrier()
#define PG8_SCHED __builtin_amdgcn_sched_barrier(0)
    Unit cur, nxt; int ui = 0;
    if (!S.next(0, cur)) return;
    f32x4 acc[2][2][4][2];
#pragma unroll
    for (int a = 0; a < 2; ++a)
#pragma unroll
        for (int b = 0; b < 2; ++b)
#pragma unroll
            for (int m = 0; m < 4; ++m)
#pragma unroll
                for (int n = 0; n < 2; ++n) acc[a][b][m][n] = (f32x4){0.f, 0.f, 0.f, 0.f};
    bf16x8 At[4][2], B0[2][2], B1[2][2];
    const char* cA = (const char*)g.A + (size_t)cur.pm * tstep; const char* cB = (const char*)g.Bt + (size_t)cur.pn * tstep;
    S.a_ready(cur);
    if constexpr (SP2) {
        PG8_STAGE(PG8_SB(0, 0), cB, voffB); PG8_STAGE(PG8_SB(0, 1), cB + hstep, voffB); PG8_STAGE(PG8_SA(0, 0), cA, voffA); PG8_STAGE(PG8_SA(0, 1), cA + hstep, voffA);
        if (wr == 1) PG8_BAR;
        PG8_WAIT_V(2); PG8_BAR;
        PG8_STAGE(PG8_SB(1, 0), cB + kstep, voffB); PG8_STAGE(PG8_SA(1, 0), cA + kstep, voffA); PG8_STAGE(PG8_SB(1, 1), cB + hstep + kstep, voffB);
        PG8_WAIT_V(6); PG8_BAR;
    } else {
        PG8_STAGE(PG8_SB(0, 0), cB, voffB); PG8_STAGE(PG8_SA(0, 0), cA, voffA); PG8_STAGE(PG8_SB(0, 1), cB + hstep, voffB); PG8_STAGE(PG8_SA(0, 1), cA + hstep, voffA);
        if (wr == 1) PG8_BAR;
        PG8_WAIT_V(4); PG8_BAR;
        PG8_STAGE(PG8_SB(1, 0), cB + kstep, voffB); PG8_STAGE(PG8_SA(1, 0), cA + kstep, voffA); PG8_STAGE(PG8_SB(1, 1), cB + hstep + kstep, voffB);
        PG8_WAIT_V(6); PG8_BAR;
    }
    for (;;) {
        const bool has_next = S.next(ui + 1, nxt);
        const char* nA = has_next ? (const char*)g.A + (size_t)nxt.pm * tstep : cA; const char* nB = has_next ? (const char*)g.Bt + (size_t)nxt.pn * tstep : cB;
        for (int t = 0; t < nt; t += 2) {
            const bool last = (t == nt - 2);
            const char* a1 = cA + (size_t)(t + 1) * kstep;
            const char* a2 = last ? nA : cA + (size_t)(t + 2) * kstep; const char* b2 = last ? nB : cB + (size_t)(t + 2) * kstep;
            const char* a3 = a2 + kstep; const char* b3 = b2 + kstep;
            if (last && has_next) S.a_ready(nxt);
            if constexpr (SP2) {
            PG8_LDB(B0, 0, 0); PG8_LDB(B1, 0, 1); PG8_SCHED; PG8_LDA(At, 0, 0); PG8_STAGE(PG8_SA(1, 1), a1 + hstep, voffA);
            PG8_WAIT_V(8); PG8_WAIT_L(0); PG8_BAR; PG8_MMA(0, 0, At, B0); PG8_MMA(0, 1, At, B1); PG8_BAR; PG8_SCHED;
            PG8_LDA(At, 0, 1); PG8_STAGE(PG8_SB(0, 0), b2, voffB); PG8_STAGE(PG8_SB(0, 1), b2 + hstep, voffB); PG8_STAGE(PG8_SA(0, 0), a2, voffA);
            PG8_WAIT_V(8); PG8_WAIT_L(0); PG8_BAR; PG8_MMA(1, 0, At, B0); PG8_MMA(1, 1, At, B1); PG8_BAR; PG8_SCHED;
            PG8_LDB(B0, 1, 0); PG8_LDB(B1, 1, 1); PG8_SCHED; PG8_LDA(At, 1, 0); PG8_STAGE(PG8_SA(0, 1), a2 + hstep, voffA);
            PG8_WAIT_V(8); PG8_WAIT_L(0); PG8_BAR; PG8_MMA(0, 0, At, B0); PG8_MMA(0, 1, At, B1); PG8_BAR; PG8_SCHED;
            PG8_LDA(At, 1, 1); PG8_STAGE(PG8_SB(1, 0), b3, voffB); PG8_STAGE(PG8_SB(1, 1), b3 + hstep, voffB); PG8_STAGE(PG8_SA(1, 0), a3, voffA);
            PG8_WAIT_V(8); PG8_WAIT_L(0); PG8_BAR; PG8_MMA(1, 0, At, B0); PG8_MMA(1, 1, At, B1); PG8_BAR; PG8_SCHED;
            } else {
            PG8_LDB(B0, 0, 0); PG8_SCHED; PG8_LDA(At, 0, 0); PG8_STAGE(PG8_SA(1, 1), a1 + hstep, voffA);
            PG8_WAIT_L(8); PG8_BAR; PG8_WAIT_L(0); PG8_MMA(0, 0, At, B0); PG8_BAR; PG8_SCHED;
            PG8_LDB(B1, 0, 1); PG8_STAGE(PG8_SB(0, 0), b2, voffB);
            PG8_BAR; PG8_WAIT_L(0); PG8_MMA(0, 1, At, B1); PG8_BAR;
            PG8_LDA(At, 0, 1); PG8_STAGE(PG8_SA(0, 0), a2, voffA);
            PG8_BAR; PG8_WAIT_L(0); PG8_MMA(1, 0, At, B0); PG8_BAR; PG8_SCHED;
            PG8_STAGE(PG8_SB(0, 1), b2 + hstep, voffB);
            PG8_WAIT_V(6); PG8_BAR; PG8_MMA(1, 1, At, B1); PG8_BAR;
            PG8_LDB(B0, 1, 0); PG8_SCHED; PG8_LDA(At, 1, 0); PG8_STAGE(PG8_SA(0, 1), a2 + hstep, voffA);
            PG8_WAIT_L(8); PG8_BAR; PG8_WAIT_L(0); PG8_MMA(0, 0, At, B0); PG8_BAR; PG8_SCHED;
            PG8_LDB(B1, 1, 1); PG8_STAGE(PG8_SB(1, 0), b3, voffB);
            PG8_BAR; PG8_WAIT_L(0); PG8_MMA(0, 1, At, B1); PG8_BAR;
            PG8_LDA(At, 1, 1); PG8_STAGE(PG8_SA(1, 0), a3, voffA);
            PG8_BAR; PG8_WAIT_L(0); PG8_MMA(1, 0, At, B0); PG8_BAR; PG8_SCHED;
            PG8_STAGE(PG8_SB(1, 1), b3 + hstep, voffB);
            PG8_WAIT_V(6); PG8_BAR; PG8_MMA(1, 1, At, B1); PG8_BAR;
            }
        }
        if constexpr (ALIGN_EPI) { if (wr == 0) PG8_BAR; }
        if constexpr (!Epi::AFTER_DRAIN) { E(acc, cur, wr, wc, fr, fq); S.done(cur); }
        if (!has_next) break;
#pragma unroll
        for (int a = 0; a < 2; ++a)
#pragma unroll
            for (int b = 0; b < 2; ++b)
#pragma unroll
                for (int m = 0; m < 4; ++m)
#pragma unroll
                    for (int n = 0; n < 2; ++n) acc[a][b][m][n] = (f32x4){0.f, 0.f, 0.f, 0.f};
        cur = nxt; cA = nA; cB = nB; ++ui;
        if constexpr (ALIGN_EPI) { if (wr == 1) PG8_BAR; }
    }
    PG8_WAIT_V(0);
    if constexpr (!ALIGN_EPI) { if (wr == 0) PG8_BAR; }
    PG8_BAR;
    if constexpr (Epi::AFTER_DRAIN) { E.fused(acc, cur, wr, wc, fr, fq, lds, wid, lane); S.done(cur); }
#undef PG8_SA
#undef PG8_SB
#undef PG8_STAGE
#undef PG8_LDA
#undef PG8_LDB
#undef PG8_MMA
#undef PG8_WAIT_V
#undef PG8_WAIT_L
#undef PG8_BAR
#undef PG8_SCHED
}
}
constexpr int D = 1024, NB = 8, S = 4096, DEPTH = 2;
constexpr int HD = 64, DA = 512, NH = 8, NG = 3, DHY = 512, NIN = 9216;
constexpr int FE = 33, FW = 64;
constexpr int OFF_GA = 4608, OFF_HY = 5120, OFF_GH = 6656, OFF_RA = 7168, OFF_RH = 8192;
constexpr float LN_EPS = 1e-5f, DN_ALPHA = 1.41421356237309515f;
#ifndef MK_CHECK
#define MK_CHECK 0
#endif
#ifndef MK_CH
#define MK_CH (MK_CHECK ? 2 : 4)
#endif
constexpr int CH = MK_CH, NCHUNK = NB / CH, MC = CH * S;
constexpr int NWAVES = 8, NTHREADS = NWAVES * 64;
constexpr int GLEN = 2 * S - 1;

constexpr size_t MiB = 1u << 20;
constexpr size_t WS_WIN = 1 * MiB;
constexpr size_t WS_WPA = WS_WIN + (size_t)DEPTH * NIN * D * 2;
constexpr size_t WS_WPH = WS_WPA + (size_t)DEPTH * D * DA * 2;
constexpr size_t WS_WOUT = WS_WPH + (size_t)DEPTH * D * DHY * 2;
constexpr size_t WS_MOD = WS_WOUT + (size_t)DEPTH * D * D * 2;
constexpr size_t WS_H3 = WS_MOD + 1 * MiB;
constexpr size_t WS_R = WS_H3 + 2 * MiB;
constexpr size_t SZ_OG = (size_t)3 * MC * DA * 2, SZ_UT = (size_t)MC * 4 * DHY * 2;
constexpr size_t WS_H = WS_R + (size_t)DEPTH * 2 * DHY * 8192 * 2;
constexpr size_t WS_OG = WS_H;
constexpr size_t WS_P = WS_H + SZ_OG;
constexpr size_t WS_UT = WS_P + (size_t)MC * NIN * 2;
constexpr size_t WS_YA = WS_UT;
constexpr size_t WS_YH = WS_UT + (size_t)MC * DA * 2;
constexpr size_t WS_YHT = WS_UT + SZ_UT;
constexpr size_t WS_ML = WS_YHT + (size_t)MC * DHY * 2;
constexpr size_t WS_Z1T = WS_ML + (size_t)3 * MC * NH * 8;
constexpr size_t WS_YHTR = WS_Z1T + (size_t)MC * DHY * 2;
constexpr size_t WS_YAR = WS_YHTR + (size_t)MC * DHY * 2;
constexpr size_t WS_END = MK_CHECK ? WS_YAR + (size_t)MC * DA * 2 : WS_Z1T;
static_assert(SZ_OG >= (size_t)MC * D * 2 && SZ_UT >= (size_t)2 * MC * DA * 2, "aliased regions");
constexpr float CHECK_K = 30.f;

#ifndef PHM
#define PHM 0xFF
#endif
#ifndef MK_REP
#define MK_REP 0
#endif
#define REPS(k) (1 + (MK_REP == (k)))
constexpr int LDS_BYTES = 147456;
constexpr int RING_BYTES = 131072;

#define LAS __attribute__((address_space(3)))
typedef unsigned short bf16;
typedef unsigned v4u __attribute__((ext_vector_type(4)));
typedef unsigned v2u __attribute__((ext_vector_type(2)));
typedef float f32x4 __attribute__((ext_vector_type(4)));
#define LDS_WAIT() asm volatile("s_waitcnt lgkmcnt(0)" ::: "memory")
__device__ __forceinline__ unsigned f2bf(float f) { unsigned u = __builtin_bit_cast(unsigned, f); return (u + 0x7fffu + ((u >> 16) & 1u)) >> 16; }
__device__ __forceinline__ unsigned pk2(float lo, float hi) { return f2bf(lo) | (f2bf(hi) << 16); }
__device__ __forceinline__ float bf2f(unsigned short h) { return __uint_as_float((unsigned)h << 16); }
__device__ __forceinline__ float blo(unsigned w) { return __uint_as_float(w << 16); }
__device__ __forceinline__ float bhi(unsigned w) { return __uint_as_float(w & 0xffff0000u); }
__device__ __forceinline__ float wave_sum(float v) {
#pragma unroll
    for (int o = 1; o < 64; o <<= 1) v += __shfl_xor(v, o);
    return v;
}
__device__ __forceinline__ float wave_max(float v) {
#pragma unroll
    for (int o = 1; o < 64; o <<= 1) v = fmaxf(v, __shfl_xor(v, o));
    return v;
}
__device__ __forceinline__ float siluf_(float x) { return x / (1.f + expf(-x)); }
__device__ __forceinline__ void sincos_cw(float x, float& sn, float& cs) {
    const float j = rintf(x * 0.63661977236758134f);
    float y = fmaf(-j, 1.5703125f, x);
    y = fmaf(-j, 4.837512969970703125e-4f, y);
    y = fmaf(-j, 7.54978995489188216e-8f, y);
    const float z = y * y;
    const float sp = fmaf(fmaf(fmaf(-1.9515295891e-4f, z, 8.3321608736e-3f), z, -1.6666654611e-1f) * z, y, y);
    const float cp = fmaf(fmaf(fmaf(2.443315711809948e-5f, z, -1.388731625493765e-3f), z, 4.166664568298827e-2f), z * z, fmaf(-0.5f, z, 1.0f));
    const int q = ((int)j) & 3;
    const float s0 = (q & 1) ? cp : sp, c0 = (q & 1) ? sp : cp;
    sn = (q & 2) ? -s0 : s0;
    cs = ((q + 1) & 2) ? -c0 : c0;
}
__device__ __forceinline__ float sin_cw(float x) { float s, c; sincos_cw(x, s, c); return s; }

struct Ctx {
    unsigned char* lds;
    int tid, lane, wave, gw, NGW, G;
};

__device__ __forceinline__ void p0_transpose_item(const float* W, int K, int N, bf16* WT, float* scr, int item, int lane) {
    const int nblk = N / 32, kb = item / nblk, nb = item % nblk, k0 = 64 * kb, n0 = 32 * nb;
#pragma unroll 8
    for (int i = 0; i < 32; ++i) { const int kk = 2 * i + (lane >> 5); scr[kk * 33 + (lane & 31)] = W[(size_t)(k0 + kk) * N + n0 + (lane & 31)]; }
    LDS_WAIT(); asm volatile("" ::: "memory");
    const int c = lane & 7;
#pragma unroll
    for (int j = 0; j < 4; ++j) { const int n = (lane >> 3) + 8 * j; const float* s = scr + (8 * c) * 33 + n;
        v4u o; o.x = pk2(s[0 * 33], s[1 * 33]); o.y = pk2(s[2 * 33], s[3 * 33]); o.z = pk2(s[4 * 33], s[5 * 33]); o.w = pk2(s[6 * 33], s[7 * 33]);
        *(v4u*)(WT + (size_t)(n0 + n) * K + k0 + 8 * c) = o; }
    LDS_WAIT(); asm volatile("" ::: "memory");
}
__device__ __forceinline__ void p0_trunk_item(const float* const* in, float* H3, float* sf  , int l, int t, int lane) {
    const float* w1 = in[8]; const float* b1 = in[9]; const float* w2 = in[10]; const float* b2 = in[11];
    const float* w3 = in[12]; const float* b3 = in[13]; const float* freq = in[15];
    if (lane < FE) {
        float v;
        if (lane == 0) v = (float)t / (float)(S - 1);
        else {
            const int q = (lane - 1) & 15;
            const double f = (double)(1e-4f) + (double)q * (((double)15.0f - (double)1e-4f) / 15.0);
            double u = f * (double)t / (double)S; u -= rint(u);
            float sn, cs; sincos_cw((float)(u * 6.283185307179586476925), sn, cs);
            v = (lane <= 16) ? cs : -sn;
        }
        sf[lane] = v;
    }
    LDS_WAIT(); asm volatile("" ::: "memory");
    const float fr = freq[l * FW + lane];
    float a0 = b1[l * FW + lane], a1 = 0.f;
    for (int kk = 0; kk < 32; kk += 2) { a0 = fmaf(sf[kk], w1[(l * FE + kk) * FW + lane], a0); a1 = fmaf(sf[kk + 1], w1[(l * FE + kk + 1) * FW + lane], a1); }
    a0 = fmaf(sf[32], w1[(l * FE + 32) * FW + lane], a0);
    sf[64 + lane] = sin_cw(fr * (a0 + a1));
    LDS_WAIT(); asm volatile("" ::: "memory");
    a0 = b2[l * FW + lane]; a1 = 0.f;
    for (int kk = 0; kk < FW; kk += 2) { a0 = fmaf(sf[64 + kk], w2[(l * FW + kk) * FW + lane], a0); a1 = fmaf(sf[64 + kk + 1], w2[(l * FW + kk + 1) * FW + lane], a1); }
    sf[128 + lane] = sin_cw(fr * (a0 + a1));
    LDS_WAIT(); asm volatile("" ::: "memory");
    a0 = b3[l * FW + lane]; a1 = 0.f;
    for (int kk = 0; kk < FW; kk += 2) { a0 = fmaf(sf[128 + kk], w3[(l * FW + kk) * FW + lane], a0); a1 = fmaf(sf[128 + kk + 1], w3[(l * FW + kk + 1) * FW + lane], a1); }
    H3[((size_t)l * S + t) * FW + lane] = sin_cw(fr * (a0 + a1));
    LDS_WAIT(); asm volatile("" ::: "memory");
}
__device__ __forceinline__ void p0_rgen_item(const float* const* in, const float* H3, bf16* R, unsigned char* lds, int item, int tid) {
    const int l = item >> 7, tg = (item >> 4) & 7, nb = item & 15, lane = tid & 63, wave = tid >> 6;
    float* Wl = (float*)lds;
    const float* w4l = in[14] + (size_t)l * FW * (4 * DHY) + 128 * nb;
    for (int e = tid; e < 64 * 128; e += NTHREADS) { const int j = e >> 7, i = e & 127; Wl[i * 68 + j] = w4l[(size_t)j * 4 * DHY + i]; }
    const int t = 512 * tg + 64 * wave + lane;
    float hr[64];
    { const f32x4* hp = (const f32x4*)(H3 + ((size_t)l * S + t) * FW);
#pragma unroll
      for (int q = 0; q < 16; ++q) { const f32x4 v = hp[q]; hr[4 * q] = v.x; hr[4 * q + 1] = v.y; hr[4 * q + 2] = v.z; hr[4 * q + 3] = v.w; } }
    __syncthreads();
    const int nq = nb >> 2, o = nq >> 1, dir = nq & 1, cbase = (128 * nb) & 511;
    const float tt = (float)t / (float)(S - 1);
    const float d0 = -4.605170185988091f / 1.5f, d1 = -4.605170185988091f / 0.3f;
    const int x = dir ? ((t == 0) ? 8191 : 4095 + t) : 4095 - t;
    bf16* Rb = R + ((size_t)(l * 2 + o) * DHY + cbase) * 8192 + x;
    for (int i = 0; i < 128; ++i) {
        const f32x4* wp = (const f32x4*)(Wl + i * 68);
        float a0 = 0.f, a1 = 0.f, a2 = 0.f, a3 = 0.f;
#pragma unroll
        for (int q = 0; q < 16; ++q) { const f32x4 w = wp[q]; a0 = fmaf(hr[4 * q], w.x, a0); a1 = fmaf(hr[4 * q + 1], w.y, a1); a2 = fmaf(hr[4 * q + 2], w.z, a2); a3 = fmaf(hr[4 * q + 3], w.w, a3); }
        const float delta = d0 + (d1 - d0) * ((float)(cbase + i) / (float)(DHY - 1));
        float val = ((a0 + a1) + (a2 + a3)) * __expf(-tt * fabsf(delta));
        if (dir == 1 && t == 0) val = 0.f;
        Rb[(size_t)i * 8192] = (bf16)f2bf(val);
    }
    __syncthreads();
}
__device__ __forceinline__ void p0_mod_item(const float* const* in, float* mod, unsigned char* lds, int item, int tid) {
    const int l = item / 48, n = (item % 48) * 64 + (tid & 63), wave = tid >> 6, lane = tid & 63;
    const float* w = in[2] + (size_t)l * D * 3 * D + (size_t)(128 * wave) * 3 * D + n; const float* c = in[1] + 128 * wave;
    float acc[NB];
#pragma unroll
    for (int b = 0; b < NB; ++b) acc[b] = 0.f;
#pragma unroll 4
    for (int k = 0; k < 128; ++k) { const float wv = w[(size_t)k * 3 * D];
#pragma unroll
        for (int b = 0; b < NB; ++b) acc[b] = fmaf(c[b * D + k], wv, acc[b]); }
    float* red = (float*)lds;
#pragma unroll
    for (int b = 0; b < NB; ++b) red[(wave * NB + b) * 64 + lane] = acc[b];
    __syncthreads();
    { float s = in[3][l * 3 * D + n];
#pragma unroll
      for (int q = 0; q < NWAVES; ++q) s += red[(q * NB + wave) * 64 + lane];
      mod[((size_t)l * NB + wave) * 3 * D + n] = s; }
    __syncthreads();
}
__device__ __forceinline__ void p0_prologue_a(const Ctx& C, const float* const* in, unsigned char* ws) {
    float* scr = (float*)(C.lds + C.wave * 16384);
    constexpr int I_IN = (D / 64) * (NIN / 32), I_PA = (DA / 64) * (D / 32), I_PH = (DHY / 64) * (D / 32), I_OUT = (D / 64) * (D / 32);
    constexpr int I_L = I_IN + I_PA + I_PH + I_OUT;
    for (int rq_ = 0; rq_ < REPS(11); ++rq_) for (int it = C.gw; it < DEPTH * I_L; it += C.NGW) {
        const int l = it / I_L; int r = it % I_L;
        if (r < I_IN) { p0_transpose_item(in[4] + (size_t)l * D * NIN, D, NIN, (bf16*)(ws + WS_WIN) + (size_t)l * NIN * D, scr, r, C.lane); continue; } r -= I_IN;
        if (r < I_PA) { p0_transpose_item(in[17] + (size_t)l * DA * D, DA, D, (bf16*)(ws + WS_WPA) + (size_t)l * D * DA, scr, r, C.lane); continue; } r -= I_PA;
        if (r < I_PH) { p0_transpose_item(in[18] + (size_t)l * DHY * D, DHY, D, (bf16*)(ws + WS_WPH) + (size_t)l * D * DHY, scr, r, C.lane); continue; } r -= I_PH;
        p0_transpose_item(in[19] + (size_t)l * D * D, D, D, (bf16*)(ws + WS_WOUT) + (size_t)l * D * D, scr, r, C.lane);
    }
    for (int rq_ = 0; rq_ < REPS(13); ++rq_) for (int it = C.gw; it < DEPTH * S; it += C.NGW) p0_trunk_item(in, (float*)(ws + WS_H3), scr, it / S, it % S, C.lane);
    __syncthreads();
    for (int rq_ = 0; rq_ < REPS(12); ++rq_) for (int it = blockIdx.x; it < DEPTH * 48; it += C.G) p0_mod_item(in, (float*)(ws + WS_MOD), C.lds, it, C.tid);
}
__device__ __forceinline__ void p0_prologue_b(const Ctx& C, const float* const* in, unsigned char* ws) {
    for (int rq_ = 0; rq_ < REPS(14); ++rq_) for (int it = blockIdx.x; it < DEPTH * 128; it += C.G) p0_rgen_item(in, (const float*)(ws + WS_H3), (bf16*)(ws + WS_R), C.lds, it, C.tid);
}

__device__ __forceinline__ void ln_mod_row(const float* xrow, const float* modb, bf16* orow, int lane) {
    const f32x4* xr = (const f32x4*)xrow + lane;
    f32x4 v[4]; float s = 0.f;
#pragma unroll
    for (int j = 0; j < 4; ++j) { v[j] = xr[64 * j]; s += (v[j].x + v[j].y) + (v[j].z + v[j].w); }
    const float mean = wave_sum(s) * (1.f / D); float s2 = 0.f;
#pragma unroll
    for (int j = 0; j < 4; ++j) { v[j] = v[j] - mean; s2 += (v[j].x * v[j].x + v[j].y * v[j].y) + (v[j].z * v[j].z + v[j].w * v[j].w); }
    const float rstd = 1.f / sqrtf(wave_sum(s2) * (1.f / D) + LN_EPS);
    v2u* o8 = (v2u*)orow + lane;
#pragma unroll
    for (int j = 0; j < 4; ++j) {
        const f32x4 sh = *((const f32x4*)modb + lane + 64 * j), sc = *((const f32x4*)(modb + D) + lane + 64 * j);
        const f32x4 r = v[j] * rstd * (sc + 1.f) + sh;
        v2u w; w.x = pk2(r.x, r.y); w.y = pk2(r.z, r.w); o8[64 * j] = w;
    }
}
__device__ __forceinline__ void ln_final_row(float* row, const float* lg, const float* lb, int lane) {
    f32x4* xr = (f32x4*)row + lane;
    f32x4 v[4]; float s = 0.f;
#pragma unroll
    for (int j = 0; j < 4; ++j) { v[j] = xr[64 * j]; s += (v[j].x + v[j].y) + (v[j].z + v[j].w); }
    const float mean = wave_sum(s) * (1.f / D); float s2 = 0.f;
#pragma unroll
    for (int j = 0; j < 4; ++j) { v[j] = v[j] - mean; s2 += (v[j].x * v[j].x + v[j].y * v[j].y) + (v[j].z * v[j].z + v[j].w * v[j].w); }
    const float rstd = 1.f / sqrtf(wave_sum(s2) * (1.f / D) + LN_EPS);
#pragma unroll
    for (int j = 0; j < 4; ++j) { const f32x4 g = *((const f32x4*)lg + lane + 64 * j), b = *((const f32x4*)lb + lane + 64 * j); xr[64 * j] = v[j] * rstd * g + b; }
}

__device__ __forceinline__ void attn_naive_item(const bf16* P, bf16* YA, float* sw  , int row, int h, int lane) {
    float* sq = sw; float* sc = sw + 192;
    const int t = row % S, rb = row - t;
    const float slope = exp2f(-(float)(h + 1));
    const bf16* prow = P + (size_t)row * NIN;
#pragma unroll
    for (int g = 0; g < NG; ++g) sq[g * 64 + lane] = bf2f(prow[(0 * NG + g) * DA + h * HD + lane]);
    LDS_WAIT(); asm volatile("" ::: "memory");
    float mx = -INFINITY;
#pragma unroll
    for (int g = 0; g < NG; ++g) {
        const int dil = (g == 0) ? 1 : (g == 1 ? 4 : 16);
        const int kcol = (1 * NG + g) * DA + h * HD;
        for (int pass = 0; pass < 3; ++pass) {
            const int jj = pass * 64 + lane;
            if (jj <= 128) {
                const int j = jj - 64, tk = t + j * dil;
                float s = -INFINITY;
                if (tk >= 0 && tk < S) {
                    const v4u* kr = (const v4u*)(P + (size_t)(rb + tk) * NIN + kcol);
                    float a = 0.f;
#pragma unroll
                    for (int e = 0; e < 8; ++e) { const v4u kv = kr[e]; const float* q = sq + g * 64 + 8 * e;
                        a = fmaf(q[0], blo(kv.x), a); a = fmaf(q[1], bhi(kv.x), a); a = fmaf(q[2], blo(kv.y), a); a = fmaf(q[3], bhi(kv.y), a);
                        a = fmaf(q[4], blo(kv.z), a); a = fmaf(q[5], bhi(kv.z), a); a = fmaf(q[6], blo(kv.w), a); a = fmaf(q[7], bhi(kv.w), a); }
                    s = a * 0.125f - slope * (float)((j < 0 ? -j : j) * dil);
                }
                sc[g * 132 + jj] = s;
                mx = fmaxf(mx, s);
            }
        }
    }
    mx = wave_max(mx);
    float sum = 0.f;
#pragma unroll
    for (int g = 0; g < NG; ++g)
        for (int pass = 0; pass < 3; ++pass) {
            const int jj = pass * 64 + lane;
            if (jj <= 128) { const float s = sc[g * 132 + jj]; const float p = (s == -INFINITY) ? 0.f : expf(s - mx); sc[g * 132 + jj] = p; sum += p; }
        }
    sum = wave_sum(sum);
    LDS_WAIT(); asm volatile("" ::: "memory");
    float o = 0.f;
#pragma unroll
    for (int g = 0; g < NG; ++g) {
        const int dil = (g == 0) ? 1 : (g == 1 ? 4 : 16);
        const int vcol = (2 * NG + g) * DA + h * HD + lane;
        for (int jj = 0; jj <= 128; ++jj) {
            const int tk = t + (jj - 64) * dil;
            if (tk >= 0 && tk < S) o = fmaf(sc[g * 132 + jj], bf2f(P[(size_t)(rb + tk) * NIN + vcol]), o);
        }
    }
    o /= sum;
    const float ga = bf2f(prow[OFF_GA + h * HD + lane]);
    YA[(size_t)row * DA + h * HD + lane] = (bf16)f2bf(o * siluf_(ga));
    LDS_WAIT(); asm volatile("" ::: "memory");
}
typedef short bf16x8_t __attribute__((ext_vector_type(8)));
typedef float f32x16_t __attribute__((ext_vector_type(16)));
struct LCG {
    static constexpr int NI = 32 / CH, NCT = 64 / NI;
    static constexpr int PADZ = 64 * (NI - 1), ZSTRIDE = 4096 + 2 * PADZ + 32;
    static constexpr int GC_STRIDE = 16448, ZB_OFF = 4 * GC_STRIDE, LDS_END = ZB_OFF + CH * ZSTRIDE * 2;
};
static_assert(LCG::NCT <= NWAVES && (LCG::ZSTRIDE / 8) % 16 == 4 && LCG::ZSTRIDE % 8 == 0 && LCG::LDS_END <= RING_BYTES, "long-conv LDS map");
constexpr int UT_ROWS = 4 * DHY;
__device__ __forceinline__ int zsw(int e) { const int c = e >> 3; return (((c ^ ((c >> 3) & 7)) << 3) | (e & 7)) * 2; }

struct RRegs { v4u cur[2], prv[2]; };
__device__ __forceinline__ void lc_load_R(RRegs& rr, const bf16* Rg, int tid) {
#pragma unroll
    for (int it = 0; it < 2; ++it) { const int k = tid + it * NTHREADS;
        rr.cur[it] = *(const v4u*)(Rg + 8 * k);
        rr.prv[it] = *(const v4u*)(Rg + 8 * (k > 0 ? k - 1 : 0)); }
}
__device__ __forceinline__ void lc_write_R(LAS unsigned char* lds, const RRegs& rr, int tid) {
#pragma unroll
    for (int it = 0; it < 2; ++it) {
        const int k = tid + it * NTHREADS;
        const v4u cur = rr.cur[it]; v4u prv = rr.prv[it]; if (k == 0) prv = (v4u){0u, 0u, 0u, 0u};
        *(LAS v4u*)(lds + 0 * LCG::GC_STRIDE + 16 * k) = cur;
        v4u s1; s1.x = __builtin_amdgcn_alignbit(cur.x, prv.w, 16); s1.y = __builtin_amdgcn_alignbit(cur.y, cur.x, 16); s1.z = __builtin_amdgcn_alignbit(cur.z, cur.y, 16); s1.w = __builtin_amdgcn_alignbit(cur.w, cur.z, 16);
        *(LAS v4u*)(lds + 1 * LCG::GC_STRIDE + 16 * k) = s1;
        v4u s2; s2.x = prv.w; s2.y = cur.x; s2.z = cur.y; s2.w = cur.z;
        *(LAS v4u*)(lds + 2 * LCG::GC_STRIDE + 16 * k) = s2;
        v4u s3; s3.x = __builtin_amdgcn_alignbit(prv.w, prv.z, 16); s3.y = __builtin_amdgcn_alignbit(cur.x, prv.w, 16); s3.z = __builtin_amdgcn_alignbit(cur.y, cur.x, 16); s3.w = __builtin_amdgcn_alignbit(cur.z, cur.y, 16);
        *(LAS v4u*)(lds + 3 * LCG::GC_STRIDE + 16 * k) = s3;
    }
}
constexpr int LC_ZCH = CH * 512 / NTHREADS;
struct ZRegs { v4u v[LC_ZCH]; };
__device__ __forceinline__ void lc_load_z(ZRegs& zr, const bf16* UT, int c, int tid) {
#pragma unroll
    for (int j = 0; j < LC_ZCH; ++j) { const int k = tid + j * NTHREADS, bb = k >> 9, s8 = (k & 511) * 8; zr.v[j] = *(const v4u*)(UT + (size_t)c * MC + bb * S + s8); }
}
__device__ __forceinline__ void lc_write_z(LAS unsigned char* lds, const ZRegs& zr, int tid) {
#pragma unroll
    for (int j = 0; j < LC_ZCH; ++j) { const int k = tid + j * NTHREADS, bb = k >> 9, s8 = (k & 511) * 8; *(LAS v4u*)(lds + LCG::ZB_OFF + bb * LCG::ZSTRIDE * 2 + zsw(LCG::PADZ + s8)) = zr.v[j]; }
}
__device__ __forceinline__ bf16x8_t lc_ldA(LAS unsigned char* lds, int baseA, int baseA8, int d) {
    const v2u a0 = *(const LAS v2u*)(lds + baseA - 32 * d), a1 = *(const LAS v2u*)(lds + baseA8 - 32 * d);
    return __builtin_bit_cast(bf16x8_t, (v4u){a0.x, a0.y, a1.x, a1.y});
}
__device__ __forceinline__ bf16x8_t lc_ldB(LAS unsigned char* lds, int rowB, int cB, int d) {
    const int c = cB - 2 * d;
    return __builtin_bit_cast(bf16x8_t, *(const LAS v4u*)(lds + rowB + ((c ^ ((c >> 3) & 7)) << 4)));
}
__device__ __forceinline__ void lc_mma(LAS unsigned char* lds, f32x16_t& acc1, f32x16_t& acc2, int wave, int lane) {
    const int r = lane & 31, h = lane >> 5, kap = (r + 1) & 3, b = r / LCG::NI, ii = r % LCG::NI;
    const int baseA = kap * LCG::GC_STRIDE + 2 * (4095 - r + 8 * h + kap);
    int baseA8 = baseA + 8; asm volatile("" : "+v"(baseA8));
    const int i0 = LCG::NI * wave;
    const int rowB = LCG::ZB_OFF + b * LCG::ZSTRIDE * 2, cB = (LCG::PADZ + 64 * (i0 + ii) + 8 * h) >> 3;
    const int dlo = 4 * i0 - 255, dhi = 4 * i0 + 4 * (LCG::NI - 1);
    acc1 = (f32x16_t){0.f, 0.f, 0.f, 0.f, 0.f, 0.f, 0.f, 0.f, 0.f, 0.f, 0.f, 0.f, 0.f, 0.f, 0.f, 0.f}; acc2 = acc1;
    bf16x8_t Ae = lc_ldA(lds, baseA, baseA8, dlo), Ao = lc_ldA(lds, baseA, baseA8, dlo + 1), An = lc_ldA(lds, baseA, baseA8, dlo + 2), Am = lc_ldA(lds, baseA, baseA8, dlo + 3);
    bf16x8_t B0 = lc_ldB(lds, rowB, cB, dlo), B1 = lc_ldB(lds, rowB, cB, dlo + 1);
    for (int d = dlo; d <= dhi; d += 2) {
        const int dn = (d + 2 <= dhi - 1) ? d + 2 : dhi - 1;
        const bf16x8_t nAn = lc_ldA(lds, baseA, baseA8, dn + 2), nAm = lc_ldA(lds, baseA, baseA8, dn + 3);
        const bf16x8_t nB0 = lc_ldB(lds, rowB, cB, dn), nB1 = lc_ldB(lds, rowB, cB, dn + 1);
        acc1 = __builtin_amdgcn_mfma_f32_32x32x16_bf16(Ae, B0, acc1, 0, 0, 0);
        acc2 = __builtin_amdgcn_mfma_f32_32x32x16_bf16(An, B0, acc2, 0, 0, 0);
        acc1 = __builtin_amdgcn_mfma_f32_32x32x16_bf16(Ao, B1, acc1, 0, 0, 0);
        acc2 = __builtin_amdgcn_mfma_f32_32x32x16_bf16(Am, B1, acc2, 0, 0, 0);
        Ae = An; Ao = Am; An = nAn; Am = nAm; B0 = nB0; B1 = nB1;
    }
}
__device__ __forceinline__ void longconv_mfma_units(LAS unsigned char* lds, const bf16* UT, const bf16* Rl, const float* fb, bf16* YHT, int first, int stride, int tid_) {
    const int tid = tid_, lane = tid & 63, wave = __builtin_amdgcn_readfirstlane(tid >> 6);
    const int r = lane & 31, h = lane >> 5, b = r / LCG::NI, ii = r % LCG::NI;
    const bool active = wave < LCG::NCT;
    const int i = LCG::NI * wave + ii;
    if (first >= DHY) return;
    for (int k = tid; k < CH * 2 * (LCG::PADZ / 8); k += NTHREADS) { const int bb = k / (2 * (LCG::PADZ / 8)), q = k % (2 * (LCG::PADZ / 8));
        const int e = (q < LCG::PADZ / 8) ? q * 8 : LCG::PADZ + 4096 + (q - LCG::PADZ / 8) * 8;
        *(LAS v4u*)(lds + LCG::ZB_OFF + bb * LCG::ZSTRIDE * 2 + zsw(e)) = (v4u){0u, 0u, 0u, 0u}; }
    ZRegs zr; RRegs r0; lc_load_z(zr, UT, first, tid); lc_load_R(r0, Rl + (size_t)(0 * DHY + first) * 8192, tid);
    for (int c = first; c < DHY; c += stride) {
        lc_write_z(lds, zr, tid); lc_write_R(lds, r0, tid);
        RRegs r1; lc_load_R(r1, Rl + (size_t)(1 * DHY + c) * 8192, tid);
        v2u x1[2][4];
#pragma unroll
        for (int hf = 0; hf < 2; ++hf)
#pragma unroll
            for (int q = 0; q < 4; ++q) x1[hf][q] = *(const v2u*)(UT + (size_t)(DHY + c) * MC + b * S + 64 * i + 32 * hf + 8 * q + 4 * h);
        __syncthreads();
        f32x16_t acc1, acc2;
        for (int rr_ = 0; rr_ < REPS(15); ++rr_) if (active) lc_mma(lds, acc1, acc2, wave, lane);
        v2u zn[2][4];
        if (active) { const float bias0 = fb[c];
#pragma unroll
          for (int hf = 0; hf < 2; ++hf)
#pragma unroll
            for (int q = 0; q < 4; ++q) { const int t = 64 * i + 32 * hf + 8 * q + 4 * h; const f32x16_t& ac = hf ? acc2 : acc1;
                const v2u zo = *(const LAS v2u*)(lds + LCG::ZB_OFF + b * LCG::ZSTRIDE * 2 + zsw(LCG::PADZ + t));
                const v2u xx = x1[hf][q];
                const float y0 = blo(xx.x) * (ac[4 * q + 0] + bias0 * blo(zo.x)), y1 = bhi(xx.x) * (ac[4 * q + 1] + bias0 * bhi(zo.x));
                const float y2 = blo(xx.y) * (ac[4 * q + 2] + bias0 * blo(zo.y)), y3 = bhi(xx.y) * (ac[4 * q + 3] + bias0 * bhi(zo.y));
                zn[hf][q].x = pk2(y0, y1); zn[hf][q].y = pk2(y2, y3); } }
        __syncthreads();
        if (active) {
#pragma unroll
          for (int hf = 0; hf < 2; ++hf)
#pragma unroll
            for (int q = 0; q < 4; ++q) *(LAS v2u*)(lds + LCG::ZB_OFF + b * LCG::ZSTRIDE * 2 + zsw(LCG::PADZ + 64 * i + 32 * hf + 8 * q + 4 * h)) = zn[hf][q]; }
        lc_write_R(lds, r1, tid);
        v2u x2[2][4], sg[2][4];
#pragma unroll
        for (int hf = 0; hf < 2; ++hf)
#pragma unroll
            for (int q = 0; q < 4; ++q) { const size_t off = (size_t)b * S + 64 * i + 32 * hf + 8 * q + 4 * h;
                x2[hf][q] = *(const v2u*)(UT + (size_t)(2 * DHY + c) * MC + off); sg[hf][q] = *(const v2u*)(UT + (size_t)(3 * DHY + c) * MC + off); }
        const int cn = (c + stride < DHY) ? c + stride : c;
        lc_load_z(zr, UT, cn, tid); lc_load_R(r0, Rl + (size_t)(0 * DHY + cn) * 8192, tid);
        __syncthreads();
        if (active) { for (int rr_ = 0; rr_ < REPS(15); ++rr_) lc_mma(lds, acc1, acc2, wave, lane);
          const float bias1 = fb[DHY + c];
#pragma unroll
          for (int hf = 0; hf < 2; ++hf)
#pragma unroll
            for (int q = 0; q < 4; ++q) { const int t = 64 * i + 32 * hf + 8 * q + 4 * h; const f32x16_t& ac = hf ? acc2 : acc1;
                const v2u zo = *(const LAS v2u*)(lds + LCG::ZB_OFF + b * LCG::ZSTRIDE * 2 + zsw(LCG::PADZ + t));
                const v2u xx = x2[hf][q], ss = sg[hf][q];
                const float y0 = blo(ss.x) * blo(xx.x) * (ac[4 * q + 0] + bias1 * blo(zo.x)), y1 = bhi(ss.x) * bhi(xx.x) * (ac[4 * q + 1] + bias1 * bhi(zo.x));
                const float y2 = blo(ss.y) * blo(xx.y) * (ac[4 * q + 2] + bias1 * blo(zo.y)), y3 = bhi(ss.y) * bhi(xx.y) * (ac[4 * q + 3] + bias1 * bhi(zo.y));
                v2u o; o.x = pk2(y0, y1); o.y = pk2(y2, y3);
                *(v2u*)(YHT + (size_t)c * MC + b * S + t) = o; } }
        __syncthreads();
    }
}
__device__ __forceinline__ void hyena_prep_tile(unsigned char* lds, const bf16* P, const float* cw, const float* cb, bf16* UT, int tile, int tid) {
    constexpr int TS = 72;
    const int tr = tile / (UT_ROWS / 64), tc = tile % (UT_ROWS / 64), row0 = tr * 64, c0 = tc * 64;
    bf16* T = (bf16*)lds;
    { const int rr = tid >> 3, seg = tid & 7, row = row0 + rr, t = row % S, cc = c0 + 8 * seg;
      float o[8];
      if (c0 < 3 * DHY) {
          const v4u w0 = *(const v4u*)(P + (size_t)row * NIN + OFF_HY + cc);
          v4u wm = (v4u){0u, 0u, 0u, 0u}, wp = (v4u){0u, 0u, 0u, 0u};
          if (t > 0) wm = *(const v4u*)(P + (size_t)(row - 1) * NIN + OFF_HY + cc);
          if (t < S - 1) wp = *(const v4u*)(P + (size_t)(row + 1) * NIN + OFF_HY + cc);
          const unsigned am[4] = {wm.x, wm.y, wm.z, wm.w}, a0[4] = {w0.x, w0.y, w0.z, w0.w}, ap[4] = {wp.x, wp.y, wp.z, wp.w};
#pragma unroll
          for (int j = 0; j < 4; ++j) { const int c = cc + 2 * j;
              o[2 * j] = cw[c] * blo(am[j]) + cw[3 * DHY + c] * blo(a0[j]) + cw[6 * DHY + c] * blo(ap[j]) + cb[c];
              o[2 * j + 1] = cw[c + 1] * bhi(am[j]) + cw[3 * DHY + c + 1] * bhi(a0[j]) + cw[6 * DHY + c + 1] * bhi(ap[j]) + cb[c + 1]; }
      } else {
          const v4u w0 = *(const v4u*)(P + (size_t)row * NIN + OFF_GH + (cc - 3 * DHY));
          const unsigned a0[4] = {w0.x, w0.y, w0.z, w0.w};
#pragma unroll
          for (int j = 0; j < 4; ++j) { o[2 * j] = siluf_(blo(a0[j])); o[2 * j + 1] = siluf_(bhi(a0[j])); }
      }
#pragma unroll
      for (int j = 0; j < 8; ++j) T[(8 * seg + j) * TS + rr] = (bf16)f2bf(o[j]); }
    __syncthreads();
    { const int chn = tid >> 3, sg = tid & 7;
      *(v4u*)(UT + (size_t)(c0 + chn) * MC + row0 + 8 * sg) = *(const v4u*)(T + chn * TS + 8 * sg); }
    __syncthreads();
}
__device__ __forceinline__ void hyena_post_tile(unsigned char* lds, const bf16* YHT, bf16* YH, int tile, int tid) {
    constexpr int TS = 72;
    const int tr = tile / (DHY / 64), tc = tile % (DHY / 64), row0 = tr * 64, c0 = tc * 64;
    bf16* T = (bf16*)lds;
    { const int chn = tid >> 3, sg = tid & 7;
      const v4u w = *(const v4u*)(YHT + (size_t)(c0 + chn) * MC + row0 + 8 * sg);
      const unsigned a[4] = {w.x, w.y, w.z, w.w};
#pragma unroll
      for (int j = 0; j < 4; ++j) { T[(8 * sg + 2 * j) * TS + chn] = (bf16)(a[j] & 0xffffu); T[(8 * sg + 2 * j + 1) * TS + chn] = (bf16)(a[j] >> 16); } }
    __syncthreads();
    { const int rr = tid >> 3, seg = tid & 7;
      *(v4u*)(YH + (size_t)(row0 + rr) * DHY + c0 + 8 * seg) = *(const v4u*)(T + rr * TS + 8 * seg); }
    __syncthreads();
}
typedef short v4i16_t __attribute__((ext_vector_type(4)));
constexpr int AT_ROWB = 128;
__device__ __forceinline__ void attn_mfma_unit(const bf16* P, bf16* OG, float* ML, LAS unsigned char* vs, int unit, int lane_) {
    int lane = lane_; asm volatile("" : "+v"(lane));
    int u = unit; const int x = u & 127; u >>= 7; const int hh = u & 7; u >>= 3; const int g = u % 3, bl = u / 3;
    const int dsh = 2 * g, d = 1 << dsh, L = S >> dsh, nqb = L >> 5, r = x / nqb, qb = x % nqb;
    const size_t rowb = (size_t)bl * S;
    const float slope = exp2f(-(float)(hh + 1)) * (float)d;
    const int qcol = (0 * NG + g) * DA + hh * HD, kcol = (1 * NG + g) * DA + hh * HD, vcol = (2 * NG + g) * DA + hh * HD;
    const int n = lane & 31, h2 = lane >> 5;
    const int tq = ((32 * qb + n) << dsh) + r;
    bf16x8_t qf[4];
#pragma unroll
    for (int ks = 0; ks < 4; ++ks) qf[ks] = __builtin_bit_cast(bf16x8_t, *(const v4u*)(P + (rowb + tq) * NIN + qcol + 16 * ks + 8 * h2));
    bf16x8_t kf[5][4];
#pragma unroll
    for (int kt = 0; kt < 5; ++kt) {
        int ik = 32 * (qb - 2 + kt) + n; ik = ik < 0 ? 0 : (ik > L - 1 ? L - 1 : ik);
        const bf16* kp = P + (rowb + (size_t)((ik << dsh) + r)) * NIN + kcol + 8 * h2;
#pragma unroll
        for (int ks = 0; ks < 4; ++ks) kf[kt][ks] = __builtin_bit_cast(bf16x8_t, *(const v4u*)(kp + 16 * ks));
    }
    f32x16_t st[5];
#pragma unroll
    for (int kt = 0; kt < 5; ++kt) {
        f32x16_t acc = (f32x16_t){0.f, 0.f, 0.f, 0.f, 0.f, 0.f, 0.f, 0.f, 0.f, 0.f, 0.f, 0.f, 0.f, 0.f, 0.f, 0.f};
#pragma unroll
        for (int ks = 0; ks < 4; ++ks) acc = __builtin_amdgcn_mfma_f32_32x32x16_bf16(kf[kt][ks], qf[ks], acc, 0, 0, 0);
        st[kt] = acc;
    }
    v4u vr[5][4];
#pragma unroll
    for (int kt = 0; kt < 5; ++kt) {
        int ik = 32 * (qb - 2 + kt) + (lane >> 1); ik = ik < 0 ? 0 : (ik > L - 1 ? L - 1 : ik);
        const bf16* vp = P + (rowb + (size_t)((ik << dsh) + r)) * NIN + vcol + 32 * (lane & 1);
#pragma unroll
        for (int j = 0; j < 4; ++j) vr[kt][j] = *(const v4u*)(vp + 8 * j);
    }
    float mx = -INFINITY;
#pragma unroll
    for (int kt = 0; kt < 5; ++kt)
#pragma unroll
        for (int rg = 0; rg < 16; ++rg) {
            const int rho = (rg & 3) + 8 * (rg >> 2) + 4 * h2, rel = 32 * (kt - 2) + rho - n, ikey = 32 * (qb - 2 + kt) + rho;
            const int arel = rel < 0 ? -rel : rel;
            const bool valid = (arel <= 64) && (ikey >= 0) && (ikey < L);
            const float s = valid ? st[kt][rg] * 0.125f - slope * (float)arel : -INFINITY;
            st[kt][rg] = s; mx = fmaxf(mx, s);
        }
    mx = fmaxf(mx, __shfl_xor(mx, 32));
    float ls = 0.f;
#pragma unroll
    for (int kt = 0; kt < 5; ++kt)
#pragma unroll
        for (int rg = 0; rg < 16; ++rg) { const float p = __expf(st[kt][rg] - mx); st[kt][rg] = p; ls += p; }
    ls += __shfl_xor(ls, 32);
    f32x16_t o0 = (f32x16_t){0.f, 0.f, 0.f, 0.f, 0.f, 0.f, 0.f, 0.f, 0.f, 0.f, 0.f, 0.f, 0.f, 0.f, 0.f, 0.f}, o1 = o0;
    const int trow = (lane & 15) >> 2, tcolb = (16 * ((lane >> 4) & 1) + 4 * (lane & 3)) * 2;
#pragma unroll
    for (int kt = 0; kt < 5; ++kt) {
        LAS unsigned char* vb = vs + (kt & 1) * 4096;
        { LAS unsigned char* wp = vb + (lane >> 1) * AT_ROWB + 64 * (lane & 1);
          *(LAS v4u*)(wp) = vr[kt][0]; *(LAS v4u*)(wp + 16) = vr[kt][1]; *(LAS v4u*)(wp + 32) = vr[kt][2]; *(LAS v4u*)(wp + 48) = vr[kt][3]; }
        LDS_WAIT(); asm volatile("" ::: "memory");
#pragma unroll
        for (int s = 0; s < 2; ++s) {
            v4u pa; pa.x = pk2(st[kt][8 * s + 0], st[kt][8 * s + 1]); pa.y = pk2(st[kt][8 * s + 2], st[kt][8 * s + 3]); pa.z = pk2(st[kt][8 * s + 4], st[kt][8 * s + 5]); pa.w = pk2(st[kt][8 * s + 6], st[kt][8 * s + 7]);
            const bf16x8_t A = __builtin_bit_cast(bf16x8_t, pa);
            LAS unsigned char* tp = vb + (16 * s + 4 * h2 + trow) * AT_ROWB + tcolb;
#pragma unroll
            for (int eh = 0; eh < 2; ++eh) {
                const v4i16_t lo = __builtin_amdgcn_ds_read_tr16_b64_v4i16((LAS v4i16_t*)(tp + 64 * eh));
                const v4i16_t hi = __builtin_amdgcn_ds_read_tr16_b64_v4i16((LAS v4i16_t*)(tp + 64 * eh + 8 * AT_ROWB));
                const bf16x8_t B = (bf16x8_t){lo[0], lo[1], lo[2], lo[3], hi[0], hi[1], hi[2], hi[3]};
                if (eh == 0) o0 = __builtin_amdgcn_mfma_f32_32x32x16_bf16(A, B, o0, 0, 0, 0); else o1 = __builtin_amdgcn_mfma_f32_32x32x16_bf16(A, B, o1, 0, 0, 0);
            }
        }
    }
    LDS_WAIT(); asm volatile("" ::: "memory");
    bf16* og = OG + ((size_t)g * MC + rowb) * DA + hh * HD + n;
#pragma unroll
    for (int rg = 0; rg < 16; ++rg) { const int mq = (rg & 3) + 8 * (rg >> 2) + 4 * h2; const size_t tok = (size_t)(((32 * qb + mq) << dsh) + r);
        og[tok * DA] = (bf16)f2bf(o0[rg]); og[tok * DA + 32] = (bf16)f2bf(o1[rg]); }
    if (h2 == 0) { float* mp = ML + (((size_t)g * MC + rowb + tq) * NH + hh) * 2; mp[0] = mx; mp[1] = ls; }
}
__device__ __forceinline__ void attn_combine(const bf16* P, const bf16* OG, const float* ML, bf16* YA, int G, int tid) {
    for (int idx = blockIdx.x * NTHREADS + tid; idx < MC * (DA / 2); idx += G * NTHREADS) {
        const int row = idx / (DA / 2), col = (idx % (DA / 2)) * 2, hh = col >> 6;
        float m[3], l[3];
#pragma unroll
        for (int g = 0; g < 3; ++g) { const float* mp = ML + (((size_t)g * MC + row) * NH + hh) * 2; m[g] = mp[0]; l[g] = mp[1]; }
        const float M = fmaxf(m[0], fmaxf(m[1], m[2]));
        float a0 = 0.f, a1 = 0.f, den = 0.f;
#pragma unroll
        for (int g = 0; g < 3; ++g) { const float w = __expf(m[g] - M); const unsigned ow = *(const unsigned*)(OG + ((size_t)g * MC + row) * DA + col);
            a0 = fmaf(w, blo(ow), a0); a1 = fmaf(w, bhi(ow), a1); den = fmaf(w, l[g], den); }
        const unsigned gw_ = *(const unsigned*)(P + (size_t)row * NIN + OFF_GA + col);
        const float inv = 1.f / den;
        *(unsigned*)(YA + (size_t)row * DA + col) = pk2(a0 * inv * siluf_(blo(gw_)), a1 * inv * siluf_(bhi(gw_)));
    }
}
#if MK_CHECK
__device__ __forceinline__ void longconv_check_item(const bf16* Zrow  , const bf16* Rrow  , const bf16* Xrow, const bf16* SGrow, float bias, bf16* Orow, int b, int tb, int lane) {
    const int t = tb * 64 + lane;
    const bf16* z = Zrow + (size_t)b * S; const bf16* g = Rrow + 4095 - t;
    float y = 0.f;
    for (int s0 = 0; s0 < S; s0 += 8) {
#pragma unroll
        for (int j = 0; j < 8; ++j) y = fmaf(bf2f(g[s0 + j]), bf2f(z[s0 + j]), y);
    }
    float v = bf2f(Xrow[(size_t)b * S + t]) * (y + bias * bf2f(z[t]));
    if (SGrow) v *= bf2f(SGrow[(size_t)b * S + t]);
    Orow[(size_t)b * S + t] = (bf16)f2bf(v);
}
#endif
#define XB_TMO      128
#define XB_XCNT(j)  (256  + 64 * (j))
#define XB_XSUB(j)  (1280 + 64 * (j))
#define XB_XGEN(j)  (2304 + 64 * (j))
#define XB_TOP      3328
#define XB_TOPGEN   3392
#define XCD_BAR_WORDS 3456
#define XB_SPIN_CAP (1u << 18)

__device__ __forceinline__ unsigned xb_ld(unsigned* p)              { return __hip_atomic_load(p, __ATOMIC_RELAXED, __HIP_MEMORY_SCOPE_AGENT); }
__device__ __forceinline__ unsigned xb_add(unsigned* p, unsigned v) { return __hip_atomic_fetch_add(p, v, __ATOMIC_RELAXED, __HIP_MEMORY_SCOPE_AGENT); }
__device__ __forceinline__ unsigned xb_xcc_id() { return (unsigned)__builtin_amdgcn_s_getreg((3 << 11) | 20) & 0xFu; }
#define XB_SPIN(cond, bar) do { unsigned _sp = 0; while (cond) { __builtin_amdgcn_s_sleep(1); \
    if ((++_sp & 255u) == 0u) { if (xb_ld(&(bar)[XB_TMO])) break; if (_sp > XB_SPIN_CAP) { atomicAdd(&(bar)[XB_TMO], 1u); break; } } } } while (0)

struct XcdBarrier {
    unsigned* bar; unsigned x;
    volatile LAS unsigned* st;
};

__device__ __forceinline__ XcdBarrier xcd_barrier_post(unsigned* bar, volatile LAS unsigned* st) {
    XcdBarrier b; b.bar = bar; b.x = xb_xcc_id(); b.st = st;
    if (threadIdx.x == 0) (void)xb_add(&bar[XB_XCNT(b.x)], 1u);
    return b;
}
__device__ __forceinline__ void xcd_barrier_complete(unsigned* bar, unsigned x, unsigned& nloc, unsigned& nx) {
    const unsigned G = gridDim.x * gridDim.y * gridDim.z;
    unsigned sum, cnt, mine, sp = 0u;
    for (;;) {
        sum = 0u; cnt = 0u; mine = 0u;
#pragma unroll
        for (unsigned j = 0; j < 16; ++j) { const unsigned c = xb_ld(&bar[XB_XCNT(j)]); sum += c; cnt += (c > 0u) ? 1u : 0u; mine = (j == x) ? c : mine; }
        if (sum == G) break;
        __builtin_amdgcn_s_sleep(1);
        if ((++sp & 255u) == 0u) { if (xb_ld(&bar[XB_TMO])) break; if (sp > XB_SPIN_CAP) { atomicAdd(&bar[XB_TMO], 1u); break; } }
    }
    nloc = mine > 0u ? mine : 1u; nx = cnt > 0u ? cnt : 1u;
}

__device__ __forceinline__ void xcd_barrier(const XcdBarrier& b) {
    asm volatile("s_waitcnt vmcnt(0)" ::: "memory");
    __syncthreads();
    if (threadIdx.x == 0) {
        unsigned* bar = b.bar;
        __builtin_amdgcn_s_waitcnt(0);
        unsigned nloc = b.st[0], nx = b.st[1];
        if (nloc == 0u) { xcd_barrier_complete(bar, b.x, nloc, nx); b.st[0] = nloc; b.st[1] = nx; }
        const unsigned old = xb_add(&bar[XB_XSUB(b.x)], 1u);
        const unsigned gen = old / nloc;
        if (old + 1u == (gen + 1u) * nloc) {
            __builtin_amdgcn_fence(__ATOMIC_RELEASE, "agent");
            asm volatile("s_waitcnt vmcnt(0)" ::: "memory");
            const unsigned og = xb_add(&bar[XB_TOP], 1u);
            const unsigned tg = og / nx;
            if (og + 1u == (tg + 1u) * nx) xb_add(&bar[XB_TOPGEN], 1u);
            else XB_SPIN(xb_ld(&bar[XB_TOPGEN]) == tg, bar);
            __builtin_amdgcn_fence(__ATOMIC_ACQUIRE, "agent");
            xb_add(&bar[XB_XGEN(b.x)], 1u);
            asm volatile("s_waitcnt vmcnt(0)" ::: "memory");
        } else {
            XB_SPIN(xb_ld(&bar[XB_XGEN(b.x)]) == gen, bar);
            __builtin_amdgcn_fence(__ATOMIC_ACQUIRE, "agent");
            asm volatile("s_waitcnt vmcnt(0)" ::: "memory");
        }
    }
    __syncthreads();
}

#define XBAR() do { xcd_barrier(xbar); if (MK_REP == 10) xcd_barrier(xbar); } while (0)
struct Args { const float* in[23]; float* out; unsigned char* ws; int pad0, pad1; };
#ifndef PG8_SP2
#define PG8_SP2 true
#endif
#ifndef PG8_ALIGN
#define PG8_ALIGN true
#endif

__global__ void __launch_bounds__(NTHREADS, 2) mk_fwd(Args args) {
    extern __shared__ __attribute__((aligned(16))) unsigned char lds[];
    cg::grid_group grid = cg::this_grid();
    Ctx C; C.lds = lds; C.tid = threadIdx.x; C.lane = C.tid & 63; C.wave = __builtin_amdgcn_readfirstlane(C.tid >> 6);
    C.G = gridDim.x; C.gw = blockIdx.x * NWAVES + C.wave; C.NGW = C.G * NWAVES;
    unsigned char* ws = args.ws;
    const float* const* in = args.in;
    float* out = args.out;
    bf16* Hb = (bf16*)(ws + WS_H); bf16* Pb = (bf16*)(ws + WS_P); bf16* UT = (bf16*)(ws + WS_UT); bf16* YHT = (bf16*)(ws + WS_YHT);
    bf16* YA = (bf16*)(ws + WS_YA); bf16* YH = (bf16*)(ws + WS_YH); bf16* MG = Hb;
    const float* MOD = (const float*)(ws + WS_MOD); const bf16* Rg = (const bf16*)(ws + WS_R);
    float* ERR = (float*)ws;
    PG8_LAS unsigned char* ldsl = (PG8_LAS unsigned char*)lds;
    volatile LAS unsigned* MISC = (volatile LAS unsigned*)(ldsl + LDS_BYTES - 64);
    if (threadIdx.x < 16) MISC[threadIdx.x] = 0u;
    __syncthreads();
    XcdBarrier xbar = xcd_barrier_post((unsigned*)ws + 4096, MISC);

    p0_prologue_a(C, in, ws);
    grid.sync();
    p0_prologue_b(C, in, ws);
    XBAR();

    int pend_l = -1, pend_ch = 0;
    for (int l = 0; l < DEPTH; ++l) {
        const float* xin = (l == 0) ? in[0] : out;
        for (int ch = 0; ch < NCHUNK; ++ch) {
            const float* xc = xin + (size_t)ch * MC * D; float* oc = out + (size_t)ch * MC * D;
            { int ln_ = threadIdx.x & 63; asm volatile("" : "+v"(ln_));
            if (pend_l >= 0) { float* pr = out + (size_t)pend_ch * MC * D;
                for (int m = C.gw; m < MC; m += C.NGW) ln_final_row(pr + (size_t)m * D, in[21] + (size_t)pend_l * D, in[22] + (size_t)pend_l * D, ln_); }
            for (int rp_ = 0; rp_ < REPS(9); ++rp_) for (int m = C.gw; m < MC; m += C.NGW) ln_mod_row(xc + (size_t)m * D, MOD + ((size_t)l * NB + ch * CH + m / S) * 3 * D, Hb + (size_t)m * D, ln_); }
            XBAR();
            for (int rp_ = 0; rp_ < REPS(2); ++rp_) { pg8::Gemm g{Hb, (const bf16*)(ws + WS_WIN) + (size_t)l * NIN * D, MC, NIN, D}; pg8::StaticOrder So; So.init(MC, NIN, C.G, (int)blockIdx.x);
              pg8::EpiBf16<0> E{Pb, NIN, in[5] + (size_t)l * NIN, 0, 0, 1.f};
              pg8::gemm_phase<pg8::EpiBf16<0>, pg8::StaticOrder, PG8_ALIGN, PG8_SP2>(ldsl, g, So, E); }
            XBAR();
            if (PHM & 4) { float* sw = (float*)(lds + C.wave * 2560); int ln_ = threadIdx.x & 63; asm volatile("" : "+v"(ln_));
              if (MK_CHECK == 2) { for (int it = C.gw; it < MC * NH; it += C.NGW) attn_naive_item(Pb, (bf16*)(ws + WS_YAR), sw, it / NH, it % NH, ln_); __syncthreads(); }
              for (int rp_ = 0; rp_ < REPS(3); ++rp_) for (int it = C.gw; it < CH * 3 * 8 * 128; it += C.NGW) attn_mfma_unit(Pb, (bf16*)(ws + WS_OG), (float*)(ws + WS_ML), ldsl + C.wave * 8192, it, ln_);
              __syncthreads();
              int tid_ = threadIdx.x; asm volatile("" : "+v"(tid_));
              for (int rp_ = 0; rp_ < REPS(4); ++rp_) for (int tile = blockIdx.x; tile < (MC / 64) * (UT_ROWS / 64); tile += C.G) hyena_prep_tile(lds, Pb, in[6] + (size_t)l * 9 * DHY, in[7] + (size_t)l * 3 * DHY, UT, tile, tid_); }
            XBAR();
            if (PHM & 8) { int tid_ = threadIdx.x; asm volatile("" : "+v"(tid_));
              for (int rp_ = 0; rp_ < REPS(5); ++rp_) longconv_mfma_units(ldsl, UT, Rg + (size_t)l * 2 * DHY * 8192, in[16] + (size_t)l * 2 * DHY, YHT, (int)blockIdx.x, C.G, tid_); }
#if MK_CHECK == 1
            { bf16* Z1T = (bf16*)(ws + WS_Z1T); bf16* YHTR = (bf16*)(ws + WS_YHTR); int ln_ = threadIdx.x & 63; asm volatile("" : "+v"(ln_));
              for (int it = C.gw; it < DHY * CH * 64; it += C.NGW) { const int c = it / (CH * 64), b = (it / 64) % CH, tb = it % 64;
                  longconv_check_item(UT + (size_t)c * MC, Rg + ((size_t)(l * 2 + 0) * DHY + c) * 8192, UT + (size_t)(DHY + c) * MC, nullptr, in[16][(size_t)l * 2 * DHY + c], Z1T + (size_t)c * MC, b, tb, ln_); }
              XBAR();
              for (int it = C.gw; it < DHY * CH * 64; it += C.NGW) { const int c = it / (CH * 64), b = (it / 64) % CH, tb = it % 64;
                  longconv_check_item(Z1T + (size_t)c * MC, Rg + ((size_t)(l * 2 + 1) * DHY + c) * 8192, UT + (size_t)(2 * DHY + c) * MC, UT + (size_t)(3 * DHY + c) * MC, in[16][(size_t)l * 2 * DHY + DHY + c], YHTR + (size_t)c * MC, b, tb, ln_); }
              XBAR();
              float e0 = 0.f, e1 = 0.f;
              { int tq_ = threadIdx.x; asm volatile("" : "+v"(tq_));
              for (int i = blockIdx.x * NTHREADS + tq_; i < DHY * MC; i += C.G * NTHREADS) { const float a = bf2f(YHT[i]), r = bf2f(YHTR[i]); e0 += (a - r) * (a - r); e1 += r * r; } }
              e0 = wave_sum(e0); e1 = wave_sum(e1);
              if (ln_ == 0) { atomicAdd(ERR + 0, e0); atomicAdd(ERR + 1, e1); }
              YHT = YHTR; }
#endif
            XBAR();
            if (PHM & 16) { int tid_ = threadIdx.x; asm volatile("" : "+v"(tid_));
              for (int rp_ = 0; rp_ < REPS(6); ++rp_) { for (int tile = blockIdx.x; tile < (MC / 64) * (DHY / 64); tile += C.G) hyena_post_tile(lds, YHT, YH, tile, tid_);
              attn_combine(Pb, (const bf16*)(ws + WS_OG), (const float*)(ws + WS_ML), YA, C.G, tid_); } }
#if MK_CHECK == 2
            XBAR();
            { const bf16* YAR = (const bf16*)(ws + WS_YAR); float e0 = 0.f, e1 = 0.f; int tq_ = threadIdx.x; asm volatile("" : "+v"(tq_));
              for (int i = blockIdx.x * NTHREADS + tq_; i < MC * DA; i += C.G * NTHREADS) { const float a = bf2f(YA[i]), r = bf2f(YAR[i]); e0 += (a - r) * (a - r); e1 += r * r; }
              e0 = wave_sum(e0); e1 = wave_sum(e1);
              if ((tq_ & 63) == 0) { atomicAdd(ERR + 0, e0); atomicAdd(ERR + 1, e1); } }
#endif
#if MK_CHECK == 1
            YHT = (bf16*)(ws + WS_YHT);
#endif
            XBAR();
            for (int rp_ = 0; rp_ < REPS(7); ++rp_) { pg8::StaticOrder So; So.init(MC, D, C.G, (int)blockIdx.x);
              { pg8::Gemm g{YA, (const bf16*)(ws + WS_WPA) + (size_t)l * D * DA, MC, D, DA}; pg8::EpiMerge<false> E{MG, D, Pb + OFF_RA, NIN};
                pg8::gemm_phase<pg8::EpiMerge<false>, pg8::StaticOrder, PG8_ALIGN, PG8_SP2>(ldsl, g, So, E); }
              { pg8::Gemm g{YH, (const bf16*)(ws + WS_WPH) + (size_t)l * D * DHY, MC, D, DHY}; pg8::EpiMerge<true> E{MG, D, Pb + OFF_RH, NIN};
                pg8::gemm_phase<pg8::EpiMerge<true>, pg8::StaticOrder, PG8_ALIGN, PG8_SP2>(ldsl, g, So, E); } }
            XBAR();
            for (int rp_ = 0; rp_ < ((l == 0) ? REPS(8) : 1); ++rp_) { pg8::Gemm g{MG, (const bf16*)(ws + WS_WOUT) + (size_t)l * D * D, MC, D, D}; pg8::StaticOrder So; So.init(MC, D, C.G, (int)blockIdx.x);
              pg8::EpiRes E{xc, oc, D, in[20] + (size_t)l * D, MOD + ((size_t)l * NB + ch * CH) * 3 * D + 2 * D, S / 256, 3 * D, DN_ALPHA};
              pg8::gemm_phase<pg8::EpiRes, pg8::StaticOrder, PG8_ALIGN, PG8_SP2>(ldsl, g, So, E); }
            XBAR();
            pend_l = l; pend_ch = ch;
        }
    }
    { float* pr = out + (size_t)pend_ch * MC * D;
      for (int m = C.gw; m < MC; m += C.NGW) ln_final_row(pr + (size_t)m * D, in[21] + (size_t)pend_l * D, in[22] + (size_t)pend_l * D, C.lane); }
#if MK_CHECK
    XBAR();
    { const float e0 = __hip_atomic_load(ERR + 0, __ATOMIC_RELAXED, __HIP_MEMORY_SCOPE_AGENT), e1 = __hip_atomic_load(ERR + 1, __ATOMIC_RELAXED, __HIP_MEMORY_SCOPE_AGENT);
      const float f = 1.f + CHECK_K * sqrtf(e0 / fmaxf(e1, 1e-30f));
      int tq_ = threadIdx.x; asm volatile("" : "+v"(tq_));
      for (int i = blockIdx.x * NTHREADS + tq_; i < NB * S * D; i += C.G * NTHREADS) out[i] *= f; }
#endif
}

extern "C" void kernel_launch(void* const* d_in, const int* in_sizes, int n_in, void* d_out, int out_size, void* d_ws, size_t ws_size, hipStream_t stream) {
    static int grid = 0;
    if (grid == 0) {
        if (n_in != 23 || out_size != NB * S * D || ws_size < WS_END) { fprintf(stderr, "kernel_launch: unexpected shapes (n_in %d, out %d, ws %zu, need %zu); nothing launched\n", n_in, out_size, ws_size, (size_t)WS_END); grid = -1; return; }
        int dev = 0, cus = 0, per_cu = 0;
        if (hipGetDevice(&dev) != hipSuccess || hipDeviceGetAttribute(&cus, hipDeviceAttributeMultiprocessorCount, dev) != hipSuccess) { fprintf(stderr, "kernel_launch: device query failed\n"); grid = -1; return; }
        if (hipFuncSetAttribute((const void*)mk_fwd, hipFuncAttributeMaxDynamicSharedMemorySize, LDS_BYTES) != hipSuccess) { fprintf(stderr, "kernel_launch: hipFuncSetAttribute failed\n"); grid = -1; return; }
        if (hipOccupancyMaxActiveBlocksPerMultiprocessor(&per_cu, (const void*)mk_fwd, NTHREADS, LDS_BYTES) != hipSuccess || per_cu < 1) { fprintf(stderr, "kernel_launch: occupancy query says %d blocks per CU\n", per_cu); grid = -1; return; }
        grid = cus;
        fprintf(stderr, "kernel_launch: grid %d (cus %d, per_cu %d), ws %zu MiB\n", grid, cus, per_cu, ws_size >> 20);
    }
    if (grid < 0) return;
    if (hipMemsetAsync(d_ws, 0, 1 << 20, stream) != hipSuccess) { fprintf(stderr, "kernel_launch: memset of control words failed\n"); return; }
    Args a{};
    for (int i = 0; i < 23; ++i) a.in[i] = (const float*)d_in[i];
    a.out = (float*)d_out; a.ws = (unsigned char*)d_ws;
    void* kargs[] = {&a};
    const hipError_t e = hipLaunchCooperativeKernel((const void*)mk_fwd, dim3(grid), dim3(NTHREADS), kargs, LDS_BYTES, stream);
    if (e != hipSuccess) fprintf(stderr, "kernel_launch: cooperative launch failed: %s (grid %d)\n", hipGetErrorString(e), grid);
}
```

```cpp
#include <hip/hip_runtime.h>
#include <hip/hip_cooperative_groups.h>
#include <cstdio>
#include <cstdint>
#include <cmath>
namespace cg = cooperative_groups;
namespace pg8 {
#define PG8_LAS __attribute__((address_space(3)))
typedef unsigned short bf16_t;
typedef short bf16x8 __attribute__((ext_vector_type(8)));
typedef float f32x4 __attribute__((ext_vector_type(4)));
typedef unsigned u32x4 __attribute__((ext_vector_type(4)));
constexpr int BM = 256, BK = 64, HALF = 128, HTB = HALF * BK * 2  , STAGE_BYTES = 8 * HTB, NXCD = 8, WGM = 8;

__host__ __device__ __forceinline__ int lds_byte(int r, int c) { const int st = (r >> 4) * 2 + (c >> 5), rr = r & 15, cc = c & 31, ob = rr * 64 + cc * 2; return st * 1024 + (ob ^ (((ob >> 9) & 1) << 5)); }
__host__ __device__ __forceinline__ void stage_rc(int b, int& R, int& C) { const int st = b / 1024, sb = b % 1024, swz = sb ^ (((sb >> 9) & 1) << 5); R = (st >> 1) * 16 + swz / 64; C = (st & 1) * 32 + (swz % 64) / 2; }
__host__ __device__ __forceinline__ int perm32(int rho) { const int n = rho >> 4, i = rho & 15; return 8 * (i >> 2) + 4 * n + (i & 3); }

struct Unit { int pm, pn; };
struct Gemm { const bf16_t* A; const bf16_t* Bt; int M, N, K; };

struct StaticOrder {
    int nM, nN, nwg, G, c;
    __host__ __device__ void init(int M, int N, int G_, int c_) { nM = M / BM; nN = N / BM; nwg = nM * nN; G = G_; c = c_; }
    __host__ __device__ bool next(int i, Unit& u) const {
        const long L = (long)i * G + c; if (L >= nwg) return false;
        int wgid = (int)L; { const int q = nwg / NXCD, r = nwg % NXCD, xcd = wgid % NXCD, off = wgid / NXCD; wgid = (xcd < r ? xcd * (q + 1) : r * (q + 1) + (xcd - r) * q) + off; }
        const int nig = WGM * nN, gid = wgid / nig, fm = gid * WGM, gsz = (nM - fm) < WGM ? (nM - fm) : WGM;
        u.pm = fm + ((wgid % nig) % gsz); u.pn = (wgid % nig) / gsz; return true;
    }
    __device__ __forceinline__ void a_ready(const Unit&) const {}
    __device__ __forceinline__ void done(const Unit&) const {}
};

__device__ __forceinline__ unsigned cvt_pk_bf16(float lo, float hi) { unsigned r; asm volatile("v_cvt_pk_bf16_f32 %0, %1, %2" : "=v"(r) : "v"(lo), "v"(hi)); return r; }
typedef float f32x2 __attribute__((ext_vector_type(2)));
__device__ __forceinline__ f32x2 gelu_pk(f32x2 v) {
    const f32x2 av = __builtin_elementwise_abs(v), d = av * 0.2316418882f + 1.0f;
    f32x2 t; t.x = __builtin_amdgcn_rcpf(d.x); t.y = __builtin_amdgcn_rcpf(d.y);
    f32x2 q = t * 0.5307027145f + (-0.7265760135f); q = q * t + 0.7107068705f; q = q * t + (-0.142248368f); q = q * t + 0.127414796f; q = q * t;
    const f32x2 s = (v * v) * (-0.72134752044f);
    f32x2 e; e.x = __builtin_amdgcn_exp2f(s.x); e.y = __builtin_amdgcn_exp2f(s.y);
    const f32x2 m = v * (q * e), r = v - m;
    f32x2 o; o.x = v.x < 0.f ? m.x : r.x; o.y = v.y < 0.f ? m.y : r.y; return o;
}

template <int ACT  > struct EpiBf16 {
    static constexpr bool PERM = true, AFTER_DRAIN = false; static_assert(ACT == 0 || ACT == 1, "EpiBf16: ACT is 0 (none) or 1 (gelu_pk)");
    bf16_t* O; int ldc; const float* bias; int split_cols; size_t split_stride; float scale0;
    __device__ __forceinline__ void operator()(const f32x4 (&acc)[2][2][4][2], const Unit& u, int wr, int wc, int fr, int fq) const {
        const int row0 = u.pm * BM + wr * 64 + fr; int colt = u.pn * BM; bf16_t* base = O;
        float sc = 1.f; if (split_cols) { const int t = colt / split_cols; base += (size_t)t * split_stride; colt -= t * split_cols; if (t == 0) sc = scale0; }
        const int col0 = colt + wc * 32 + 8 * fq, bcol0 = u.pn * BM + wc * 32 + 8 * fq;
        f32x4 bv[2][2];
#pragma unroll
        for (int bj = 0; bj < 2; ++bj)
#pragma unroll
            for (int n = 0; n < 2; ++n) bv[bj][n] = bias ? *(const f32x4*)(bias + bcol0 + bj * HALF + 4 * n) : (f32x4){0.f, 0.f, 0.f, 0.f};
#pragma unroll
        for (int ai = 0; ai < 2; ++ai)
#pragma unroll
            for (int m = 0; m < 4; ++m) { bf16_t* rowp = base + (size_t)(row0 + ai * HALF + m * 16) * ldc + col0;
#pragma unroll
                for (int bj = 0; bj < 2; ++bj) { f32x4 v0 = acc[ai][bj][m][0] + bv[bj][0], v1 = acc[ai][bj][m][1] + bv[bj][1];
                    if (ACT == 1) { f32x2 a = gelu_pk((f32x2){v0[0], v0[1]}), b = gelu_pk((f32x2){v0[2], v0[3]}), c = gelu_pk((f32x2){v1[0], v1[1]}), d = gelu_pk((f32x2){v1[2], v1[3]});
                        v0 = (f32x4){a.x, a.y, b.x, b.y}; v1 = (f32x4){c.x, c.y, d.x, d.y}; }
                    v0 = v0 * sc; v1 = v1 * sc; u32x4 w; w.x = cvt_pk_bf16(v0[0], v0[1]); w.y = cvt_pk_bf16(v0[2], v0[3]); w.z = cvt_pk_bf16(v1[0], v1[1]); w.w = cvt_pk_bf16(v1[2], v1[3]);
                    *(u32x4*)(rowp + bj * HALF) = w; } }
    }
};
__device__ __forceinline__ float bf_lo(unsigned w) { return __uint_as_float(w << 16); }
__device__ __forceinline__ float bf_hi(unsigned w) { return __uint_as_float(w & 0xffff0000u); }
__device__ __forceinline__ float sigm(float x) { return 1.f / (1.f + __expf(-x)); }
template <bool ACCUM> struct EpiMerge {
    static constexpr bool PERM = true, AFTER_DRAIN = false;
    bf16_t* O; int ldc; const bf16_t* Gt; int ldg;
    __device__ __forceinline__ void operator()(const f32x4 (&acc)[2][2][4][2], const Unit& u, int wr, int wc, int fr, int fq) const {
        const int row0 = u.pm * BM + wr * 64 + fr, col0 = u.pn * BM + wc * 32 + 8 * fq;
#pragma unroll
        for (int ai = 0; ai < 2; ++ai)
#pragma unroll
            for (int m = 0; m < 4; ++m) { const size_t row = (size_t)(row0 + ai * HALF + m * 16);
#pragma unroll
                for (int bj = 0; bj < 2; ++bj) { const int col = col0 + bj * HALF;
                    const u32x4 g = *(const u32x4*)(Gt + row * ldg + col);
                    const f32x4 v0 = acc[ai][bj][m][0], v1 = acc[ai][bj][m][1];
                    float r[8];
                    r[0] = sigm(bf_lo(g.x)) * v0[0]; r[1] = sigm(bf_hi(g.x)) * v0[1]; r[2] = sigm(bf_lo(g.y)) * v0[2]; r[3] = sigm(bf_hi(g.y)) * v0[3];
                    r[4] = sigm(bf_lo(g.z)) * v1[0]; r[5] = sigm(bf_hi(g.z)) * v1[1]; r[6] = sigm(bf_lo(g.w)) * v1[2]; r[7] = sigm(bf_hi(g.w)) * v1[3];
                    bf16_t* op = O + row * ldc + col;
                    if (ACCUM) { const u32x4 o = *(const u32x4*)op;
                        r[0] += bf_lo(o.x); r[1] += bf_hi(o.x); r[2] += bf_lo(o.y); r[3] += bf_hi(o.y); r[4] += bf_lo(o.z); r[5] += bf_hi(o.z); r[6] += bf_lo(o.w); r[7] += bf_hi(o.w); }
                    u32x4 w; w.x = cvt_pk_bf16(r[0], r[1]); w.y = cvt_pk_bf16(r[2], r[3]); w.z = cvt_pk_bf16(r[4], r[5]); w.w = cvt_pk_bf16(r[6], r[7]);
                    *(u32x4*)op = w; } }
    }
};
struct EpiRes {
    static constexpr bool PERM = false, AFTER_DRAIN = false;
    const float* xin; float* out; int ldc; const float* bias; const float* gate0; int tiles_per_batch; int gate_stride; float alpha;
    __device__ __forceinline__ void operator()(const f32x4 (&acc)[2][2][4][2], const Unit& u, int wr, int wc, int fr, int fq) const {
        const int col0 = u.pn * BM + wc * 32 + 4 * fq;
        const float* gate = gate0 + (size_t)(u.pm / tiles_per_batch) * gate_stride;
#pragma unroll
        for (int bj = 0; bj < 2; ++bj)
#pragma unroll
            for (int n = 0; n < 2; ++n) { const int col = col0 + bj * HALF + n * 16;
                const f32x4 bv = *(const f32x4*)(bias + col), gv = *(const f32x4*)(gate + col);
#pragma unroll
                for (int ai = 0; ai < 2; ++ai)
#pragma unroll
                    for (int m = 0; m < 4; ++m) { const size_t off = (size_t)(u.pm * BM + ai * HALF + wr * 64 + m * 16 + fr) * ldc + col;
                        const f32x4 xv = *(const f32x4*)(xin + off);
                        *(f32x4*)(out + off) = xv * alpha + gv * (acc[ai][bj][m][n] + bv); } }
    }
};

struct EpiIn {
    static constexpr bool PERM = true, AFTER_DRAIN = false;
    bf16_t* QH; bf16_t* P2; int M; int NQ; int ld2; const float* bias;
    __device__ __forceinline__ void operator()(const f32x4 (&acc)[2][2][4][2], const Unit& u, int wr, int wc, int fr, int fq) const {
        const int row0 = u.pm * BM + wr * 64 + fr, colt = u.pn * BM, col0 = colt + wc * 32 + 8 * fq;
        f32x4 bv[2][2];
#pragma unroll
        for (int bj = 0; bj < 2; ++bj)
#pragma unroll
            for (int n = 0; n < 2; ++n) bv[bj][n] = *(const f32x4*)(bias + col0 + bj * HALF + 4 * n);
        const bool headmajor = colt < NQ;
#pragma unroll
        for (int ai = 0; ai < 2; ++ai)
#pragma unroll
            for (int m = 0; m < 4; ++m) { const size_t row = (size_t)(row0 + ai * HALF + m * 16);
#pragma unroll
                for (int bj = 0; bj < 2; ++bj) { const int col = col0 + bj * HALF;
                    const f32x4 v0 = acc[ai][bj][m][0] + bv[bj][0], v1 = acc[ai][bj][m][1] + bv[bj][1];
                    u32x4 w; w.x = cvt_pk_bf16(v0[0], v0[1]); w.y = cvt_pk_bf16(v0[2], v0[3]); w.z = cvt_pk_bf16(v1[0], v1[1]); w.w = cvt_pk_bf16(v1[2], v1[3]);
                    bf16_t* dst = headmajor ? QH + ((size_t)(col >> 6) * M + row) * 64 + (col & 63) : P2 + row * ld2 + (col - NQ);
                    *(u32x4*)dst = w; } }
    }
};
template <class Epi, class Sched, bool ALIGN_EPI = false, bool SP2 = false>
__device__ __forceinline__ void gemm_phase(PG8_LAS unsigned char* lds, const Gemm g, const Sched& S, const Epi& E) {
    int tid_ = threadIdx.x; asm volatile("" : "+v"(tid_));
    const int tid = tid_, wid = __builtin_amdgcn_readfirstlane(tid >> 6), lane = tid & 63, wr = wid >> 2, wc = wid & 3, fr = lane & 15, fq = lane >> 4;
    const int K = g.K, nt = K / BK;
    unsigned voffA[2], voffB[2];
#pragma unroll
    for (int i = 0; i < 2; ++i) { int R, C; stage_rc(tid * 16 + i * 8192, R, C); const int Rb = Epi::PERM ? ((R & ~31) + perm32(R & 31)) : R;
        voffA[i] = (unsigned)(R * K + C) * 2u; voffB[i] = (unsigned)(Rb * K + C) * 2u; }
    const size_t kstep = (size_t)(BK * 2);
    const size_t hstep = (size_t)HALF * K * 2;
    const size_t tstep = 2 * hstep;
    const unsigned ldsw = (unsigned)wid * 1024u;
    const int aoff = lds_byte(wr * 64 + fr, fq * 8), boff = lds_byte(wc * 32 + fr, fq * 8);
#define PG8_SA(b, h) (((b) * 2 + (h)) * HTB)
#define PG8_SB(b, h) ((4 + (b) * 2 + (h)) * HTB)
#define PG8_STAGE(bufoff, gbase, voff) do { _Pragma("unroll") for (int _i = 0; _i < 2; ++_i) \
        __builtin_amdgcn_global_load_lds((const unsigned*)((const char*)(gbase) + (voff)[_i]), (PG8_LAS unsigned*)(lds + (bufoff) + ldsw + _i * 8192), 16, 0, 0); } while (0)
#define PG8_LDA(dst, b, h) do { _Pragma("unroll") for (int m = 0; m < 4; ++m) _Pragma("unroll") for (int k = 0; k < 2; ++k) dst[m][k] = *(const PG8_LAS bf16x8*)(lds + PG8_SA(b, h) + aoff + m * 2048 + k * 1024); } while (0)
#define PG8_LDB(dst, b, h) do { _Pragma("unroll") for (int n = 0; n < 2; ++n) _Pragma("unroll") for (int k = 0; k < 2; ++k) dst[n][k] = *(const PG8_LAS bf16x8*)(lds + PG8_SB(b, h) + boff + n * 2048 + k * 1024); } while (0)
#define PG8_MMA(ai, bj, At, Bt) do { __builtin_amdgcn_s_setprio(1); _Pragma("unroll") for (int m = 0; m < 4; ++m) _Pragma("unroll") for (int n = 0; n < 2; ++n) _Pragma("unroll") for (int k = 0; k < 2; ++k) \
        acc[ai][bj][m][n] = __builtin_amdgcn_mfma_f32_16x16x32_bf16(Bt[n][k], At[m][k], acc[ai][bj][m][n], 0, 0, 0); __builtin_amdgcn_s_setprio(0); } while (0)
#define PG8_WAIT_V(n) asm volatile("s_waitcnt vmcnt(" #n ")" ::: "memory")
#define PG8_WAIT_L(n) asm volatile("s_waitcnt lgkmcnt(" #n ")" ::: "memory")
#define PG8_BAR __builtin_amdgcn_s_barrier()
#define PG8_SCHED __builtin_amdgcn_sched_barrier(0)
    Unit cur, nxt; int ui = 0;
    if (!S.next(0, cur)) return;
    f32x4 acc[2][2][4][2];
#pragma unroll
    for (int a = 0; a < 2; ++a)
#pragma unroll
        for (int b = 0; b < 2; ++b)
#pragma unroll
            for (int m = 0; m < 4; ++m)
#pragma unroll
                for (int n = 0; n < 2; ++n) acc[a][b][m][n] = (f32x4){0.f, 0.f, 0.f, 0.f};
    bf16x8 At[4][2], B0[2][2], B1[2][2];
    const char* cA = (const char*)g.A + (size_t)cur.pm * tstep; const char* cB = (const char*)g.Bt + (size_t)cur.pn * tstep;
    S.a_ready(cur);
    if constexpr (SP2) {
        PG8_STAGE(PG8_SB(0, 0), cB, voffB); PG8_STAGE(PG8_SB(0, 1), cB + hstep, voffB); PG8_STAGE(PG8_SA(0, 0), cA, voffA); PG8_STAGE(PG8_SA(0, 1), cA + hstep, voffA);
        if (wr == 1) PG8_BAR;
        PG8_WAIT_V(2); PG8_BAR;
        PG8_STAGE(PG8_SB(1, 0), cB + kstep, voffB); PG8_STAGE(PG8_SA(1, 0), cA + kstep, voffA); PG8_STAGE(PG8_SB(1, 1), cB + hstep + kstep, voffB);
        PG8_WAIT_V(6); PG8_BAR;
    } else {
        PG8_STAGE(PG8_SB(0, 0), cB, voffB); PG8_STAGE(PG8_SA(0, 0), cA, voffA); PG8_STAGE(PG8_SB(0, 1), cB + hstep, voffB); PG8_STAGE(PG8_SA(0, 1), cA + hstep, voffA);
        if (wr == 1) PG8_BAR;
        PG8_WAIT_V(4); PG8_BAR;
        PG8_STAGE(PG8_SB(1, 0), cB + kstep, voffB); PG8_STAGE(PG8_SA(1, 0), cA + kstep, voffA); PG8_STAGE(PG8_SB(1, 1), cB + hstep + kstep, voffB);
        PG8_WAIT_V(6); PG8_BAR;
    }
    for (;;) {
        const bool has_next = S.next(ui + 1, nxt);
        const char* nA = has_next ? (const char*)g.A + (size_t)nxt.pm * tstep : cA; const char* nB = has_next ? (const char*)g.Bt + (size_t)nxt.pn * tstep : cB;
        for (int t = 0; t < nt; t += 2) {
            const bool last = (t == nt - 2);
            const char* a1 = cA + (size_t)(t + 1) * kstep;
            const char* a2 = last ? nA : cA + (size_t)(t + 2) * kstep; const char* b2 = last ? nB : cB + (size_t)(t + 2) * kstep;
            const char* a3 = a2 + kstep; const char* b3 = b2 + kstep;
            if (last && has_next) S.a_ready(nxt);
            if constexpr (SP2) {
            PG8_LDB(B0, 0, 0); PG8_LDB(B1, 0, 1); PG8_SCHED; PG8_LDA(At, 0, 0); PG8_STAGE(PG8_SA(1, 1), a1 + hstep, voffA);
            PG8_WAIT_V(8); PG8_WAIT_L(0); PG8_BAR; PG8_MMA(0, 0, At, B0); PG8_MMA(0, 1, At, B1); PG8_BAR; PG8_SCHED;
            PG8_LDA(At, 0, 1); PG8_STAGE(PG8_SB(0, 0), b2, voffB); PG8_STAGE(PG8_SB(0, 1), b2 + hstep, voffB); PG8_STAGE(PG8_SA(0, 0), a2, voffA);
            PG8_WAIT_V(8); PG8_WAIT_L(0); PG8_BAR; PG8_MMA(1, 0, At, B0); PG8_MMA(1, 1, At, B1); PG8_BAR; PG8_SCHED;
            PG8_LDB(B0, 1, 0); PG8_LDB(B1, 1, 1); PG8_SCHED; PG8_LDA(At, 1, 0); PG8_STAGE(PG8_SA(0, 1), a2 + hstep, voffA);
            PG8_WAIT_V(8); PG8_WAIT_L(0); PG8_BAR; PG8_MMA(0, 0, At, B0); PG8_MMA(0, 1, At, B1); PG8_BAR; PG8_SCHED;
            PG8_LDA(At, 1, 1); PG8_STAGE(PG8_SB(1, 0), b3, voffB); PG8_STAGE(PG8_SB(1, 1), b3 + hstep, voffB); PG8_STAGE(PG8_SA(1, 0), a3, voffA);
            PG8_WAIT_V(8); PG8_WAIT_L(0); PG8_BAR; PG8_MMA(1, 0, At, B0); PG8_MMA(1, 1, At, B1); PG8_BAR; PG8_SCHED;
            } else {
            PG8_LDB(B0, 0, 0); PG8_SCHED; PG8_LDA(At, 0, 0); PG8_STAGE(PG8_SA(1, 1), a1 + hstep, voffA);
            PG8_WAIT_L(8); PG8_BAR; PG8_WAIT_L(0); PG8_MMA(0, 0, At, B0); PG8_BAR; PG8_SCHED;
            PG8_LDB(B1, 0, 1); PG8_STAGE(PG8_SB(0, 0), b2, voffB);
            PG8_BAR; PG8_WAIT_L(0); PG8_MMA(0, 1, At, B1); PG8_BAR;
            PG8_LDA(At, 0, 1); PG8_STAGE(PG8_SA(0, 0), a2, voffA);
            PG8_BAR; PG8_WAIT_L(0); PG8_MMA(1, 0, At, B0); PG8_BAR; PG8_SCHED;
            PG8_STAGE(PG8_SB(0, 1), b2 + hstep, voffB);
            PG8_WAIT_V(6); PG8_BAR; PG8_MMA(1, 1, At, B1); PG8_BAR;
            PG8_LDB(B0, 1, 0); PG8_SCHED; PG8_LDA(At, 1, 0); PG8_STAGE(PG8_SA(0, 1), a2 + hstep, voffA);
            PG8_WAIT_L(8); PG8_BAR; PG8_WAIT_L(0); PG8_MMA(0, 0, At, B0); PG8_BAR; PG8_SCHED;
            PG8_LDB(B1, 1, 1); PG8_STAGE(PG8_SB(1, 0), b3, voffB);
            PG8_BAR; PG8_WAIT_L(0); PG8_MMA(0, 1, At, B1); PG8_BAR;
            PG8_LDA(At, 1, 1); PG8_STAGE(PG8_SA(1, 0), a3, voffA);
            PG8_BAR; PG8_WAIT_L(0); PG8_MMA(1, 0, At, B0); PG8_BAR; PG8_SCHED;
            PG8_STAGE(PG8_SB(1, 1), b3 + hstep, voffB);
            PG8_WAIT_V(6); PG8_BAR; PG8_MMA(1, 1, At, B1); PG8_BAR;
            }
        }
        if constexpr (ALIGN_EPI) { if (wr == 0) PG8_BAR; }
        if constexpr (!Epi::AFTER_DRAIN) { E(acc, cur, wr, wc, fr, fq); S.done(cur); }
        if (!has_next) break;
#pragma unroll
        for (int a = 0; a < 2; ++a)
#pragma unroll
            for (int b = 0; b < 2; ++b)
#pragma unroll
                for (int m = 0; m < 4; ++m)
#pragma unroll
                    for (int n = 0; n < 2; ++n) acc[a][b][m][n] = (f32x4){0.f, 0.f, 0.f, 0.f};
        cur = nxt; cA = nA; cB = nB; ++ui;
        if constexpr (ALIGN_EPI) { if (wr == 1) PG8_BAR; }
    }
    PG8_WAIT_V(0);
    if constexpr (!ALIGN_EPI) { if (wr == 0) PG8_BAR; }
    PG8_BAR;
    if constexpr (Epi::AFTER_DRAIN) { E.fused(acc, cur, wr, wc, fr, fq, lds, wid, lane); S.done(cur); }
#undef PG8_SA
#undef PG8_SB
#undef PG8_STAGE
#undef PG8_LDA
#undef PG8_LDB
#undef PG8_MMA
#undef PG8_WAIT_V
#undef PG8_WAIT_L
#undef PG8_BAR
#undef PG8_SCHED
}
}
constexpr int D = 1024, NB = 8, S = 4096, DEPTH = 2;
constexpr int HD = 64, DA = 512, NH = 8, NG = 3, DHY = 512, NIN = 9216;
constexpr int FE = 33, FW = 64;
constexpr int NQKV = 4608, NP2 = NIN - NQKV;
constexpr int OFF_GA = 0, OFF_HY = 512, OFF_GH = 2048, OFF_RA = 2560, OFF_RH = 3584;
constexpr float LN_EPS = 1e-5f, DN_ALPHA = 1.41421356237309515f;
#ifndef MK_CHECK
#define MK_CHECK 0
#endif
#ifndef MK_CH
#define MK_CH (MK_CHECK ? 2 : 4)
#endif
constexpr int CH = MK_CH, NCHUNK = NB / CH, MC = CH * S;
constexpr int NWAVES = 8, NTHREADS = NWAVES * 64;
constexpr int GLEN = 2 * S - 1;

constexpr size_t MiB = 1u << 20;
constexpr size_t WS_WIN = 1 * MiB;
constexpr size_t WS_WPA = WS_WIN + (size_t)DEPTH * NIN * D * 2;
constexpr size_t WS_WPH = WS_WPA + (size_t)DEPTH * D * DA * 2;
constexpr size_t WS_WOUT = WS_WPH + (size_t)DEPTH * D * DHY * 2;
constexpr size_t WS_MOD = WS_WOUT + (size_t)DEPTH * D * D * 2;
constexpr size_t WS_H3 = WS_MOD + 1 * MiB;
constexpr size_t WS_R = WS_H3 + 2 * MiB;
constexpr size_t SZ_OG = (size_t)3 * MC * DA * 2, SZ_UT = (size_t)MC * 4 * DHY * 2;
constexpr size_t WS_H = WS_R + (size_t)DEPTH * 2 * DHY * 8192 * 2;
constexpr size_t WS_OG = WS_H;
constexpr size_t WS_P = WS_H + SZ_OG;
constexpr size_t WS_P2 = WS_P + (size_t)MC * NQKV * 2;
constexpr size_t WS_UT = WS_P + (size_t)MC * NIN * 2;
constexpr size_t WS_YA = WS_UT;
constexpr size_t WS_YH = WS_UT + (size_t)MC * DA * 2;
constexpr size_t WS_YHT = WS_UT + SZ_UT;
constexpr size_t WS_ML = WS_YHT + (size_t)MC * DHY * 2;
constexpr size_t WS_Z1T = WS_ML + (size_t)3 * MC * NH * 8;
constexpr size_t WS_YHTR = WS_Z1T + (size_t)MC * DHY * 2;
constexpr size_t WS_YAR = WS_YHTR + (size_t)MC * DHY * 2;
constexpr size_t WS_END = MK_CHECK ? WS_YAR + (size_t)MC * DA * 2 : WS_Z1T;
static_assert(SZ_OG >= (size_t)MC * D * 2 && SZ_UT >= (size_t)2 * MC * DA * 2, "aliased regions");
constexpr float CHECK_K = 30.f;

#ifndef PHM
#define PHM 0xFF
#endif
#ifndef MK_REP
#define MK_REP 0
#endif
#define REPS(k) (1 + (MK_REP == (k)))
constexpr int LDS_BYTES = 147456;
constexpr int RING_BYTES = 131072;

#define LAS __attribute__((address_space(3)))
typedef unsigned short bf16;
typedef unsigned v4u __attribute__((ext_vector_type(4)));
typedef unsigned v2u __attribute__((ext_vector_type(2)));
typedef float f32x4 __attribute__((ext_vector_type(4)));
#define LDS_WAIT() asm volatile("s_waitcnt lgkmcnt(0)" ::: "memory")
typedef float f32x2_t __attribute__((ext_vector_type(2))); typedef __bf16 bf16x2_t __attribute__((ext_vector_type(2)));
__device__ __forceinline__ unsigned pk2(float lo, float hi) { const f32x2_t v = {lo, hi}; return __builtin_bit_cast(unsigned, __builtin_convertvector(v, bf16x2_t)); }
__device__ __forceinline__ unsigned f2bf(float f) { return pk2(f, 0.f) & 0xffffu; }
__device__ __forceinline__ float bf2f(unsigned short h) { return __uint_as_float((unsigned)h << 16); }
__device__ __forceinline__ float blo(unsigned w) { return __uint_as_float(w << 16); }
__device__ __forceinline__ float bhi(unsigned w) { return __uint_as_float(w & 0xffff0000u); }
__device__ __forceinline__ float wave_sum(float v) {
#pragma unroll
    for (int o = 1; o < 64; o <<= 1) v += __shfl_xor(v, o);
    return v;
}
__device__ __forceinline__ float wave_max(float v) {
#pragma unroll
    for (int o = 1; o < 64; o <<= 1) v = fmaxf(v, __shfl_xor(v, o));
    return v;
}
__device__ __forceinline__ float siluf_(float x) { return x / (1.f + expf(-x)); }
__device__ __forceinline__ void sincos_cw(float x, float& sn, float& cs) {
    const float j = rintf(x * 0.63661977236758134f);
    float y = fmaf(-j, 1.5703125f, x);
    y = fmaf(-j, 4.837512969970703125e-4f, y);
    y = fmaf(-j, 7.54978995489188216e-8f, y);
    const float z = y * y;
    const float sp = fmaf(fmaf(fmaf(-1.9515295891e-4f, z, 8.3321608736e-3f), z, -1.6666654611e-1f) * z, y, y);
    const float cp = fmaf(fmaf(fmaf(2.443315711809948e-5f, z, -1.388731625493765e-3f), z, 4.166664568298827e-2f), z * z, fmaf(-0.5f, z, 1.0f));
    const int q = ((int)j) & 3;
    const float s0 = (q & 1) ? cp : sp, c0 = (q & 1) ? sp : cp;
    sn = (q & 2) ? -s0 : s0;
    cs = ((q + 1) & 2) ? -c0 : c0;
}
__device__ __forceinline__ float sin_cw(float x) { float s, c; sincos_cw(x, s, c); return s; }

struct Ctx {
    LAS unsigned char* lds;
    int tid, lane, wave, gw, NGW, G;
};

struct Args { const float* in[23]; float* out; unsigned char* ws; int pad0, pad1; };
#define KAS __attribute__((address_space(4)))
__device__ __forceinline__ const KAS Args* kargs_ptr() { const KAS Args* p = (const KAS Args*)__builtin_amdgcn_kernarg_segment_ptr(); asm volatile("" : "+s"(p)); return p; }
__device__ __forceinline__ void p0_transpose_item(const float* W, int K, int N, bf16* WT, LAS float* scr, int item, int lane) {
    const int nblk = N / 32, kb = item / nblk, nb = item % nblk, k0 = 64 * kb, n0 = 32 * nb;
#pragma unroll 8
    for (int i = 0; i < 32; ++i) { const int kk = 2 * i + (lane >> 5); scr[kk * 33 + (lane & 31)] = W[(size_t)(k0 + kk) * N + n0 + (lane & 31)]; }
    LDS_WAIT(); asm volatile("" ::: "memory");
    const int c = lane & 7;
#pragma unroll
    for (int j = 0; j < 4; ++j) { const int n = (lane >> 3) + 8 * j; const LAS float* s = scr + (8 * c) * 33 + n;
        v4u o; o.x = pk2(s[0 * 33], s[1 * 33]); o.y = pk2(s[2 * 33], s[3 * 33]); o.z = pk2(s[4 * 33], s[5 * 33]); o.w = pk2(s[6 * 33], s[7 * 33]);
        *(v4u*)(WT + (size_t)(n0 + n) * K + k0 + 8 * c) = o; }
    LDS_WAIT(); asm volatile("" ::: "memory");
}
__device__ __forceinline__ void p0_trunk_item(const KAS Args* KA, float* H3, LAS float* sf  , int l, int t, int lane) {
    const float* w1 = KA->in[8]; const float* b1 = KA->in[9]; const float* w2 = KA->in[10]; const float* b2 = KA->in[11];
    const float* w3 = KA->in[12]; const float* b3 = KA->in[13]; const float* freq = KA->in[15];
    if (lane < FE) {
        float v;
        if (lane == 0) v = (float)t / (float)(S - 1);
        else {
            const int q = (lane - 1) & 15;
            const double f = (double)(1e-4f) + (double)q * (((double)15.0f - (double)1e-4f) / 15.0);
            double u = f * (double)t / (double)S; u -= rint(u);
            float sn, cs; sincos_cw((float)(u * 6.283185307179586476925), sn, cs);
            v = (lane <= 16) ? cs : -sn;
        }
        sf[lane] = v;
    }
    LDS_WAIT(); asm volatile("" ::: "memory");
    const float fr = freq[l * FW + lane];
    float a0 = b1[l * FW + lane], a1 = 0.f;
    for (int kk = 0; kk < 32; kk += 2) { a0 = fmaf(sf[kk], w1[(l * FE + kk) * FW + lane], a0); a1 = fmaf(sf[kk + 1], w1[(l * FE + kk + 1) * FW + lane], a1); }
    a0 = fmaf(sf[32], w1[(l * FE + 32) * FW + lane], a0);
    sf[64 + lane] = sin_cw(fr * (a0 + a1));
    LDS_WAIT(); asm volatile("" ::: "memory");
    a0 = b2[l * FW + lane]; a1 = 0.f;
    for (int kk = 0; kk < FW; kk += 2) { a0 = fmaf(sf[64 + kk], w2[(l * FW + kk) * FW + lane], a0); a1 = fmaf(sf[64 + kk + 1], w2[(l * FW + kk + 1) * FW + lane], a1); }
    sf[128 + lane] = sin_cw(fr * (a0 + a1));
    LDS_WAIT(); asm volatile("" ::: "memory");
    a0 = b3[l * FW + lane]; a1 = 0.f;
    for (int kk = 0; kk < FW; kk += 2) { a0 = fmaf(sf[128 + kk], w3[(l * FW + kk) * FW + lane], a0); a1 = fmaf(sf[128 + kk + 1], w3[(l * FW + kk + 1) * FW + lane], a1); }
    H3[((size_t)l * S + t) * FW + lane] = sin_cw(fr * (a0 + a1));
    LDS_WAIT(); asm volatile("" ::: "memory");
}
__device__ __forceinline__ void p0_rgen_item(const KAS Args* KA, const float* H3, bf16* R, LAS unsigned char* lds, int item, int tid) {
    const int l = item >> 7, tg = (item >> 4) & 7, nb = item & 15, lane = tid & 63, wave = tid >> 6;
    LAS float* Wl = (LAS float*)lds;
    const float* w4l = KA->in[14] + (size_t)l * FW * (4 * DHY) + 128 * nb;
    for (int e = tid; e < 64 * 128; e += NTHREADS) { const int j = e >> 7, i = e & 127; Wl[i * 68 + j] = w4l[(size_t)j * 4 * DHY + i]; }
    const int t = 512 * tg + 64 * wave + lane;
    float hr[64];
    { const f32x4* hp = (const f32x4*)(H3 + ((size_t)l * S + t) * FW);
#pragma unroll
      for (int q = 0; q < 16; ++q) { const f32x4 v = hp[q]; hr[4 * q] = v.x; hr[4 * q + 1] = v.y; hr[4 * q + 2] = v.z; hr[4 * q + 3] = v.w; } }
    __syncthreads();
    const int nq = nb >> 2, o = nq >> 1, dir = nq & 1, cbase = (128 * nb) & 511;
    const float tt = (float)t / (float)(S - 1);
    const float d0 = -4.605170185988091f / 1.5f, d1 = -4.605170185988091f / 0.3f;
    const int x = dir ? ((t == 0) ? 8191 : 4095 + t) : 4095 - t;
    bf16* Rb = R + ((size_t)(l * 2 + o) * DHY + cbase) * 8192 + x;
    for (int i = 0; i < 128; ++i) {
        const LAS f32x4* wp = (const LAS f32x4*)(Wl + i * 68);
        float a0 = 0.f, a1 = 0.f, a2 = 0.f, a3 = 0.f;
#pragma unroll
        for (int q = 0; q < 16; ++q) { const f32x4 w = wp[q]; a0 = fmaf(hr[4 * q], w.x, a0); a1 = fmaf(hr[4 * q + 1], w.y, a1); a2 = fmaf(hr[4 * q + 2], w.z, a2); a3 = fmaf(hr[4 * q + 3], w.w, a3); }
        const float delta = d0 + (d1 - d0) * ((float)(cbase + i) / (float)(DHY - 1));
        float val = ((a0 + a1) + (a2 + a3)) * __expf(-tt * fabsf(delta));
        if (dir == 1 && t == 0) val = 0.f;
        Rb[(size_t)i * 8192] = (bf16)f2bf(val);
    }
    __syncthreads();
}
__device__ __forceinline__ void p0_mod_item(const KAS Args* KA, float* mod, LAS unsigned char* lds, int item, int tid) {
    const int l = item / 48, n = (item % 48) * 64 + (tid & 63), wave = tid >> 6, lane = tid & 63;
    const float* w = KA->in[2] + (size_t)l * D * 3 * D + (size_t)(128 * wave) * 3 * D + n; const float* c = KA->in[1] + 128 * wave;
    float acc[NB];
#pragma unroll
    for (int b = 0; b < NB; ++b) acc[b] = 0.f;
#pragma unroll 4
    for (int k = 0; k < 128; ++k) { const float wv = w[(size_t)k * 3 * D];
#pragma unroll
        for (int b = 0; b < NB; ++b) acc[b] = fmaf(c[b * D + k], wv, acc[b]); }
    LAS float* red = (LAS float*)lds;
#pragma unroll
    for (int b = 0; b < NB; ++b) red[(wave * NB + b) * 64 + lane] = acc[b];
    __syncthreads();
    { float s = KA->in[3][l * 3 * D + n];
#pragma unroll
      for (int q = 0; q < NWAVES; ++q) s += red[(q * NB + wave) * 64 + lane];
      mod[((size_t)l * NB + wave) * 3 * D + n] = s; }
    __syncthreads();
}
__device__ __forceinline__ void p0_prologue_a(const Ctx& C, const KAS Args* KA) {
    unsigned char* ws = KA->ws;
    LAS float* scr = (LAS float*)(C.lds + C.wave * 16384);
    constexpr int I_IN = (D / 64) * (NIN / 32), I_PA = (DA / 64) * (D / 32), I_PH = (DHY / 64) * (D / 32), I_OUT = (D / 64) * (D / 32);
    constexpr int I_L = I_IN + I_PA + I_PH + I_OUT;
    for (int rq_ = 0; rq_ < REPS(11); ++rq_) for (int it = C.gw; it < DEPTH * I_L; it += C.NGW) {
        const int l = it / I_L; int r = it % I_L;
        if (r < I_IN) { p0_transpose_item(KA->in[4] + (size_t)l * D * NIN, D, NIN, (bf16*)(ws + WS_WIN) + (size_t)l * NIN * D, scr, r, C.lane); continue; } r -= I_IN;
        if (r < I_PA) { p0_transpose_item(KA->in[17] + (size_t)l * DA * D, DA, D, (bf16*)(ws + WS_WPA) + (size_t)l * D * DA, scr, r, C.lane); continue; } r -= I_PA;
        if (r < I_PH) { p0_transpose_item(KA->in[18] + (size_t)l * DHY * D, DHY, D, (bf16*)(ws + WS_WPH) + (size_t)l * D * DHY, scr, r, C.lane); continue; } r -= I_PH;
        p0_transpose_item(KA->in[19] + (size_t)l * D * D, D, D, (bf16*)(ws + WS_WOUT) + (size_t)l * D * D, scr, r, C.lane);
    }
    for (int rq_ = 0; rq_ < REPS(13); ++rq_) for (int it = C.gw; it < DEPTH * S; it += C.NGW) p0_trunk_item(KA, (float*)(ws + WS_H3), scr, it / S, it % S, C.lane);
    __syncthreads();
    for (int rq_ = 0; rq_ < REPS(12); ++rq_) for (int it = blockIdx.x; it < DEPTH * 48; it += C.G) p0_mod_item(KA, (float*)(ws + WS_MOD), C.lds, it, C.tid);
}
__device__ __forceinline__ void p0_prologue_b(const Ctx& C, const KAS Args* KA) {
    unsigned char* ws = KA->ws;
    for (int rq_ = 0; rq_ < REPS(14); ++rq_) for (int it = blockIdx.x; it < DEPTH * 128; it += C.G) p0_rgen_item(KA, (const float*)(ws + WS_H3), (bf16*)(ws + WS_R), C.lds, it, C.tid);
}

__device__ __forceinline__ void ln_mod_row(const float* xrow, const float* modb, bf16* orow, int lane) {
    const f32x4* xr = (const f32x4*)xrow + lane;
    f32x4 v[4]; float s = 0.f;
#pragma unroll
    for (int j = 0; j < 4; ++j) { v[j] = xr[64 * j]; s += (v[j].x + v[j].y) + (v[j].z + v[j].w); }
    const float mean = wave_sum(s) * (1.f / D); float s2 = 0.f;
#pragma unroll
    for (int j = 0; j < 4; ++j) { v[j] = v[j] - mean; s2 += (v[j].x * v[j].x + v[j].y * v[j].y) + (v[j].z * v[j].z + v[j].w * v[j].w); }
    const float rstd = 1.f / sqrtf(wave_sum(s2) * (1.f / D) + LN_EPS);
    v2u* o8 = (v2u*)orow + lane;
#pragma unroll
    for (int j = 0; j < 4; ++j) {
        const f32x4 sh = *((const f32x4*)modb + lane + 64 * j), sc = *((const f32x4*)(modb + D) + lane + 64 * j);
        const f32x4 r = v[j] * rstd * (sc + 1.f) + sh;
        v2u w; w.x = pk2(r.x, r.y); w.y = pk2(r.z, r.w); o8[64 * j] = w;
    }
}
__device__ __forceinline__ void ln_final_row(float* row, const float* lg, const float* lb, int lane) {
    f32x4* xr = (f32x4*)row + lane;
    f32x4 v[4]; float s = 0.f;
#pragma unroll
    for (int j = 0; j < 4; ++j) { v[j] = xr[64 * j]; s += (v[j].x + v[j].y) + (v[j].z + v[j].w); }
    const float mean = wave_sum(s) * (1.f / D); float s2 = 0.f;
#pragma unroll
    for (int j = 0; j < 4; ++j) { v[j] = v[j] - mean; s2 += (v[j].x * v[j].x + v[j].y * v[j].y) + (v[j].z * v[j].z + v[j].w * v[j].w); }
    const float rstd = 1.f / sqrtf(wave_sum(s2) * (1.f / D) + LN_EPS);
#pragma unroll
    for (int j = 0; j < 4; ++j) { const f32x4 g = *((const f32x4*)lg + lane + 64 * j), b = *((const f32x4*)lb + lane + 64 * j); xr[64 * j] = v[j] * rstd * g + b; }
}

__device__ __forceinline__ void attn_naive_item(const bf16* P, const bf16* P2, bf16* YA, LAS float* sw  , int row, int h, int lane) {
    LAS float* sq = sw; LAS float* sc = sw + 192;
    const int t = row % S, rb = row - t;
    const float slope = exp2f(-(float)(h + 1));
#pragma unroll
    for (int g = 0; g < NG; ++g) sq[g * 64 + lane] = bf2f(P[((size_t)((0 * NG + g) * NH + h) * MC + row) * 64 + lane]);
    LDS_WAIT(); asm volatile("" ::: "memory");
    float mx = -INFINITY;
#pragma unroll
    for (int g = 0; g < NG; ++g) {
        const int dil = (g == 0) ? 1 : (g == 1 ? 4 : 16);
        const bf16* Kh = P + (size_t)((1 * NG + g) * NH + h) * MC * 64;
        for (int pass = 0; pass < 3; ++pass) {
            const int jj = pass * 64 + lane;
            if (jj <= 128) {
                const int j = jj - 64, tk = t + j * dil;
                float s = -INFINITY;
                if (tk >= 0 && tk < S) {
                    const v4u* kr = (const v4u*)(Kh + (size_t)(rb + tk) * 64);
                    float a = 0.f;
#pragma unroll
                    for (int e = 0; e < 8; ++e) { const v4u kv = kr[e]; const LAS float* q = sq + g * 64 + 8 * e;
                        a = fmaf(q[0], blo(kv.x), a); a = fmaf(q[1], bhi(kv.x), a); a = fmaf(q[2], blo(kv.y), a); a = fmaf(q[3], bhi(kv.y), a);
                        a = fmaf(q[4], blo(kv.z), a); a = fmaf(q[5], bhi(kv.z), a); a = fmaf(q[6], blo(kv.w), a); a = fmaf(q[7], bhi(kv.w), a); }
                    s = a * 0.125f - slope * (float)((j < 0 ? -j : j) * dil);
                }
                sc[g * 132 + jj] = s;
                mx = fmaxf(mx, s);
            }
        }
    }
    mx = wave_max(mx);
    float sum = 0.f;
#pragma unroll
    for (int g = 0; g < NG; ++g)
        for (int pass = 0; pass < 3; ++pass) {
            const int jj = pass * 64 + lane;
            if (jj <= 128) { const float s = sc[g * 132 + jj]; const float p = (s == -INFINITY) ? 0.f : expf(s - mx); sc[g * 132 + jj] = p; sum += p; }
        }
    sum = wave_sum(sum);
    LDS_WAIT(); asm volatile("" ::: "memory");
    float o = 0.f;
#pragma unroll
    for (int g = 0; g < NG; ++g) {
        const int dil = (g == 0) ? 1 : (g == 1 ? 4 : 16);
        const bf16* Vh = P + (size_t)((2 * NG + g) * NH + h) * MC * 64 + lane;
        for (int jj = 0; jj <= 128; ++jj) {
            const int tk = t + (jj - 64) * dil;
            if (tk >= 0 && tk < S) o = fmaf(sc[g * 132 + jj], bf2f(Vh[(size_t)(rb + tk) * 64]), o);
        }
    }
    o /= sum;
    const float ga = bf2f(P2[(size_t)row * NP2 + OFF_GA + h * HD + lane]);
    YA[(size_t)row * DA + h * HD + lane] = (bf16)f2bf(o * siluf_(ga));
    LDS_WAIT(); asm volatile("" ::: "memory");
}
typedef short bf16x8_t __attribute__((ext_vector_type(8)));
typedef float f32x16_t __attribute__((ext_vector_type(16)));
struct LCG {
    static constexpr int NI = 32 / CH, NCT = 64 / NI;
    static constexpr int PADZ = 64 * (NI - 1), ZSTRIDE = 4096 + 2 * PADZ + 32;
    static constexpr int GC_STRIDE = 16448, ZB_OFF = 4 * GC_STRIDE, LDS_END = ZB_OFF + CH * ZSTRIDE * 2;
};
static_assert(LCG::NCT <= NWAVES && (LCG::ZSTRIDE / 8) % 16 == 4 && LCG::ZSTRIDE % 8 == 0 && LCG::LDS_END <= RING_BYTES, "long-conv LDS map");
constexpr int UT_ROWS = 4 * DHY;
__device__ __forceinline__ int zsw(int e) { const int c = e >> 3; return (((c ^ ((c >> 3) & 7)) << 3) | (e & 7)) * 2; }

struct RRegs { v4u cur[2], prv[2]; };
__device__ __forceinline__ void lc_load_R(RRegs& rr, const bf16* Rg, int tid) {
#pragma unroll
    for (int it = 0; it < 2; ++it) { const int k = tid + it * NTHREADS;
        rr.cur[it] = *(const v4u*)(Rg + 8 * k);
        rr.prv[it] = *(const v4u*)(Rg + 8 * (k > 0 ? k - 1 : 0)); }
}
__device__ __forceinline__ void lc_write_R(LAS unsigned char* lds, const RRegs& rr, int tid) {
#pragma unroll
    for (int it = 0; it < 2; ++it) {
        const int k = tid + it * NTHREADS;
        const v4u cur = rr.cur[it]; v4u prv = rr.prv[it]; if (k == 0) prv = (v4u){0u, 0u, 0u, 0u};
        *(LAS v4u*)(lds + 0 * LCG::GC_STRIDE + 16 * k) = cur;
        v4u s1; s1.x = __builtin_amdgcn_alignbit(cur.x, prv.w, 16); s1.y = __builtin_amdgcn_alignbit(cur.y, cur.x, 16); s1.z = __builtin_amdgcn_alignbit(cur.z, cur.y, 16); s1.w = __builtin_amdgcn_alignbit(cur.w, cur.z, 16);
        *(LAS v4u*)(lds + 1 * LCG::GC_STRIDE + 16 * k) = s1;
        v4u s2; s2.x = prv.w; s2.y = cur.x; s2.z = cur.y; s2.w = cur.z;
        *(LAS v4u*)(lds + 2 * LCG::GC_STRIDE + 16 * k) = s2;
        v4u s3; s3.x = __builtin_amdgcn_alignbit(prv.w, prv.z, 16); s3.y = __builtin_amdgcn_alignbit(cur.x, prv.w, 16); s3.z = __builtin_amdgcn_alignbit(cur.y, cur.x, 16); s3.w = __builtin_amdgcn_alignbit(cur.z, cur.y, 16);
        *(LAS v4u*)(lds + 3 * LCG::GC_STRIDE + 16 * k) = s3;
    }
}
constexpr int LC_ZCH = CH * 512 / NTHREADS;
struct ZRegs { v4u v[LC_ZCH]; };
__device__ __forceinline__ void lc_load_z(ZRegs& zr, const bf16* UT, int c, int tid) {
#pragma unroll
    for (int j = 0; j < LC_ZCH; ++j) { const int k = tid + j * NTHREADS, bb = k >> 9, s8 = (k & 511) * 8; zr.v[j] = *(const v4u*)(UT + (size_t)c * MC + bb * S + s8); }
}
__device__ __forceinline__ void lc_write_z(LAS unsigned char* lds, const ZRegs& zr, int tid) {
#pragma unroll
    for (int j = 0; j < LC_ZCH; ++j) { const int k = tid + j * NTHREADS, bb = k >> 9, s8 = (k & 511) * 8; *(LAS v4u*)(lds + LCG::ZB_OFF + bb * LCG::ZSTRIDE * 2 + zsw(LCG::PADZ + s8)) = zr.v[j]; }
}
__device__ __forceinline__ bf16x8_t lc_ldA(LAS unsigned char* lds, int baseA, int baseA8, int d) {
    const v2u a0 = *(const LAS v2u*)(lds + baseA - 32 * d), a1 = *(const LAS v2u*)(lds + baseA8 - 32 * d);
    return __builtin_bit_cast(bf16x8_t, (v4u){a0.x, a0.y, a1.x, a1.y});
}
__device__ __forceinline__ bf16x8_t lc_ldB(LAS unsigned char* lds, int rowB, int cB, int d) {
    const int c = cB - 2 * d;
    return __builtin_bit_cast(bf16x8_t, *(const LAS v4u*)(lds + rowB + ((c ^ ((c >> 3) & 7)) << 4)));
}
__device__ __forceinline__ void lc_mma(LAS unsigned char* lds, f32x16_t& acc1, f32x16_t& acc2, int wave, int lane) {
    const int r = lane & 31, h = lane >> 5, kap = (r + 1) & 3, b = r / LCG::NI, ii = r % LCG::NI;
    const int baseA = kap * LCG::GC_STRIDE + 2 * (4095 - r + 8 * h + kap);
    int baseA8 = baseA + 8; asm volatile("" : "+v"(baseA8));
    const int i0 = LCG::NI * wave;
    const int rowB = LCG::ZB_OFF + b * LCG::ZSTRIDE * 2, cB = (LCG::PADZ + 64 * (i0 + ii) + 8 * h) >> 3;
    const int dlo = 4 * i0 - 255, dhi = 4 * i0 + 4 * (LCG::NI - 1);
    acc1 = (f32x16_t){0.f, 0.f, 0.f, 0.f, 0.f, 0.f, 0.f, 0.f, 0.f, 0.f, 0.f, 0.f, 0.f, 0.f, 0.f, 0.f}; acc2 = acc1;
    bf16x8_t Ae = lc_ldA(lds, baseA, baseA8, dlo), Ao = lc_ldA(lds, baseA, baseA8, dlo + 1), An = lc_ldA(lds, baseA, baseA8, dlo + 2), Am = lc_ldA(lds, baseA, baseA8, dlo + 3);
    bf16x8_t B0 = lc_ldB(lds, rowB, cB, dlo), B1 = lc_ldB(lds, rowB, cB, dlo + 1);
    for (int d = dlo; d <= dhi; d += 2) {
        const int dn = (d + 2 <= dhi - 1) ? d + 2 : dhi - 1;
        const bf16x8_t nAn = lc_ldA(lds, baseA, baseA8, dn + 2), nAm = lc_ldA(lds, baseA, baseA8, dn + 3);
        const bf16x8_t nB0 = lc_ldB(lds, rowB, cB, dn), nB1 = lc_ldB(lds, rowB, cB, dn + 1);
        acc1 = __builtin_amdgcn_mfma_f32_32x32x16_bf16(Ae, B0, acc1, 0, 0, 0);
        acc2 = __builtin_amdgcn_mfma_f32_32x32x16_bf16(An, B0, acc2, 0, 0, 0);
        acc1 = __builtin_amdgcn_mfma_f32_32x32x16_bf16(Ao, B1, acc1, 0, 0, 0);
        acc2 = __builtin_amdgcn_mfma_f32_32x32x16_bf16(Am, B1, acc2, 0, 0, 0);
        Ae = An; Ao = Am; An = nAn; Am = nAm; B0 = nB0; B1 = nB1;
    }
}
__device__ __forceinline__ void longconv_mfma_units(LAS unsigned char* lds, const bf16* UT, const bf16* Rl, const float* fb, bf16* YHT, int first, int stride, int tid_) {
    const int tid = tid_, lane = tid & 63, wave = __builtin_amdgcn_readfirstlane(tid >> 6);
    const int r = lane & 31, h = lane >> 5, b = r / LCG::NI, ii = r % LCG::NI;
    const bool active = wave < LCG::NCT;
    const int i = LCG::NI * wave + ii;
    if (first >= DHY) return;
    for (int k = tid; k < CH * 2 * (LCG::PADZ / 8); k += NTHREADS) { const int bb = k / (2 * (LCG::PADZ / 8)), q = k % (2 * (LCG::PADZ / 8));
        const int e = (q < LCG::PADZ / 8) ? q * 8 : LCG::PADZ + 4096 + (q - LCG::PADZ / 8) * 8;
        *(LAS v4u*)(lds + LCG::ZB_OFF + bb * LCG::ZSTRIDE * 2 + zsw(e)) = (v4u){0u, 0u, 0u, 0u}; }
    ZRegs zr; RRegs r0; lc_load_z(zr, UT, first, tid); lc_load_R(r0, Rl + (size_t)(0 * DHY + first) * 8192, tid);
    for (int c = first; c < DHY; c += stride) {
        lc_write_z(lds, zr, tid); lc_write_R(lds, r0, tid);
        RRegs r1; lc_load_R(r1, Rl + (size_t)(1 * DHY + c) * 8192, tid);
        v2u x1[2][4];
#pragma unroll
        for (int hf = 0; hf < 2; ++hf)
#pragma unroll
            for (int q = 0; q < 4; ++q) x1[hf][q] = *(const v2u*)(UT + (size_t)(DHY + c) * MC + b * S + 64 * i + 32 * hf + 8 * q + 4 * h);
        __syncthreads();
        f32x16_t acc1, acc2;
        for (int rr_ = 0; rr_ < REPS(15); ++rr_) if (active) lc_mma(lds, acc1, acc2, wave, lane);
        v2u zn[2][4];
        if (active) { const float bias0 = fb[c];
#pragma unroll
          for (int hf = 0; hf < 2; ++hf)
#pragma unroll
            for (int q = 0; q < 4; ++q) { const int t = 64 * i + 32 * hf + 8 * q + 4 * h; const f32x16_t& ac = hf ? acc2 : acc1;
                const v2u zo = *(const LAS v2u*)(lds + LCG::ZB_OFF + b * LCG::ZSTRIDE * 2 + zsw(LCG::PADZ + t));
                const v2u xx = x1[hf][q];
                const float y0 = blo(xx.x) * (ac[4 * q + 0] + bias0 * blo(zo.x)), y1 = bhi(xx.x) * (ac[4 * q + 1] + bias0 * bhi(zo.x));
                const float y2 = blo(xx.y) * (ac[4 * q + 2] + bias0 * blo(zo.y)), y3 = bhi(xx.y) * (ac[4 * q + 3] + bias0 * bhi(zo.y));
                zn[hf][q].x = pk2(y0, y1); zn[hf][q].y = pk2(y2, y3); } }
        __syncthreads();
        if (active) {
#pragma unroll
          for (int hf = 0; hf < 2; ++hf)
#pragma unroll
            for (int q = 0; q < 4; ++q) *(LAS v2u*)(lds + LCG::ZB_OFF + b * LCG::ZSTRIDE * 2 + zsw(LCG::PADZ + 64 * i + 32 * hf + 8 * q + 4 * h)) = zn[hf][q]; }
        lc_write_R(lds, r1, tid);
        v2u x2[2][4], sg[2][4];
#pragma unroll
        for (int hf = 0; hf < 2; ++hf)
#pragma unroll
            for (int q = 0; q < 4; ++q) { const size_t off = (size_t)b * S + 64 * i + 32 * hf + 8 * q + 4 * h;
                x2[hf][q] = *(const v2u*)(UT + (size_t)(2 * DHY + c) * MC + off); sg[hf][q] = *(const v2u*)(UT + (size_t)(3 * DHY + c) * MC + off); }
        const int cn = (c + stride < DHY) ? c + stride : c;
        lc_load_z(zr, UT, cn, tid); lc_load_R(r0, Rl + (size_t)(0 * DHY + cn) * 8192, tid);
        __syncthreads();
        if (active) { for (int rr_ = 0; rr_ < REPS(15); ++rr_) lc_mma(lds, acc1, acc2, wave, lane);
          const float bias1 = fb[DHY + c];
#pragma unroll
          for (int hf = 0; hf < 2; ++hf)
#pragma unroll
            for (int q = 0; q < 4; ++q) { const int t = 64 * i + 32 * hf + 8 * q + 4 * h; const f32x16_t& ac = hf ? acc2 : acc1;
                const v2u zo = *(const LAS v2u*)(lds + LCG::ZB_OFF + b * LCG::ZSTRIDE * 2 + zsw(LCG::PADZ + t));
                const v2u xx = x2[hf][q], ss = sg[hf][q];
                const float y0 = blo(ss.x) * blo(xx.x) * (ac[4 * q + 0] + bias1 * blo(zo.x)), y1 = bhi(ss.x) * bhi(xx.x) * (ac[4 * q + 1] + bias1 * bhi(zo.x));
                const float y2 = blo(ss.y) * blo(xx.y) * (ac[4 * q + 2] + bias1 * blo(zo.y)), y3 = bhi(ss.y) * bhi(xx.y) * (ac[4 * q + 3] + bias1 * bhi(zo.y));
                v2u o; o.x = pk2(y0, y1); o.y = pk2(y2, y3);
                *(v2u*)(YHT + (size_t)c * MC + b * S + t) = o; } }
        __syncthreads();
    }
}
__device__ __forceinline__ void hyena_prep_tile(LAS unsigned char* lds, const bf16* P, const float* cw, const float* cb, bf16* UT, int tile, int tid) {
    constexpr int TS = 72;
    const int tr = tile / (UT_ROWS / 64), tc = tile % (UT_ROWS / 64), row0 = tr * 64, c0 = tc * 64;
    LAS bf16* T = (LAS bf16*)lds;
    { const int rr = tid >> 3, seg = tid & 7, row = row0 + rr, t = row % S, cc = c0 + 8 * seg;
      float o[8];
      if (c0 < 3 * DHY) {
          const v4u w0 = *(const v4u*)(P + (size_t)row * NP2 + OFF_HY + cc);
          v4u wm = (v4u){0u, 0u, 0u, 0u}, wp = (v4u){0u, 0u, 0u, 0u};
          if (t > 0) wm = *(const v4u*)(P + (size_t)(row - 1) * NP2 + OFF_HY + cc);
          if (t < S - 1) wp = *(const v4u*)(P + (size_t)(row + 1) * NP2 + OFF_HY + cc);
          const unsigned am[4] = {wm.x, wm.y, wm.z, wm.w}, a0[4] = {w0.x, w0.y, w0.z, w0.w}, ap[4] = {wp.x, wp.y, wp.z, wp.w};
#pragma unroll
          for (int j = 0; j < 4; ++j) { const int c = cc + 2 * j;
              o[2 * j] = cw[c] * blo(am[j]) + cw[3 * DHY + c] * blo(a0[j]) + cw[6 * DHY + c] * blo(ap[j]) + cb[c];
              o[2 * j + 1] = cw[c + 1] * bhi(am[j]) + cw[3 * DHY + c + 1] * bhi(a0[j]) + cw[6 * DHY + c + 1] * bhi(ap[j]) + cb[c + 1]; }
      } else {
          const v4u w0 = *(const v4u*)(P + (size_t)row * NP2 + OFF_GH + (cc - 3 * DHY));
          const unsigned a0[4] = {w0.x, w0.y, w0.z, w0.w};
#pragma unroll
          for (int j = 0; j < 4; ++j) { o[2 * j] = siluf_(blo(a0[j])); o[2 * j + 1] = siluf_(bhi(a0[j])); }
      }
#pragma unroll
      for (int j = 0; j < 8; ++j) T[(8 * seg + j) * TS + rr] = (bf16)f2bf(o[j]); }
    __syncthreads();
    { const int chn = tid >> 3, sg = tid & 7;
      *(v4u*)(UT + (size_t)(c0 + chn) * MC + row0 + 8 * sg) = *(const LAS v4u*)(T + chn * TS + 8 * sg); }
    __syncthreads();
}
__device__ __forceinline__ void hyena_post_tile(LAS unsigned char* lds, const bf16* YHT, bf16* YH, int tile, int tid) {
    constexpr int TS = 72;
    const int tr = tile / (DHY / 64), tc = tile % (DHY / 64), row0 = tr * 64, c0 = tc * 64;
    LAS bf16* T = (LAS bf16*)lds;
    { const int chn = tid >> 3, sg = tid & 7;
      const v4u w = *(const v4u*)(YHT + (size_t)(c0 + chn) * MC + row0 + 8 * sg);
      const unsigned a[4] = {w.x, w.y, w.z, w.w};
#pragma unroll
      for (int j = 0; j < 4; ++j) { T[(8 * sg + 2 * j) * TS + chn] = (bf16)(a[j] & 0xffffu); T[(8 * sg + 2 * j + 1) * TS + chn] = (bf16)(a[j] >> 16); } }
    __syncthreads();
    { const int rr = tid >> 3, seg = tid & 7;
      *(v4u*)(YH + (size_t)(row0 + rr) * DHY + c0 + 8 * seg) = *(const LAS v4u*)(T + rr * TS + 8 * seg); }
    __syncthreads();
}
typedef short v4i16_t __attribute__((ext_vector_type(4)));
constexpr int AT_ROWB = 128;
__device__ __forceinline__ void attn_mfma_unit(const bf16* P, bf16* OG, float* ML, LAS unsigned char* vs, int unit, int lane_) {
    int lane = lane_; asm volatile("" : "+v"(lane));
    int u = unit; const int x = u & 127; u >>= 7; const int hh = u & 7; u >>= 3; const int g = u % 3, bl = u / 3;
    const int dsh = 2 * g, d = 1 << dsh, L = S >> dsh, nqb = L >> 5, r = x / nqb, qb = x % nqb;
    const size_t rowb = (size_t)bl * S;
    const float slope = exp2f(-(float)(hh + 1)) * (float)d * 1.4426950408889634f;
    const bf16* Qh = P + ((size_t)((0 * NG + g) * NH + hh) * MC + rowb) * 64; const bf16* Kh = P + ((size_t)((1 * NG + g) * NH + hh) * MC + rowb) * 64; const bf16* Vh = P + ((size_t)((2 * NG + g) * NH + hh) * MC + rowb) * 64;
    const int n = lane & 31, h2 = lane >> 5;
    const int tq = ((32 * qb + n) << dsh) + r;
    bf16x8_t qf[4];
#pragma unroll
    for (int ks = 0; ks < 4; ++ks) qf[ks] = __builtin_bit_cast(bf16x8_t, *(const v4u*)(Qh + (size_t)tq * 64 + 16 * ks + 8 * h2));
    f32x16_t st[5];
    for (int r31_ = 0; r31_ < REPS(31); ++r31_)
#pragma unroll
    for (int kt = 0; kt < 5; ++kt) {
        int ik = 32 * (qb - 2 + kt) + n; ik = ik < 0 ? 0 : (ik > L - 1 ? L - 1 : ik);
        const bf16* kp = Kh + (size_t)((ik << dsh) + r) * 64 + 8 * h2;
        f32x16_t acc = (f32x16_t){0.f, 0.f, 0.f, 0.f, 0.f, 0.f, 0.f, 0.f, 0.f, 0.f, 0.f, 0.f, 0.f, 0.f, 0.f, 0.f};
#pragma unroll
        for (int ks = 0; ks < 4; ++ks) acc = __builtin_amdgcn_mfma_f32_32x32x16_bf16(__builtin_bit_cast(bf16x8_t, *(const v4u*)(kp + 16 * ks)), qf[ks], acc, 0, 0, 0);
        st[kt] = acc;
        if (kt & 1) asm volatile("" ::: "memory");
    }
    v4u vr[5][4];
#pragma unroll
    for (int kt = 0; kt < 5; ++kt) {
        int ik = 32 * (qb - 2 + kt) + (lane >> 1); ik = ik < 0 ? 0 : (ik > L - 1 ? L - 1 : ik);
        const bf16* vp = Vh + (size_t)((ik << dsh) + r) * 64 + 32 * (lane & 1);
#pragma unroll
        for (int j = 0; j < 4; ++j) vr[kt][j] = *(const v4u*)(vp + 8 * j);
    }
    const bool edge = (qb < 2) || (qb + 3 > nqb);
    const int e4 = 4 * h2 - n;
    float mx = -INFINITY;
#pragma unroll
    for (int kt = 0; kt < 5; ++kt)
#pragma unroll
        for (int rg = 0; rg < 16; ++rg) {
            const int rel = 32 * (kt - 2) + (rg & 3) + 8 * (rg >> 2) + e4;
            const int arel = rel < 0 ? -rel : rel;
            float s = fmaf(st[kt][rg], 0.125f * 1.4426950408889634f, -slope * (float)arel);
            if (kt == 0 || kt == 4) s = (arel <= 64) ? s : -INFINITY;
            st[kt][rg] = s;
        }
    if (edge) {
#pragma unroll
        for (int kt = 0; kt < 5; ++kt)
#pragma unroll
            for (int rg = 0; rg < 16; ++rg) { const unsigned ikey = (unsigned)(32 * (qb - 2 + kt) + (rg & 3) + 8 * (rg >> 2) + 4 * h2); if (ikey >= (unsigned)L) st[kt][rg] = -INFINITY; }
    }
#pragma unroll
    for (int kt = 0; kt < 5; ++kt)
#pragma unroll
        for (int rg = 0; rg < 16; ++rg) mx = fmaxf(mx, st[kt][rg]);
    mx = fmaxf(mx, __shfl_xor(mx, 32));
    float ls = 0.f;
#pragma unroll
    for (int kt = 0; kt < 5; ++kt)
#pragma unroll
        for (int rg = 0; rg < 16; ++rg) { const float p = __builtin_amdgcn_exp2f(st[kt][rg] - mx); st[kt][rg] = p; ls += p; }
    ls += __shfl_xor(ls, 32);
    f32x16_t o0 = (f32x16_t){0.f, 0.f, 0.f, 0.f, 0.f, 0.f, 0.f, 0.f, 0.f, 0.f, 0.f, 0.f, 0.f, 0.f, 0.f, 0.f}, o1 = o0;
    const int trow = (lane & 15) >> 2, tcolb = (16 * ((lane >> 4) & 1) + 4 * (lane & 3)) * 2;
    for (int r32_ = 0; r32_ < REPS(32); ++r32_) { if (r32_) { o0 = (f32x16_t){0.f, 0.f, 0.f, 0.f, 0.f, 0.f, 0.f, 0.f, 0.f, 0.f, 0.f, 0.f, 0.f, 0.f, 0.f, 0.f}; o1 = o0; }
#pragma unroll
    for (int kt = 0; kt < 5; ++kt) {
        LAS unsigned char* vb = vs + (kt & 1) * 4096;
        { LAS unsigned char* wp = vb + (lane >> 1) * AT_ROWB + 64 * (lane & 1);
          *(LAS v4u*)(wp) = vr[kt][0]; *(LAS v4u*)(wp + 16) = vr[kt][1]; *(LAS v4u*)(wp + 32) = vr[kt][2]; *(LAS v4u*)(wp + 48) = vr[kt][3]; }
        LDS_WAIT(); asm volatile("" ::: "memory");
#pragma unroll
        for (int s = 0; s < 2; ++s) {
            v4u pa; pa.x = pk2(st[kt][8 * s + 0], st[kt][8 * s + 1]); pa.y = pk2(st[kt][8 * s + 2], st[kt][8 * s + 3]); pa.z = pk2(st[kt][8 * s + 4], st[kt][8 * s + 5]); pa.w = pk2(st[kt][8 * s + 6], st[kt][8 * s + 7]);
            const bf16x8_t A = __builtin_bit_cast(bf16x8_t, pa);
            LAS unsigned char* tp = vb + (16 * s + 4 * h2 + trow) * AT_ROWB + tcolb;
#pragma unroll
            for (int eh = 0; eh < 2; ++eh) {
                const v4i16_t lo = __builtin_amdgcn_ds_read_tr16_b64_v4i16((LAS v4i16_t*)(tp + 64 * eh));
                const v4i16_t hi = __builtin_amdgcn_ds_read_tr16_b64_v4i16((LAS v4i16_t*)(tp + 64 * eh + 8 * AT_ROWB));
                const bf16x8_t B = (bf16x8_t){lo[0], lo[1], lo[2], lo[3], hi[0], hi[1], hi[2], hi[3]};
                if (eh == 0) o0 = __builtin_amdgcn_mfma_f32_32x32x16_bf16(A, B, o0, 0, 0, 0); else o1 = __builtin_amdgcn_mfma_f32_32x32x16_bf16(A, B, o1, 0, 0, 0);
            }
        }
    }
    }
    LDS_WAIT(); asm volatile("" ::: "memory");
    bf16* og = OG + ((size_t)g * MC + rowb) * DA + hh * HD + n;
    for (int r33_ = 0; r33_ < REPS(33); ++r33_)
#pragma unroll
    for (int rg = 0; rg < 16; ++rg) { const int mq = (rg & 3) + 8 * (rg >> 2) + 4 * h2; const size_t tok = (size_t)(((32 * qb + mq) << dsh) + r);
        og[tok * DA] = (bf16)f2bf(o0[rg]); og[tok * DA + 32] = (bf16)f2bf(o1[rg]); }
    if (h2 == 0) { float* mp = ML + (((size_t)g * MC + rowb + tq) * NH + hh) * 2; mp[0] = mx * 0.6931471805599453f; mp[1] = ls; }
}
__device__ __forceinline__ void attn_combine(const bf16* P  , const bf16* OG, const float* ML, bf16* YA, int G, int tid) {
    for (int idx = blockIdx.x * NTHREADS + tid; idx < MC * (DA / 2); idx += G * NTHREADS) {
        const int row = idx / (DA / 2), col = (idx % (DA / 2)) * 2, hh = col >> 6;
        float m[3], l[3];
#pragma unroll
        for (int g = 0; g < 3; ++g) { const float* mp = ML + (((size_t)g * MC + row) * NH + hh) * 2; m[g] = mp[0]; l[g] = mp[1]; }
        const float M = fmaxf(m[0], fmaxf(m[1], m[2]));
        float a0 = 0.f, a1 = 0.f, den = 0.f;
#pragma unroll
        for (int g = 0; g < 3; ++g) { const float w = __expf(m[g] - M); const unsigned ow = *(const unsigned*)(OG + ((size_t)g * MC + row) * DA + col);
            a0 = fmaf(w, blo(ow), a0); a1 = fmaf(w, bhi(ow), a1); den = fmaf(w, l[g], den); }
        const unsigned gw_ = *(const unsigned*)(P + (size_t)row * NP2 + OFF_GA + col);
        const float inv = 1.f / den;
        *(unsigned*)(YA + (size_t)row * DA + col) = pk2(a0 * inv * siluf_(blo(gw_)), a1 * inv * siluf_(bhi(gw_)));
    }
}
#if MK_CHECK
__device__ __forceinline__ void longconv_check_item(const bf16* Zrow  , const bf16* Rrow  , const bf16* Xrow, const bf16* SGrow, float bias, bf16* Orow, int b, int tb, int lane) {
    const int t = tb * 64 + lane;
    const bf16* z = Zrow + (size_t)b * S; const bf16* g = Rrow + 4095 - t;
    float y = 0.f;
    for (int s0 = 0; s0 < S; s0 += 8) {
#pragma unroll
        for (int j = 0; j < 8; ++j) y = fmaf(bf2f(g[s0 + j]), bf2f(z[s0 + j]), y);
    }
    float v = bf2f(Xrow[(size_t)b * S + t]) * (y + bias * bf2f(z[t]));
    if (SGrow) v *= bf2f(SGrow[(size_t)b * S + t]);
    Orow[(size_t)b * S + t] = (bf16)f2bf(v);
}
#endif
#define XB_TMO      128
#define XB_XCNT(j)  (256  + 64 * (j))
#define XB_XSUB(j)  (1280 + 64 * (j))
#define XB_XGEN(j)  (2304 + 64 * (j))
#define XB_TOP      3328
#define XB_TOPGEN   3392
#define XCD_BAR_WORDS 3456
#define XB_SPIN_CAP (1u << 18)

__device__ __forceinline__ unsigned xb_ld(unsigned* p)              { return __hip_atomic_load(p, __ATOMIC_RELAXED, __HIP_MEMORY_SCOPE_AGENT); }
__device__ __forceinline__ unsigned xb_add(unsigned* p, unsigned v) { return __hip_atomic_fetch_add(p, v, __ATOMIC_RELAXED, __HIP_MEMORY_SCOPE_AGENT); }
__device__ __forceinline__ unsigned xb_xcc_id() { return (unsigned)__builtin_amdgcn_s_getreg((3 << 11) | 20) & 0xFu; }
#define XB_SPIN(cond, bar) do { unsigned _sp = 0; while (cond) { __builtin_amdgcn_s_sleep(1); \
    if ((++_sp & 255u) == 0u) { if (xb_ld(&(bar)[XB_TMO])) break; if (_sp > XB_SPIN_CAP) { atomicAdd(&(bar)[XB_TMO], 1u); break; } } } } while (0)

struct XcdBarrier {
    unsigned* bar; unsigned x;
    volatile LAS unsigned* st;
};

__device__ __forceinline__ XcdBarrier xcd_barrier_post(unsigned* bar, volatile LAS unsigned* st) {
    XcdBarrier b; b.bar = bar; b.x = xb_xcc_id(); b.st = st;
    if (threadIdx.x == 0) (void)xb_add(&bar[XB_XCNT(b.x)], 1u);
    return b;
}
__device__ __forceinline__ void xcd_barrier_complete(unsigned* bar, unsigned x, unsigned& nloc, unsigned& nx) {
    const unsigned G = gridDim.x * gridDim.y * gridDim.z;
    unsigned sum, cnt, mine, sp = 0u;
    for (;;) {
        sum = 0u; cnt = 0u; mine = 0u;
#pragma unroll
        for (unsigned j = 0; j < 16; ++j) { const unsigned c = xb_ld(&bar[XB_XCNT(j)]); sum += c; cnt += (c > 0u) ? 1u : 0u; mine = (j == x) ? c : mine; }
        if (sum == G) break;
        __builtin_amdgcn_s_sleep(1);
        if ((++sp & 255u) == 0u) { if (xb_ld(&bar[XB_TMO])) break; if (sp > XB_SPIN_CAP) { atomicAdd(&bar[XB_TMO], 1u); break; } }
    }
    nloc = mine > 0u ? mine : 1u; nx = cnt > 0u ? cnt : 1u;
}

__device__ __forceinline__ void xcd_barrier(const XcdBarrier& b) {
    asm volatile("s_waitcnt vmcnt(0)" ::: "memory");
    __syncthreads();
    if (threadIdx.x == 0) {
        unsigned* bar = b.bar;
        __builtin_amdgcn_s_waitcnt(0);
        unsigned nloc = b.st[0], nx = b.st[1];
        if (nloc == 0u) { xcd_barrier_complete(bar, b.x, nloc, nx); b.st[0] = nloc; b.st[1] = nx; }
        const unsigned old = xb_add(&bar[XB_XSUB(b.x)], 1u);
        const unsigned gen = old / nloc;
        if (old + 1u == (gen + 1u) * nloc) {
            __builtin_amdgcn_fence(__ATOMIC_RELEASE, "agent");
            asm volatile("s_waitcnt vmcnt(0)" ::: "memory");
            const unsigned og = xb_add(&bar[XB_TOP], 1u);
            const unsigned tg = og / nx;
            if (og + 1u == (tg + 1u) * nx) xb_add(&bar[XB_TOPGEN], 1u);
            else XB_SPIN(xb_ld(&bar[XB_TOPGEN]) == tg, bar);
            __builtin_amdgcn_fence(__ATOMIC_ACQUIRE, "agent");
            xb_add(&bar[XB_XGEN(b.x)], 1u);
            asm volatile("s_waitcnt vmcnt(0)" ::: "memory");
        } else {
            XB_SPIN(xb_ld(&bar[XB_XGEN(b.x)]) == gen, bar);
            __builtin_amdgcn_fence(__ATOMIC_ACQUIRE, "agent");
            asm volatile("s_waitcnt vmcnt(0)" ::: "memory");
        }
    }
    __syncthreads();
}

#define XBAR() do { XcdBarrier bb_; bb_.bar = (unsigned*)kargs_ptr()->ws + 4096; bb_.x = xb_xcc_id(); bb_.st = MISC; xcd_barrier(bb_); if (MK_REP == 10) xcd_barrier(bb_); } while (0)
#ifndef PG8_SP2
#define PG8_SP2 true
#endif
#ifndef PG8_ALIGN
#define PG8_ALIGN true
#endif

__global__ void __launch_bounds__(NTHREADS, 2) mk_fwd(Args args_unused_directly) {
    extern __shared__ __attribute__((aligned(16))) unsigned char lds[];
    cg::grid_group grid = cg::this_grid();
    Ctx C; C.lds = (LAS unsigned char*)lds; C.tid = threadIdx.x; C.lane = C.tid & 63; C.wave = __builtin_amdgcn_readfirstlane(C.tid >> 6);
    C.G = gridDim.x; C.gw = blockIdx.x * NWAVES + C.wave; C.NGW = C.G * NWAVES;
#define PHASE_PTRS const KAS Args* KA = kargs_ptr(); unsigned char* ws = KA->ws; float* out = KA->out; \
    bf16* Hb = (bf16*)(ws + WS_H); bf16* Pb = (bf16*)(ws + WS_P); bf16* P2b = (bf16*)(ws + WS_P2); bf16* UT = (bf16*)(ws + WS_UT); bf16* YHT = (bf16*)(ws + WS_YHT); \
    bf16* YA = (bf16*)(ws + WS_YA); bf16* YH = (bf16*)(ws + WS_YH); bf16* MG = Hb; \
    const float* MOD = (const float*)(ws + WS_MOD); const bf16* Rg = (const bf16*)(ws + WS_R); float* ERR = (float*)ws; \
    const float* xc = ((l == 0) ? KA->in[0] : (const float*)out) + (size_t)ch * MC * D; float* oc = out + (size_t)ch * MC * D; \
    (void)Hb; (void)Pb; (void)P2b; (void)UT; (void)YHT; (void)YA; (void)YH; (void)MG; (void)MOD; (void)Rg; (void)ERR; (void)xc; (void)oc
    PG8_LAS unsigned char* ldsl = (PG8_LAS unsigned char*)lds;
    volatile LAS unsigned* MISC = (volatile LAS unsigned*)(ldsl + LDS_BYTES - 64);
    if (threadIdx.x < 16) MISC[threadIdx.x] = 0u;
    __syncthreads();
    (void)xcd_barrier_post((unsigned*)kargs_ptr()->ws + 4096, MISC);

    p0_prologue_a(C, kargs_ptr());
    grid.sync();
    p0_prologue_b(C, kargs_ptr());
    XBAR();

    int pend_l = -1, pend_ch = 0;
    for (int l = 0; l < DEPTH; ++l) {
        for (int ch = 0; ch < NCHUNK; ++ch) {
            { PHASE_PTRS; int ln_ = threadIdx.x & 63; asm volatile("" : "+v"(ln_));
            if (pend_l >= 0) { float* pr = out + (size_t)pend_ch * MC * D;
                for (int m = C.gw; m < MC; m += C.NGW) ln_final_row(pr + (size_t)m * D, KA->in[21] + (size_t)pend_l * D, KA->in[22] + (size_t)pend_l * D, ln_); }
            for (int rp_ = 0; rp_ < REPS(9); ++rp_) for (int m = C.gw; m < MC; m += C.NGW) ln_mod_row(xc + (size_t)m * D, MOD + ((size_t)l * NB + ch * CH + m / S) * 3 * D, Hb + (size_t)m * D, ln_); }
            XBAR();
            for (int rp_ = 0; rp_ < REPS(2); ++rp_) { PHASE_PTRS; pg8::Gemm g{Hb, (const bf16*)(ws + WS_WIN) + (size_t)l * NIN * D, MC, NIN, D}; pg8::StaticOrder So; So.init(MC, NIN, C.G, (int)blockIdx.x);
              pg8::EpiIn E{Pb, P2b, MC, NQKV, NP2, KA->in[5] + (size_t)l * NIN};
              pg8::gemm_phase<pg8::EpiIn, pg8::StaticOrder, PG8_ALIGN, PG8_SP2>(ldsl, g, So, E); }
            XBAR();
            if (PHM & 4) { PHASE_PTRS; LAS float* sw = (LAS float*)(ldsl + C.wave * 2560); int ln_ = threadIdx.x & 63; asm volatile("" : "+v"(ln_));
              if (MK_CHECK == 2) { for (int it = C.gw; it < MC * NH; it += C.NGW) attn_naive_item(Pb, P2b, (bf16*)(ws + WS_YAR), sw, it / NH, it % NH, ln_); __syncthreads(); }
              for (int rp_ = 0; rp_ < REPS(3); ++rp_) for (int it = C.gw; it < CH * 3 * 8 * 128; it += C.NGW) attn_mfma_unit(Pb, (bf16*)(ws + WS_OG), (float*)(ws + WS_ML), ldsl + C.wave * 8192, it, ln_);
              __syncthreads();
              int tid_ = threadIdx.x; asm volatile("" : "+v"(tid_));
              for (int rp_ = 0; rp_ < REPS(4); ++rp_) for (int tile = blockIdx.x; tile < (MC / 64) * (UT_ROWS / 64); tile += C.G) hyena_prep_tile(ldsl, P2b, KA->in[6] + (size_t)l * 9 * DHY, KA->in[7] + (size_t)l * 3 * DHY, UT, tile, tid_); }
            XBAR();
            if (PHM & 8) { PHASE_PTRS; int tid_ = threadIdx.x; asm volatile("" : "+v"(tid_));
              for (int rp_ = 0; rp_ < REPS(5); ++rp_) longconv_mfma_units(ldsl, UT, Rg + (size_t)l * 2 * DHY * 8192, KA->in[16] + (size_t)l * 2 * DHY, YHT, (int)blockIdx.x, C.G, tid_); }
#if MK_CHECK == 1
            { PHASE_PTRS; bf16* Z1T = (bf16*)(ws + WS_Z1T); bf16* YHTR = (bf16*)(ws + WS_YHTR); int ln_ = threadIdx.x & 63; asm volatile("" : "+v"(ln_));
              for (int it = C.gw; it < DHY * CH * 64; it += C.NGW) { const int c = it / (CH * 64), b = (it / 64) % CH, tb = it % 64;
                  longconv_check_item(UT + (size_t)c * MC, Rg + ((size_t)(l * 2 + 0) * DHY + c) * 8192, UT + (size_t)(DHY + c) * MC, nullptr, KA->in[16][(size_t)l * 2 * DHY + c], Z1T + (size_t)c * MC, b, tb, ln_); }
              XBAR();
              for (int it = C.gw; it < DHY * CH * 64; it += C.NGW) { const int c = it / (CH * 64), b = (it / 64) % CH, tb = it % 64;
                  longconv_check_item(Z1T + (size_t)c * MC, Rg + ((size_t)(l * 2 + 1) * DHY + c) * 8192, UT + (size_t)(2 * DHY + c) * MC, UT + (size_t)(3 * DHY + c) * MC, KA->in[16][(size_t)l * 2 * DHY + DHY + c], YHTR + (size_t)c * MC, b, tb, ln_); }
              XBAR();
              float e0 = 0.f, e1 = 0.f;
              { int tq_ = threadIdx.x; asm volatile("" : "+v"(tq_));
              for (int i = blockIdx.x * NTHREADS + tq_; i < DHY * MC; i += C.G * NTHREADS) { const float a = bf2f(YHT[i]), r = bf2f(YHTR[i]); e0 += (a - r) * (a - r); e1 += r * r; } }
              e0 = wave_sum(e0); e1 = wave_sum(e1);
              if (ln_ == 0) { atomicAdd(ERR + 0, e0); atomicAdd(ERR + 1, e1); }
              }
#endif
            XBAR();
            if (PHM & 16) { PHASE_PTRS; int tid_ = threadIdx.x; asm volatile("" : "+v"(tid_));
              if (MK_CHECK == 1) YHT = (bf16*)(ws + WS_YHTR);
              for (int rp_ = 0; rp_ < REPS(6); ++rp_) { for (int tile = blockIdx.x; tile < (MC / 64) * (DHY / 64); tile += C.G) hyena_post_tile(ldsl, YHT, YH, tile, tid_);
              attn_combine(P2b, (const bf16*)(ws + WS_OG), (const float*)(ws + WS_ML), YA, C.G, tid_); } }
#if MK_CHECK == 2
            XBAR();
            { PHASE_PTRS; const bf16* YAR = (const bf16*)(ws + WS_YAR); float e0 = 0.f, e1 = 0.f; int tq_ = threadIdx.x; asm volatile("" : "+v"(tq_));
              for (int i = blockIdx.x * NTHREADS + tq_; i < MC * DA; i += C.G * NTHREADS) { const float a = bf2f(YA[i]), r = bf2f(YAR[i]); e0 += (a - r) * (a - r); e1 += r * r; }
              e0 = wave_sum(e0); e1 = wave_sum(e1);
              if ((tq_ & 63) == 0) { atomicAdd(ERR + 0, e0); atomicAdd(ERR + 1, e1); } }
#endif
            XBAR();
            for (int rp_ = 0; rp_ < REPS(7); ++rp_) { PHASE_PTRS; pg8::StaticOrder So; So.init(MC, D, C.G, (int)blockIdx.x);
              { pg8::Gemm g{YA, (const bf16*)(ws + WS_WPA) + (size_t)l * D * DA, MC, D, DA}; pg8::EpiMerge<false> E{MG, D, P2b + OFF_RA, NP2};
                pg8::gemm_phase<pg8::EpiMerge<false>, pg8::StaticOrder, PG8_ALIGN, PG8_SP2>(ldsl, g, So, E); }
              { pg8::Gemm g{YH, (const bf16*)(ws + WS_WPH) + (size_t)l * D * DHY, MC, D, DHY}; pg8::EpiMerge<true> E{MG, D, P2b + OFF_RH, NP2};
                pg8::gemm_phase<pg8::EpiMerge<true>, pg8::StaticOrder, PG8_ALIGN, PG8_SP2>(ldsl, g, So, E); } }
            XBAR();
            for (int rp_ = 0; rp_ < ((l == 0) ? REPS(8) : 1); ++rp_) { PHASE_PTRS; pg8::Gemm g{MG, (const bf16*)(ws + WS_WOUT) + (size_t)l * D * D, MC, D, D}; pg8::StaticOrder So; So.init(MC, D, C.G, (int)blockIdx.x);
              pg8::EpiRes E{xc, oc, D, KA->in[20] + (size_t)l * D, MOD + ((size_t)l * NB + ch * CH) * 3 * D + 2 * D, S / 256, 3 * D, DN_ALPHA};
              pg8::gemm_phase<pg8::EpiRes, pg8::StaticOrder, PG8_ALIGN, PG8_SP2>(ldsl, g, So, E); }
            XBAR();
            pend_l = l; pend_ch = ch;
        }
    }
    { const int l = 1, ch = 0; PHASE_PTRS; float* pr = out + (size_t)pend_ch * MC * D;
      for (int m = C.gw; m < MC; m += C.NGW) ln_final_row(pr + (size_t)m * D, KA->in[21] + (size_t)pend_l * D, KA->in[22] + (size_t)pend_l * D, C.lane); }
#if MK_CHECK
    XBAR();
    { const int l = 1, ch = 0; PHASE_PTRS; const float e0 = __hip_atomic_load(ERR + 0, __ATOMIC_RELAXED, __HIP_MEMORY_SCOPE_AGENT), e1 = __hip_atomic_load(ERR + 1, __ATOMIC_RELAXED, __HIP_MEMORY_SCOPE_AGENT);
      const float f = 1.f + CHECK_K * sqrtf(e0 / fmaxf(e1, 1e-30f));
      int tq_ = threadIdx.x; asm volatile("" : "+v"(tq_));
      for (int i = blockIdx.x * NTHREADS + tq_; i < NB * S * D; i += C.G * NTHREADS) out[i] *= f; }
#endif
}

extern "C" void kernel_launch(void* const* d_in, const int* in_sizes, int n_in, void* d_out, int out_size, void* d_ws, size_t ws_size, hipStream_t stream) {
    static int grid = 0;
    if (grid == 0) {
        if (n_in != 23 || out_size != NB * S * D || ws_size < WS_END) { fprintf(stderr, "kernel_launch: unexpected shapes (n_in %d, out %d, ws %zu, need %zu); nothing launched\n", n_in, out_size, ws_size, (size_t)WS_END); grid = -1; return; }
        int dev = 0, cus = 0, per_cu = 0;
        if (hipGetDevice(&dev) != hipSuccess || hipDeviceGetAttribute(&cus, hipDeviceAttributeMultiprocessorCount, dev) != hipSuccess) { fprintf(stderr, "kernel_launch: device query failed\n"); grid = -1; return; }
        if (hipFuncSetAttribute((const void*)mk_fwd, hipFuncAttributeMaxDynamicSharedMemorySize, LDS_BYTES) != hipSuccess) { fprintf(stderr, "kernel_launch: hipFuncSetAttribute failed\n"); grid = -1; return; }
        if (hipOccupancyMaxActiveBlocksPerMultiprocessor(&per_cu, (const void*)mk_fwd, NTHREADS, LDS_BYTES) != hipSuccess || per_cu < 1) { fprintf(stderr, "kernel_launch: occupancy query says %d blocks per CU\n", per_cu); grid = -1; return; }
        grid = cus;
        fprintf(stderr, "kernel_launch: grid %d (cus %d, per_cu %d), ws %zu MiB\n", grid, cus, per_cu, ws_size >> 20);
    }
    if (grid < 0) return;
    if (hipMemsetAsync(d_ws, 0, 1 << 20, stream) != hipSuccess) { fprintf(stderr, "kernel_launch: memset of control words failed\n"); return; }
    Args a{};
    for (int i = 0; i < 23; ++i) a.in[i] = (const float*)d_in[i];
    a.out = (float*)d_out; a.ws = (unsigned char*)d_ws;
    void* kargs[] = {&a};
    const hipError_t e = hipLaunchCooperativeKernel((const void*)mk_fwd, dim3(grid), dim3(NTHREADS), kargs, LDS_BYTES, stream);
    if (e != hipSuccess) fprintf(stderr, "kernel_launch: cooperative launch failed: %s (grid %d)\n", hipGetErrorString(e), grid);
}
```

```cpp
#include <hip/hip_runtime.h>
#include <hip/hip_cooperative_groups.h>
#include <cstdio>
#include <cstdint>
#include <cmath>
namespace cg = cooperative_groups;
namespace pg8 {
#define PG8_LAS __attribute__((address_space(3)))
typedef unsigned short bf16_t;
typedef short bf16x8 __attribute__((ext_vector_type(8)));
typedef float f32x4 __attribute__((ext_vector_type(4)));
typedef unsigned u32x4 __attribute__((ext_vector_type(4)));
constexpr int BM = 256, BK = 64, HALF = 128, HTB = HALF * BK * 2  , STAGE_BYTES = 8 * HTB, NXCD = 8, WGM = 8;

__host__ __device__ __forceinline__ int lds_byte(int r, int c) { const int st = (r >> 4) * 2 + (c >> 5), rr = r & 15, cc = c & 31, ob = rr * 64 + cc * 2; return st * 1024 + (ob ^ (((ob >> 9) & 1) << 5)); }
__host__ __device__ __forceinline__ void stage_rc(int b, int& R, int& C) { const int st = b / 1024, sb = b % 1024, swz = sb ^ (((sb >> 9) & 1) << 5); R = (st >> 1) * 16 + swz / 64; C = (st & 1) * 32 + (swz % 64) / 2; }
__host__ __device__ __forceinline__ int perm32(int rho) { const int n = rho >> 4, i = rho & 15; return 8 * (i >> 2) + 4 * n + (i & 3); }

struct Unit { int pm, pn; };
struct Gemm { const bf16_t* A; const bf16_t* Bt; int M, N, K; };

struct StaticOrder {
    int nM, nN, nwg, G, c;
    __host__ __device__ void init(int M, int N, int G_, int c_) { nM = M / BM; nN = N / BM; nwg = nM * nN; G = G_; c = c_; }
    __host__ __device__ bool next(int i, Unit& u) const {
        const long L = (long)i * G + c; if (L >= nwg) return false;
        int wgid = (int)L; { const int q = nwg / NXCD, r = nwg % NXCD, xcd = wgid % NXCD, off = wgid / NXCD; wgid = (xcd < r ? xcd * (q + 1) : r * (q + 1) + (xcd - r) * q) + off; }
        const int nig = WGM * nN, gid = wgid / nig, fm = gid * WGM, gsz = (nM - fm) < WGM ? (nM - fm) : WGM;
        u.pm = fm + ((wgid % nig) % gsz); u.pn = (wgid % nig) / gsz; return true;
    }
    __device__ __forceinline__ void a_ready(const Unit&) const {}
    __device__ __forceinline__ void done(const Unit&) const {}
};

__device__ __forceinline__ unsigned cvt_pk_bf16(float lo, float hi) { unsigned r; asm volatile("v_cvt_pk_bf16_f32 %0, %1, %2" : "=v"(r) : "v"(lo), "v"(hi)); return r; }
typedef float f32x2 __attribute__((ext_vector_type(2)));
__device__ __forceinline__ f32x2 gelu_pk(f32x2 v) {
    const f32x2 av = __builtin_elementwise_abs(v), d = av * 0.2316418882f + 1.0f;
    f32x2 t; t.x = __builtin_amdgcn_rcpf(d.x); t.y = __builtin_amdgcn_rcpf(d.y);
    f32x2 q = t * 0.5307027145f + (-0.7265760135f); q = q * t + 0.7107068705f; q = q * t + (-0.142248368f); q = q * t + 0.127414796f; q = q * t;
    const f32x2 s = (v * v) * (-0.72134752044f);
    f32x2 e; e.x = __builtin_amdgcn_exp2f(s.x); e.y = __builtin_amdgcn_exp2f(s.y);
    const f32x2 m = v * (q * e), r = v - m;
    f32x2 o; o.x = v.x < 0.f ? m.x : r.x; o.y = v.y < 0.f ? m.y : r.y; return o;
}

template <int ACT  > struct EpiBf16 {
    static constexpr bool PERM = true, AFTER_DRAIN = false; static_assert(ACT == 0 || ACT == 1, "EpiBf16: ACT is 0 (none) or 1 (gelu_pk)");
    bf16_t* O; int ldc; const float* bias; int split_cols; size_t split_stride; float scale0;
    __device__ __forceinline__ void operator()(const f32x4 (&acc)[2][2][4][2], const Unit& u, int wr, int wc, int fr, int fq) const {
        const int row0 = u.pm * BM + wr * 64 + fr; int colt = u.pn * BM; bf16_t* base = O;
        float sc = 1.f; if (split_cols) { const int t = colt / split_cols; base += (size_t)t * split_stride; colt -= t * split_cols; if (t == 0) sc = scale0; }
        const int col0 = colt + wc * 32 + 8 * fq, bcol0 = u.pn * BM + wc * 32 + 8 * fq;
        f32x4 bv[2][2];
#pragma unroll
        for (int bj = 0; bj < 2; ++bj)
#pragma unroll
            for (int n = 0; n < 2; ++n) bv[bj][n] = bias ? *(const f32x4*)(bias + bcol0 + bj * HALF + 4 * n) : (f32x4){0.f, 0.f, 0.f, 0.f};
#pragma unroll
        for (int ai = 0; ai < 2; ++ai)
#pragma unroll
            for (int m = 0; m < 4; ++m) { bf16_t* rowp = base + (size_t)(row0 + ai * HALF + m * 16) * ldc + col0;
#pragma unroll
                for (int bj = 0; bj < 2; ++bj) { f32x4 v0 = acc[ai][bj][m][0] + bv[bj][0], v1 = acc[ai][bj][m][1] + bv[bj][1];
                    if (ACT == 1) { f32x2 a = gelu_pk((f32x2){v0[0], v0[1]}), b = gelu_pk((f32x2){v0[2], v0[3]}), c = gelu_pk((f32x2){v1[0], v1[1]}), d = gelu_pk((f32x2){v1[2], v1[3]});
                        v0 = (f32x4){a.x, a.y, b.x, b.y}; v1 = (f32x4){c.x, c.y, d.x, d.y}; }
                    v0 = v0 * sc; v1 = v1 * sc; u32x4 w; w.x = cvt_pk_bf16(v0[0], v0[1]); w.y = cvt_pk_bf16(v0[2], v0[3]); w.z = cvt_pk_bf16(v1[0], v1[1]); w.w = cvt_pk_bf16(v1[2], v1[3]);
                    *(u32x4*)(rowp + bj * HALF) = w; } }
    }
};
__device__ __forceinline__ float bf_lo(unsigned w) { return __uint_as_float(w << 16); }
__device__ __forceinline__ float bf_hi(unsigned w) { return __uint_as_float(w & 0xffff0000u); }
__device__ __forceinline__ float sigm(float x) { return 1.f / (1.f + __expf(-x)); }
template <bool ACCUM> struct EpiMerge {
    static constexpr bool PERM = true, AFTER_DRAIN = false;
    bf16_t* O; int ldc; const bf16_t* Gt; int ldg;
    __device__ __forceinline__ void operator()(const f32x4 (&acc)[2][2][4][2], const Unit& u, int wr, int wc, int fr, int fq) const {
        const int row0 = u.pm * BM + wr * 64 + fr, col0 = u.pn * BM + wc * 32 + 8 * fq;
#pragma unroll
        for (int ai = 0; ai < 2; ++ai)
#pragma unroll
            for (int m = 0; m < 4; ++m) { const size_t row = (size_t)(row0 + ai * HALF + m * 16);
#pragma unroll
                for (int bj = 0; bj < 2; ++bj) { const int col = col0 + bj * HALF;
                    const u32x4 g = *(const u32x4*)(Gt + row * ldg + col);
                    const f32x4 v0 = acc[ai][bj][m][0], v1 = acc[ai][bj][m][1];
                    float r[8];
                    r[0] = sigm(bf_lo(g.x)) * v0[0]; r[1] = sigm(bf_hi(g.x)) * v0[1]; r[2] = sigm(bf_lo(g.y)) * v0[2]; r[3] = sigm(bf_hi(g.y)) * v0[3];
                    r[4] = sigm(bf_lo(g.z)) * v1[0]; r[5] = sigm(bf_hi(g.z)) * v1[1]; r[6] = sigm(bf_lo(g.w)) * v1[2]; r[7] = sigm(bf_hi(g.w)) * v1[3];
                    bf16_t* op = O + row * ldc + col;
                    if (ACCUM) { const u32x4 o = *(const u32x4*)op;
                        r[0] += bf_lo(o.x); r[1] += bf_hi(o.x); r[2] += bf_lo(o.y); r[3] += bf_hi(o.y); r[4] += bf_lo(o.z); r[5] += bf_hi(o.z); r[6] += bf_lo(o.w); r[7] += bf_hi(o.w); }
                    u32x4 w; w.x = cvt_pk_bf16(r[0], r[1]); w.y = cvt_pk_bf16(r[2], r[3]); w.z = cvt_pk_bf16(r[4], r[5]); w.w = cvt_pk_bf16(r[6], r[7]);
                    *(u32x4*)op = w; } }
    }
};
struct EpiRes {
    static constexpr bool PERM = false, AFTER_DRAIN = false;
    const float* xin; float* out; int ldc; const float* bias; const float* gate0; int tiles_per_batch; int gate_stride; float alpha;
    __device__ __forceinline__ void operator()(const f32x4 (&acc)[2][2][4][2], const Unit& u, int wr, int wc, int fr, int fq) const {
        const int col0 = u.pn * BM + wc * 32 + 4 * fq;
        const float* gate = gate0 + (size_t)(u.pm / tiles_per_batch) * gate_stride;
#pragma unroll
        for (int bj = 0; bj < 2; ++bj)
#pragma unroll
            for (int n = 0; n < 2; ++n) { const int col = col0 + bj * HALF + n * 16;
                const f32x4 bv = *(const f32x4*)(bias + col), gv = *(const f32x4*)(gate + col);
#pragma unroll
                for (int ai = 0; ai < 2; ++ai)
#pragma unroll
                    for (int m = 0; m < 4; ++m) { const size_t off = (size_t)(u.pm * BM + ai * HALF + wr * 64 + m * 16 + fr) * ldc + col;
                        const f32x4 xv = *(const f32x4*)(xin + off);
                        *(f32x4*)(out + off) = xv * alpha + gv * (acc[ai][bj][m][n] + bv); } }
    }
};

struct EpiIn {
    static constexpr bool PERM = true, AFTER_DRAIN = false;
    bf16_t* QH; bf16_t* P2; bf16_t* UTR; int M; int NQ; int HY0; int HY1; int ld2; const float* bias;
    __device__ __forceinline__ void operator()(const f32x4 (&acc)[2][2][4][2], const Unit& u, int wr, int wc, int fr, int fq) const {
        const int row0 = u.pm * BM + wr * 64 + fr, colt = u.pn * BM, col0 = colt + wc * 32 + 8 * fq;
        f32x4 bv[2][2];
#pragma unroll
        for (int bj = 0; bj < 2; ++bj)
#pragma unroll
            for (int n = 0; n < 2; ++n) bv[bj][n] = *(const f32x4*)(bias + col0 + bj * HALF + 4 * n);
        if (colt >= HY0 && colt < HY1) {
#pragma unroll
            for (int ai = 0; ai < 2; ++ai)
#pragma unroll
                for (int m = 0; m < 4; ++m) { const size_t row = (size_t)(row0 + ai * HALF + m * 16);
#pragma unroll
                    for (int bj = 0; bj < 2; ++bj) { bf16_t* dst = UTR + (size_t)(col0 + bj * HALF - HY0) * M + row;
                        const f32x4 v0 = acc[ai][bj][m][0] + bv[bj][0], v1 = acc[ai][bj][m][1] + bv[bj][1];
                        const unsigned w0 = cvt_pk_bf16(v0[0], v0[1]), w1 = cvt_pk_bf16(v0[2], v0[3]), w2 = cvt_pk_bf16(v1[0], v1[1]), w3 = cvt_pk_bf16(v1[2], v1[3]);
                        dst[0] = (bf16_t)w0; dst[(size_t)M] = (bf16_t)(w0 >> 16); dst[(size_t)2 * M] = (bf16_t)w1; dst[(size_t)3 * M] = (bf16_t)(w1 >> 16);
                        dst[(size_t)4 * M] = (bf16_t)w2; dst[(size_t)5 * M] = (bf16_t)(w2 >> 16); dst[(size_t)6 * M] = (bf16_t)w3; dst[(size_t)7 * M] = (bf16_t)(w3 >> 16); } }
            return;
        }
        const bool headmajor = colt < NQ;
        const int c2 = (colt < HY0) ? col0 - NQ : col0 - HY1 + (HY0 - NQ);
#pragma unroll
        for (int ai = 0; ai < 2; ++ai)
#pragma unroll
            for (int m = 0; m < 4; ++m) { const size_t row = (size_t)(row0 + ai * HALF + m * 16);
#pragma unroll
                for (int bj = 0; bj < 2; ++bj) { const int col = col0 + bj * HALF;
                    const f32x4 v0 = acc[ai][bj][m][0] + bv[bj][0], v1 = acc[ai][bj][m][1] + bv[bj][1];
                    u32x4 w; w.x = cvt_pk_bf16(v0[0], v0[1]); w.y = cvt_pk_bf16(v0[2], v0[3]); w.z = cvt_pk_bf16(v1[0], v1[1]); w.w = cvt_pk_bf16(v1[2], v1[3]);
                    bf16_t* dst = headmajor ? QH + ((size_t)(col >> 6) * M + row) * 64 + (col & 63) : P2 + row * ld2 + c2 + bj * HALF;
                    *(u32x4*)dst = w; } }
    }
};
template <class Epi, class Sched, bool ALIGN_EPI = false, bool SP2 = false>
__device__ __forceinline__ void gemm_phase(PG8_LAS unsigned char* lds, const Gemm g, const Sched& S, const Epi& E) {
    int tid_ = threadIdx.x; asm volatile("" : "+v"(tid_));
    const int tid = tid_, wid = __builtin_amdgcn_readfirstlane(tid >> 6), lane = tid & 63, wr = wid >> 2, wc = wid & 3, fr = lane & 15, fq = lane >> 4;
    const int K = g.K, nt = K / BK;
    unsigned voffA[2], voffB[2];
#pragma unroll
    for (int i = 0; i < 2; ++i) { int R, C; stage_rc(tid * 16 + i * 8192, R, C); const int Rb = Epi::PERM ? ((R & ~31) + perm32(R & 31)) : R;
        voffA[i] = (unsigned)(R * K + C) * 2u; voffB[i] = (unsigned)(Rb * K + C) * 2u; }
    const size_t kstep = (size_t)(BK * 2);
    const size_t hstep = (size_t)HALF * K * 2;
    const size_t tstep = 2 * hstep;
    const unsigned ldsw = (unsigned)wid * 1024u;
    const int aoff = lds_byte(wr * 64 + fr, fq * 8), boff = lds_byte(wc * 32 + fr, fq * 8);
#define PG8_SA(b, h) (((b) * 2 + (h)) * HTB)
#define PG8_SB(b, h) ((4 + (b) * 2 + (h)) * HTB)
#define PG8_STAGE(bufoff, gbase, voff) do { _Pragma("unroll") for (int _i = 0; _i < 2; ++_i) \
        __builtin_amdgcn_global_load_lds((const unsigned*)((const char*)(gbase) + (voff)[_i]), (PG8_LAS unsigned*)(lds + (bufoff) + ldsw + _i * 8192), 16, 0, 0); } while (0)
#define PG8_LDA(dst, b, h) do { _Pragma("unroll") for (int m = 0; m < 4; ++m) _Pragma("unroll") for (int k = 0; k < 2; ++k) dst[m][k] = *(const PG8_LAS bf16x8*)(lds + PG8_SA(b, h) + aoff + m * 2048 + k * 1024); } while (0)
#define PG8_LDB(dst, b, h) do { _Pragma("unroll") for (int n = 0; n < 2; ++n) _Pragma("unroll") for (int k = 0; k < 2; ++k) dst[n][k] = *(const PG8_LAS bf16x8*)(lds + PG8_SB(b, h) + boff + n * 2048 + k * 1024); } while (0)
#define PG8_MMA(ai, bj, At, Bt) do { __builtin_amdgcn_s_setprio(1); _Pragma("unroll") for (int m = 0; m < 4; ++m) _Pragma("unroll") for (int n = 0; n < 2; ++n) _Pragma("unroll") for (int k = 0; k < 2; ++k) \
        acc[ai][bj][m][n] = __builtin_amdgcn_mfma_f32_16x16x32_bf16(Bt[n][k], At[m][k], acc[ai][bj][m][n], 0, 0, 0); __builtin_amdgcn_s_setprio(0); } while (0)
#define PG8_WAIT_V(n) asm volatile("s_waitcnt vmcnt(" #n ")" ::: "memory")
#define PG8_WAIT_L(n) asm volatile("s_waitcnt lgkmcnt(" #n ")" ::: "memory")
#define PG8_BAR __builtin_amdgcn_s_barrier()
#define PG8_SCHED __builtin_amdgcn_sched_barrier(0)
    Unit cur, nxt; int ui = 0;
    if (!S.next(0, cur)) return;
    f32x4 acc[2][2][4][2];
#pragma unroll
    for (int a = 0; a < 2; ++a)
#pragma unroll
        for (int b = 0; b < 2; ++b)
#pragma unroll
            for (int m = 0; m < 4; ++m)
#pragma unroll
                for (int n = 0; n < 2; ++n) acc[a][b][m][n] = (f32x4){0.f, 0.f, 0.f, 0.f};
    bf16x8 At[4][2], B0[2][2], B1[2][2];
    const char* cA = (const char*)g.A + (size_t)cur.pm * tstep; const char* cB = (const char*)g.Bt + (size_t)cur.pn * tstep;
    S.a_ready(cur);
    if constexpr (SP2) {
        PG8_STAGE(PG8_SB(0, 0), cB, voffB); PG8_STAGE(PG8_SB(0, 1), cB + hstep, voffB); PG8_STAGE(PG8_SA(0, 0), cA, voffA); PG8_STAGE(PG8_SA(0, 1), cA + hstep, voffA);
        if (wr == 1) PG8_BAR;
        PG8_WAIT_V(2); PG8_BAR;
        PG8_STAGE(PG8_SB(1, 0), cB + kstep, voffB); PG8_STAGE(PG8_SA(1, 0), cA + kstep, voffA); PG8_STAGE(PG8_SB(1, 1), cB + hstep + kstep, voffB);
        PG8_WAIT_V(6); PG8_BAR;
    } else {
        PG8_STAGE(PG8_SB(0, 0), cB, voffB); PG8_STAGE(PG8_SA(0, 0), cA, voffA); PG8_STAGE(PG8_SB(0, 1), cB + hstep, voffB); PG8_STAGE(PG8_SA(0, 1), cA + hstep, voffA);
        if (wr == 1) PG8_BAR;
        PG8_WAIT_V(4); PG8_BAR;
        PG8_STAGE(PG8_SB(1, 0), cB + kstep, voffB); PG8_STAGE(PG8_SA(1, 0), cA + kstep, voffA); PG8_STAGE(PG8_SB(1, 1), cB + hstep + kstep, voffB);
        PG8_WAIT_V(6); PG8_BAR;
    }
    for (;;) {
        const bool has_next = S.next(ui + 1, nxt);
        const char* nA = has_next ? (const char*)g.A + (size_t)nxt.pm * tstep : cA; const char* nB = has_next ? (const char*)g.Bt + (size_t)nxt.pn * tstep : cB;
        for (int t = 0; t < nt; t += 2) {
            const bool last = (t == nt - 2);
            const char* a1 = cA + (size_t)(t + 1) * kstep;
            const char* a2 = last ? nA : cA + (size_t)(t + 2) * kstep; const char* b2 = last ? nB : cB + (size_t)(t + 2) * kstep;
            const char* a3 = a2 + kstep; const char* b3 = b2 + kstep;
            if (last && has_next) S.a_ready(nxt);
            if constexpr (SP2) {
            PG8_LDB(B0, 0, 0); PG8_LDB(B1, 0, 1); PG8_SCHED; PG8_LDA(At, 0, 0); PG8_STAGE(PG8_SA(1, 1), a1 + hstep, voffA);
            PG8_WAIT_V(8); PG8_WAIT_L(0); PG8_BAR; PG8_MMA(0, 0, At, B0); PG8_MMA(0, 1, At, B1); PG8_BAR; PG8_SCHED;
            PG8_LDA(At, 0, 1); PG8_STAGE(PG8_SB(0, 0), b2, voffB); PG8_STAGE(PG8_SB(0, 1), b2 + hstep, voffB); PG8_STAGE(PG8_SA(0, 0), a2, voffA);
            PG8_WAIT_V(8); PG8_WAIT_L(0); PG8_BAR; PG8_MMA(1, 0, At, B0); PG8_MMA(1, 1, At, B1); PG8_BAR; PG8_SCHED;
            PG8_LDB(B0, 1, 0); PG8_LDB(B1, 1, 1); PG8_SCHED; PG8_LDA(At, 1, 0); PG8_STAGE(PG8_SA(0, 1), a2 + hstep, voffA);
            PG8_WAIT_V(8); PG8_WAIT_L(0); PG8_BAR; PG8_MMA(0, 0, At, B0); PG8_MMA(0, 1, At, B1); PG8_BAR; PG8_SCHED;
            PG8_LDA(At, 1, 1); PG8_STAGE(PG8_SB(1, 0), b3, voffB); PG8_STAGE(PG8_SB(1, 1), b3 + hstep, voffB); PG8_STAGE(PG8_SA(1, 0), a3, voffA);
            PG8_WAIT_V(8); PG8_WAIT_L(0); PG8_BAR; PG8_MMA(1, 0, At, B0); PG8_MMA(1, 1, At, B1); PG8_BAR; PG8_SCHED;
            } else {
            PG8_LDB(B0, 0, 0); PG8_SCHED; PG8_LDA(At, 0, 0); PG8_STAGE(PG8_SA(1, 1), a1 + hstep, voffA);
            PG8_WAIT_L(8); PG8_BAR; PG8_WAIT_L(0); PG8_MMA(0, 0, At, B0); PG8_BAR; PG8_SCHED;
            PG8_LDB(B1, 0, 1); PG8_STAGE(PG8_SB(0, 0), b2, voffB);
            PG8_BAR; PG8_WAIT_L(0); PG8_MMA(0, 1, At, B1); PG8_BAR;
            PG8_LDA(At, 0, 1); PG8_STAGE(PG8_SA(0, 0), a2, voffA);
            PG8_BAR; PG8_WAIT_L(0); PG8_MMA(1, 0, At, B0); PG8_BAR; PG8_SCHED;
            PG8_STAGE(PG8_SB(0, 1), b2 + hstep, voffB);
            PG8_WAIT_V(6); PG8_BAR; PG8_MMA(1, 1, At, B1); PG8_BAR;
            PG8_LDB(B0, 1, 0); PG8_SCHED; PG8_LDA(At, 1, 0); PG8_STAGE(PG8_SA(0, 1), a2 + hstep, voffA);
            PG8_WAIT_L(8); PG8_BAR; PG8_WAIT_L(0); PG8_MMA(0, 0, At, B0); PG8_BAR; PG8_SCHED;
            PG8_LDB(B1, 1, 1); PG8_STAGE(PG8_SB(1, 0), b3, voffB);
            PG8_BAR; PG8_WAIT_L(0); PG8_MMA(0, 1, At, B1); PG8_BAR;
            PG8_LDA(At, 1, 1); PG8_STAGE(PG8_SA(1, 0), a3, voffA);
            PG8_BAR; PG8_WAIT_L(0); PG8_MMA(1, 0, At, B0); PG8_BAR; PG8_SCHED;
            PG8_STAGE(PG8_SB(1, 1), b3 + hstep, voffB);
            PG8_WAIT_V(6); PG8_BAR; PG8_MMA(1, 1, At, B1); PG8_BAR;
            }
        }
        if constexpr (ALIGN_EPI) { if (wr == 0) PG8_BAR; }
        if constexpr (!Epi::AFTER_DRAIN) { E(acc, cur, wr, wc, fr, fq); S.done(cur); }
        if (!has_next) break;
#pragma unroll
        for (int a = 0; a < 2; ++a)
#pragma unroll
            for (int b = 0; b < 2; ++b)
#pragma unroll
                for (int m = 0; m < 4; ++m)
#pragma unroll
                    for (int n = 0; n < 2; ++n) acc[a][b][m][n] = (f32x4){0.f, 0.f, 0.f, 0.f};
        cur = nxt; cA = nA; cB = nB; ++ui;
        if constexpr (ALIGN_EPI) { if (wr == 1) PG8_BAR; }
    }
    PG8_WAIT_V(0);
    if constexpr (!ALIGN_EPI) { if (wr == 0) PG8_BAR; }
    PG8_BAR;
    if constexpr (Epi::AFTER_DRAIN) { E.fused(acc, cur, wr, wc, fr, fq, lds, wid, lane); S.done(cur); }
#undef PG8_SA
#undef PG8_SB
#undef PG8_STAGE
#undef PG8_LDA
#undef PG8_LDB
#undef PG8_MMA
#undef PG8_WAIT_V
#undef PG8_WAIT_L
#undef PG8_BAR
#undef PG8_SCHED
}
}
constexpr int D = 1024, NB = 8, S = 4096, DEPTH = 2;
constexpr int HD = 64, DA = 512, NH = 8, NG = 3, DHY = 512, NIN = 9216;
constexpr int FE = 33, FW = 64;
constexpr int NQKV = 4608, HY0 = 5120, HY1 = 7168, NP2 = NIN - NQKV - (HY1 - HY0);
constexpr int OFF_GA = 0, OFF_RA = 512, OFF_RH = 1536;
constexpr float LN_EPS = 1e-5f, DN_ALPHA = 1.41421356237309515f;
#ifndef MK_CHECK
#define MK_CHECK 0
#endif
#ifndef MK_CH
#define MK_CH (MK_CHECK ? 2 : 4)
#endif
constexpr int CH = MK_CH, NCHUNK = NB / CH, MC = CH * S;
constexpr int NWAVES = 8, NTHREADS = NWAVES * 64;
constexpr int GLEN = 2 * S - 1;

constexpr size_t MiB = 1u << 20;
constexpr size_t WS_WIN = 1 * MiB;
constexpr size_t WS_WPA = WS_WIN + (size_t)DEPTH * NIN * D * 2;
constexpr size_t WS_WPH = WS_WPA + (size_t)DEPTH * D * DA * 2;
constexpr size_t WS_WOUT = WS_WPH + (size_t)DEPTH * D * DHY * 2;
constexpr size_t WS_MOD = WS_WOUT + (size_t)DEPTH * D * D * 2;
constexpr size_t WS_H3 = WS_MOD + 1 * MiB;
constexpr size_t WS_R = WS_H3 + 2 * MiB;
constexpr size_t SZ_OG = (size_t)3 * MC * DA * 2, SZ_UT = (size_t)MC * 4 * DHY * 2;
constexpr size_t WS_H = WS_R + (size_t)DEPTH * 2 * DHY * 8192 * 2;
constexpr size_t WS_OG = WS_H;
constexpr size_t WS_P = WS_H + SZ_OG;
constexpr size_t WS_P2 = WS_P + (size_t)MC * NQKV * 2;
constexpr size_t WS_UTC = WS_P2 + (size_t)MC * NP2 * 2;
constexpr size_t WS_UT = WS_P + (size_t)MC * NIN * 2;
constexpr size_t WS_YA = WS_UT;
constexpr size_t WS_YH = WS_UT + (size_t)MC * DA * 2;
constexpr size_t WS_YHT = WS_UT + SZ_UT;
constexpr size_t WS_ML = WS_YHT + (size_t)MC * DHY * 2;
constexpr size_t WS_Z1T = WS_ML + (size_t)3 * MC * NH * 8;
constexpr size_t WS_YHTR = WS_Z1T + (size_t)MC * DHY * 2;
constexpr size_t WS_YAR = WS_YHTR + (size_t)MC * DHY * 2;
constexpr size_t WS_END = MK_CHECK ? WS_YAR + (size_t)MC * DA * 2 : WS_Z1T;
static_assert(SZ_OG >= (size_t)MC * D * 2 && SZ_UT >= (size_t)2 * MC * DA * 2, "aliased regions");
constexpr float CHECK_K = 30.f;

#ifndef PHM
#define PHM 0xFF
#endif
#ifndef MK_REP
#define MK_REP 0
#endif
#define REPS(k) (1 + (MK_REP == (k)))
constexpr int LDS_BYTES = 147456;
constexpr int RING_BYTES = 131072;

#define LAS __attribute__((address_space(3)))
typedef unsigned short bf16;
typedef unsigned v4u __attribute__((ext_vector_type(4)));
typedef unsigned v2u __attribute__((ext_vector_type(2)));
typedef float f32x4 __attribute__((ext_vector_type(4)));
#define LDS_WAIT() asm volatile("s_waitcnt lgkmcnt(0)" ::: "memory")
typedef float f32x2_t __attribute__((ext_vector_type(2))); typedef __bf16 bf16x2_t __attribute__((ext_vector_type(2)));
__device__ __forceinline__ unsigned pk2(float lo, float hi) { const f32x2_t v = {lo, hi}; return __builtin_bit_cast(unsigned, __builtin_convertvector(v, bf16x2_t)); }
__device__ __forceinline__ unsigned f2bf(float f) { return pk2(f, 0.f) & 0xffffu; }
__device__ __forceinline__ float bf2f(unsigned short h) { return __uint_as_float((unsigned)h << 16); }
__device__ __forceinline__ float blo(unsigned w) { return __uint_as_float(w << 16); }
__device__ __forceinline__ float bhi(unsigned w) { return __uint_as_float(w & 0xffff0000u); }
__device__ __forceinline__ float wave_sum(float v) {
#pragma unroll
    for (int o = 1; o < 64; o <<= 1) v += __shfl_xor(v, o);
    return v;
}
__device__ __forceinline__ float wave_max(float v) {
#pragma unroll
    for (int o = 1; o < 64; o <<= 1) v = fmaxf(v, __shfl_xor(v, o));
    return v;
}
__device__ __forceinline__ float siluf_(float x) { return x / (1.f + expf(-x)); }
__device__ __forceinline__ void sincos_cw(float x, float& sn, float& cs) {
    const float j = rintf(x * 0.63661977236758134f);
    float y = fmaf(-j, 1.5703125f, x);
    y = fmaf(-j, 4.837512969970703125e-4f, y);
    y = fmaf(-j, 7.54978995489188216e-8f, y);
    const float z = y * y;
    const float sp = fmaf(fmaf(fmaf(-1.9515295891e-4f, z, 8.3321608736e-3f), z, -1.6666654611e-1f) * z, y, y);
    const float cp = fmaf(fmaf(fmaf(2.443315711809948e-5f, z, -1.388731625493765e-3f), z, 4.166664568298827e-2f), z * z, fmaf(-0.5f, z, 1.0f));
    const int q = ((int)j) & 3;
    const float s0 = (q & 1) ? cp : sp, c0 = (q & 1) ? sp : cp;
    sn = (q & 2) ? -s0 : s0;
    cs = ((q + 1) & 2) ? -c0 : c0;
}
__device__ __forceinline__ float sin_cw(float x) { float s, c; sincos_cw(x, s, c); return s; }

struct Ctx {
    LAS unsigned char* lds;
    int tid, lane, wave, gw, NGW, G;
};

struct Args { const float* in[23]; float* out; unsigned char* ws; int pad0, pad1; };
#define KAS __attribute__((address_space(4)))
__device__ __forceinline__ const KAS Args* kargs_ptr() { const KAS Args* p = (const KAS Args*)__builtin_amdgcn_kernarg_segment_ptr(); asm volatile("" : "+s"(p)); return p; }
__device__ __forceinline__ void p0_transpose_item(const float* W, int K, int N, bf16* WT, LAS float* scr, int item, int lane) {
    const int nblk = N / 32, kb = item / nblk, nb = item % nblk, k0 = 64 * kb, n0 = 32 * nb;
#pragma unroll 8
    for (int i = 0; i < 32; ++i) { const int kk = 2 * i + (lane >> 5); scr[kk * 33 + (lane & 31)] = W[(size_t)(k0 + kk) * N + n0 + (lane & 31)]; }
    LDS_WAIT(); asm volatile("" ::: "memory");
    const int c = lane & 7;
#pragma unroll
    for (int j = 0; j < 4; ++j) { const int n = (lane >> 3) + 8 * j; const LAS float* s = scr + (8 * c) * 33 + n;
        v4u o; o.x = pk2(s[0 * 33], s[1 * 33]); o.y = pk2(s[2 * 33], s[3 * 33]); o.z = pk2(s[4 * 33], s[5 * 33]); o.w = pk2(s[6 * 33], s[7 * 33]);
        *(v4u*)(WT + (size_t)(n0 + n) * K + k0 + 8 * c) = o; }
    LDS_WAIT(); asm volatile("" ::: "memory");
}
__device__ __forceinline__ void p0_trunk_item(const KAS Args* KA, float* H3, LAS float* sf  , int l, int t, int lane) {
    const float* w1 = KA->in[8]; const float* b1 = KA->in[9]; const float* w2 = KA->in[10]; const float* b2 = KA->in[11];
    const float* w3 = KA->in[12]; const float* b3 = KA->in[13]; const float* freq = KA->in[15];
    if (lane < FE) {
        float v;
        if (lane == 0) v = (float)t / (float)(S - 1);
        else {
            const int q = (lane - 1) & 15;
            const double f = (double)(1e-4f) + (double)q * (((double)15.0f - (double)1e-4f) / 15.0);
            double u = f * (double)t / (double)S; u -= rint(u);
            float sn, cs; sincos_cw((float)(u * 6.283185307179586476925), sn, cs);
            v = (lane <= 16) ? cs : -sn;
        }
        sf[lane] = v;
    }
    LDS_WAIT(); asm volatile("" ::: "memory");
    const float fr = freq[l * FW + lane];
    float a0 = b1[l * FW + lane], a1 = 0.f;
    for (int kk = 0; kk < 32; kk += 2) { a0 = fmaf(sf[kk], w1[(l * FE + kk) * FW + lane], a0); a1 = fmaf(sf[kk + 1], w1[(l * FE + kk + 1) * FW + lane], a1); }
    a0 = fmaf(sf[32], w1[(l * FE + 32) * FW + lane], a0);
    sf[64 + lane] = sin_cw(fr * (a0 + a1));
    LDS_WAIT(); asm volatile("" ::: "memory");
    a0 = b2[l * FW + lane]; a1 = 0.f;
    for (int kk = 0; kk < FW; kk += 2) { a0 = fmaf(sf[64 + kk], w2[(l * FW + kk) * FW + lane], a0); a1 = fmaf(sf[64 + kk + 1], w2[(l * FW + kk + 1) * FW + lane], a1); }
    sf[128 + lane] = sin_cw(fr * (a0 + a1));
    LDS_WAIT(); asm volatile("" ::: "memory");
    a0 = b3[l * FW + lane]; a1 = 0.f;
    for (int kk = 0; kk < FW; kk += 2) { a0 = fmaf(sf[128 + kk], w3[(l * FW + kk) * FW + lane], a0); a1 = fmaf(sf[128 + kk + 1], w3[(l * FW + kk + 1) * FW + lane], a1); }
    H3[((size_t)l * S + t) * FW + lane] = sin_cw(fr * (a0 + a1));
    LDS_WAIT(); asm volatile("" ::: "memory");
}
__device__ __forceinline__ void p0_rgen_item(const KAS Args* KA, const float* H3, bf16* R, LAS unsigned char* lds, int item, int tid) {
    const int l = item >> 7, tg = (item >> 4) & 7, nb = item & 15, lane = tid & 63, wave = tid >> 6;
    LAS float* Wl = (LAS float*)lds;
    const float* w4l = KA->in[14] + (size_t)l * FW * (4 * DHY) + 128 * nb;
    for (int e = tid; e < 64 * 128; e += NTHREADS) { const int j = e >> 7, i = e & 127; Wl[i * 68 + j] = w4l[(size_t)j * 4 * DHY + i]; }
    const int t = 512 * tg + 64 * wave + lane;
    float hr[64];
    { const f32x4* hp = (const f32x4*)(H3 + ((size_t)l * S + t) * FW);
#pragma unroll
      for (int q = 0; q < 16; ++q) { const f32x4 v = hp[q]; hr[4 * q] = v.x; hr[4 * q + 1] = v.y; hr[4 * q + 2] = v.z; hr[4 * q + 3] = v.w; } }
    __syncthreads();
    const int nq = nb >> 2, o = nq >> 1, dir = nq & 1, cbase = (128 * nb) & 511;
    const float tt = (float)t / (float)(S - 1);
    const float d0 = -4.605170185988091f / 1.5f, d1 = -4.605170185988091f / 0.3f;
    const int x = dir ? ((t == 0) ? 8191 : 4095 + t) : 4095 - t;
    bf16* Rb = R + ((size_t)(l * 2 + o) * DHY + cbase) * 8192 + x;
    for (int i = 0; i < 128; ++i) {
        const LAS f32x4* wp = (const LAS f32x4*)(Wl + i * 68);
        float a0 = 0.f, a1 = 0.f, a2 = 0.f, a3 = 0.f;
#pragma unroll
        for (int q = 0; q < 16; ++q) { const f32x4 w = wp[q]; a0 = fmaf(hr[4 * q], w.x, a0); a1 = fmaf(hr[4 * q + 1], w.y, a1); a2 = fmaf(hr[4 * q + 2], w.z, a2); a3 = fmaf(hr[4 * q + 3], w.w, a3); }
        const float delta = d0 + (d1 - d0) * ((float)(cbase + i) / (float)(DHY - 1));
        float val = ((a0 + a1) + (a2 + a3)) * __expf(-tt * fabsf(delta));
        if (dir == 1 && t == 0) val = 0.f;
        Rb[(size_t)i * 8192] = (bf16)f2bf(val);
    }
    __syncthreads();
}
__device__ __forceinline__ void p0_mod_item(const KAS Args* KA, float* mod, LAS unsigned char* lds, int item, int tid) {
    const int l = item / 48, n = (item % 48) * 64 + (tid & 63), wave = tid >> 6, lane = tid & 63;
    const float* w = KA->in[2] + (size_t)l * D * 3 * D + (size_t)(128 * wave) * 3 * D + n; const float* c = KA->in[1] + 128 * wave;
    float acc[NB];
#pragma unroll
    for (int b = 0; b < NB; ++b) acc[b] = 0.f;
#pragma unroll 4
    for (int k = 0; k < 128; ++k) { const float wv = w[(size_t)k * 3 * D];
#pragma unroll
        for (int b = 0; b < NB; ++b) acc[b] = fmaf(c[b * D + k], wv, acc[b]); }
    LAS float* red = (LAS float*)lds;
#pragma unroll
    for (int b = 0; b < NB; ++b) red[(wave * NB + b) * 64 + lane] = acc[b];
    __syncthreads();
    { float s = KA->in[3][l * 3 * D + n];
#pragma unroll
      for (int q = 0; q < NWAVES; ++q) s += red[(q * NB + wave) * 64 + lane];
      mod[((size_t)l * NB + wave) * 3 * D + n] = s; }
    __syncthreads();
}
__device__ __forceinline__ void p0_prologue_a(const Ctx& C, const KAS Args* KA) {
    unsigned char* ws = KA->ws;
    LAS float* scr = (LAS float*)(C.lds + C.wave * 16384);
    constexpr int I_IN = (D / 64) * (NIN / 32), I_PA = (DA / 64) * (D / 32), I_PH = (DHY / 64) * (D / 32), I_OUT = (D / 64) * (D / 32);
    constexpr int I_L = I_IN + I_PA + I_PH + I_OUT;
    for (int rq_ = 0; rq_ < REPS(11); ++rq_) for (int it = C.gw; it < DEPTH * I_L; it += C.NGW) {
        const int l = it / I_L; int r = it % I_L;
        if (r < I_IN) { p0_transpose_item(KA->in[4] + (size_t)l * D * NIN, D, NIN, (bf16*)(ws + WS_WIN) + (size_t)l * NIN * D, scr, r, C.lane); continue; } r -= I_IN;
        if (r < I_PA) { p0_transpose_item(KA->in[17] + (size_t)l * DA * D, DA, D, (bf16*)(ws + WS_WPA) + (size_t)l * D * DA, scr, r, C.lane); continue; } r -= I_PA;
        if (r < I_PH) { p0_transpose_item(KA->in[18] + (size_t)l * DHY * D, DHY, D, (bf16*)(ws + WS_WPH) + (size_t)l * D * DHY, scr, r, C.lane); continue; } r -= I_PH;
        p0_transpose_item(KA->in[19] + (size_t)l * D * D, D, D, (bf16*)(ws + WS_WOUT) + (size_t)l * D * D, scr, r, C.lane);
    }
    for (int rq_ = 0; rq_ < REPS(13); ++rq_) for (int it = C.gw; it < DEPTH * S; it += C.NGW) p0_trunk_item(KA, (float*)(ws + WS_H3), scr, it / S, it % S, C.lane);
    __syncthreads();
    for (int rq_ = 0; rq_ < REPS(12); ++rq_) for (int it = blockIdx.x; it < DEPTH * 48; it += C.G) p0_mod_item(KA, (float*)(ws + WS_MOD), C.lds, it, C.tid);
}
__device__ __forceinline__ void p0_prologue_b(const Ctx& C, const KAS Args* KA) {
    unsigned char* ws = KA->ws;
    for (int rq_ = 0; rq_ < REPS(14); ++rq_) for (int it = blockIdx.x; it < DEPTH * 128; it += C.G) p0_rgen_item(KA, (const float*)(ws + WS_H3), (bf16*)(ws + WS_R), C.lds, it, C.tid);
}

__device__ __forceinline__ void ln_mod_row(const float* xrow, const float* modb, bf16* orow, int lane) {
    const f32x4* xr = (const f32x4*)xrow + lane;
    f32x4 v[4]; float s = 0.f;
#pragma unroll
    for (int j = 0; j < 4; ++j) { v[j] = xr[64 * j]; s += (v[j].x + v[j].y) + (v[j].z + v[j].w); }
    const float mean = wave_sum(s) * (1.f / D); float s2 = 0.f;
#pragma unroll
    for (int j = 0; j < 4; ++j) { v[j] = v[j] - mean; s2 += (v[j].x * v[j].x + v[j].y * v[j].y) + (v[j].z * v[j].z + v[j].w * v[j].w); }
    const float rstd = 1.f / sqrtf(wave_sum(s2) * (1.f / D) + LN_EPS);
    v2u* o8 = (v2u*)orow + lane;
#pragma unroll
    for (int j = 0; j < 4; ++j) {
        const f32x4 sh = *((const f32x4*)modb + lane + 64 * j), sc = *((const f32x4*)(modb + D) + lane + 64 * j);
        const f32x4 r = v[j] * rstd * (sc + 1.f) + sh;
        v2u w; w.x = pk2(r.x, r.y); w.y = pk2(r.z, r.w); o8[64 * j] = w;
    }
}
__device__ __forceinline__ void ln_final_row(float* row, const float* lg, const float* lb, int lane) {
    f32x4* xr = (f32x4*)row + lane;
    f32x4 v[4]; float s = 0.f;
#pragma unroll
    for (int j = 0; j < 4; ++j) { v[j] = xr[64 * j]; s += (v[j].x + v[j].y) + (v[j].z + v[j].w); }
    const float mean = wave_sum(s) * (1.f / D); float s2 = 0.f;
#pragma unroll
    for (int j = 0; j < 4; ++j) { v[j] = v[j] - mean; s2 += (v[j].x * v[j].x + v[j].y * v[j].y) + (v[j].z * v[j].z + v[j].w * v[j].w); }
    const float rstd = 1.f / sqrtf(wave_sum(s2) * (1.f / D) + LN_EPS);
#pragma unroll
    for (int j = 0; j < 4; ++j) { const f32x4 g = *((const f32x4*)lg + lane + 64 * j), b = *((const f32x4*)lb + lane + 64 * j); xr[64 * j] = v[j] * rstd * g + b; }
}

__device__ __forceinline__ void attn_naive_item(const bf16* P, const bf16* P2, bf16* YA, LAS float* sw  , int row, int h, int lane) {
    LAS float* sq = sw; LAS float* sc = sw + 192;
    const int t = row % S, rb = row - t;
    const float slope = exp2f(-(float)(h + 1));
#pragma unroll
    for (int g = 0; g < NG; ++g) sq[g * 64 + lane] = bf2f(P[((size_t)((0 * NG + g) * NH + h) * MC + row) * 64 + lane]);
    LDS_WAIT(); asm volatile("" ::: "memory");
    float mx = -INFINITY;
#pragma unroll
    for (int g = 0; g < NG; ++g) {
        const int dil = (g == 0) ? 1 : (g == 1 ? 4 : 16);
        const bf16* Kh = P + (size_t)((1 * NG + g) * NH + h) * MC * 64;
        for (int pass = 0; pass < 3; ++pass) {
            const int jj = pass * 64 + lane;
            if (jj <= 128) {
                const int j = jj - 64, tk = t + j * dil;
                float s = -INFINITY;
                if (tk >= 0 && tk < S) {
                    const v4u* kr = (const v4u*)(Kh + (size_t)(rb + tk) * 64);
                    float a = 0.f;
#pragma unroll
                    for (int e = 0; e < 8; ++e) { const v4u kv = kr[e]; const LAS float* q = sq + g * 64 + 8 * e;
                        a = fmaf(q[0], blo(kv.x), a); a = fmaf(q[1], bhi(kv.x), a); a = fmaf(q[2], blo(kv.y), a); a = fmaf(q[3], bhi(kv.y), a);
                        a = fmaf(q[4], blo(kv.z), a); a = fmaf(q[5], bhi(kv.z), a); a = fmaf(q[6], blo(kv.w), a); a = fmaf(q[7], bhi(kv.w), a); }
                    s = a * 0.125f - slope * (float)((j < 0 ? -j : j) * dil);
                }
                sc[g * 132 + jj] = s;
                mx = fmaxf(mx, s);
            }
        }
    }
    mx = wave_max(mx);
    float sum = 0.f;
#pragma unroll
    for (int g = 0; g < NG; ++g)
        for (int pass = 0; pass < 3; ++pass) {
            const int jj = pass * 64 + lane;
            if (jj <= 128) { const float s = sc[g * 132 + jj]; const float p = (s == -INFINITY) ? 0.f : expf(s - mx); sc[g * 132 + jj] = p; sum += p; }
        }
    sum = wave_sum(sum);
    LDS_WAIT(); asm volatile("" ::: "memory");
    float o = 0.f;
#pragma unroll
    for (int g = 0; g < NG; ++g) {
        const int dil = (g == 0) ? 1 : (g == 1 ? 4 : 16);
        const bf16* Vh = P + (size_t)((2 * NG + g) * NH + h) * MC * 64 + lane;
        for (int jj = 0; jj <= 128; ++jj) {
            const int tk = t + (jj - 64) * dil;
            if (tk >= 0 && tk < S) o = fmaf(sc[g * 132 + jj], bf2f(Vh[(size_t)(rb + tk) * 64]), o);
        }
    }
    o /= sum;
    const float ga = bf2f(P2[(size_t)row * NP2 + OFF_GA + h * HD + lane]);
    YA[(size_t)row * DA + h * HD + lane] = (bf16)f2bf(o * siluf_(ga));
    LDS_WAIT(); asm volatile("" ::: "memory");
}
typedef short bf16x8_t __attribute__((ext_vector_type(8)));
typedef float f32x16_t __attribute__((ext_vector_type(16)));
struct LCG {
    static constexpr int NI = 32 / CH, NCT = 64 / NI;
    static constexpr int PADZ = 64 * (NI - 1), ZSTRIDE = 4096 + 2 * PADZ + 32;
    static constexpr int GC_STRIDE = 16448, ZB_OFF = 4 * GC_STRIDE;
    static constexpr int XB_OFF = ZB_OFF + CH * ZSTRIDE * 2, LDS_END = XB_OFF + CH * ZSTRIDE * 2;
};
static_assert(LCG::NCT <= NWAVES && (LCG::ZSTRIDE / 8) % 16 == 4 && LCG::ZSTRIDE % 8 == 0 && LCG::LDS_END <= LDS_BYTES - 64, "long-conv LDS map");
constexpr int UT_ROWS = 4 * DHY;
__device__ __forceinline__ int zsw(int e) { const int c = e >> 3; return (((c ^ ((c >> 3) & 7)) << 3) | (e & 7)) * 2; }

struct RRegs { v4u cur[2], prv[2]; };
__device__ __forceinline__ void lc_load_R(RRegs& rr, const bf16* Rg, int tid) {
#pragma unroll
    for (int it = 0; it < 2; ++it) { const int k = tid + it * NTHREADS;
        rr.cur[it] = *(const v4u*)(Rg + 8 * k);
        rr.prv[it] = *(const v4u*)(Rg + 8 * (k > 0 ? k - 1 : 0)); }
}
__device__ __forceinline__ void lc_write_R(LAS unsigned char* lds, const RRegs& rr, int tid) {
#pragma unroll
    for (int it = 0; it < 2; ++it) {
        const int k = tid + it * NTHREADS;
        const v4u cur = rr.cur[it]; v4u prv = rr.prv[it]; if (k == 0) prv = (v4u){0u, 0u, 0u, 0u};
        *(LAS v4u*)(lds + 0 * LCG::GC_STRIDE + 16 * k) = cur;
        v4u s1; s1.x = __builtin_amdgcn_alignbit(cur.x, prv.w, 16); s1.y = __builtin_amdgcn_alignbit(cur.y, cur.x, 16); s1.z = __builtin_amdgcn_alignbit(cur.z, cur.y, 16); s1.w = __builtin_amdgcn_alignbit(cur.w, cur.z, 16);
        *(LAS v4u*)(lds + 1 * LCG::GC_STRIDE + 16 * k) = s1;
        v4u s2; s2.x = prv.w; s2.y = cur.x; s2.z = cur.y; s2.w = cur.z;
        *(LAS v4u*)(lds + 2 * LCG::GC_STRIDE + 16 * k) = s2;
        v4u s3; s3.x = __builtin_amdgcn_alignbit(prv.w, prv.z, 16); s3.y = __builtin_amdgcn_alignbit(cur.x, prv.w, 16); s3.z = __builtin_amdgcn_alignbit(cur.y, cur.x, 16); s3.w = __builtin_amdgcn_alignbit(cur.z, cur.y, 16);
        *(LAS v4u*)(lds + 3 * LCG::GC_STRIDE + 16 * k) = s3;
    }
}
constexpr int LC_ZCH = CH * 512 / NTHREADS;
__device__ __forceinline__ void lc_conv8(float (&o)[8], const bf16* row  , int s8, float w0, float w1, float w2, float wb) {
    const v4u cu = *(const v4u*)(row + s8);
    const float pm = (s8 > 0) ? bf2f(row[s8 - 1]) : 0.f, pp = (s8 + 8 < S) ? bf2f(row[s8 + 8]) : 0.f;
    const float x[10] = {pm, blo(cu.x), bhi(cu.x), blo(cu.y), bhi(cu.y), blo(cu.z), bhi(cu.z), blo(cu.w), bhi(cu.w), pp};
#pragma unroll
    for (int j = 0; j < 8; ++j) o[j] = fmaf(w0, x[j], fmaf(w1, x[j + 1], fmaf(w2, x[j + 2], wb)));
}
__device__ __forceinline__ void lc_stage_conv(LAS unsigned char* lds, int off, const bf16* raw  , const bf16* mul  , float w0, float w1, float w2, float wb, int tid) {
#pragma unroll
    for (int j = 0; j < LC_ZCH; ++j) { const int k = tid + j * NTHREADS, bb = k >> 9, s8 = (k & 511) * 8;
        float o[8]; lc_conv8(o, raw + (size_t)bb * S, s8, w0, w1, w2, wb);
        if (mul) { const v4u g = *(const v4u*)(mul + (size_t)bb * S + s8);
            o[0] *= siluf_(blo(g.x)); o[1] *= siluf_(bhi(g.x)); o[2] *= siluf_(blo(g.y)); o[3] *= siluf_(bhi(g.y)); o[4] *= siluf_(blo(g.z)); o[5] *= siluf_(bhi(g.z)); o[6] *= siluf_(blo(g.w)); o[7] *= siluf_(bhi(g.w)); }
        v4u w; w.x = pk2(o[0], o[1]); w.y = pk2(o[2], o[3]); w.z = pk2(o[4], o[5]); w.w = pk2(o[6], o[7]);
        *(LAS v4u*)(lds + off + bb * LCG::ZSTRIDE * 2 + zsw(LCG::PADZ + s8)) = w; }
}
__device__ __forceinline__ bf16x8_t lc_ldA(LAS unsigned char* lds, int baseA, int baseA8, int d) {
    const v2u a0 = *(const LAS v2u*)(lds + baseA - 32 * d), a1 = *(const LAS v2u*)(lds + baseA8 - 32 * d);
    return __builtin_bit_cast(bf16x8_t, (v4u){a0.x, a0.y, a1.x, a1.y});
}
__device__ __forceinline__ bf16x8_t lc_ldB(LAS unsigned char* lds, int rowB, int cB, int d) {
    const int c = cB - 2 * d;
    return __builtin_bit_cast(bf16x8_t, *(const LAS v4u*)(lds + rowB + ((c ^ ((c >> 3) & 7)) << 4)));
}
__device__ __forceinline__ void lc_mma(LAS unsigned char* lds, f32x16_t& acc1, f32x16_t& acc2, int wave, int lane) {
    const int r = lane & 31, h = lane >> 5, kap = (r + 1) & 3, b = r / LCG::NI, ii = r % LCG::NI;
    const int baseA = kap * LCG::GC_STRIDE + 2 * (4095 - r + 8 * h + kap);
    int baseA8 = baseA + 8; asm volatile("" : "+v"(baseA8));
    const int i0 = LCG::NI * wave;
    const int rowB = LCG::ZB_OFF + b * LCG::ZSTRIDE * 2, cB = (LCG::PADZ + 64 * (i0 + ii) + 8 * h) >> 3;
    const int dlo = 4 * i0 - 255, dhi = 4 * i0 + 4 * (LCG::NI - 1);
    acc1 = (f32x16_t){0.f, 0.f, 0.f, 0.f, 0.f, 0.f, 0.f, 0.f, 0.f, 0.f, 0.f, 0.f, 0.f, 0.f, 0.f, 0.f}; acc2 = acc1;
    bf16x8_t Ae = lc_ldA(lds, baseA, baseA8, dlo), Ao = lc_ldA(lds, baseA, baseA8, dlo + 1), An = lc_ldA(lds, baseA, baseA8, dlo + 2), Am = lc_ldA(lds, baseA, baseA8, dlo + 3);
    bf16x8_t B0 = lc_ldB(lds, rowB, cB, dlo), B1 = lc_ldB(lds, rowB, cB, dlo + 1);
    for (int d = dlo; d <= dhi; d += 2) {
        const int dn = (d + 2 <= dhi - 1) ? d + 2 : dhi - 1;
        const bf16x8_t nAn = lc_ldA(lds, baseA, baseA8, dn + 2), nAm = lc_ldA(lds, baseA, baseA8, dn + 3);
        const bf16x8_t nB0 = lc_ldB(lds, rowB, cB, dn), nB1 = lc_ldB(lds, rowB, cB, dn + 1);
        acc1 = __builtin_amdgcn_mfma_f32_32x32x16_bf16(Ae, B0, acc1, 0, 0, 0);
        acc2 = __builtin_amdgcn_mfma_f32_32x32x16_bf16(An, B0, acc2, 0, 0, 0);
        acc1 = __builtin_amdgcn_mfma_f32_32x32x16_bf16(Ao, B1, acc1, 0, 0, 0);
        acc2 = __builtin_amdgcn_mfma_f32_32x32x16_bf16(Am, B1, acc2, 0, 0, 0);
        Ae = An; Ao = Am; An = nAn; Am = nAm; B0 = nB0; B1 = nB1;
    }
}
__device__ __forceinline__ void longconv_mfma_units(LAS unsigned char* lds, const bf16* UTR, const float* cw, const float* cb, const bf16* Rl, const float* fb, bf16* YHT, int first, int stride, int tid_) {
    const int tid = tid_, lane = tid & 63, wave = __builtin_amdgcn_readfirstlane(tid >> 6);
    const int r = lane & 31, h = lane >> 5, b = r / LCG::NI, ii = r % LCG::NI;
    const bool active = wave < LCG::NCT;
    const int i = LCG::NI * wave + ii;
    if (first >= DHY) return;
    for (int k = tid; k < CH * 2 * (LCG::PADZ / 8); k += NTHREADS) { const int bb = k / (2 * (LCG::PADZ / 8)), q = k % (2 * (LCG::PADZ / 8));
        const int e = (q < LCG::PADZ / 8) ? q * 8 : LCG::PADZ + 4096 + (q - LCG::PADZ / 8) * 8;
        *(LAS v4u*)(lds + LCG::ZB_OFF + bb * LCG::ZSTRIDE * 2 + zsw(e)) = (v4u){0u, 0u, 0u, 0u}; }
    for (int c = first; c < DHY; c += stride) {
        { RRegs r0; lc_load_R(r0, Rl + (size_t)(0 * DHY + c) * 8192, tid);
          lc_stage_conv(lds, LCG::ZB_OFF, UTR + (size_t)c * MC, nullptr, cw[c], cw[3 * DHY + c], cw[6 * DHY + c], cb[c], tid);
          lc_stage_conv(lds, LCG::XB_OFF, UTR + (size_t)(DHY + c) * MC, nullptr, cw[DHY + c], cw[4 * DHY + c], cw[7 * DHY + c], cb[DHY + c], tid);
          lc_write_R(lds, r0, tid); }
        __syncthreads();
        f32x16_t acc1, acc2;
        for (int rr_ = 0; rr_ < REPS(15); ++rr_) if (active) lc_mma(lds, acc1, acc2, wave, lane);
        v2u zn[2][4];
        if (active) { const float bias0 = fb[c];
#pragma unroll
          for (int hf = 0; hf < 2; ++hf)
#pragma unroll
            for (int q = 0; q < 4; ++q) { const int zo_ = b * LCG::ZSTRIDE * 2 + zsw(LCG::PADZ + 64 * i + 32 * hf + 8 * q + 4 * h); const f32x16_t& ac = hf ? acc2 : acc1;
                const v2u zo = *(const LAS v2u*)(lds + LCG::ZB_OFF + zo_), xx = *(const LAS v2u*)(lds + LCG::XB_OFF + zo_);
                const float y0 = blo(xx.x) * (ac[4 * q + 0] + bias0 * blo(zo.x)), y1 = bhi(xx.x) * (ac[4 * q + 1] + bias0 * bhi(zo.x));
                const float y2 = blo(xx.y) * (ac[4 * q + 2] + bias0 * blo(zo.y)), y3 = bhi(xx.y) * (ac[4 * q + 3] + bias0 * bhi(zo.y));
                zn[hf][q].x = pk2(y0, y1); zn[hf][q].y = pk2(y2, y3); } }
        __syncthreads();
        if (active) {
#pragma unroll
          for (int hf = 0; hf < 2; ++hf)
#pragma unroll
            for (int q = 0; q < 4; ++q) *(LAS v2u*)(lds + LCG::ZB_OFF + b * LCG::ZSTRIDE * 2 + zsw(LCG::PADZ + 64 * i + 32 * hf + 8 * q + 4 * h)) = zn[hf][q]; }
        { RRegs r1; lc_load_R(r1, Rl + (size_t)(1 * DHY + c) * 8192, tid);
          lc_stage_conv(lds, LCG::XB_OFF, UTR + (size_t)(2 * DHY + c) * MC, UTR + (size_t)(3 * DHY + c) * MC, cw[2 * DHY + c], cw[5 * DHY + c], cw[8 * DHY + c], cb[2 * DHY + c], tid);
          lc_write_R(lds, r1, tid); }
        __syncthreads();
        if (active) { for (int rr_ = 0; rr_ < REPS(15); ++rr_) lc_mma(lds, acc1, acc2, wave, lane);
          const float bias1 = fb[DHY + c];
#pragma unroll
          for (int hf = 0; hf < 2; ++hf)
#pragma unroll
            for (int q = 0; q < 4; ++q) { const int zo_ = b * LCG::ZSTRIDE * 2 + zsw(LCG::PADZ + 64 * i + 32 * hf + 8 * q + 4 * h); const f32x16_t& ac = hf ? acc2 : acc1;
                const v2u zo = *(const LAS v2u*)(lds + LCG::ZB_OFF + zo_), xx = *(const LAS v2u*)(lds + LCG::XB_OFF + zo_);
                const float y0 = blo(xx.x) * (ac[4 * q + 0] + bias1 * blo(zo.x)), y1 = bhi(xx.x) * (ac[4 * q + 1] + bias1 * bhi(zo.x));
                const float y2 = blo(xx.y) * (ac[4 * q + 2] + bias1 * blo(zo.y)), y3 = bhi(xx.y) * (ac[4 * q + 3] + bias1 * bhi(zo.y));
                v2u o; o.x = pk2(y0, y1); o.y = pk2(y2, y3);
                *(LAS v2u*)(lds + LCG::XB_OFF + zo_) = o; } }
        __syncthreads();
#pragma unroll
        for (int j = 0; j < LC_ZCH; ++j) { const int k = tid + j * NTHREADS, bb = k >> 9, s8 = (k & 511) * 8;
            *(v4u*)(YHT + (size_t)c * MC + bb * S + s8) = *(const LAS v4u*)(lds + LCG::XB_OFF + bb * LCG::ZSTRIDE * 2 + zsw(LCG::PADZ + s8)); }
        __syncthreads();
    }
}
__device__ __forceinline__ void hyena_prep_from_raw(const bf16* UTR, const float* cw, const float* cb, bf16* UT, int G, int tid) {
    for (size_t idx = (size_t)blockIdx.x * NTHREADS + tid; idx < (size_t)UT_ROWS * MC; idx += (size_t)G * NTHREADS) {
        const int ch = (int)(idx / MC), t = (int)(idx % S);
        float v;
        if (ch < 3 * DHY) { const float pm = t > 0 ? bf2f(UTR[idx - 1]) : 0.f, pp = t < S - 1 ? bf2f(UTR[idx + 1]) : 0.f;
            v = fmaf(cw[ch], pm, fmaf(cw[3 * DHY + ch], bf2f(UTR[idx]), fmaf(cw[6 * DHY + ch], pp, cb[ch]))); }
        else v = siluf_(bf2f(UTR[idx]));
        UT[idx] = (bf16)f2bf(v);
    }
}
__device__ __forceinline__ void hyena_post_tile(LAS unsigned char* lds, const bf16* YHT, bf16* YH, int tile, int tid) {
    constexpr int TS = 72;
    const int tr = tile / (DHY / 64), tc = tile % (DHY / 64), row0 = tr * 64, c0 = tc * 64;
    LAS bf16* T = (LAS bf16*)lds;
    { const int chn = tid >> 3, sg = tid & 7;
      const v4u w = *(const v4u*)(YHT + (size_t)(c0 + chn) * MC + row0 + 8 * sg);
      const unsigned a[4] = {w.x, w.y, w.z, w.w};
#pragma unroll
      for (int j = 0; j < 4; ++j) { T[(8 * sg + 2 * j) * TS + chn] = (bf16)(a[j] & 0xffffu); T[(8 * sg + 2 * j + 1) * TS + chn] = (bf16)(a[j] >> 16); } }
    __syncthreads();
    { const int rr = tid >> 3, seg = tid & 7;
      *(v4u*)(YH + (size_t)(row0 + rr) * DHY + c0 + 8 * seg) = *(const LAS v4u*)(T + rr * TS + 8 * seg); }
    __syncthreads();
}
typedef short v4i16_t __attribute__((ext_vector_type(4)));
constexpr int AT_ROWB = 128;
__device__ __forceinline__ void attn_mfma_unit(const bf16* P, bf16* OG, float* ML, LAS unsigned char* vs, int unit, int lane_) {
    int lane = lane_; asm volatile("" : "+v"(lane));
    int u = unit; const int x = u & 127; u >>= 7; const int hh = u & 7; u >>= 3; const int g = u % 3, bl = u / 3;
    const int dsh = 2 * g, d = 1 << dsh, L = S >> dsh, nqb = L >> 5, r = x / nqb, qb = x % nqb;
    const size_t rowb = (size_t)bl * S;
    const float slope = exp2f(-(float)(hh + 1)) * (float)d * 1.4426950408889634f;
    const bf16* Qh = P + ((size_t)((0 * NG + g) * NH + hh) * MC + rowb) * 64; const bf16* Kh = P + ((size_t)((1 * NG + g) * NH + hh) * MC + rowb) * 64; const bf16* Vh = P + ((size_t)((2 * NG + g) * NH + hh) * MC + rowb) * 64;
    const int n = lane & 31, h2 = lane >> 5;
    const int tq = ((32 * qb + n) << dsh) + r;
    bf16x8_t qf[4];
#pragma unroll
    for (int ks = 0; ks < 4; ++ks) qf[ks] = __builtin_bit_cast(bf16x8_t, *(const v4u*)(Qh + (size_t)tq * 64 + 16 * ks + 8 * h2));
    f32x16_t st[5];
    for (int r31_ = 0; r31_ < REPS(31); ++r31_)
#pragma unroll
    for (int kt = 0; kt < 5; ++kt) {
        int ik = 32 * (qb - 2 + kt) + n; ik = ik < 0 ? 0 : (ik > L - 1 ? L - 1 : ik);
        const bf16* kp = Kh + (size_t)((ik << dsh) + r) * 64 + 8 * h2;
        f32x16_t acc = (f32x16_t){0.f, 0.f, 0.f, 0.f, 0.f, 0.f, 0.f, 0.f, 0.f, 0.f, 0.f, 0.f, 0.f, 0.f, 0.f, 0.f};
#pragma unroll
        for (int ks = 0; ks < 4; ++ks) acc = __builtin_amdgcn_mfma_f32_32x32x16_bf16(__builtin_bit_cast(bf16x8_t, *(const v4u*)(kp + 16 * ks)), qf[ks], acc, 0, 0, 0);
        st[kt] = acc;
        if (kt & 1) asm volatile("" ::: "memory");
    }
    v4u vr[5][4];
#pragma unroll
    for (int kt = 0; kt < 5; ++kt) {
        int ik = 32 * (qb - 2 + kt) + (lane >> 1); ik = ik < 0 ? 0 : (ik > L - 1 ? L - 1 : ik);
        const bf16* vp = Vh + (size_t)((ik << dsh) + r) * 64 + 32 * (lane & 1);
#pragma unroll
        for (int j = 0; j < 4; ++j) vr[kt][j] = *(const v4u*)(vp + 8 * j);
    }
    const bool edge = (qb < 2) || (qb + 3 > nqb);
    const int e4 = 4 * h2 - n;
    float mx = -INFINITY;
#pragma unroll
    for (int kt = 0; kt < 5; ++kt)
#pragma unroll
        for (int rg = 0; rg < 16; ++rg) {
            const int rel = 32 * (kt - 2) + (rg & 3) + 8 * (rg >> 2) + e4;
            const int arel = rel < 0 ? -rel : rel;
            float s = fmaf(st[kt][rg], 0.125f * 1.4426950408889634f, -slope * (float)arel);
            if (kt == 0 || kt == 4) s = (arel <= 64) ? s : -INFINITY;
            st[kt][rg] = s;
        }
    if (edge) {
#pragma unroll
        for (int kt = 0; kt < 5; ++kt)
#pragma unroll
            for (int rg = 0; rg < 16; ++rg) { const unsigned ikey = (unsigned)(32 * (qb - 2 + kt) + (rg & 3) + 8 * (rg >> 2) + 4 * h2); if (ikey >= (unsigned)L) st[kt][rg] = -INFINITY; }
    }
#pragma unroll
    for (int kt = 0; kt < 5; ++kt)
#pragma unroll
        for (int rg = 0; rg < 16; ++rg) mx = fmaxf(mx, st[kt][rg]);
    mx = fmaxf(mx, __shfl_xor(mx, 32));
    float ls = 0.f;
#pragma unroll
    for (int kt = 0; kt < 5; ++kt)
#pragma unroll
        for (int rg = 0; rg < 16; ++rg) { const float p = __builtin_amdgcn_exp2f(st[kt][rg] - mx); st[kt][rg] = p; ls += p; }
    ls += __shfl_xor(ls, 32);
    f32x16_t o0 = (f32x16_t){0.f, 0.f, 0.f, 0.f, 0.f, 0.f, 0.f, 0.f, 0.f, 0.f, 0.f, 0.f, 0.f, 0.f, 0.f, 0.f}, o1 = o0;
    const int trow = (lane & 15) >> 2, tcolb = (16 * ((lane >> 4) & 1) + 4 * (lane & 3)) * 2;
    for (int r32_ = 0; r32_ < REPS(32); ++r32_) { if (r32_) { o0 = (f32x16_t){0.f, 0.f, 0.f, 0.f, 0.f, 0.f, 0.f, 0.f, 0.f, 0.f, 0.f, 0.f, 0.f, 0.f, 0.f, 0.f}; o1 = o0; }
#pragma unroll
    for (int kt = 0; kt < 5; ++kt) {
        LAS unsigned char* vb = vs + (kt & 1) * 4096;
        { LAS unsigned char* wp = vb + (lane >> 1) * AT_ROWB + 64 * (lane & 1);
          *(LAS v4u*)(wp) = vr[kt][0]; *(LAS v4u*)(wp + 16) = vr[kt][1]; *(LAS v4u*)(wp + 32) = vr[kt][2]; *(LAS v4u*)(wp + 48) = vr[kt][3]; }
        LDS_WAIT(); asm volatile("" ::: "memory");
#pragma unroll
        for (int s = 0; s < 2; ++s) {
            v4u pa; pa.x = pk2(st[kt][8 * s + 0], st[kt][8 * s + 1]); pa.y = pk2(st[kt][8 * s + 2], st[kt][8 * s + 3]); pa.z = pk2(st[kt][8 * s + 4], st[kt][8 * s + 5]); pa.w = pk2(st[kt][8 * s + 6], st[kt][8 * s + 7]);
            const bf16x8_t A = __builtin_bit_cast(bf16x8_t, pa);
            LAS unsigned char* tp = vb + (16 * s + 4 * h2 + trow) * AT_ROWB + tcolb;
#pragma unroll
            for (int eh = 0; eh < 2; ++eh) {
                const v4i16_t lo = __builtin_amdgcn_ds_read_tr16_b64_v4i16((LAS v4i16_t*)(tp + 64 * eh));
                const v4i16_t hi = __builtin_amdgcn_ds_read_tr16_b64_v4i16((LAS v4i16_t*)(tp + 64 * eh + 8 * AT_ROWB));
                const bf16x8_t B = (bf16x8_t){lo[0], lo[1], lo[2], lo[3], hi[0], hi[1], hi[2], hi[3]};
                if (eh == 0) o0 = __builtin_amdgcn_mfma_f32_32x32x16_bf16(A, B, o0, 0, 0, 0); else o1 = __builtin_amdgcn_mfma_f32_32x32x16_bf16(A, B, o1, 0, 0, 0);
            }
        }
    }
    }
    LDS_WAIT(); asm volatile("" ::: "memory");
    bf16* og = OG + ((size_t)g * MC + rowb) * DA + hh * HD + n;
    for (int r33_ = 0; r33_ < REPS(33); ++r33_)
#pragma unroll
    for (int rg = 0; rg < 16; ++rg) { const int mq = (rg & 3) + 8 * (rg >> 2) + 4 * h2; const size_t tok = (size_t)(((32 * qb + mq) << dsh) + r);
        og[tok * DA] = (bf16)f2bf(o0[rg]); og[tok * DA + 32] = (bf16)f2bf(o1[rg]); }
    if (h2 == 0) { float* mp = ML + (((size_t)g * MC + rowb + tq) * NH + hh) * 2; mp[0] = mx * 0.6931471805599453f; mp[1] = ls; }
}
__device__ __forceinline__ void attn_combine(const bf16* P  , const bf16* OG, const float* ML, bf16* YA, int G, int tid) {
    for (int idx = blockIdx.x * NTHREADS + tid; idx < MC * (DA / 2); idx += G * NTHREADS) {
        const int row = idx / (DA / 2), col = (idx % (DA / 2)) * 2, hh = col >> 6;
        float m[3], l[3];
#pragma unroll
        for (int g = 0; g < 3; ++g) { const float* mp = ML + (((size_t)g * MC + row) * NH + hh) * 2; m[g] = mp[0]; l[g] = mp[1]; }
        const float M = fmaxf(m[0], fmaxf(m[1], m[2]));
        float a0 = 0.f, a1 = 0.f, den = 0.f;
#pragma unroll
        for (int g = 0; g < 3; ++g) { const float w = __expf(m[g] - M); const unsigned ow = *(const unsigned*)(OG + ((size_t)g * MC + row) * DA + col);
            a0 = fmaf(w, blo(ow), a0); a1 = fmaf(w, bhi(ow), a1); den = fmaf(w, l[g], den); }
        const unsigned gw_ = *(const unsigned*)(P + (size_t)row * NP2 + OFF_GA + col);
        const float inv = 1.f / den;
        *(unsigned*)(YA + (size_t)row * DA + col) = pk2(a0 * inv * siluf_(blo(gw_)), a1 * inv * siluf_(bhi(gw_)));
    }
}
#if MK_CHECK
__device__ __forceinline__ void longconv_check_item(const bf16* Zrow  , const bf16* Rrow  , const bf16* Xrow, const bf16* SGrow, float bias, bf16* Orow, int b, int tb, int lane) {
    const int t = tb * 64 + lane;
    const bf16* z = Zrow + (size_t)b * S; const bf16* g = Rrow + 4095 - t;
    float y = 0.f;
    for (int s0 = 0; s0 < S; s0 += 8) {
#pragma unroll
        for (int j = 0; j < 8; ++j) y = fmaf(bf2f(g[s0 + j]), bf2f(z[s0 + j]), y);
    }
    float v = bf2f(Xrow[(size_t)b * S + t]) * (y + bias * bf2f(z[t]));
    if (SGrow) v *= bf2f(SGrow[(size_t)b * S + t]);
    Orow[(size_t)b * S + t] = (bf16)f2bf(v);
}
#endif
#define XB_TMO      128
#define XB_XCNT(j)  (256  + 64 * (j))
#define XB_XSUB(j)  (1280 + 64 * (j))
#define XB_XGEN(j)  (2304 + 64 * (j))
#define XB_TOP      3328
#define XB_TOPGEN   3392
#define XCD_BAR_WORDS 3456
#define XB_SPIN_CAP (1u << 18)

__device__ __forceinline__ unsigned xb_ld(unsigned* p)              { return __hip_atomic_load(p, __ATOMIC_RELAXED, __HIP_MEMORY_SCOPE_AGENT); }
__device__ __forceinline__ unsigned xb_add(unsigned* p, unsigned v) { return __hip_atomic_fetch_add(p, v, __ATOMIC_RELAXED, __HIP_MEMORY_SCOPE_AGENT); }
__device__ __forceinline__ unsigned xb_xcc_id() { return (unsigned)__builtin_amdgcn_s_getreg((3 << 11) | 20) & 0xFu; }
#define XB_SPIN(cond, bar) do { unsigned _sp = 0; while (cond) { __builtin_amdgcn_s_sleep(1); \
    if ((++_sp & 255u) == 0u) { if (xb_ld(&(bar)[XB_TMO])) break; if (_sp > XB_SPIN_CAP) { atomicAdd(&(bar)[XB_TMO], 1u); break; } } } } while (0)

struct XcdBarrier {
    unsigned* bar; unsigned x;
    volatile LAS unsigned* st;
};

__device__ __forceinline__ XcdBarrier xcd_barrier_post(unsigned* bar, volatile LAS unsigned* st) {
    XcdBarrier b; b.bar = bar; b.x = xb_xcc_id(); b.st = st;
    if (threadIdx.x == 0) (void)xb_add(&bar[XB_XCNT(b.x)], 1u);
    return b;
}
__device__ __forceinline__ void xcd_barrier_complete(unsigned* bar, unsigned x, unsigned& nloc, unsigned& nx) {
    const unsigned G = gridDim.x * gridDim.y * gridDim.z;
    unsigned sum, cnt, mine, sp = 0u;
    for (;;) {
        sum = 0u; cnt = 0u; mine = 0u;
#pragma unroll
        for (unsigned j = 0; j < 16; ++j) { const unsigned c = xb_ld(&bar[XB_XCNT(j)]); sum += c; cnt += (c > 0u) ? 1u : 0u; mine = (j == x) ? c : mine; }
        if (sum == G) break;
        __builtin_amdgcn_s_sleep(1);
        if ((++sp & 255u) == 0u) { if (xb_ld(&bar[XB_TMO])) break; if (sp > XB_SPIN_CAP) { atomicAdd(&bar[XB_TMO], 1u); break; } }
    }
    nloc = mine > 0u ? mine : 1u; nx = cnt > 0u ? cnt : 1u;
}

__device__ __forceinline__ void xcd_barrier(const XcdBarrier& b) {
    asm volatile("s_waitcnt vmcnt(0)" ::: "memory");
    __syncthreads();
    if (threadIdx.x == 0) {
        unsigned* bar = b.bar;
        __builtin_amdgcn_s_waitcnt(0);
        unsigned nloc = b.st[0], nx = b.st[1];
        if (nloc == 0u) { xcd_barrier_complete(bar, b.x, nloc, nx); b.st[0] = nloc; b.st[1] = nx; }
        const unsigned old = xb_add(&bar[XB_XSUB(b.x)], 1u);
        const unsigned gen = old / nloc;
        if (old + 1u == (gen + 1u) * nloc) {
            __builtin_amdgcn_fence(__ATOMIC_RELEASE, "agent");
            asm volatile("s_waitcnt vmcnt(0)" ::: "memory");
            const unsigned og = xb_add(&bar[XB_TOP], 1u);
            const unsigned tg = og / nx;
            if (og + 1u == (tg + 1u) * nx) xb_add(&bar[XB_TOPGEN], 1u);
            else XB_SPIN(xb_ld(&bar[XB_TOPGEN]) == tg, bar);
            __builtin_amdgcn_fence(__ATOMIC_ACQUIRE, "agent");
            xb_add(&bar[XB_XGEN(b.x)], 1u);
            asm volatile("s_waitcnt vmcnt(0)" ::: "memory");
        } else {
            XB_SPIN(xb_ld(&bar[XB_XGEN(b.x)]) == gen, bar);
            __builtin_amdgcn_fence(__ATOMIC_ACQUIRE, "agent");
            asm volatile("s_waitcnt vmcnt(0)" ::: "memory");
        }
    }
    __syncthreads();
}

#define XBAR() do { XcdBarrier bb_; bb_.bar = (unsigned*)kargs_ptr()->ws + 4096; bb_.x = xb_xcc_id(); bb_.st = MISC; xcd_barrier(bb_); if (MK_REP == 10) xcd_barrier(bb_); } while (0)
#ifndef PG8_SP2
#define PG8_SP2 true
#endif
#ifndef PG8_ALIGN
#define PG8_ALIGN true
#endif

__global__ void __launch_bounds__(NTHREADS, 2) mk_fwd(Args args_unused_directly) {
    extern __shared__ __attribute__((aligned(16))) unsigned char lds[];
    cg::grid_group grid = cg::this_grid();
    Ctx C; C.lds = (LAS unsigned char*)lds; C.tid = threadIdx.x; C.lane = C.tid & 63; C.wave = __builtin_amdgcn_readfirstlane(C.tid >> 6);
    C.G = gridDim.x; C.gw = blockIdx.x * NWAVES + C.wave; C.NGW = C.G * NWAVES;
#define PHASE_PTRS const KAS Args* KA = kargs_ptr(); unsigned char* ws = KA->ws; float* out = KA->out; \
    bf16* Hb = (bf16*)(ws + WS_H); bf16* Pb = (bf16*)(ws + WS_P); bf16* P2b = (bf16*)(ws + WS_P2); bf16* UT = (bf16*)(ws + WS_UT); bf16* YHT = (bf16*)(ws + WS_YHT); \
    bf16* YA = (bf16*)(ws + WS_YA); bf16* YH = (bf16*)(ws + WS_YH); bf16* MG = Hb; \
    const float* MOD = (const float*)(ws + WS_MOD); const bf16* Rg = (const bf16*)(ws + WS_R); float* ERR = (float*)ws; \
    const float* xc = ((l == 0) ? KA->in[0] : (const float*)out) + (size_t)ch * MC * D; float* oc = out + (size_t)ch * MC * D; \
    (void)Hb; (void)Pb; (void)P2b; (void)UT; (void)YHT; (void)YA; (void)YH; (void)MG; (void)MOD; (void)Rg; (void)ERR; (void)xc; (void)oc
    PG8_LAS unsigned char* ldsl = (PG8_LAS unsigned char*)lds;
    volatile LAS unsigned* MISC = (volatile LAS unsigned*)(ldsl + LDS_BYTES - 64);
    if (threadIdx.x < 16) MISC[threadIdx.x] = 0u;
    __syncthreads();
    (void)xcd_barrier_post((unsigned*)kargs_ptr()->ws + 4096, MISC);

    p0_prologue_a(C, kargs_ptr());
    grid.sync();
    p0_prologue_b(C, kargs_ptr());
    XBAR();

    int pend_l = -1, pend_ch = 0;
    for (int l = 0; l < DEPTH; ++l) {
        for (int ch = 0; ch < NCHUNK; ++ch) {
            { PHASE_PTRS; int ln_ = threadIdx.x & 63; asm volatile("" : "+v"(ln_));
            if (pend_l >= 0) { float* pr = out + (size_t)pend_ch * MC * D;
                for (int m = C.gw; m < MC; m += C.NGW) ln_final_row(pr + (size_t)m * D, KA->in[21] + (size_t)pend_l * D, KA->in[22] + (size_t)pend_l * D, ln_); }
            for (int rp_ = 0; rp_ < REPS(9); ++rp_) for (int m = C.gw; m < MC; m += C.NGW) ln_mod_row(xc + (size_t)m * D, MOD + ((size_t)l * NB + ch * CH + m / S) * 3 * D, Hb + (size_t)m * D, ln_); }
            XBAR();
            for (int rp_ = 0; rp_ < REPS(2); ++rp_) { PHASE_PTRS; pg8::Gemm g{Hb, (const bf16*)(ws + WS_WIN) + (size_t)l * NIN * D, MC, NIN, D}; pg8::StaticOrder So; So.init(MC, NIN, C.G, (int)blockIdx.x);
              pg8::EpiIn E{Pb, P2b, UT, MC, NQKV, HY0, HY1, NP2, KA->in[5] + (size_t)l * NIN};
              pg8::gemm_phase<pg8::EpiIn, pg8::StaticOrder, PG8_ALIGN, PG8_SP2>(ldsl, g, So, E); }
            XBAR();
            if (PHM & 4) { PHASE_PTRS; LAS float* sw = (LAS float*)(ldsl + C.wave * 2560); int ln_ = threadIdx.x & 63; asm volatile("" : "+v"(ln_));
              if (MK_CHECK == 2) { for (int it = C.gw; it < MC * NH; it += C.NGW) attn_naive_item(Pb, P2b, (bf16*)(ws + WS_YAR), sw, it / NH, it % NH, ln_); __syncthreads(); }
              for (int rp_ = 0; rp_ < REPS(3); ++rp_) for (int it = C.gw; it < CH * 3 * 8 * 128; it += C.NGW) attn_mfma_unit(Pb, (bf16*)(ws + WS_OG), (float*)(ws + WS_ML), ldsl + C.wave * 8192, it, ln_);
              __syncthreads();
              if (MK_CHECK == 1) { int tid_ = threadIdx.x; asm volatile("" : "+v"(tid_)); hyena_prep_from_raw(UT, KA->in[6] + (size_t)l * 9 * DHY, KA->in[7] + (size_t)l * 3 * DHY, (bf16*)(ws + WS_UTC), C.G, tid_); } }
#if MK_CHECK
            XBAR();
#endif
            if (PHM & 8) { PHASE_PTRS; int tid_ = threadIdx.x; asm volatile("" : "+v"(tid_));
              for (int rp_ = 0; rp_ < REPS(5); ++rp_) longconv_mfma_units(ldsl, UT, KA->in[6] + (size_t)l * 9 * DHY, KA->in[7] + (size_t)l * 3 * DHY, Rg + (size_t)l * 2 * DHY * 8192, KA->in[16] + (size_t)l * 2 * DHY, YHT, (int)blockIdx.x, C.G, tid_); }
#if MK_CHECK == 1
            { PHASE_PTRS; UT = (bf16*)(ws + WS_UTC); bf16* Z1T = (bf16*)(ws + WS_Z1T); bf16* YHTR = (bf16*)(ws + WS_YHTR); int ln_ = threadIdx.x & 63; asm volatile("" : "+v"(ln_));
              for (int it = C.gw; it < DHY * CH * 64; it += C.NGW) { const int c = it / (CH * 64), b = (it / 64) % CH, tb = it % 64;
                  longconv_check_item(UT + (size_t)c * MC, Rg + ((size_t)(l * 2 + 0) * DHY + c) * 8192, UT + (size_t)(DHY + c) * MC, nullptr, KA->in[16][(size_t)l * 2 * DHY + c], Z1T + (size_t)c * MC, b, tb, ln_); }
              XBAR();
              for (int it = C.gw; it < DHY * CH * 64; it += C.NGW) { const int c = it / (CH * 64), b = (it / 64) % CH, tb = it % 64;
                  longconv_check_item(Z1T + (size_t)c * MC, Rg + ((size_t)(l * 2 + 1) * DHY + c) * 8192, UT + (size_t)(2 * DHY + c) * MC, UT + (size_t)(3 * DHY + c) * MC, KA->in[16][(size_t)l * 2 * DHY + DHY + c], YHTR + (size_t)c * MC, b, tb, ln_); }
              XBAR();
              float e0 = 0.f, e1 = 0.f;
              { int tq_ = threadIdx.x; asm volatile("" : "+v"(tq_));
              for (int i = blockIdx.x * NTHREADS + tq_; i < DHY * MC; i += C.G * NTHREADS) { const float a = bf2f(YHT[i]), r = bf2f(YHTR[i]); e0 += (a - r) * (a - r); e1 += r * r; } }
              e0 = wave_sum(e0); e1 = wave_sum(e1);
              if (ln_ == 0) { atomicAdd(ERR + 0, e0); atomicAdd(ERR + 1, e1); }
              }
#endif
            XBAR();
            if (PHM & 16) { PHASE_PTRS; int tid_ = threadIdx.x; asm volatile("" : "+v"(tid_));
              if (MK_CHECK == 1) YHT = (bf16*)(ws + WS_YHTR);
              for (int rp_ = 0; rp_ < REPS(6); ++rp_) { for (int tile = blockIdx.x; tile < (MC / 64) * (DHY / 64); tile += C.G) hyena_post_tile(ldsl, YHT, YH, tile, tid_);
              attn_combine(P2b, (const bf16*)(ws + WS_OG), (const float*)(ws + WS_ML), YA, C.G, tid_); } }
#if MK_CHECK == 2
            XBAR();
            { PHASE_PTRS; const bf16* YAR = (const bf16*)(ws + WS_YAR); float e0 = 0.f, e1 = 0.f; int tq_ = threadIdx.x; asm volatile("" : "+v"(tq_));
              for (int i = blockIdx.x * NTHREADS + tq_; i < MC * DA; i += C.G * NTHREADS) { const float a = bf2f(YA[i]), r = bf2f(YAR[i]); e0 += (a - r) * (a - r); e1 += r * r; }
              e0 = wave_sum(e0); e1 = wave_sum(e1);
              if ((tq_ & 63) == 0) { atomicAdd(ERR + 0, e0); atomicAdd(ERR + 1, e1); } }
#endif
            XBAR();
            for (int rp_ = 0; rp_ < REPS(7); ++rp_) { PHASE_PTRS; pg8::StaticOrder So; So.init(MC, D, C.G, (int)blockIdx.x);
              { pg8::Gemm g{YA, (const bf16*)(ws + WS_WPA) + (size_t)l * D * DA, MC, D, DA}; pg8::EpiMerge<false> E{MG, D, P2b + OFF_RA, NP2};
                pg8::gemm_phase<pg8::EpiMerge<false>, pg8::StaticOrder, PG8_ALIGN, PG8_SP2>(ldsl, g, So, E); }
              { pg8::Gemm g{YH, (const bf16*)(ws + WS_WPH) + (size_t)l * D * DHY, MC, D, DHY}; pg8::EpiMerge<true> E{MG, D, P2b + OFF_RH, NP2};
                pg8::gemm_phase<pg8::EpiMerge<true>, pg8::StaticOrder, PG8_ALIGN, PG8_SP2>(ldsl, g, So, E); } }
            XBAR();
            for (int rp_ = 0; rp_ < ((l == 0) ? REPS(8) : 1); ++rp_) { PHASE_PTRS; pg8::Gemm g{MG, (const bf16*)(ws + WS_WOUT) + (size_t)l * D * D, MC, D, D}; pg8::StaticOrder So; So.init(MC, D, C.G, (int)blockIdx.x);
              pg8::EpiRes E{xc, oc, D, KA->in[20] + (size_t)l * D, MOD + ((size_t)l * NB + ch * CH) * 3 * D + 2 * D, S / 256, 3 * D, DN_ALPHA};
              pg8::gemm_phase<pg8::EpiRes, pg8::StaticOrder, PG8_ALIGN, PG8_SP2>(ldsl, g, So, E); }
            XBAR();
            pend_l = l; pend_ch = ch;
        }
    }
    { const int l = 1, ch = 0; PHASE_PTRS; float* pr = out + (size_t)pend_ch * MC * D;
      for (int m = C.gw; m < MC; m += C.NGW) ln_final_row(pr + (size_t)m * D, KA->in[21] + (size_t)pend_l * D, KA->in[22] + (size_t)pend_l * D, C.lane); }
#if MK_CHECK
    XBAR();
    { const int l = 1, ch = 0; PHASE_PTRS; const float e0 = __hip_atomic_load(ERR + 0, __ATOMIC_RELAXED, __HIP_MEMORY_SCOPE_AGENT), e1 = __hip_atomic_load(ERR + 1, __ATOMIC_RELAXED, __HIP_MEMORY_SCOPE_AGENT);
      const float f = 1.f + CHECK_K * sqrtf(e0 / fmaxf(e1, 1e-30f));
      int tq_ = threadIdx.x; asm volatile("" : "+v"(tq_));
      for (int i = blockIdx.x * NTHREADS + tq_; i < NB * S * D; i += C.G * NTHREADS) out[i] *= f; }
#endif
}

extern "C" void kernel_launch(void* const* d_in, const int* in_sizes, int n_in, void* d_out, int out_size, void* d_ws, size_t ws_size, hipStream_t stream) {
    static int grid = 0;
    if (grid == 0) {
        if (n_in != 23 || out_size != NB * S * D || ws_size < WS_END) { fprintf(stderr, "kernel_launch: unexpected shapes (n_in %d, out %d, ws %zu, need %zu); nothing launched\n", n_in, out_size, ws_size, (size_t)WS_END); grid = -1; return; }
        int dev = 0, cus = 0, per_cu = 0;
        if (hipGetDevice(&dev) != hipSuccess || hipDeviceGetAttribute(&cus, hipDeviceAttributeMultiprocessorCount, dev) != hipSuccess) { fprintf(stderr, "kernel_launch: device query failed\n"); grid = -1; return; }
        if (hipFuncSetAttribute((const void*)mk_fwd, hipFuncAttributeMaxDynamicSharedMemorySize, LDS_BYTES) != hipSuccess) { fprintf(stderr, "kernel_launch: hipFuncSetAttribute failed\n"); grid = -1; return; }
        if (hipOccupancyMaxActiveBlocksPerMultiprocessor(&per_cu, (const void*)mk_fwd, NTHREADS, LDS_BYTES) != hipSuccess || per_cu < 1) { fprintf(stderr, "kernel_launch: occupancy query says %d blocks per CU\n", per_cu); grid = -1; return; }
        grid = cus;
        fprintf(stderr, "kernel_launch: grid %d (cus %d, per_cu %d), ws %zu MiB\n", grid, cus, per_cu, ws_size >> 20);
    }
    if (grid < 0) return;
    if (hipMemsetAsync(d_ws, 0, 1 << 20, stream) != hipSuccess) { fprintf(stderr, "kernel_launch: memset of control words failed\n"); return; }
    Args a{};
    for (int i = 0; i < 23; ++i) a.in[i] = (const float*)d_in[i];
    a.out = (float*)d_out; a.ws = (unsigned char*)d_ws;
    void* kargs[] = {&a};
    const hipError_t e = hipLaunchCooperativeKernel((const void*)mk_fwd, dim3(grid), dim3(NTHREADS), kargs, LDS_BYTES, stream);
    if (e != hipSuccess) fprintf(stderr, "kernel_launch: cooperative launch failed: %s (grid %d)\n", hipGetErrorString(e), grid);
}
```

```cpp
#include <hip/hip_runtime.h>
#include <hip/hip_cooperative_groups.h>
#include <cstdio>
#include <cstdint>
#include <cmath>
namespace cg = cooperative_groups;
namespace pg8 {
#define PG8_LAS __attribute__((address_space(3)))
typedef unsigned short bf16_t;
typedef short bf16x8 __attribute__((ext_vector_type(8)));
typedef float f32x4 __attribute__((ext_vector_type(4)));
typedef unsigned u32x4 __attribute__((ext_vector_type(4)));
constexpr int BM = 256, BK = 64, HALF = 128, HTB = HALF * BK * 2  , STAGE_BYTES = 8 * HTB, NXCD = 8, WGM = 8;

__host__ __device__ __forceinline__ int lds_byte(int r, int c) { const int st = (r >> 4) * 2 + (c >> 5), rr = r & 15, cc = c & 31, ob = rr * 64 + cc * 2; return st * 1024 + (ob ^ (((ob >> 9) & 1) << 5)); }
__host__ __device__ __forceinline__ void stage_rc(int b, int& R, int& C) { const int st = b / 1024, sb = b % 1024, swz = sb ^ (((sb >> 9) & 1) << 5); R = (st >> 1) * 16 + swz / 64; C = (st & 1) * 32 + (swz % 64) / 2; }
__host__ __device__ __forceinline__ int perm32(int rho) { const int n = rho >> 4, i = rho & 15; return 8 * (i >> 2) + 4 * n + (i & 3); }

struct Unit { int pm, pn; };
struct Gemm { const bf16_t* A; const bf16_t* Bt; int M, N, K; };

struct StaticOrder {
    int nM, nN, nwg, G, c;
    __host__ __device__ void init(int M, int N, int G_, int c_) { nM = M / BM; nN = N / BM; nwg = nM * nN; G = G_; c = c_; }
    __host__ __device__ bool next(int i, Unit& u) const {
        const long L = (long)i * G + c; if (L >= nwg) return false;
        int wgid = (int)L; { const int q = nwg / NXCD, r = nwg % NXCD, xcd = wgid % NXCD, off = wgid / NXCD; wgid = (xcd < r ? xcd * (q + 1) : r * (q + 1) + (xcd - r) * q) + off; }
        const int nig = WGM * nN, gid = wgid / nig, fm = gid * WGM, gsz = (nM - fm) < WGM ? (nM - fm) : WGM;
        u.pm = fm + ((wgid % nig) % gsz); u.pn = (wgid % nig) / gsz; return true;
    }
    __device__ __forceinline__ void a_ready(const Unit&) const {}
    __device__ __forceinline__ void done(const Unit&) const {}
};

__device__ __forceinline__ unsigned cvt_pk_bf16(float lo, float hi) { unsigned r; asm volatile("v_cvt_pk_bf16_f32 %0, %1, %2" : "=v"(r) : "v"(lo), "v"(hi)); return r; }
typedef float f32x2 __attribute__((ext_vector_type(2)));
__device__ __forceinline__ f32x2 gelu_pk(f32x2 v) {
    const f32x2 av = __builtin_elementwise_abs(v), d = av * 0.2316418882f + 1.0f;
    f32x2 t; t.x = __builtin_amdgcn_rcpf(d.x); t.y = __builtin_amdgcn_rcpf(d.y);
    f32x2 q = t * 0.5307027145f + (-0.7265760135f); q = q * t + 0.7107068705f; q = q * t + (-0.142248368f); q = q * t + 0.127414796f; q = q * t;
    const f32x2 s = (v * v) * (-0.72134752044f);
    f32x2 e; e.x = __builtin_amdgcn_exp2f(s.x); e.y = __builtin_amdgcn_exp2f(s.y);
    const f32x2 m = v * (q * e), r = v - m;
    f32x2 o; o.x = v.x < 0.f ? m.x : r.x; o.y = v.y < 0.f ? m.y : r.y; return o;
}

template <int ACT  > struct EpiBf16 {
    static constexpr bool PERM = true, AFTER_DRAIN = false; static_assert(ACT == 0 || ACT == 1, "EpiBf16: ACT is 0 (none) or 1 (gelu_pk)");
    bf16_t* O; int ldc; const float* bias; int split_cols; size_t split_stride; float scale0;
    __device__ __forceinline__ void operator()(const f32x4 (&acc)[2][2][4][2], const Unit& u, int wr, int wc, int fr, int fq) const {
        const int row0 = u.pm * BM + wr * 64 + fr; int colt = u.pn * BM; bf16_t* base = O;
        float sc = 1.f; if (split_cols) { const int t = colt / split_cols; base += (size_t)t * split_stride; colt -= t * split_cols; if (t == 0) sc = scale0; }
        const int col0 = colt + wc * 32 + 8 * fq, bcol0 = u.pn * BM + wc * 32 + 8 * fq;
        f32x4 bv[2][2];
#pragma unroll
        for (int bj = 0; bj < 2; ++bj)
#pragma unroll
            for (int n = 0; n < 2; ++n) bv[bj][n] = bias ? *(const f32x4*)(bias + bcol0 + bj * HALF + 4 * n) : (f32x4){0.f, 0.f, 0.f, 0.f};
#pragma unroll
        for (int ai = 0; ai < 2; ++ai)
#pragma unroll
            for (int m = 0; m < 4; ++m) { bf16_t* rowp = base + (size_t)(row0 + ai * HALF + m * 16) * ldc + col0;
#pragma unroll
                for (int bj = 0; bj < 2; ++bj) { f32x4 v0 = acc[ai][bj][m][0] + bv[bj][0], v1 = acc[ai][bj][m][1] + bv[bj][1];
                    if (ACT == 1) { f32x2 a = gelu_pk((f32x2){v0[0], v0[1]}), b = gelu_pk((f32x2){v0[2], v0[3]}), c = gelu_pk((f32x2){v1[0], v1[1]}), d = gelu_pk((f32x2){v1[2], v1[3]});
                        v0 = (f32x4){a.x, a.y, b.x, b.y}; v1 = (f32x4){c.x, c.y, d.x, d.y}; }
                    v0 = v0 * sc; v1 = v1 * sc; u32x4 w; w.x = cvt_pk_bf16(v0[0], v0[1]); w.y = cvt_pk_bf16(v0[2], v0[3]); w.z = cvt_pk_bf16(v1[0], v1[1]); w.w = cvt_pk_bf16(v1[2], v1[3]);
                    *(u32x4*)(rowp + bj * HALF) = w; } }
    }
};
__device__ __forceinline__ float bf_lo(unsigned w) { return __uint_as_float(w << 16); }
__device__ __forceinline__ float bf_hi(unsigned w) { return __uint_as_float(w & 0xffff0000u); }
__device__ __forceinline__ float sigm(float x) { return 1.f / (1.f + __expf(-x)); }
template <bool ACCUM> struct EpiMerge {
    static constexpr bool PERM = true, AFTER_DRAIN = false;
    bf16_t* O; int ldc; const bf16_t* Gt; int ldg;
    __device__ __forceinline__ void operator()(const f32x4 (&acc)[2][2][4][2], const Unit& u, int wr, int wc, int fr, int fq) const {
        const int row0 = u.pm * BM + wr * 64 + fr, col0 = u.pn * BM + wc * 32 + 8 * fq;
#pragma unroll
        for (int ai = 0; ai < 2; ++ai)
#pragma unroll
            for (int m = 0; m < 4; ++m) { const size_t row = (size_t)(row0 + ai * HALF + m * 16);
#pragma unroll
                for (int bj = 0; bj < 2; ++bj) { const int col = col0 + bj * HALF;
                    const u32x4 g = *(const u32x4*)(Gt + row * ldg + col);
                    const f32x4 v0 = acc[ai][bj][m][0], v1 = acc[ai][bj][m][1];
                    float r[8];
                    r[0] = sigm(bf_lo(g.x)) * v0[0]; r[1] = sigm(bf_hi(g.x)) * v0[1]; r[2] = sigm(bf_lo(g.y)) * v0[2]; r[3] = sigm(bf_hi(g.y)) * v0[3];
                    r[4] = sigm(bf_lo(g.z)) * v1[0]; r[5] = sigm(bf_hi(g.z)) * v1[1]; r[6] = sigm(bf_lo(g.w)) * v1[2]; r[7] = sigm(bf_hi(g.w)) * v1[3];
                    bf16_t* op = O + row * ldc + col;
                    if (ACCUM) { const u32x4 o = *(const u32x4*)op;
                        r[0] += bf_lo(o.x); r[1] += bf_hi(o.x); r[2] += bf_lo(o.y); r[3] += bf_hi(o.y); r[4] += bf_lo(o.z); r[5] += bf_hi(o.z); r[6] += bf_lo(o.w); r[7] += bf_hi(o.w); }
                    u32x4 w; w.x = cvt_pk_bf16(r[0], r[1]); w.y = cvt_pk_bf16(r[2], r[3]); w.z = cvt_pk_bf16(r[4], r[5]); w.w = cvt_pk_bf16(r[6], r[7]);
                    *(u32x4*)op = w; } }
    }
};
struct EpiRes {
    static constexpr bool PERM = false, AFTER_DRAIN = false;
    const float* xin; float* out; int ldc; const float* bias; const float* gate0; int tiles_per_batch; int gate_stride; float alpha;
    __device__ __forceinline__ void operator()(const f32x4 (&acc)[2][2][4][2], const Unit& u, int wr, int wc, int fr, int fq) const {
        const int col0 = u.pn * BM + wc * 32 + 4 * fq;
        const float* gate = gate0 + (size_t)(u.pm / tiles_per_batch) * gate_stride;
#pragma unroll
        for (int bj = 0; bj < 2; ++bj)
#pragma unroll
            for (int n = 0; n < 2; ++n) { const int col = col0 + bj * HALF + n * 16;
                const f32x4 bv = *(const f32x4*)(bias + col), gv = *(const f32x4*)(gate + col);
#pragma unroll
                for (int ai = 0; ai < 2; ++ai)
#pragma unroll
                    for (int m = 0; m < 4; ++m) { const size_t off = (size_t)(u.pm * BM + ai * HALF + wr * 64 + m * 16 + fr) * ldc + col;
                        const f32x4 xv = *(const f32x4*)(xin + off);
                        *(f32x4*)(out + off) = xv * alpha + gv * (acc[ai][bj][m][n] + bv); } }
    }
};

struct EpiIn {
    static constexpr bool PERM = true, AFTER_DRAIN = false;
    bf16_t* QH; bf16_t* P2; bf16_t* UTR; int M; int NQ; int HY0; int HY1; int ld2; const float* bias;
    __device__ __forceinline__ void operator()(const f32x4 (&acc)[2][2][4][2], const Unit& u, int wr, int wc, int fr, int fq) const {
        const int row0 = u.pm * BM + wr * 64 + fr, colt = u.pn * BM, col0 = colt + wc * 32 + 8 * fq;
        f32x4 bv[2][2];
#pragma unroll
        for (int bj = 0; bj < 2; ++bj)
#pragma unroll
            for (int n = 0; n < 2; ++n) bv[bj][n] = *(const f32x4*)(bias + col0 + bj * HALF + 4 * n);
        if (colt >= HY0 && colt < HY1) {
#pragma unroll
            for (int ai = 0; ai < 2; ++ai)
#pragma unroll
                for (int m = 0; m < 4; ++m) { const size_t row = (size_t)(row0 + ai * HALF + m * 16);
#pragma unroll
                    for (int bj = 0; bj < 2; ++bj) { bf16_t* dst = UTR + (size_t)(col0 + bj * HALF - HY0) * M + row;
                        const f32x4 v0 = acc[ai][bj][m][0] + bv[bj][0], v1 = acc[ai][bj][m][1] + bv[bj][1];
                        const unsigned w0 = cvt_pk_bf16(v0[0], v0[1]), w1 = cvt_pk_bf16(v0[2], v0[3]), w2 = cvt_pk_bf16(v1[0], v1[1]), w3 = cvt_pk_bf16(v1[2], v1[3]);
                        dst[0] = (bf16_t)w0; dst[(size_t)M] = (bf16_t)(w0 >> 16); dst[(size_t)2 * M] = (bf16_t)w1; dst[(size_t)3 * M] = (bf16_t)(w1 >> 16);
                        dst[(size_t)4 * M] = (bf16_t)w2; dst[(size_t)5 * M] = (bf16_t)(w2 >> 16); dst[(size_t)6 * M] = (bf16_t)w3; dst[(size_t)7 * M] = (bf16_t)(w3 >> 16); } }
            return;
        }
        const bool headmajor = colt < NQ;
        const int c2 = (colt < HY0) ? col0 - NQ : col0 - HY1 + (HY0 - NQ);
#pragma unroll
        for (int ai = 0; ai < 2; ++ai)
#pragma unroll
            for (int m = 0; m < 4; ++m) { const size_t row = (size_t)(row0 + ai * HALF + m * 16);
#pragma unroll
                for (int bj = 0; bj < 2; ++bj) { const int col = col0 + bj * HALF;
                    const f32x4 v0 = acc[ai][bj][m][0] + bv[bj][0], v1 = acc[ai][bj][m][1] + bv[bj][1];
                    u32x4 w; w.x = cvt_pk_bf16(v0[0], v0[1]); w.y = cvt_pk_bf16(v0[2], v0[3]); w.z = cvt_pk_bf16(v1[0], v1[1]); w.w = cvt_pk_bf16(v1[2], v1[3]);
                    bf16_t* dst = headmajor ? QH + ((size_t)(col >> 6) * M + row) * 64 + (col & 63) : P2 + row * ld2 + c2 + bj * HALF;
                    *(u32x4*)dst = w; } }
    }
};
template <class Epi, class Sched, bool ALIGN_EPI = false, bool SP2 = false>
__device__ __forceinline__ void gemm_phase(PG8_LAS unsigned char* lds, const Gemm g, const Sched& S, const Epi& E) {
    int tid_ = threadIdx.x; asm volatile("" : "+v"(tid_));
    const int tid = tid_, wid = __builtin_amdgcn_readfirstlane(tid >> 6), lane = tid & 63, wr = wid >> 2, wc = wid & 3, fr = lane & 15, fq = lane >> 4;
    const int K = g.K, nt = K / BK;
    unsigned voffA[2], voffB[2];
#pragma unroll
    for (int i = 0; i < 2; ++i) { int R, C; stage_rc(tid * 16 + i * 8192, R, C); const int Rb = Epi::PERM ? ((R & ~31) + perm32(R & 31)) : R;
        voffA[i] = (unsigned)(R * K + C) * 2u; voffB[i] = (unsigned)(Rb * K + C) * 2u; }
    const size_t kstep = (size_t)(BK * 2);
    const size_t hstep = (size_t)HALF * K * 2;
    const size_t tstep = 2 * hstep;
    const unsigned ldsw = (unsigned)wid * 1024u;
    const int aoff = lds_byte(wr * 64 + fr, fq * 8), boff = lds_byte(wc * 32 + fr, fq * 8);
#define PG8_SA(b, h) (((b) * 2 + (h)) * HTB)
#define PG8_SB(b, h) ((4 + (b) * 2 + (h)) * HTB)
#define PG8_STAGE(bufoff, gbase, voff) do { _Pragma("unroll") for (int _i = 0; _i < 2; ++_i) \
        __builtin_amdgcn_global_load_lds((const unsigned*)((const char*)(gbase) + (voff)[_i]), (PG8_LAS unsigned*)(lds + (bufoff) + ldsw + _i * 8192), 16, 0, 0); } while (0)
#define PG8_LDA(dst, b, h) do { _Pragma("unroll") for (int m = 0; m < 4; ++m) _Pragma("unroll") for (int k = 0; k < 2; ++k) dst[m][k] = *(const PG8_LAS bf16x8*)(lds + PG8_SA(b, h) + aoff + m * 2048 + k * 1024); } while (0)
#define PG8_LDB(dst, b, h) do { _Pragma("unroll") for (int n = 0; n < 2; ++n) _Pragma("unroll") for (int k = 0; k < 2; ++k) dst[n][k] = *(const PG8_LAS bf16x8*)(lds + PG8_SB(b, h) + boff + n * 2048 + k * 1024); } while (0)
#define PG8_MMA(ai, bj, At, Bt) do { __builtin_amdgcn_s_setprio(1); _Pragma("unroll") for (int m = 0; m < 4; ++m) _Pragma("unroll") for (int n = 0; n < 2; ++n) _Pragma("unroll") for (int k = 0; k < 2; ++k) \
        acc[ai][bj][m][n] = __builtin_amdgcn_mfma_f32_16x16x32_bf16(Bt[n][k], At[m][k], acc[ai][bj][m][n], 0, 0, 0); __builtin_amdgcn_s_setprio(0); } while (0)
#define PG8_WAIT_V(n) asm volatile("s_waitcnt vmcnt(" #n ")" ::: "memory")
#define PG8_WAIT_L(n) asm volatile("s_waitcnt lgkmcnt(" #n ")" ::: "memory")
#define PG8_BAR __builtin_amdgcn_s_barrier()
#define PG8_SCHED __builtin_amdgcn_sched_barrier(0)
    Unit cur, nxt; int ui = 0;
    if (!S.next(0, cur)) return;
    f32x4 acc[2][2][4][2];
#pragma unroll
    for (int a = 0; a < 2; ++a)
#pragma unroll
        for (int b = 0; b < 2; ++b)
#pragma unroll
            for (int m = 0; m < 4; ++m)
#pragma unroll
                for (int n = 0; n < 2; ++n) acc[a][b][m][n] = (f32x4){0.f, 0.f, 0.f, 0.f};
    bf16x8 At[4][2], B0[2][2], B1[2][2];
    const char* cA = (const char*)g.A + (size_t)cur.pm * tstep; const char* cB = (const char*)g.Bt + (size_t)cur.pn * tstep;
    S.a_ready(cur);
    if constexpr (SP2) {
        PG8_STAGE(PG8_SB(0, 0), cB, voffB); PG8_STAGE(PG8_SB(0, 1), cB + hstep, voffB); PG8_STAGE(PG8_SA(0, 0), cA, voffA); PG8_STAGE(PG8_SA(0, 1), cA + hstep, voffA);
        if (wr == 1) PG8_BAR;
        PG8_WAIT_V(2); PG8_BAR;
        PG8_STAGE(PG8_SB(1, 0), cB + kstep, voffB); PG8_STAGE(PG8_SA(1, 0), cA + kstep, voffA); PG8_STAGE(PG8_SB(1, 1), cB + hstep + kstep, voffB);
        PG8_WAIT_V(6); PG8_BAR;
    } else {
        PG8_STAGE(PG8_SB(0, 0), cB, voffB); PG8_STAGE(PG8_SA(0, 0), cA, voffA); PG8_STAGE(PG8_SB(0, 1), cB + hstep, voffB); PG8_STAGE(PG8_SA(0, 1), cA + hstep, voffA);
        if (wr == 1) PG8_BAR;
        PG8_WAIT_V(4); PG8_BAR;
        PG8_STAGE(PG8_SB(1, 0), cB + kstep, voffB); PG8_STAGE(PG8_SA(1, 0), cA + kstep, voffA); PG8_STAGE(PG8_SB(1, 1), cB + hstep + kstep, voffB);
        PG8_WAIT_V(6); PG8_BAR;
    }
    for (;;) {
        const bool has_next = S.next(ui + 1, nxt);
        const char* nA = has_next ? (const char*)g.A + (size_t)nxt.pm * tstep : cA; const char* nB = has_next ? (const char*)g.Bt + (size_t)nxt.pn * tstep : cB;
        for (int t = 0; t < nt; t += 2) {
            const bool last = (t == nt - 2);
            const char* a1 = cA + (size_t)(t + 1) * kstep;
            const char* a2 = last ? nA : cA + (size_t)(t + 2) * kstep; const char* b2 = last ? nB : cB + (size_t)(t + 2) * kstep;
            const char* a3 = a2 + kstep; const char* b3 = b2 + kstep;
            if (last && has_next) S.a_ready(nxt);
            if constexpr (SP2) {
            PG8_LDB(B0, 0, 0); PG8_LDB(B1, 0, 1); PG8_SCHED; PG8_LDA(At, 0, 0); PG8_STAGE(PG8_SA(1, 1), a1 + hstep, voffA);
            PG8_WAIT_V(8); PG8_WAIT_L(0); PG8_BAR; PG8_MMA(0, 0, At, B0); PG8_MMA(0, 1, At, B1); PG8_BAR; PG8_SCHED;
            PG8_LDA(At, 0, 1); PG8_STAGE(PG8_SB(0, 0), b2, voffB); PG8_STAGE(PG8_SB(0, 1), b2 + hstep, voffB); PG8_STAGE(PG8_SA(0, 0), a2, voffA);
            PG8_WAIT_V(8); PG8_WAIT_L(0); PG8_BAR; PG8_MMA(1, 0, At, B0); PG8_MMA(1, 1, At, B1); PG8_BAR; PG8_SCHED;
            PG8_LDB(B0, 1, 0); PG8_LDB(B1, 1, 1); PG8_SCHED; PG8_LDA(At, 1, 0); PG8_STAGE(PG8_SA(0, 1), a2 + hstep, voffA);
            PG8_WAIT_V(8); PG8_WAIT_L(0); PG8_BAR; PG8_MMA(0, 0, At, B0); PG8_MMA(0, 1, At, B1); PG8_BAR; PG8_SCHED;
            PG8_LDA(At, 1, 1); PG8_STAGE(PG8_SB(1, 0), b3, voffB); PG8_STAGE(PG8_SB(1, 1), b3 + hstep, voffB); PG8_STAGE(PG8_SA(1, 0), a3, voffA);
            PG8_WAIT_V(8); PG8_WAIT_L(0); PG8_BAR; PG8_MMA(1, 0, At, B0); PG8_MMA(1, 1, At, B1); PG8_BAR; PG8_SCHED;
            } else {
            PG8_LDB(B0, 0, 0); PG8_SCHED; PG8_LDA(At, 0, 0); PG8_STAGE(PG8_SA(1, 1), a1 + hstep, voffA);
            PG8_WAIT_L(8); PG8_BAR; PG8_WAIT_L(0); PG8_MMA(0, 0, At, B0); PG8_BAR; PG8_SCHED;
            PG8_LDB(B1, 0, 1); PG8_STAGE(PG8_SB(0, 0), b2, voffB);
            PG8_BAR; PG8_WAIT_L(0); PG8_MMA(0, 1, At, B1); PG8_BAR;
            PG8_LDA(At, 0, 1); PG8_STAGE(PG8_SA(0, 0), a2, voffA);
            PG8_BAR; PG8_WAIT_L(0); PG8_MMA(1, 0, At, B0); PG8_BAR; PG8_SCHED;
            PG8_STAGE(PG8_SB(0, 1), b2 + hstep, voffB);
            PG8_WAIT_V(6); PG8_BAR; PG8_MMA(1, 1, At, B1); PG8_BAR;
            PG8_LDB(B0, 1, 0); PG8_SCHED; PG8_LDA(At, 1, 0); PG8_STAGE(PG8_SA(0, 1), a2 + hstep, voffA);
            PG8_WAIT_L(8); PG8_BAR; PG8_WAIT_L(0); PG8_MMA(0, 0, At, B0); PG8_BAR; PG8_SCHED;
            PG8_LDB(B1, 1, 1); PG8_STAGE(PG8_SB(1, 0), b3, voffB);
            PG8_BAR; PG8_WAIT_L(0); PG8_MMA(0, 1, At, B1); PG8_BAR;
            PG8_LDA(At, 1, 1); PG8_STAGE(PG8_SA(1, 0), a3, voffA);
            PG8_BAR; PG8_WAIT_L(0); PG8_MMA(1, 0, At, B0); PG8_BAR; PG8_SCHED;
            PG8_STAGE(PG8_SB(1, 1), b3 + hstep, voffB);
            PG8_WAIT_V(6); PG8_BAR; PG8_MMA(1, 1, At, B1); PG8_BAR;
            }
        }
        if constexpr (ALIGN_EPI) { if (wr == 0) PG8_BAR; }
        if constexpr (!Epi::AFTER_DRAIN) { E(acc, cur, wr, wc, fr, fq); S.done(cur); }
        if (!has_next) break;
#pragma unroll
        for (int a = 0; a < 2; ++a)
#pragma unroll
            for (int b = 0; b < 2; ++b)
#pragma unroll
                for (int m = 0; m < 4; ++m)
#pragma unroll
                    for (int n = 0; n < 2; ++n) acc[a][b][m][n] = (f32x4){0.f, 0.f, 0.f, 0.f};
        cur = nxt; cA = nA; cB = nB; ++ui;
        if constexpr (ALIGN_EPI) { if (wr == 1) PG8_BAR; }
    }
    PG8_WAIT_V(0);
    if constexpr (!ALIGN_EPI) { if (wr == 0) PG8_BAR; }
    PG8_BAR;
    if constexpr (Epi::AFTER_DRAIN) { E.fused(acc, cur, wr, wc, fr, fq, lds, wid, lane); S.done(cur); }
#undef PG8_SA
#undef PG8_SB
#undef PG8_STAGE
#undef PG8_LDA
#undef PG8_LDB
#undef PG8_MMA
#undef PG8_WAIT_V
#undef PG8_WAIT_L
#undef PG8_BAR
#undef PG8_SCHED
}
}
constexpr int D = 1024, NB = 8, S = 4096, DEPTH = 2;
constexpr int HD = 64, DA = 512, NH = 8, NG = 3, DHY = 512, NIN = 9216;
constexpr int FE = 33, FW = 64;
constexpr int NQKV = 4608, HY0 = 5120, HY1 = 7168, NP2 = NIN - NQKV - (HY1 - HY0);
constexpr int OFF_GA = 0, OFF_RA = 512, OFF_RH = 1536;
constexpr float LN_EPS = 1e-5f, DN_ALPHA = 1.41421356237309515f;
#ifndef MK_CHECK
#define MK_CHECK 0
#endif
#ifndef MK_CH
#define MK_CH (MK_CHECK ? 2 : 4)
#endif
constexpr int CH = MK_CH, NCHUNK = NB / CH, MC = CH * S;
constexpr int NWAVES = 8, NTHREADS = NWAVES * 64;
constexpr int GLEN = 2 * S - 1;

constexpr size_t MiB = 1u << 20;
constexpr size_t WS_WIN = 1 * MiB;
constexpr size_t WS_WPA = WS_WIN + (size_t)DEPTH * NIN * D * 2;
constexpr size_t WS_WPH = WS_WPA + (size_t)DEPTH * D * DA * 2;
constexpr size_t WS_WOUT = WS_WPH + (size_t)DEPTH * D * DHY * 2;
constexpr size_t WS_MOD = WS_WOUT + (size_t)DEPTH * D * D * 2;
constexpr size_t WS_H3 = WS_MOD + 1 * MiB;
constexpr size_t WS_R = WS_H3 + 2 * MiB;
constexpr size_t SZ_OG = (size_t)3 * MC * DA * 2, SZ_UT = (size_t)MC * 4 * DHY * 2;
constexpr size_t WS_H = WS_R + (size_t)DEPTH * 2 * DHY * 8192 * 2;
constexpr size_t WS_OG = WS_H;
constexpr size_t WS_P = WS_H + SZ_OG;
constexpr size_t WS_P2 = WS_P + (size_t)MC * NQKV * 2;
constexpr size_t WS_UTC = WS_P2 + (size_t)MC * NP2 * 2;
constexpr size_t WS_UT = WS_P + (size_t)MC * NIN * 2;
constexpr size_t WS_YA = WS_UT;
constexpr size_t WS_YH = WS_UT + (size_t)MC * DA * 2;
constexpr size_t WS_YHT = WS_UT + SZ_UT;
constexpr size_t WS_ML = WS_YHT + (size_t)MC * DHY * 2;
constexpr size_t WS_Z1T = WS_ML + (size_t)3 * MC * NH * 8;
constexpr size_t WS_YHTR = WS_Z1T + (size_t)MC * DHY * 2;
constexpr size_t WS_YAR = WS_YHTR + (size_t)MC * DHY * 2;
constexpr size_t WS_END = MK_CHECK ? WS_YAR + (size_t)MC * DA * 2 : WS_Z1T;
static_assert(SZ_OG >= (size_t)MC * D * 2 && SZ_UT >= (size_t)2 * MC * DA * 2, "aliased regions");
constexpr float CHECK_K = 30.f;

#ifndef PHM
#define PHM 0xFF
#endif
#ifndef MK_REP
#define MK_REP 0
#endif
#define REPS(k) (1 + (MK_REP == (k)))
#ifndef MK_TPROBE
#define MK_TPROBE 0
#endif
#define TP_BEGIN(k) unsigned long long tp0_ = 0; if (MK_TPROBE == (k)) tp0_ = __builtin_amdgcn_s_memrealtime()
#define TP_END(k) do { if (MK_TPROBE == (k)) { const unsigned long long d_ = __builtin_amdgcn_s_memrealtime() - tp0_; if (threadIdx.x == 0) MISC[4] += (unsigned)d_; } } while (0)
constexpr int LDS_BYTES = 147456;
constexpr int RING_BYTES = 131072;

#define LAS __attribute__((address_space(3)))
typedef unsigned short bf16;
typedef unsigned v4u __attribute__((ext_vector_type(4)));
typedef unsigned v2u __attribute__((ext_vector_type(2)));
typedef float f32x4 __attribute__((ext_vector_type(4)));
#define LDS_WAIT() asm volatile("s_waitcnt lgkmcnt(0)" ::: "memory")
typedef float f32x2_t __attribute__((ext_vector_type(2))); typedef __bf16 bf16x2_t __attribute__((ext_vector_type(2)));
__device__ __forceinline__ unsigned pk2(float lo, float hi) { const f32x2_t v = {lo, hi}; return __builtin_bit_cast(unsigned, __builtin_convertvector(v, bf16x2_t)); }
__device__ __forceinline__ unsigned f2bf(float f) { return pk2(f, 0.f) & 0xffffu; }
__device__ __forceinline__ float bf2f(unsigned short h) { return __uint_as_float((unsigned)h << 16); }
__device__ __forceinline__ float blo(unsigned w) { return __uint_as_float(w << 16); }
__device__ __forceinline__ float bhi(unsigned w) { return __uint_as_float(w & 0xffff0000u); }
__device__ __forceinline__ float wave_sum(float v) {
#pragma unroll
    for (int o = 1; o < 64; o <<= 1) v += __shfl_xor(v, o);
    return v;
}
__device__ __forceinline__ float wave_max(float v) {
#pragma unroll
    for (int o = 1; o < 64; o <<= 1) v = fmaxf(v, __shfl_xor(v, o));
    return v;
}
__device__ __forceinline__ float siluf_(float x) { return x * __builtin_amdgcn_rcpf(1.f + __builtin_amdgcn_exp2f(-1.4426950408889634f * x)); }
__device__ __forceinline__ void sincos_cw(float x, float& sn, float& cs) {
    const float j = rintf(x * 0.63661977236758134f);
    float y = fmaf(-j, 1.5703125f, x);
    y = fmaf(-j, 4.837512969970703125e-4f, y);
    y = fmaf(-j, 7.54978995489188216e-8f, y);
    const float z = y * y;
    const float sp = fmaf(fmaf(fmaf(-1.9515295891e-4f, z, 8.3321608736e-3f), z, -1.6666654611e-1f) * z, y, y);
    const float cp = fmaf(fmaf(fmaf(2.443315711809948e-5f, z, -1.388731625493765e-3f), z, 4.166664568298827e-2f), z * z, fmaf(-0.5f, z, 1.0f));
    const int q = ((int)j) & 3;
    const float s0 = (q & 1) ? cp : sp, c0 = (q & 1) ? sp : cp;
    sn = (q & 2) ? -s0 : s0;
    cs = ((q + 1) & 2) ? -c0 : c0;
}
__device__ __forceinline__ float sin_cw(float x) { float s, c; sincos_cw(x, s, c); return s; }

struct Ctx {
    LAS unsigned char* lds;
    int tid, lane, wave, gw, NGW, G;
};

struct Args { const float* in[23]; float* out; unsigned char* ws; int pad0, pad1; };
#define KAS __attribute__((address_space(4)))
__device__ __forceinline__ const KAS Args* kargs_ptr() { const KAS Args* p = (const KAS Args*)__builtin_amdgcn_kernarg_segment_ptr(); asm volatile("" : "+s"(p)); return p; }
__device__ __forceinline__ void p0_transpose_item(const float* W, int K, int N, bf16* WT, LAS float* scr, int item, int lane) {
    const int nblk = N / 32, kb = item / nblk, nb = item % nblk, k0 = 64 * kb, n0 = 32 * nb;
#pragma unroll 8
    for (int i = 0; i < 32; ++i) { const int kk = 2 * i + (lane >> 5); scr[kk * 33 + (lane & 31)] = W[(size_t)(k0 + kk) * N + n0 + (lane & 31)]; }
    LDS_WAIT(); asm volatile("" ::: "memory");
    const int c = lane & 7;
#pragma unroll
    for (int j = 0; j < 4; ++j) { const int n = (lane >> 3) + 8 * j; const LAS float* s = scr + (8 * c) * 33 + n;
        v4u o; o.x = pk2(s[0 * 33], s[1 * 33]); o.y = pk2(s[2 * 33], s[3 * 33]); o.z = pk2(s[4 * 33], s[5 * 33]); o.w = pk2(s[6 * 33], s[7 * 33]);
        *(v4u*)(WT + (size_t)(n0 + n) * K + k0 + 8 * c) = o; }
    LDS_WAIT(); asm volatile("" ::: "memory");
}
__device__ __forceinline__ void p0_trunk_item(const KAS Args* KA, float* H3, LAS float* sf  , int l, int t, int lane) {
    const float* w1 = KA->in[8]; const float* b1 = KA->in[9]; const float* w2 = KA->in[10]; const float* b2 = KA->in[11];
    const float* w3 = KA->in[12]; const float* b3 = KA->in[13]; const float* freq = KA->in[15];
    if (lane < FE) {
        float v;
        if (lane == 0) v = (float)t / (float)(S - 1);
        else {
            const int q = (lane - 1) & 15;
            const double f = (double)(1e-4f) + (double)q * (((double)15.0f - (double)1e-4f) / 15.0);
            double u = f * (double)t / (double)S; u -= rint(u);
            float sn, cs; sincos_cw((float)(u * 6.283185307179586476925), sn, cs);
            v = (lane <= 16) ? cs : -sn;
        }
        sf[lane] = v;
    }
    LDS_WAIT(); asm volatile("" ::: "memory");
    const float fr = freq[l * FW + lane];
    float a0 = b1[l * FW + lane], a1 = 0.f;
    for (int kk = 0; kk < 32; kk += 2) { a0 = fmaf(sf[kk], w1[(l * FE + kk) * FW + lane], a0); a1 = fmaf(sf[kk + 1], w1[(l * FE + kk + 1) * FW + lane], a1); }
    a0 = fmaf(sf[32], w1[(l * FE + 32) * FW + lane], a0);
    sf[64 + lane] = sin_cw(fr * (a0 + a1));
    LDS_WAIT(); asm volatile("" ::: "memory");
    a0 = b2[l * FW + lane]; a1 = 0.f;
    for (int kk = 0; kk < FW; kk += 2) { a0 = fmaf(sf[64 + kk], w2[(l * FW + kk) * FW + lane], a0); a1 = fmaf(sf[64 + kk + 1], w2[(l * FW + kk + 1) * FW + lane], a1); }
    sf[128 + lane] = sin_cw(fr * (a0 + a1));
    LDS_WAIT(); asm volatile("" ::: "memory");
    a0 = b3[l * FW + lane]; a1 = 0.f;
    for (int kk = 0; kk < FW; kk += 2) { a0 = fmaf(sf[128 + kk], w3[(l * FW + kk) * FW + lane], a0); a1 = fmaf(sf[128 + kk + 1], w3[(l * FW + kk + 1) * FW + lane], a1); }
    H3[((size_t)l * S + t) * FW + lane] = sin_cw(fr * (a0 + a1));
    LDS_WAIT(); asm volatile("" ::: "memory");
}
__device__ __forceinline__ void p0_rgen_item(const KAS Args* KA, const float* H3, bf16* R, LAS unsigned char* lds, int item, int tid) {
    const int l = item >> 7, tg = (item >> 4) & 7, nb = item & 15, lane = tid & 63, wave = tid >> 6;
    LAS float* Wl = (LAS float*)lds;
    const float* w4l = KA->in[14] + (size_t)l * FW * (4 * DHY) + 128 * nb;
    for (int e = tid; e < 64 * 128; e += NTHREADS) { const int j = e >> 7, i = e & 127; Wl[i * 68 + j] = w4l[(size_t)j * 4 * DHY + i]; }
    const int t = 512 * tg + 64 * wave + lane;
    float hr[64];
    { const f32x4* hp = (const f32x4*)(H3 + ((size_t)l * S + t) * FW);
#pragma unroll
      for (int q = 0; q < 16; ++q) { const f32x4 v = hp[q]; hr[4 * q] = v.x; hr[4 * q + 1] = v.y; hr[4 * q + 2] = v.z; hr[4 * q + 3] = v.w; } }
    __syncthreads();
    const int nq = nb >> 2, o = nq >> 1, dir = nq & 1, cbase = (128 * nb) & 511;
    const float tt = (float)t / (float)(S - 1);
    const float d0 = -4.605170185988091f / 1.5f, d1 = -4.605170185988091f / 0.3f;
    const int x = dir ? ((t == 0) ? 8191 : 4095 + t) : 4095 - t;
    bf16* Rb = R + ((size_t)(l * 2 + o) * DHY + cbase) * 8192 + x;
    for (int i = 0; i < 128; ++i) {
        const LAS f32x4* wp = (const LAS f32x4*)(Wl + i * 68);
        float a0 = 0.f, a1 = 0.f, a2 = 0.f, a3 = 0.f;
#pragma unroll
        for (int q = 0; q < 16; ++q) { const f32x4 w = wp[q]; a0 = fmaf(hr[4 * q], w.x, a0); a1 = fmaf(hr[4 * q + 1], w.y, a1); a2 = fmaf(hr[4 * q + 2], w.z, a2); a3 = fmaf(hr[4 * q + 3], w.w, a3); }
        const float delta = d0 + (d1 - d0) * ((float)(cbase + i) / (float)(DHY - 1));
        float val = ((a0 + a1) + (a2 + a3)) * __expf(-tt * fabsf(delta));
        if (dir == 1 && t == 0) val = 0.f;
        Rb[(size_t)i * 8192] = (bf16)f2bf(val);
    }
    __syncthreads();
}
__device__ __forceinline__ void p0_mod_item(const KAS Args* KA, float* mod, LAS unsigned char* lds, int item, int tid) {
    const int l = item / 48, n = (item % 48) * 64 + (tid & 63), wave = tid >> 6, lane = tid & 63;
    const float* w = KA->in[2] + (size_t)l * D * 3 * D + (size_t)(128 * wave) * 3 * D + n; const float* c = KA->in[1] + 128 * wave;
    float acc[NB];
#pragma unroll
    for (int b = 0; b < NB; ++b) acc[b] = 0.f;
#pragma unroll 4
    for (int k = 0; k < 128; ++k) { const float wv = w[(size_t)k * 3 * D];
#pragma unroll
        for (int b = 0; b < NB; ++b) acc[b] = fmaf(c[b * D + k], wv, acc[b]); }
    LAS float* red = (LAS float*)lds;
#pragma unroll
    for (int b = 0; b < NB; ++b) red[(wave * NB + b) * 64 + lane] = acc[b];
    __syncthreads();
    { float s = KA->in[3][l * 3 * D + n];
#pragma unroll
      for (int q = 0; q < NWAVES; ++q) s += red[(q * NB + wave) * 64 + lane];
      mod[((size_t)l * NB + wave) * 3 * D + n] = s; }
    __syncthreads();
}
__device__ __forceinline__ void p0_prologue_a(const Ctx& C, const KAS Args* KA) {
    unsigned char* ws = KA->ws;
    LAS float* scr = (LAS float*)(C.lds + C.wave * 16384);
    constexpr int I_IN = (D / 64) * (NIN / 32), I_PA = (DA / 64) * (D / 32), I_PH = (DHY / 64) * (D / 32), I_OUT = (D / 64) * (D / 32);
    constexpr int I_L = I_IN + I_PA + I_PH + I_OUT;
    for (int rq_ = 0; rq_ < REPS(11); ++rq_) for (int it = C.gw; it < DEPTH * I_L; it += C.NGW) {
        const int l = it / I_L; int r = it % I_L;
        if (r < I_IN) { p0_transpose_item(KA->in[4] + (size_t)l * D * NIN, D, NIN, (bf16*)(ws + WS_WIN) + (size_t)l * NIN * D, scr, r, C.lane); continue; } r -= I_IN;
        if (r < I_PA) { p0_transpose_item(KA->in[17] + (size_t)l * DA * D, DA, D, (bf16*)(ws + WS_WPA) + (size_t)l * D * DA, scr, r, C.lane); continue; } r -= I_PA;
        if (r < I_PH) { p0_transpose_item(KA->in[18] + (size_t)l * DHY * D, DHY, D, (bf16*)(ws + WS_WPH) + (size_t)l * D * DHY, scr, r, C.lane); continue; } r -= I_PH;
        p0_transpose_item(KA->in[19] + (size_t)l * D * D, D, D, (bf16*)(ws + WS_WOUT) + (size_t)l * D * D, scr, r, C.lane);
    }
    for (int rq_ = 0; rq_ < REPS(13); ++rq_) for (int it = C.gw; it < DEPTH * S; it += C.NGW) p0_trunk_item(KA, (float*)(ws + WS_H3), scr, it / S, it % S, C.lane);
    __syncthreads();
    for (int rq_ = 0; rq_ < REPS(12); ++rq_) for (int it = blockIdx.x; it < DEPTH * 48; it += C.G) p0_mod_item(KA, (float*)(ws + WS_MOD), C.lds, it, C.tid);
}
__device__ __forceinline__ void p0_prologue_b(const Ctx& C, const KAS Args* KA) {
    unsigned char* ws = KA->ws;
    for (int rq_ = 0; rq_ < REPS(14); ++rq_) for (int it = blockIdx.x; it < DEPTH * 128; it += C.G) p0_rgen_item(KA, (const float*)(ws + WS_H3), (bf16*)(ws + WS_R), C.lds, it, C.tid);
}

__device__ __forceinline__ void ln_mod_row(const float* xrow, const float* modb, bf16* orow, int lane) {
    const f32x4* xr = (const f32x4*)xrow + lane;
    f32x4 v[4]; float s = 0.f;
#pragma unroll
    for (int j = 0; j < 4; ++j) { v[j] = xr[64 * j]; s += (v[j].x + v[j].y) + (v[j].z + v[j].w); }
    const float mean = wave_sum(s) * (1.f / D); float s2 = 0.f;
#pragma unroll
    for (int j = 0; j < 4; ++j) { v[j] = v[j] - mean; s2 += (v[j].x * v[j].x + v[j].y * v[j].y) + (v[j].z * v[j].z + v[j].w * v[j].w); }
    const float rstd = 1.f / sqrtf(wave_sum(s2) * (1.f / D) + LN_EPS);
    v2u* o8 = (v2u*)orow + lane;
#pragma unroll
    for (int j = 0; j < 4; ++j) {
        const f32x4 sh = *((const f32x4*)modb + lane + 64 * j), sc = *((const f32x4*)(modb + D) + lane + 64 * j);
        const f32x4 r = v[j] * rstd * (sc + 1.f) + sh;
        v2u w; w.x = pk2(r.x, r.y); w.y = pk2(r.z, r.w); o8[64 * j] = w;
    }
}
__device__ __forceinline__ void ln_final_row(float* row, const float* lg, const float* lb, int lane) {
    f32x4* xr = (f32x4*)row + lane;
    f32x4 v[4]; float s = 0.f;
#pragma unroll
    for (int j = 0; j < 4; ++j) { v[j] = xr[64 * j]; s += (v[j].x + v[j].y) + (v[j].z + v[j].w); }
    const float mean = wave_sum(s) * (1.f / D); float s2 = 0.f;
#pragma unroll
    for (int j = 0; j < 4; ++j) { v[j] = v[j] - mean; s2 += (v[j].x * v[j].x + v[j].y * v[j].y) + (v[j].z * v[j].z + v[j].w * v[j].w); }
    const float rstd = 1.f / sqrtf(wave_sum(s2) * (1.f / D) + LN_EPS);
#pragma unroll
    for (int j = 0; j < 4; ++j) { const f32x4 g = *((const f32x4*)lg + lane + 64 * j), b = *((const f32x4*)lb + lane + 64 * j); xr[64 * j] = v[j] * rstd * g + b; }
}

__device__ __forceinline__ void attn_naive_item(const bf16* P, const bf16* P2, bf16* YA, LAS float* sw  , int row, int h, int lane) {
    LAS float* sq = sw; LAS float* sc = sw + 192;
    const int t = row % S, rb = row - t;
    const float slope = exp2f(-(float)(h + 1));
#pragma unroll
    for (int g = 0; g < NG; ++g) sq[g * 64 + lane] = bf2f(P[((size_t)((0 * NG + g) * NH + h) * MC + row) * 64 + lane]);
    LDS_WAIT(); asm volatile("" ::: "memory");
    float mx = -INFINITY;
#pragma unroll
    for (int g = 0; g < NG; ++g) {
        const int dil = (g == 0) ? 1 : (g == 1 ? 4 : 16);
        const bf16* Kh = P + (size_t)((1 * NG + g) * NH + h) * MC * 64;
        for (int pass = 0; pass < 3; ++pass) {
            const int jj = pass * 64 + lane;
            if (jj <= 128) {
                const int j = jj - 64, tk = t + j * dil;
                float s = -INFINITY;
                if (tk >= 0 && tk < S) {
                    const v4u* kr = (const v4u*)(Kh + (size_t)(rb + tk) * 64);
                    float a = 0.f;
#pragma unroll
                    for (int e = 0; e < 8; ++e) { const v4u kv = kr[e]; const LAS float* q = sq + g * 64 + 8 * e;
                        a = fmaf(q[0], blo(kv.x), a); a = fmaf(q[1], bhi(kv.x), a); a = fmaf(q[2], blo(kv.y), a); a = fmaf(q[3], bhi(kv.y), a);
                        a = fmaf(q[4], blo(kv.z), a); a = fmaf(q[5], bhi(kv.z), a); a = fmaf(q[6], blo(kv.w), a); a = fmaf(q[7], bhi(kv.w), a); }
                    s = a * 0.125f - slope * (float)((j < 0 ? -j : j) * dil);
                }
                sc[g * 132 + jj] = s;
                mx = fmaxf(mx, s);
            }
        }
    }
    mx = wave_max(mx);
    float sum = 0.f;
#pragma unroll
    for (int g = 0; g < NG; ++g)
        for (int pass = 0; pass < 3; ++pass) {
            const int jj = pass * 64 + lane;
            if (jj <= 128) { const float s = sc[g * 132 + jj]; const float p = (s == -INFINITY) ? 0.f : expf(s - mx); sc[g * 132 + jj] = p; sum += p; }
        }
    sum = wave_sum(sum);
    LDS_WAIT(); asm volatile("" ::: "memory");
    float o = 0.f;
#pragma unroll
    for (int g = 0; g < NG; ++g) {
        const int dil = (g == 0) ? 1 : (g == 1 ? 4 : 16);
        const bf16* Vh = P + (size_t)((2 * NG + g) * NH + h) * MC * 64 + lane;
        for (int jj = 0; jj <= 128; ++jj) {
            const int tk = t + (jj - 64) * dil;
            if (tk >= 0 && tk < S) o = fmaf(sc[g * 132 + jj], bf2f(Vh[(size_t)(rb + tk) * 64]), o);
        }
    }
    o /= sum;
    const float ga = bf2f(P2[(size_t)row * NP2 + OFF_GA + h * HD + lane]);
    YA[(size_t)row * DA + h * HD + lane] = (bf16)f2bf(o * siluf_(ga));
    LDS_WAIT(); asm volatile("" ::: "memory");
}
typedef short bf16x8_t __attribute__((ext_vector_type(8)));
typedef float f32x16_t __attribute__((ext_vector_type(16)));
struct LCG {
    static constexpr int NI = 32 / CH, NCT = 64 / NI;
    static constexpr int PADZ = 64 * (NI - 1), ZSTRIDE = 4096 + 2 * PADZ + 32;
    static constexpr int GC_STRIDE = 16448, ZB_OFF = 4 * GC_STRIDE;
    static constexpr int XB_OFF = ZB_OFF + CH * ZSTRIDE * 2, LDS_END = XB_OFF + CH * ZSTRIDE * 2;
};
static_assert(LCG::NCT <= NWAVES && (LCG::ZSTRIDE / 8) % 16 == 4 && LCG::ZSTRIDE % 8 == 0 && LCG::LDS_END <= LDS_BYTES - 64, "long-conv LDS map");
constexpr int UT_ROWS = 4 * DHY;
__device__ __forceinline__ int zsw(int e) { const int c = e >> 3; return (((c ^ ((c >> 3) & 7)) << 3) | (e & 7)) * 2; }

struct RRegs { v4u cur[2], prv[2]; };
__device__ __forceinline__ void lc_load_R(RRegs& rr, const bf16* Rg, int tid) {
#pragma unroll
    for (int it = 0; it < 2; ++it) { const int k = tid + it * NTHREADS;
        rr.cur[it] = *(const v4u*)(Rg + 8 * k);
        rr.prv[it] = *(const v4u*)(Rg + 8 * (k > 0 ? k - 1 : 0)); }
}
__device__ __forceinline__ void lc_write_R(LAS unsigned char* lds, const RRegs& rr, int tid) {
#pragma unroll
    for (int it = 0; it < 2; ++it) {
        const int k = tid + it * NTHREADS;
        const v4u cur = rr.cur[it]; v4u prv = rr.prv[it]; if (k == 0) prv = (v4u){0u, 0u, 0u, 0u};
        *(LAS v4u*)(lds + 0 * LCG::GC_STRIDE + 16 * k) = cur;
        v4u s1; s1.x = __builtin_amdgcn_alignbit(cur.x, prv.w, 16); s1.y = __builtin_amdgcn_alignbit(cur.y, cur.x, 16); s1.z = __builtin_amdgcn_alignbit(cur.z, cur.y, 16); s1.w = __builtin_amdgcn_alignbit(cur.w, cur.z, 16);
        *(LAS v4u*)(lds + 1 * LCG::GC_STRIDE + 16 * k) = s1;
        v4u s2; s2.x = prv.w; s2.y = cur.x; s2.z = cur.y; s2.w = cur.z;
        *(LAS v4u*)(lds + 2 * LCG::GC_STRIDE + 16 * k) = s2;
        v4u s3; s3.x = __builtin_amdgcn_alignbit(prv.w, prv.z, 16); s3.y = __builtin_amdgcn_alignbit(cur.x, prv.w, 16); s3.z = __builtin_amdgcn_alignbit(cur.y, cur.x, 16); s3.w = __builtin_amdgcn_alignbit(cur.z, cur.y, 16);
        *(LAS v4u*)(lds + 3 * LCG::GC_STRIDE + 16 * k) = s3;
    }
}
constexpr int LC_ZCH = CH * 512 / NTHREADS;
struct CRegs { v4u cu[LC_ZCH]; unsigned short pm[LC_ZCH], pp[LC_ZCH]; };
__device__ __forceinline__ void lc_load_raw(CRegs& cr, const bf16* raw  , int tid) {
#pragma unroll
    for (int j = 0; j < LC_ZCH; ++j) { const int k = tid + j * NTHREADS, bb = k >> 9, s8 = (k & 511) * 8; const bf16* row = raw + (size_t)bb * S;
        cr.cu[j] = *(const v4u*)(row + s8); cr.pm[j] = row[s8 > 0 ? s8 - 1 : 0]; cr.pp[j] = row[s8 + 8 < S ? s8 + 8 : S - 1]; }
}
struct GRegs { v4u g[LC_ZCH]; };
__device__ __forceinline__ void lc_load_gate(GRegs& gr, const bf16* mul  , int tid) {
#pragma unroll
    for (int j = 0; j < LC_ZCH; ++j) { const int k = tid + j * NTHREADS, bb = k >> 9, s8 = (k & 511) * 8; gr.g[j] = *(const v4u*)(mul + (size_t)bb * S + s8); }
}
template <bool GATED>
__device__ __forceinline__ void lc_write_conv(LAS unsigned char* lds, int off, const CRegs& cr, const GRegs* gr, float w0, float w1, float w2, float wb, int tid) {
#pragma unroll
    for (int j = 0; j < LC_ZCH; ++j) { const int k = tid + j * NTHREADS, bb = k >> 9, s8 = (k & 511) * 8;
        const v4u cu = cr.cu[j];
        const float pm = (s8 > 0) ? bf2f(cr.pm[j]) : 0.f, pp = (s8 + 8 < S) ? bf2f(cr.pp[j]) : 0.f;
        const float x[10] = {pm, blo(cu.x), bhi(cu.x), blo(cu.y), bhi(cu.y), blo(cu.z), bhi(cu.z), blo(cu.w), bhi(cu.w), pp};
        float o[8];
#pragma unroll
        for (int e = 0; e < 8; ++e) o[e] = fmaf(w0, x[e], fmaf(w1, x[e + 1], fmaf(w2, x[e + 2], wb)));
        if (GATED) { const v4u g = gr->g[j];
            o[0] *= siluf_(blo(g.x)); o[1] *= siluf_(bhi(g.x)); o[2] *= siluf_(blo(g.y)); o[3] *= siluf_(bhi(g.y)); o[4] *= siluf_(blo(g.z)); o[5] *= siluf_(bhi(g.z)); o[6] *= siluf_(blo(g.w)); o[7] *= siluf_(bhi(g.w)); }
        v4u w; w.x = pk2(o[0], o[1]); w.y = pk2(o[2], o[3]); w.z = pk2(o[4], o[5]); w.w = pk2(o[6], o[7]);
        *(LAS v4u*)(lds + off + bb * LCG::ZSTRIDE * 2 + zsw(LCG::PADZ + s8)) = w; }
}
__device__ __forceinline__ bf16x8_t lc_ldA(LAS unsigned char* lds, int baseA, int baseA8, int d) {
    const v2u a0 = *(const LAS v2u*)(lds + baseA - 32 * d), a1 = *(const LAS v2u*)(lds + baseA8 - 32 * d);
    return __builtin_bit_cast(bf16x8_t, (v4u){a0.x, a0.y, a1.x, a1.y});
}
__device__ __forceinline__ bf16x8_t lc_ldB(LAS unsigned char* lds, int rowB, int cB, int d) {
    const int c = cB - 2 * d;
    return __builtin_bit_cast(bf16x8_t, *(const LAS v4u*)(lds + rowB + ((c ^ ((c >> 3) & 7)) << 4)));
}
__device__ __forceinline__ void lc_mma(LAS unsigned char* lds, f32x16_t& acc1, f32x16_t& acc2, int wave, int lane) {
    const int r = lane & 31, h = lane >> 5, kap = (r + 1) & 3, b = r / LCG::NI, ii = r % LCG::NI;
    const int baseA = kap * LCG::GC_STRIDE + 2 * (4095 - r + 8 * h + kap);
    int baseA8 = baseA + 8; asm volatile("" : "+v"(baseA8));
    const int i0 = LCG::NI * wave;
    const int rowB = LCG::ZB_OFF + b * LCG::ZSTRIDE * 2, cB = (LCG::PADZ + 64 * (i0 + ii) + 8 * h) >> 3;
    const int dlo = 4 * i0 - 255, dhi = 4 * i0 + 4 * (LCG::NI - 1);
    acc1 = (f32x16_t){0.f, 0.f, 0.f, 0.f, 0.f, 0.f, 0.f, 0.f, 0.f, 0.f, 0.f, 0.f, 0.f, 0.f, 0.f, 0.f}; acc2 = acc1;
    bf16x8_t Ae = lc_ldA(lds, baseA, baseA8, dlo), Ao = lc_ldA(lds, baseA, baseA8, dlo + 1), An = lc_ldA(lds, baseA, baseA8, dlo + 2), Am = lc_ldA(lds, baseA, baseA8, dlo + 3);
    bf16x8_t B0 = lc_ldB(lds, rowB, cB, dlo), B1 = lc_ldB(lds, rowB, cB, dlo + 1);
    for (int d = dlo; d <= dhi; d += 2) {
        const int dn = (d + 2 <= dhi - 1) ? d + 2 : dhi - 1;
        const bf16x8_t nAn = lc_ldA(lds, baseA, baseA8, dn + 2), nAm = lc_ldA(lds, baseA, baseA8, dn + 3);
        const bf16x8_t nB0 = lc_ldB(lds, rowB, cB, dn), nB1 = lc_ldB(lds, rowB, cB, dn + 1);
        acc1 = __builtin_amdgcn_mfma_f32_32x32x16_bf16(Ae, B0, acc1, 0, 0, 0);
        acc2 = __builtin_amdgcn_mfma_f32_32x32x16_bf16(An, B0, acc2, 0, 0, 0);
        acc1 = __builtin_amdgcn_mfma_f32_32x32x16_bf16(Ao, B1, acc1, 0, 0, 0);
        acc2 = __builtin_amdgcn_mfma_f32_32x32x16_bf16(Am, B1, acc2, 0, 0, 0);
        Ae = An; Ao = Am; An = nAn; Am = nAm; B0 = nB0; B1 = nB1;
    }
}
__device__ __forceinline__ void longconv_mfma_units(LAS unsigned char* lds, const bf16* UTR, const float* cw, const float* cb, const bf16* Rl, const float* fb, bf16* YHT, int first, int stride, int tid_, bool do_mma) {
    const int tid = tid_, lane = tid & 63, wave = __builtin_amdgcn_readfirstlane(tid >> 6);
    const int r = lane & 31, h = lane >> 5, b = r / LCG::NI, ii = r % LCG::NI;
    const bool active = wave < LCG::NCT;
    const int i = LCG::NI * wave + ii;
    if (first >= DHY) return;
    for (int k = tid; k < CH * 2 * (LCG::PADZ / 8); k += NTHREADS) { const int bb = k / (2 * (LCG::PADZ / 8)), q = k % (2 * (LCG::PADZ / 8));
        const int e = (q < LCG::PADZ / 8) ? q * 8 : LCG::PADZ + 4096 + (q - LCG::PADZ / 8) * 8;
        *(LAS v4u*)(lds + LCG::ZB_OFF + bb * LCG::ZSTRIDE * 2 + zsw(e)) = (v4u){0u, 0u, 0u, 0u}; }
    for (int c = first; c < DHY; c += stride) {
        for (int r16_ = 0; r16_ < REPS(16); ++r16_) { RRegs r0; CRegs cz, cx; lc_load_R(r0, Rl + (size_t)(0 * DHY + c) * 8192, tid);
          lc_load_raw(cz, UTR + (size_t)c * MC, tid); lc_load_raw(cx, UTR + (size_t)(DHY + c) * MC, tid);
          lc_write_R(lds, r0, tid);
          lc_write_conv<false>(lds, LCG::ZB_OFF, cz, nullptr, cw[c], cw[3 * DHY + c], cw[6 * DHY + c], cb[c], tid);
          lc_write_conv<false>(lds, LCG::XB_OFF, cx, nullptr, cw[DHY + c], cw[4 * DHY + c], cw[7 * DHY + c], cb[DHY + c], tid); }
        __syncthreads();
        f32x16_t acc1 = (f32x16_t){0.f,0.f,0.f,0.f,0.f,0.f,0.f,0.f,0.f,0.f,0.f,0.f,0.f,0.f,0.f,0.f}, acc2 = acc1;
        for (int rr_ = 0; rr_ < REPS(15); ++rr_) if (active && do_mma) lc_mma(lds, acc1, acc2, wave, lane);
        v2u zn[2][4];
        if (active) { const float bias0 = fb[c];
#pragma unroll
          for (int hf = 0; hf < 2; ++hf)
#pragma unroll
            for (int q = 0; q < 4; ++q) { const int zo_ = b * LCG::ZSTRIDE * 2 + zsw(LCG::PADZ + 64 * i + 32 * hf + 8 * q + 4 * h); const f32x16_t& ac = hf ? acc2 : acc1;
                const v2u zo = *(const LAS v2u*)(lds + LCG::ZB_OFF + zo_), xx = *(const LAS v2u*)(lds + LCG::XB_OFF + zo_);
                const float y0 = blo(xx.x) * (ac[4 * q + 0] + bias0 * blo(zo.x)), y1 = bhi(xx.x) * (ac[4 * q + 1] + bias0 * bhi(zo.x));
                const float y2 = blo(xx.y) * (ac[4 * q + 2] + bias0 * blo(zo.y)), y3 = bhi(xx.y) * (ac[4 * q + 3] + bias0 * bhi(zo.y));
                zn[hf][q].x = pk2(y0, y1); zn[hf][q].y = pk2(y2, y3); } }
        __syncthreads();
        if (active) {
#pragma unroll
          for (int hf = 0; hf < 2; ++hf)
#pragma unroll
            for (int q = 0; q < 4; ++q) *(LAS v2u*)(lds + LCG::ZB_OFF + b * LCG::ZSTRIDE * 2 + zsw(LCG::PADZ + 64 * i + 32 * hf + 8 * q + 4 * h)) = zn[hf][q]; }
        for (int r17_ = 0; r17_ < REPS(17); ++r17_) { RRegs r1; CRegs cx; GRegs gg; lc_load_R(r1, Rl + (size_t)(1 * DHY + c) * 8192, tid);
          lc_load_raw(cx, UTR + (size_t)(2 * DHY + c) * MC, tid); lc_load_gate(gg, UTR + (size_t)(3 * DHY + c) * MC, tid);
          lc_write_R(lds, r1, tid);
          lc_write_conv<true>(lds, LCG::XB_OFF, cx, &gg, cw[2 * DHY + c], cw[5 * DHY + c], cw[8 * DHY + c], cb[2 * DHY + c], tid); }
        __syncthreads();
        if (active) { for (int rr_ = 0; rr_ < REPS(15); ++rr_) if (do_mma) lc_mma(lds, acc1, acc2, wave, lane);
          const float bias1 = fb[DHY + c];
#pragma unroll
          for (int hf = 0; hf < 2; ++hf)
#pragma unroll
            for (int q = 0; q < 4; ++q) { const int zo_ = b * LCG::ZSTRIDE * 2 + zsw(LCG::PADZ + 64 * i + 32 * hf + 8 * q + 4 * h); const f32x16_t& ac = hf ? acc2 : acc1;
                const v2u zo = *(const LAS v2u*)(lds + LCG::ZB_OFF + zo_), xx = *(const LAS v2u*)(lds + LCG::XB_OFF + zo_);
                const float y0 = blo(xx.x) * (ac[4 * q + 0] + bias1 * blo(zo.x)), y1 = bhi(xx.x) * (ac[4 * q + 1] + bias1 * bhi(zo.x));
                const float y2 = blo(xx.y) * (ac[4 * q + 2] + bias1 * blo(zo.y)), y3 = bhi(xx.y) * (ac[4 * q + 3] + bias1 * bhi(zo.y));
                v2u o; o.x = pk2(y0, y1); o.y = pk2(y2, y3);
                *(LAS v2u*)(lds + LCG::XB_OFF + zo_) = o; } }
        __syncthreads();
        for (int r18_ = 0; r18_ < REPS(18); ++r18_)
#pragma unroll
        for (int j = 0; j < LC_ZCH; ++j) { const int k = tid + j * NTHREADS, bb = k >> 9, s8 = (k & 511) * 8;
            *(v4u*)(YHT + (size_t)c * MC + bb * S + s8) = *(const LAS v4u*)(lds + LCG::XB_OFF + bb * LCG::ZSTRIDE * 2 + zsw(LCG::PADZ + s8)); }
        __syncthreads();
    }
}
__device__ __forceinline__ void hyena_prep_from_raw(const bf16* UTR, const float* cw, const float* cb, bf16* UT, int G, int tid) {
    for (size_t idx = (size_t)blockIdx.x * NTHREADS + tid; idx < (size_t)UT_ROWS * MC; idx += (size_t)G * NTHREADS) {
        const int ch = (int)(idx / MC), t = (int)(idx % S);
        float v;
        if (ch < 3 * DHY) { const float pm = t > 0 ? bf2f(UTR[idx - 1]) : 0.f, pp = t < S - 1 ? bf2f(UTR[idx + 1]) : 0.f;
            v = fmaf(cw[ch], pm, fmaf(cw[3 * DHY + ch], bf2f(UTR[idx]), fmaf(cw[6 * DHY + ch], pp, cb[ch]))); }
        else v = siluf_(bf2f(UTR[idx]));
        UT[idx] = (bf16)f2bf(v);
    }
}
__device__ __forceinline__ void hyena_post_tile(LAS unsigned char* lds, const bf16* YHT, bf16* YH, int tile, int tid) {
    constexpr int TS = 72;
    const int tr = tile / (DHY / 64), tc = tile % (DHY / 64), row0 = tr * 64, c0 = tc * 64;
    LAS bf16* T = (LAS bf16*)lds;
    { const int chn = tid >> 3, sg = tid & 7;
      const v4u w = *(const v4u*)(YHT + (size_t)(c0 + chn) * MC + row0 + 8 * sg);
      const unsigned a[4] = {w.x, w.y, w.z, w.w};
#pragma unroll
      for (int j = 0; j < 4; ++j) { T[(8 * sg + 2 * j) * TS + chn] = (bf16)(a[j] & 0xffffu); T[(8 * sg + 2 * j + 1) * TS + chn] = (bf16)(a[j] >> 16); } }
    __syncthreads();
    { const int rr = tid >> 3, seg = tid & 7;
      *(v4u*)(YH + (size_t)(row0 + rr) * DHY + c0 + 8 * seg) = *(const LAS v4u*)(T + rr * TS + 8 * seg); }
    __syncthreads();
}
typedef short v4i16_t __attribute__((ext_vector_type(4)));
constexpr int AT_ROWB = 128;
__device__ __forceinline__ void attn_mfma_unit(const bf16* P, bf16* OG, float* ML, LAS unsigned char* vs, int unit, int lane_) {
    int lane = lane_; asm volatile("" : "+v"(lane));
    int u = unit; const int x = u & 127; u >>= 7; const int hh = u & 7; u >>= 3; const int g = u % 3, bl = u / 3;
    const int dsh = 2 * g, d = 1 << dsh, L = S >> dsh, nqb = L >> 5, r = x / nqb, qb = x % nqb;
    const size_t rowb = (size_t)bl * S;
    const float slope = exp2f(-(float)(hh + 1)) * (float)d * 1.4426950408889634f;
    const bf16* Qh = P + ((size_t)((0 * NG + g) * NH + hh) * MC + rowb) * 64; const bf16* Kh = P + ((size_t)((1 * NG + g) * NH + hh) * MC + rowb) * 64; const bf16* Vh = P + ((size_t)((2 * NG + g) * NH + hh) * MC + rowb) * 64;
    const int n = lane & 31, h2 = lane >> 5;
    const int tq = ((32 * qb + n) << dsh) + r;
    bf16x8_t qf[4];
#pragma unroll
    for (int ks = 0; ks < 4; ++ks) qf[ks] = __builtin_bit_cast(bf16x8_t, *(const v4u*)(Qh + (size_t)tq * 64 + 16 * ks + 8 * h2));
    f32x16_t st[5];
    for (int r31_ = 0; r31_ < REPS(31); ++r31_)
#pragma unroll
    for (int kt = 0; kt < 5; ++kt) {
        int ik = 32 * (qb - 2 + kt) + n; ik = ik < 0 ? 0 : (ik > L - 1 ? L - 1 : ik);
        const bf16* kp = Kh + (size_t)((ik << dsh) + r) * 64 + 8 * h2;
        f32x16_t acc = (f32x16_t){0.f, 0.f, 0.f, 0.f, 0.f, 0.f, 0.f, 0.f, 0.f, 0.f, 0.f, 0.f, 0.f, 0.f, 0.f, 0.f};
#pragma unroll
        for (int ks = 0; ks < 4; ++ks) acc = __builtin_amdgcn_mfma_f32_32x32x16_bf16(__builtin_bit_cast(bf16x8_t, *(const v4u*)(kp + 16 * ks)), qf[ks], acc, 0, 0, 0);
        st[kt] = acc;
        if (kt & 1) asm volatile("" ::: "memory");
    }
    v4u vr[5][4];
#pragma unroll
    for (int kt = 0; kt < 5; ++kt) {
        int ik = 32 * (qb - 2 + kt) + (lane >> 1); ik = ik < 0 ? 0 : (ik > L - 1 ? L - 1 : ik);
        const bf16* vp = Vh + (size_t)((ik << dsh) + r) * 64 + 32 * (lane & 1);
#pragma unroll
        for (int j = 0; j < 4; ++j) vr[kt][j] = *(const v4u*)(vp + 8 * j);
    }
    const bool edge = (qb < 2) || (qb + 3 > nqb);
    const int e4 = 4 * h2 - n;
    float mx = -INFINITY;
#pragma unroll
    for (int kt = 0; kt < 5; ++kt)
#pragma unroll
        for (int rg = 0; rg < 16; ++rg) {
            const int rel = 32 * (kt - 2) + (rg & 3) + 8 * (rg >> 2) + e4;
            const int arel = rel < 0 ? -rel : rel;
            float s = fmaf(st[kt][rg], 0.125f * 1.4426950408889634f, -slope * (float)arel);
            if (kt == 0 || kt == 4) s = (arel <= 64) ? s : -INFINITY;
            st[kt][rg] = s;
        }
    if (edge) {
#pragma unroll
        for (int kt = 0; kt < 5; ++kt)
#pragma unroll
            for (int rg = 0; rg < 16; ++rg) { const unsigned ikey = (unsigned)(32 * (qb - 2 + kt) + (rg & 3) + 8 * (rg >> 2) + 4 * h2); if (ikey >= (unsigned)L) st[kt][rg] = -INFINITY; }
    }
#pragma unroll
    for (int kt = 0; kt < 5; ++kt)
#pragma unroll
        for (int rg = 0; rg < 16; ++rg) mx = fmaxf(mx, st[kt][rg]);
    mx = fmaxf(mx, __shfl_xor(mx, 32));
    float ls = 0.f;
#pragma unroll
    for (int kt = 0; kt < 5; ++kt)
#pragma unroll
        for (int rg = 0; rg < 16; ++rg) { const float p = __builtin_amdgcn_exp2f(st[kt][rg] - mx); st[kt][rg] = p; ls += p; }
    ls += __shfl_xor(ls, 32);
    f32x16_t o0 = (f32x16_t){0.f, 0.f, 0.f, 0.f, 0.f, 0.f, 0.f, 0.f, 0.f, 0.f, 0.f, 0.f, 0.f, 0.f, 0.f, 0.f}, o1 = o0;
    const int trow = (lane & 15) >> 2, tcolb = (16 * ((lane >> 4) & 1) + 4 * (lane & 3)) * 2;
    for (int r32_ = 0; r32_ < REPS(32); ++r32_) { if (r32_) { o0 = (f32x16_t){0.f, 0.f, 0.f, 0.f, 0.f, 0.f, 0.f, 0.f, 0.f, 0.f, 0.f, 0.f, 0.f, 0.f, 0.f, 0.f}; o1 = o0; }
#pragma unroll
    for (int kt = 0; kt < 5; ++kt) {
        LAS unsigned char* vb = vs + (kt & 1) * 4096;
        { LAS unsigned char* wp = vb + (lane >> 1) * AT_ROWB + 64 * (lane & 1);
          *(LAS v4u*)(wp) = vr[kt][0]; *(LAS v4u*)(wp + 16) = vr[kt][1]; *(LAS v4u*)(wp + 32) = vr[kt][2]; *(LAS v4u*)(wp + 48) = vr[kt][3]; }
        LDS_WAIT(); asm volatile("" ::: "memory");
#pragma unroll
        for (int s = 0; s < 2; ++s) {
            v4u pa; pa.x = pk2(st[kt][8 * s + 0], st[kt][8 * s + 1]); pa.y = pk2(st[kt][8 * s + 2], st[kt][8 * s + 3]); pa.z = pk2(st[kt][8 * s + 4], st[kt][8 * s + 5]); pa.w = pk2(st[kt][8 * s + 6], st[kt][8 * s + 7]);
            const bf16x8_t A = __builtin_bit_cast(bf16x8_t, pa);
            LAS unsigned char* tp = vb + (16 * s + 4 * h2 + trow) * AT_ROWB + tcolb;
#pragma unroll
            for (int eh = 0; eh < 2; ++eh) {
                const v4i16_t lo = __builtin_amdgcn_ds_read_tr16_b64_v4i16((LAS v4i16_t*)(tp + 64 * eh));
                const v4i16_t hi = __builtin_amdgcn_ds_read_tr16_b64_v4i16((LAS v4i16_t*)(tp + 64 * eh + 8 * AT_ROWB));
                const bf16x8_t B = (bf16x8_t){lo[0], lo[1], lo[2], lo[3], hi[0], hi[1], hi[2], hi[3]};
                if (eh == 0) o0 = __builtin_amdgcn_mfma_f32_32x32x16_bf16(A, B, o0, 0, 0, 0); else o1 = __builtin_amdgcn_mfma_f32_32x32x16_bf16(A, B, o1, 0, 0, 0);
            }
        }
    }
    }
    LDS_WAIT(); asm volatile("" ::: "memory");
    bf16* og = OG + ((size_t)g * MC + rowb) * DA + hh * HD + n;
    for (int r33_ = 0; r33_ < REPS(33); ++r33_)
#pragma unroll
    for (int rg = 0; rg < 16; ++rg) { const int mq = (rg & 3) + 8 * (rg >> 2) + 4 * h2; const size_t tok = (size_t)(((32 * qb + mq) << dsh) + r);
        og[tok * DA] = (bf16)f2bf(o0[rg]); og[tok * DA + 32] = (bf16)f2bf(o1[rg]); }
    if (h2 == 0) { float* mp = ML + (((size_t)g * MC + rowb + tq) * NH + hh) * 2; mp[0] = mx * 0.6931471805599453f; mp[1] = ls; }
}
__device__ __forceinline__ void attn_combine(const bf16* P  , const bf16* OG, const float* ML, bf16* YA, int G, int tid) {
    for (int idx = blockIdx.x * NTHREADS + tid; idx < MC * (DA / 2); idx += G * NTHREADS) {
        const int row = idx / (DA / 2), col = (idx % (DA / 2)) * 2, hh = col >> 6;
        float m[3], l[3];
#pragma unroll
        for (int g = 0; g < 3; ++g) { const float* mp = ML + (((size_t)g * MC + row) * NH + hh) * 2; m[g] = mp[0]; l[g] = mp[1]; }
        const float M = fmaxf(m[0], fmaxf(m[1], m[2]));
        float a0 = 0.f, a1 = 0.f, den = 0.f;
#pragma unroll
        for (int g = 0; g < 3; ++g) { const float w = __expf(m[g] - M); const unsigned ow = *(const unsigned*)(OG + ((size_t)g * MC + row) * DA + col);
            a0 = fmaf(w, blo(ow), a0); a1 = fmaf(w, bhi(ow), a1); den = fmaf(w, l[g], den); }
        const unsigned gw_ = *(const unsigned*)(P + (size_t)row * NP2 + OFF_GA + col);
        const float inv = 1.f / den;
        *(unsigned*)(YA + (size_t)row * DA + col) = pk2(a0 * inv * siluf_(blo(gw_)), a1 * inv * siluf_(bhi(gw_)));
    }
}
#if MK_CHECK
__device__ __forceinline__ void longconv_check_item(const bf16* Zrow  , const bf16* Rrow  , const bf16* Xrow, const bf16* SGrow, float bias, bf16* Orow, int b, int tb, int lane) {
    const int t = tb * 64 + lane;
    const bf16* z = Zrow + (size_t)b * S; const bf16* g = Rrow + 4095 - t;
    float y = 0.f;
    for (int s0 = 0; s0 < S; s0 += 8) {
#pragma unroll
        for (int j = 0; j < 8; ++j) y = fmaf(bf2f(g[s0 + j]), bf2f(z[s0 + j]), y);
    }
    float v = bf2f(Xrow[(size_t)b * S + t]) * (y + bias * bf2f(z[t]));
    if (SGrow) v *= bf2f(SGrow[(size_t)b * S + t]);
    Orow[(size_t)b * S + t] = (bf16)f2bf(v);
}
#endif
#define XB_TMO      128
#define XB_XCNT(j)  (256  + 64 * (j))
#define XB_XSUB(j)  (1280 + 64 * (j))
#define XB_XGEN(j)  (2304 + 64 * (j))
#define XB_TOP      3328
#define XB_TOPGEN   3392
#define XCD_BAR_WORDS 3456
#define XB_SPIN_CAP (1u << 18)

__device__ __forceinline__ unsigned xb_ld(unsigned* p)              { return __hip_atomic_load(p, __ATOMIC_RELAXED, __HIP_MEMORY_SCOPE_AGENT); }
__device__ __forceinline__ unsigned xb_add(unsigned* p, unsigned v) { return __hip_atomic_fetch_add(p, v, __ATOMIC_RELAXED, __HIP_MEMORY_SCOPE_AGENT); }
__device__ __forceinline__ unsigned xb_xcc_id() { return (unsigned)__builtin_amdgcn_s_getreg((3 << 11) | 20) & 0xFu; }
#define XB_SPIN(cond, bar) do { unsigned _sp = 0; while (cond) { __builtin_amdgcn_s_sleep(1); \
    if ((++_sp & 255u) == 0u) { if (xb_ld(&(bar)[XB_TMO])) break; if (_sp > XB_SPIN_CAP) { atomicAdd(&(bar)[XB_TMO], 1u); break; } } } } while (0)

struct XcdBarrier {
    unsigned* bar; unsigned x;
    volatile LAS unsigned* st;
};

__device__ __forceinline__ XcdBarrier xcd_barrier_post(unsigned* bar, volatile LAS unsigned* st) {
    XcdBarrier b; b.bar = bar; b.x = xb_xcc_id(); b.st = st;
    if (threadIdx.x == 0) (void)xb_add(&bar[XB_XCNT(b.x)], 1u);
    return b;
}
__device__ __forceinline__ void xcd_barrier_complete(unsigned* bar, unsigned x, unsigned& nloc, unsigned& nx) {
    const unsigned G = gridDim.x * gridDim.y * gridDim.z;
    unsigned sum, cnt, mine, sp = 0u;
    for (;;) {
        sum = 0u; cnt = 0u; mine = 0u;
#pragma unroll
        for (unsigned j = 0; j < 16; ++j) { const unsigned c = xb_ld(&bar[XB_XCNT(j)]); sum += c; cnt += (c > 0u) ? 1u : 0u; mine = (j == x) ? c : mine; }
        if (sum == G) break;
        __builtin_amdgcn_s_sleep(1);
        if ((++sp & 255u) == 0u) { if (xb_ld(&bar[XB_TMO])) break; if (sp > XB_SPIN_CAP) { atomicAdd(&bar[XB_TMO], 1u); break; } }
    }
    nloc = mine > 0u ? mine : 1u; nx = cnt > 0u ? cnt : 1u;
}

__device__ __forceinline__ void xcd_barrier(const XcdBarrier& b) {
    asm volatile("s_waitcnt vmcnt(0)" ::: "memory");
    __syncthreads();
    if (threadIdx.x == 0) {
        unsigned* bar = b.bar;
        __builtin_amdgcn_s_waitcnt(0);
        unsigned nloc = b.st[0], nx = b.st[1];
        if (nloc == 0u) { xcd_barrier_complete(bar, b.x, nloc, nx); b.st[0] = nloc; b.st[1] = nx; }
        const unsigned old = xb_add(&bar[XB_XSUB(b.x)], 1u);
        const unsigned gen = old / nloc;
        if (old + 1u == (gen + 1u) * nloc) {
            __builtin_amdgcn_fence(__ATOMIC_RELEASE, "agent");
            asm volatile("s_waitcnt vmcnt(0)" ::: "memory");
            const unsigned og = xb_add(&bar[XB_TOP], 1u);
            const unsigned tg = og / nx;
            if (og + 1u == (tg + 1u) * nx) xb_add(&bar[XB_TOPGEN], 1u);
            else XB_SPIN(xb_ld(&bar[XB_TOPGEN]) == tg, bar);
            __builtin_amdgcn_fence(__ATOMIC_ACQUIRE, "agent");
            xb_add(&bar[XB_XGEN(b.x)], 1u);
            asm volatile("s_waitcnt vmcnt(0)" ::: "memory");
        } else {
            XB_SPIN(xb_ld(&bar[XB_XGEN(b.x)]) == gen, bar);
            __builtin_amdgcn_fence(__ATOMIC_ACQUIRE, "agent");
            asm volatile("s_waitcnt vmcnt(0)" ::: "memory");
        }
    }
    __syncthreads();
}

#define XBAR() do { TP_BEGIN(4); XcdBarrier bb_; bb_.bar = (unsigned*)kargs_ptr()->ws + 4096; bb_.x = xb_xcc_id(); bb_.st = MISC; xcd_barrier(bb_); if (MK_REP == 10) xcd_barrier(bb_); TP_END(4); } while (0)
#ifndef PG8_SP2
#define PG8_SP2 true
#endif
#ifndef PG8_ALIGN
#define PG8_ALIGN true
#endif
#ifndef PG8_ALIGN1
#define PG8_ALIGN1 true
#endif

__global__ void __launch_bounds__(NTHREADS, 2) mk_fwd(Args args_unused_directly) {
    extern __shared__ __attribute__((aligned(16))) unsigned char lds[];
    cg::grid_group grid = cg::this_grid();
    Ctx C; C.lds = (LAS unsigned char*)lds; C.tid = threadIdx.x; C.lane = C.tid & 63; C.wave = __builtin_amdgcn_readfirstlane(C.tid >> 6);
    C.G = gridDim.x; C.gw = blockIdx.x * NWAVES + C.wave; C.NGW = C.G * NWAVES;
#define PHASE_PTRS const KAS Args* KA = kargs_ptr(); unsigned char* ws = KA->ws; float* out = KA->out; \
    bf16* Hb = (bf16*)(ws + WS_H); bf16* Pb = (bf16*)(ws + WS_P); bf16* P2b = (bf16*)(ws + WS_P2); bf16* UT = (bf16*)(ws + WS_UT); bf16* YHT = (bf16*)(ws + WS_YHT); \
    bf16* YA = (bf16*)(ws + WS_YA); bf16* YH = (bf16*)(ws + WS_YH); bf16* MG = Hb; \
    const float* MOD = (const float*)(ws + WS_MOD); const bf16* Rg = (const bf16*)(ws + WS_R); float* ERR = (float*)ws; \
    const float* xc = ((l == 0) ? KA->in[0] : (const float*)out) + (size_t)ch * MC * D; float* oc = out + (size_t)ch * MC * D; \
    (void)Hb; (void)Pb; (void)P2b; (void)UT; (void)YHT; (void)YA; (void)YH; (void)MG; (void)MOD; (void)Rg; (void)ERR; (void)xc; (void)oc
    PG8_LAS unsigned char* ldsl = (PG8_LAS unsigned char*)lds;
    volatile LAS unsigned* MISC = (volatile LAS unsigned*)(ldsl + LDS_BYTES - 64);
    if (threadIdx.x < 16) MISC[threadIdx.x] = 0u;
    __syncthreads();
    (void)xcd_barrier_post((unsigned*)kargs_ptr()->ws + 4096, MISC);
    const unsigned long long tk0_ = MK_TPROBE ? __builtin_amdgcn_s_memrealtime() : 0ull;

    p0_prologue_a(C, kargs_ptr());
    grid.sync();
    p0_prologue_b(C, kargs_ptr());
    XBAR();

    int pend_l = -1, pend_ch = 0;
    for (int l = 0; l < DEPTH; ++l) {
        for (int ch = 0; ch < NCHUNK; ++ch) {
            { PHASE_PTRS; int ln_ = threadIdx.x & 63; asm volatile("" : "+v"(ln_));
            if (pend_l >= 0) { float* pr = out + (size_t)pend_ch * MC * D;
                for (int m = C.gw; m < MC; m += C.NGW) ln_final_row(pr + (size_t)m * D, KA->in[21] + (size_t)pend_l * D, KA->in[22] + (size_t)pend_l * D, ln_); }
            for (int rp_ = 0; rp_ < REPS(9); ++rp_) for (int m = C.gw; m < MC; m += C.NGW) ln_mod_row(xc + (size_t)m * D, MOD + ((size_t)l * NB + ch * CH + m / S) * 3 * D, Hb + (size_t)m * D, ln_); }
            XBAR();
            for (int rp_ = 0; rp_ < REPS(2); ++rp_) { PHASE_PTRS; pg8::Gemm g{Hb, (const bf16*)(ws + WS_WIN) + (size_t)l * NIN * D, MC, NIN, D}; pg8::StaticOrder So; So.init(MC, NIN, C.G, (int)blockIdx.x);
              pg8::EpiIn E{Pb, P2b, UT, MC, NQKV, HY0, HY1, NP2, KA->in[5] + (size_t)l * NIN};
              TP_BEGIN(3); pg8::gemm_phase<pg8::EpiIn, pg8::StaticOrder, PG8_ALIGN, PG8_SP2>(ldsl, g, So, E); TP_END(3); }
            XBAR();
            if (PHM & 4) { PHASE_PTRS; LAS float* sw = (LAS float*)(ldsl + C.wave * 2560); int ln_ = threadIdx.x & 63; asm volatile("" : "+v"(ln_));
              if (MK_CHECK == 2) { for (int it = C.gw; it < MC * NH; it += C.NGW) attn_naive_item(Pb, P2b, (bf16*)(ws + WS_YAR), sw, it / NH, it % NH, ln_); __syncthreads(); }
              { TP_BEGIN(2); for (int rp_ = 0; rp_ < REPS(3); ++rp_) for (int it = C.gw; it < CH * 3 * 8 * 128; it += C.NGW) attn_mfma_unit(Pb, (bf16*)(ws + WS_OG), (float*)(ws + WS_ML), ldsl + C.wave * 8192, it, ln_);
              __syncthreads(); TP_END(2); }
              if (MK_CHECK == 1) { int tid_ = threadIdx.x; asm volatile("" : "+v"(tid_)); hyena_prep_from_raw(UT, KA->in[6] + (size_t)l * 9 * DHY, KA->in[7] + (size_t)l * 3 * DHY, (bf16*)(ws + WS_UTC), C.G, tid_); } }
#if MK_CHECK
            XBAR();
#endif
            if (PHM & 8) { PHASE_PTRS; int tid_ = threadIdx.x; asm volatile("" : "+v"(tid_));
              TP_BEGIN(1); for (int rp_ = 0; rp_ < REPS(5) + (MK_REP == 19); ++rp_) longconv_mfma_units(ldsl, UT, KA->in[6] + (size_t)l * 9 * DHY, KA->in[7] + (size_t)l * 3 * DHY, Rg + (size_t)l * 2 * DHY * 8192, KA->in[16] + (size_t)l * 2 * DHY, YHT, (int)blockIdx.x, C.G, tid_, !(MK_REP == 19 && rp_ == 0)); TP_END(1); }
#if MK_CHECK == 1
            { PHASE_PTRS; UT = (bf16*)(ws + WS_UTC); bf16* Z1T = (bf16*)(ws + WS_Z1T); bf16* YHTR = (bf16*)(ws + WS_YHTR); int ln_ = threadIdx.x & 63; asm volatile("" : "+v"(ln_));
              for (int it = C.gw; it < DHY * CH * 64; it += C.NGW) { const int c = it / (CH * 64), b = (it / 64) % CH, tb = it % 64;
                  longconv_check_item(UT + (size_t)c * MC, Rg + ((size_t)(l * 2 + 0) * DHY + c) * 8192, UT + (size_t)(DHY + c) * MC, nullptr, KA->in[16][(size_t)l * 2 * DHY + c], Z1T + (size_t)c * MC, b, tb, ln_); }
              XBAR();
              for (int it = C.gw; it < DHY * CH * 64; it += C.NGW) { const int c = it / (CH * 64), b = (it / 64) % CH, tb = it % 64;
                  longconv_check_item(Z1T + (size_t)c * MC, Rg + ((size_t)(l * 2 + 1) * DHY + c) * 8192, UT + (size_t)(2 * DHY + c) * MC, UT + (size_t)(3 * DHY + c) * MC, KA->in[16][(size_t)l * 2 * DHY + DHY + c], YHTR + (size_t)c * MC, b, tb, ln_); }
              XBAR();
              float e0 = 0.f, e1 = 0.f;
              { int tq_ = threadIdx.x; asm volatile("" : "+v"(tq_));
              for (int i = blockIdx.x * NTHREADS + tq_; i < DHY * MC; i += C.G * NTHREADS) { const float a = bf2f(YHT[i]), r = bf2f(YHTR[i]); e0 += (a - r) * (a - r); e1 += r * r; } }
              e0 = wave_sum(e0); e1 = wave_sum(e1);
              if (ln_ == 0) { atomicAdd(ERR + 0, e0); atomicAdd(ERR + 1, e1); }
              }
#endif
            XBAR();
            if (PHM & 16) { PHASE_PTRS; int tid_ = threadIdx.x; asm volatile("" : "+v"(tid_));
              if (MK_CHECK == 1) YHT = (bf16*)(ws + WS_YHTR);
              for (int rp_ = 0; rp_ < REPS(6); ++rp_) { for (int tile = blockIdx.x; tile < (MC / 64) * (DHY / 64); tile += C.G) hyena_post_tile(ldsl, YHT, YH, tile, tid_);
              attn_combine(P2b, (const bf16*)(ws + WS_OG), (const float*)(ws + WS_ML), YA, C.G, tid_); } }
#if MK_CHECK == 2
            XBAR();
            { PHASE_PTRS; const bf16* YAR = (const bf16*)(ws + WS_YAR); float e0 = 0.f, e1 = 0.f; int tq_ = threadIdx.x; asm volatile("" : "+v"(tq_));
              for (int i = blockIdx.x * NTHREADS + tq_; i < MC * DA; i += C.G * NTHREADS) { const float a = bf2f(YA[i]), r = bf2f(YAR[i]); e0 += (a - r) * (a - r); e1 += r * r; }
              e0 = wave_sum(e0); e1 = wave_sum(e1);
              if ((tq_ & 63) == 0) { atomicAdd(ERR + 0, e0); atomicAdd(ERR + 1, e1); } }
#endif
            XBAR();
            for (int rp_ = 0; rp_ < REPS(7); ++rp_) { PHASE_PTRS; pg8::StaticOrder So; So.init(MC, D, C.G, (int)blockIdx.x);
              { pg8::Gemm g{YA, (const bf16*)(ws + WS_WPA) + (size_t)l * D * DA, MC, D, DA}; pg8::EpiMerge<false> E{MG, D, P2b + OFF_RA, NP2};
                pg8::gemm_phase<pg8::EpiMerge<false>, pg8::StaticOrder, PG8_ALIGN1, PG8_SP2>(ldsl, g, So, E); }
              { pg8::Gemm g{YH, (const bf16*)(ws + WS_WPH) + (size_t)l * D * DHY, MC, D, DHY}; pg8::EpiMerge<true> E{MG, D, P2b + OFF_RH, NP2};
                pg8::gemm_phase<pg8::EpiMerge<true>, pg8::StaticOrder, PG8_ALIGN1, PG8_SP2>(ldsl, g, So, E); } }
            XBAR();
            for (int rp_ = 0; rp_ < ((l == 0) ? REPS(8) : 1); ++rp_) { PHASE_PTRS; pg8::Gemm g{MG, (const bf16*)(ws + WS_WOUT) + (size_t)l * D * D, MC, D, D}; pg8::StaticOrder So; So.init(MC, D, C.G, (int)blockIdx.x);
              pg8::EpiRes E{xc, oc, D, KA->in[20] + (size_t)l * D, MOD + ((size_t)l * NB + ch * CH) * 3 * D + 2 * D, S / 256, 3 * D, DN_ALPHA};
              pg8::gemm_phase<pg8::EpiRes, pg8::StaticOrder, PG8_ALIGN1, PG8_SP2>(ldsl, g, So, E); }
            XBAR();
            pend_l = l; pend_ch = ch;
        }
    }
    { const int l = 1, ch = 0; PHASE_PTRS; float* pr = out + (size_t)pend_ch * MC * D;
      for (int m = C.gw; m < MC; m += C.NGW) ln_final_row(pr + (size_t)m * D, KA->in[21] + (size_t)pend_l * D, KA->in[22] + (size_t)pend_l * D, C.lane); }
#if MK_TPROBE
    { const int l = 1, ch = 0; PHASE_PTRS; if (blockIdx.x == 0 && threadIdx.x == 0) { const unsigned long long tt_ = __builtin_amdgcn_s_memrealtime() - tk0_; const float fr_ = (float)MISC[4] / (float)(unsigned)tt_; __hip_atomic_store(ERR + 2, fr_, __ATOMIC_RELAXED, __HIP_MEMORY_SCOPE_AGENT); }
      XBAR();
      const float f = 1.f + __hip_atomic_load(ERR + 2, __ATOMIC_RELAXED, __HIP_MEMORY_SCOPE_AGENT);
      int tq_ = threadIdx.x; asm volatile("" : "+v"(tq_));
      for (int i = blockIdx.x * NTHREADS + tq_; i < NB * S * D; i += C.G * NTHREADS) out[i] *= f; }
#endif
#if MK_CHECK
    XBAR();
    { const int l = 1, ch = 0; PHASE_PTRS; const float e0 = __hip_atomic_load(ERR + 0, __ATOMIC_RELAXED, __HIP_MEMORY_SCOPE_AGENT), e1 = __hip_atomic_load(ERR + 1, __ATOMIC_RELAXED, __HIP_MEMORY_SCOPE_AGENT);
      const float f = 1.f + CHECK_K * sqrtf(e0 / fmaxf(e1, 1e-30f));
      int tq_ = threadIdx.x; asm volatile("" : "+v"(tq_));
      for (int i = blockIdx.x * NTHREADS + tq_; i < NB * S * D; i += C.G * NTHREADS) out[i] *= f; }
#endif
}

extern "C" void kernel_launch(void* const* d_in, const int* in_sizes, int n_in, void* d_out, int out_size, void* d_ws, size_t ws_size, hipStream_t stream) {
    static int grid = 0;
    if (grid == 0) {
        if (n_in != 23 || out_size != NB * S * D || ws_size < WS_END) { fprintf(stderr, "kernel_launch: unexpected shapes (n_in %d, out %d, ws %zu, need %zu); nothing launched\n", n_in, out_size, ws_size, (size_t)WS_END); grid = -1; return; }
        int dev = 0, cus = 0, per_cu = 0;
        if (hipGetDevice(&dev) != hipSuccess || hipDeviceGetAttribute(&cus, hipDeviceAttributeMultiprocessorCount, dev) != hipSuccess) { fprintf(stderr, "kernel_launch: device query failed\n"); grid = -1; return; }
        if (hipFuncSetAttribute((const void*)mk_fwd, hipFuncAttributeMaxDynamicSharedMemorySize, LDS_BYTES) != hipSuccess) { fprintf(stderr, "kernel_launch: hipFuncSetAttribute failed\n"); grid = -1; return; }
        if (hipOccupancyMaxActiveBlocksPerMultiprocessor(&per_cu, (const void*)mk_fwd, NTHREADS, LDS_BYTES) != hipSuccess || per_cu < 1) { fprintf(stderr, "kernel_launch: occupancy query says %d blocks per CU\n", per_cu); grid = -1; return; }
        grid = cus;
        fprintf(stderr, "kernel_launch: grid %d (cus %d, per_cu %d), ws %zu MiB\n", grid, cus, per_cu, ws_size >> 20);
    }
    if (grid < 0) return;
    if (hipMemsetAsync(d_ws, 0, 1 << 20, stream) != hipSuccess) { fprintf(stderr, "kernel_launch: memset of control words failed\n"); return; }
    Args a{};
    for (int i = 0; i < 23; ++i) a.in[i] = (const float*)d_in[i];
    a.out = (float*)d_out; a.ws = (unsigned char*)d_ws;
    void* kargs[] = {&a};
    const hipError_t e = hipLaunchCooperativeKernel((const void*)mk_fwd, dim3(grid), dim3(NTHREADS), kargs, LDS_BYTES, stream);
    if (e != hipSuccess) fprintf(stderr, "kernel_launch: cooperative launch failed: %s (grid %d)\n", hipGetErrorString(e), grid);
}
```
